# Optimizing an MI355X kernel written in HIP

```python
import jax, jax.numpy as jnp
from jax import lax
import numpy as np

D_MODEL = 1024
BATCH = 8
SEQ = 4096
DEPTH = 1

HEAD_DIM = 64
NSA_HEADS = D_MODEL // (2 * HEAD_DIM)
FOX_HEADS = D_MODEL // (2 * HEAD_DIM)
NSA_KV_HEADS = max(1, NSA_HEADS // 4)
NSA_HPG = NSA_HEADS // NSA_KV_HEADS
NSA_WIDTH = NSA_HEADS * HEAD_DIM
FOX_WIDTH = FOX_HEADS * HEAD_DIM
MIX_WIDTH = NSA_WIDTH + FOX_WIDTH
KV_WIDTH = NSA_KV_HEADS * HEAD_DIM
CMP_BLOCK = 32
CMP_STRIDE = 16
CMP_HIDDEN = 2 * HEAD_DIM
SEL_BLOCK = 64
N_SELECT = 16
WINDOW = 512
NSA_Q_BLOCK = 64
FOX_Q_BLOCK = 128
ROPE_THETA = 500000.0
ROPE_DIM = HEAD_DIM // 4
N_GROUPS = 4
EXPERTS_PER_GROUP = 4
N_EXPERTS = N_GROUPS * EXPERTS_PER_GROUP
TOP_K_IN_GROUP = 2
D_EXPERT = D_MODEL // 2
PLE_DIM = 256
EPS = 1e-6
NEG_INF = -1e30
FORCE_BONUS = 1e4
IN_SPLITS = (NSA_WIDTH, KV_WIDTH, KV_WIDTH, KV_WIDTH, KV_WIDTH, KV_WIDTH, KV_WIDTH,
             3 * NSA_HEADS, FOX_WIDTH, FOX_WIDTH, FOX_WIDTH, FOX_HEADS)
IN_COLS = sum(IN_SPLITS)
IN_OFFSETS = tuple(int(v) for v in np.cumsum(IN_SPLITS)[:-1])

kernel_name = 'hymba_nsa_fox_hmoe_layer'


def _rmsnorm(x, g):
    xf = x.astype(jnp.float32)
    y = xf * lax.rsqrt(jnp.mean(xf * xf, axis=-1, keepdims=True) + EPS)
    return (y * g.astype(jnp.float32)).astype(x.dtype)


def _masked_softmax(logits, mask):
    l = jnp.where(mask, logits.astype(jnp.float32), NEG_INF)
    return jax.nn.softmax(l, axis=-1) * mask


def _partial_rope(x, pos):
    half = ROPE_DIM // 2
    inv_freq = jnp.power(jnp.float32(ROPE_THETA), -jnp.arange(half, dtype=jnp.float32) / half)
    ang = pos.astype(jnp.float32)[..., None] * inv_freq
    cos = jnp.cos(ang)[..., None, :]
    sin = jnp.sin(ang)[..., None, :]
    xf = x.astype(jnp.float32)
    x1 = xf[..., :half]
    x2 = xf[..., half:ROPE_DIM]
    out = jnp.concatenate([x1 * cos - x2 * sin, x2 * cos + x1 * sin, xf[..., ROPE_DIM:]], axis=-1)
    return out.astype(x.dtype)


def _compress(tok, pe, w1, w2, tok_idx):
    B = tok.shape[0]
    n_cmp = tok_idx.shape[0]
    blk = tok[:, tok_idx] + pe[None, None, :, None, :]
    blk = jnp.swapaxes(blk, 2, 3).reshape(B, n_cmp, NSA_KV_HEADS, CMP_BLOCK * HEAD_DIM)
    return jax.nn.silu(blk @ w1) @ w2


def _cmp_to_sel_matrix(n_cmp, n_blk):
    cs = np.arange(n_cmp)[:, None] * CMP_STRIDE
    ss = np.arange(n_blk)[None, :] * SEL_BLOCK
    ov = np.clip(np.minimum(cs + CMP_BLOCK, ss + SEL_BLOCK) - np.maximum(cs, ss), 0, None)
    return jnp.asarray(ov / CMP_BLOCK, dtype=jnp.float32)


def _nsa_mixer(q, kc_tok, vc_tok, ks, vs, kw, vw, gates, positions,
               pe_k, w_k1, w_k2, pe_v, w_v1, w_v2):
    B, S = q.shape[0], q.shape[1]
    G, HPG, HD = NSA_KV_HEADS, NSA_HPG, HEAD_DIM
    QB = NSA_Q_BLOCK
    scale = HEAD_DIM ** -0.5
    n_cmp = (S - CMP_BLOCK) // CMP_STRIDE + 1
    n_blk = S // SEL_BLOCK
    n_sel = min(N_SELECT, n_blk)
    tok_idx = np.arange(n_cmp)[:, None] * CMP_STRIDE + np.arange(CMP_BLOCK)[None, :]
    cmp_end = jnp.asarray(tok_idx[:, -1], dtype=jnp.int32)
    kc = _partial_rope(_compress(kc_tok, pe_k, w_k1, w_k2, tok_idx), positions[:, cmp_end])
    vc = _compress(vc_tok, pe_v, w_v1, w_v2, tok_idx)
    agg = _cmp_to_sel_matrix(n_cmp, n_blk)
    ks_blk = ks.reshape(B, n_blk, SEL_BLOCK, G, HD).transpose(0, 3, 1, 2, 4)
    vs_blk = vs.reshape(B, n_blk, SEL_BLOCK, G, HD).transpose(0, 3, 1, 2, 4)
    kw_pad = jnp.pad(kw, ((0, 0), (WINDOW, 0), (0, 0), (0, 0)))
    vw_pad = jnp.pad(vw, ((0, 0), (WINDOW, 0), (0, 0), (0, 0)))
    b_ix = jnp.arange(B)[:, None, None, None]
    g_ix = jnp.arange(G)[None, :, None, None]
    blk_ids = jnp.arange(n_blk)
    in_blk = jnp.arange(SEL_BLOCK)

    def block_fn(c):
        s0 = c * QB
        t = s0 + jnp.arange(QB)
        qg = lax.dynamic_slice_in_dim(q, s0, QB, axis=1).reshape(B, QB, G, HPG, HD)
        gt = lax.dynamic_slice_in_dim(gates, s0, QB, axis=1)
        s_c = jnp.einsum('bqghd,bngd->bghqn', qg, kc) * scale
        p_c = _masked_softmax(s_c, cmp_end[None, :] <= t[:, None])
        o_c = jnp.einsum('bghqn,bngd->bqghd', p_c.astype(vc.dtype), vc)
        imp = jnp.einsum('bghqn,nj->bgqj', p_c, agg)
        cur = t // SEL_BLOCK
        forced = (blk_ids[None] == 0) | (blk_ids[None] == cur[:, None]) | (blk_ids[None] == cur[:, None] - 1)
        future = blk_ids[None] * SEL_BLOCK > t[:, None]
        score = jnp.where(future, -1.0, imp + FORCE_BONUS * forced)
        _, sel = lax.top_k(score, n_sel)
        k_sel = ks_blk[b_ix, g_ix, sel].reshape(B, G, QB, n_sel * SEL_BLOCK, HD)
        v_sel = vs_blk[b_ix, g_ix, sel].reshape(B, G, QB, n_sel * SEL_BLOCK, HD)
        kpos = (sel[..., None] * SEL_BLOCK + in_blk).reshape(B, G, QB, n_sel * SEL_BLOCK)
        s_s = jnp.einsum('bqghd,bgqkd->bghqk', qg, k_sel) * scale
        p_s = _masked_softmax(s_s, (kpos <= t[:, None])[:, :, None])
        o_s = jnp.einsum('bghqk,bgqkd->bqghd', p_s.astype(v_sel.dtype), v_sel)
        k_w = lax.dynamic_slice_in_dim(kw_pad, s0, WINDOW + QB, axis=1)
        v_w = lax.dynamic_slice_in_dim(vw_pad, s0, WINDOW + QB, axis=1)
        wpos = s0 - WINDOW + jnp.arange(WINDOW + QB)
        rel = t[:, None] - wpos[None, :]
        w_mask = (rel >= 0) & (rel < WINDOW) & (wpos[None, :] >= 0)
        s_w = jnp.einsum('bqghd,bkgd->bghqk', qg, k_w) * scale
        p_w = _masked_softmax(s_w, w_mask)
        o_w = jnp.einsum('bghqk,bkgd->bqghd', p_w.astype(v_w.dtype), v_w)
        o = gt[..., 0:1] * o_c + gt[..., 1:2] * o_s + gt[..., 2:3] * o_w
        return o.reshape(B, QB, NSA_WIDTH)

    out = lax.map(block_fn, jnp.arange(S // QB))
    return out.transpose(1, 0, 2, 3).reshape(B, S, NSA_WIDTH)


def _fox_mixer(q, k, v, f_logit):
    B, S = q.shape[0], q.shape[1]
    QB = FOX_Q_BLOCK
    scale = HEAD_DIM ** -0.5
    log_f = jax.nn.log_sigmoid(f_logit.astype(jnp.float32))
    cum = jnp.cumsum(log_f, axis=1).transpose(0, 2, 1)
    kpos = jnp.arange(S)

    def block_fn(c):
        s0 = c * QB
        t = s0 + jnp.arange(QB)
        qb = lax.dynamic_slice_in_dim(q, s0, QB, axis=1)
        cq = lax.dynamic_slice_in_dim(cum, s0, QB, axis=2)
        logits = (jnp.einsum('bqhd,bkhd->bhqk', qb, k).astype(jnp.float32) * scale
                  + (cq[..., None] - cum[:, :, None, :]))
        p = _masked_softmax(logits, kpos[None, :] <= t[:, None])
        o = jnp.einsum('bhqk,bkhd->bqhd', p.astype(v.dtype), v)
        return o.reshape(B, QB, FOX_WIDTH)

    out = lax.map(block_fn, jnp.arange(S // QB))
    return out.transpose(1, 0, 2, 3).reshape(B, S, FOX_WIDTH)


def _hier_moe(u, w_group, b_group, w_router, b_router, w_gate_e, w_up_e, w_down_e):
    B, S = u.shape[0], u.shape[1]
    grp_logits = (u @ w_group + b_group).astype(jnp.float32)
    grp_prob = jax.nn.softmax(grp_logits, axis=-1)
    g_star = jnp.argmax(grp_logits, axis=-1)
    exp_logits = (u @ w_router + b_router).astype(jnp.float32).reshape(B, S, N_GROUPS, EXPERTS_PER_GROUP)
    in_logits = jnp.take_along_axis(exp_logits, g_star[..., None, None], axis=2)[..., 0, :]
    in_prob = jax.nn.softmax(in_logits, axis=-1)
    top_v, top_i = lax.top_k(in_prob, TOP_K_IN_GROUP)
    top_v = top_v / jnp.sum(top_v, axis=-1, keepdims=True)
    w = jnp.take_along_axis(grp_prob, g_star[..., None], axis=-1) * top_v
    expert_id = g_star[..., None] * EXPERTS_PER_GROUP + top_i
    combine = jnp.einsum('bsk,bske->bse', w.astype(u.dtype),
                         jax.nn.one_hot(expert_id, N_EXPERTS, dtype=u.dtype))
    y = jnp.zeros_like(u)
    for e in range(N_EXPERTS):
        hid = jax.nn.silu(u @ w_gate_e[e]) * (u @ w_up_e[e])
        y = y + combine[..., e:e + 1] * (hid @ w_down_e[e])
    return y


def setup_inputs(seed: int = 0) -> dict:
    key = jax.random.key(seed)
    ks = jax.random.split(key, 32)
    f32 = jnp.float32

    def nrm(k, shape, scale):
        return jax.random.normal(k, shape, f32) * scale

    def gain(k, shape):
        return 1.0 + 0.05 * jax.random.normal(k, shape, f32)

    L = DEPTH
    return {
        'x': nrm(ks[0], (BATCH, SEQ, D_MODEL), 1.0),
        'p': nrm(ks[1], (DEPTH, BATCH, SEQ, PLE_DIM), 1.0),
        'positions': (jnp.arange(SEQ, dtype=jnp.int32)[None, :]
                      + jax.random.randint(ks[2], (BATCH, 1), 0, SEQ, dtype=jnp.int32)),
        'g_mix': gain(ks[3], (L, D_MODEL)),
        'w_in': nrm(ks[4], (L, D_MODEL, IN_COLS), D_MODEL ** -0.5),
        'b_nsa_gate': nrm(ks[5], (L, 3 * NSA_HEADS), 0.01),
        'b_forget': 1.0 + 3.0 * jax.random.uniform(ks[6], (L, FOX_HEADS), f32),
        'pe_cmp_k': nrm(ks[7], (L, CMP_BLOCK, HEAD_DIM), 0.02),
        'w_cmp_k1': nrm(ks[8], (L, CMP_BLOCK * HEAD_DIM, CMP_HIDDEN), (CMP_BLOCK * HEAD_DIM) ** -0.5),
        'w_cmp_k2': nrm(ks[9], (L, CMP_HIDDEN, HEAD_DIM), CMP_HIDDEN ** -0.5),
        'pe_cmp_v': nrm(ks[10], (L, CMP_BLOCK, HEAD_DIM), 0.02),
        'w_cmp_v1': nrm(ks[11], (L, CMP_BLOCK * HEAD_DIM, CMP_HIDDEN), (CMP_BLOCK * HEAD_DIM) ** -0.5),
        'w_cmp_v2': nrm(ks[12], (L, CMP_HIDDEN, HEAD_DIM), CMP_HIDDEN ** -0.5),
        'beta_nsa': gain(ks[13], (L, NSA_WIDTH)),
        'beta_fox': gain(ks[14], (L, FOX_WIDTH)),
        'w_out': nrm(ks[15], (L, MIX_WIDTH, D_MODEL), MIX_WIDTH ** -0.5),
        'g_ffn': gain(ks[16], (L, D_MODEL)),
        'w_group': nrm(ks[17], (L, D_MODEL, N_GROUPS), D_MODEL ** -0.5),
        'b_group': nrm(ks[18], (L, N_GROUPS), 0.01),
        'w_router': nrm(ks[19], (L, D_MODEL, N_EXPERTS), D_MODEL ** -0.5),
        'b_router': nrm(ks[20], (L, N_EXPERTS), 0.01),
        'w_gate_e': nrm(ks[21], (L, N_EXPERTS, D_MODEL, D_EXPERT), D_MODEL ** -0.5),
        'w_up_e': nrm(ks[22], (L, N_EXPERTS, D_MODEL, D_EXPERT), D_MODEL ** -0.5),
        'w_down_e': nrm(ks[23], (L, N_EXPERTS, D_EXPERT, D_MODEL), D_EXPERT ** -0.5),
        'g_ple': gain(ks[24], (L, D_MODEL)),
        'w_ple_gate': nrm(ks[25], (L, D_MODEL, D_MODEL), D_MODEL ** -0.5),
        'b_ple_gate': nrm(ks[26], (L, D_MODEL), 0.01),
        'w_ple_proj': nrm(ks[27], (L, PLE_DIM, D_MODEL), PLE_DIM ** -0.5),
        'g_final': gain(ks[28], (D_MODEL,)),
    }


def reference(x, p, positions, g_mix, w_in, b_nsa_gate, b_forget,
              pe_cmp_k, w_cmp_k1, w_cmp_k2, pe_cmp_v, w_cmp_v1, w_cmp_v2,
              beta_nsa, beta_fox, w_out, g_ffn, w_group, b_group, w_router, b_router,
              w_gate_e, w_up_e, w_down_e, g_ple, w_ple_gate, b_ple_gate, w_ple_proj, g_final):
    B, S = x.shape[0], x.shape[1]
    h = x
    for i in range(DEPTH):
        hn = _rmsnorm(h, g_mix[i])
        proj = hn @ w_in[i]
        (q_a, kc_a, vc_a, ks_a, vs_a, kw_a, vw_a, gate_a,
         q_b, k_b, v_b, f_b) = jnp.split(proj, IN_OFFSETS, axis=-1)
        kv = lambda t: t.reshape(B, S, NSA_KV_HEADS, HEAD_DIM)
        q_nsa = _partial_rope(q_a.reshape(B, S, NSA_HEADS, HEAD_DIM), positions)
        gates = jax.nn.sigmoid(gate_a + b_nsa_gate[i]).reshape(B, S, NSA_KV_HEADS, NSA_HPG, 3)
        o_nsa = _nsa_mixer(q_nsa, kv(kc_a), kv(vc_a),
                           _partial_rope(kv(ks_a), positions), kv(vs_a),
                           _partial_rope(kv(kw_a), positions), kv(vw_a),
                           gates, positions,
                           pe_cmp_k[i], w_cmp_k1[i], w_cmp_k2[i],
                           pe_cmp_v[i], w_cmp_v1[i], w_cmp_v2[i])
        fh = lambda t: t.reshape(B, S, FOX_HEADS, HEAD_DIM)
        o_fox = _fox_mixer(fh(q_b), fh(k_b), fh(v_b), f_b + b_forget[i])
        mixed = jnp.concatenate([_rmsnorm(o_nsa, beta_nsa[i]), _rmsnorm(o_fox, beta_fox[i])], axis=-1)
        h = h + mixed @ w_out[i]
        u = _rmsnorm(h, g_ffn[i])
        h = h + _hier_moe(u, w_group[i], b_group[i], w_router[i], b_router[i],
                          w_gate_e[i], w_up_e[i], w_down_e[i])
        v_ple = _rmsnorm(h, g_ple[i])
        gate = jax.nn.sigmoid(v_ple @ w_ple_gate[i] + b_ple_gate[i])
        h = h + gate * (p[i] @ w_ple_proj[i])
    return _rmsnorm(h, g_final)
```

```cpp
#include <hip/hip_runtime.h>
#include <cstdio>
#include <cstdint>
#include <cmath>
#ifndef CFG_BATCH
#define CFG_BATCH 8
#endif
#ifndef CFG_SEQ
#define CFG_SEQ 4096
#endif
#ifndef CFG_NSEL
#define CFG_NSEL 16
#endif
#ifndef CFG_WINDOW
#define CFG_WINDOW 512
#endif
namespace nv {
constexpr int B_ = CFG_BATCH, S_ = CFG_SEQ, T_ = B_ * S_, DM = 1024, HD = 64;
constexpr int IN_COLS = 2848;
constexpr int OFF_QA = 0, OFF_KC = 512, OFF_VC = 640, OFF_KS = 768, OFF_VS = 896, OFF_KW = 1024, OFF_VW = 1152,
              OFF_GATE = 1280, OFF_QB = 1304, OFF_KB = 1816, OFF_VB = 2328, OFF_F = 2840;
constexpr int NCMP = (S_ - 32) / 16 + 1, NBLK = S_ / 64, NSEL = (CFG_NSEL < NBLK ? CFG_NSEL : NBLK), WIN = CFG_WINDOW;
constexpr float EPS = 1e-6f;
static_assert(NBLK <= 64, "selection mask is 64 bits");

#define NV_GID() ((long)blockIdx.x * (long)blockDim.x + (long)threadIdx.x)

__device__ __forceinline__ float nv_sigmoid(float x) { return 1.0f / (1.0f + expf(-x)); }
__device__ __forceinline__ float nv_silu(float x) { return x / (1.0f + expf(-x)); }
__device__ __forceinline__ float nv_logsigmoid(float x) { return fminf(x, 0.0f) - log1pf(expf(-fabsf(x))); }

__global__ void __launch_bounds__(256) k_rstd(const float* __restrict__ x, float* __restrict__ rstd, int rows) {
    long r = NV_GID(); if (r >= rows) return;
    const float* xr = x + r * DM; float s = 0.f;
    for (int k = 0; k < DM; ++k) s += xr[k] * xr[k];
    rstd[r] = 1.0f / sqrtf(s / DM + EPS);
}

__global__ void __launch_bounds__(256) k_gemm(const float* __restrict__ A, int lda, const float* __restrict__ rs, const float* __restrict__ cs,
                       const float* __restrict__ Bm, int ldb, float* __restrict__ C, int ldc, int M, int N, int K,
                       const float* __restrict__ Res, int ldr) {
    long gid = NV_GID(); const int tn = N / 4; long tiles = (long)(M / 4) * tn; if (gid >= tiles) return;
    const int m0 = (int)(gid / tn) * 4, n0 = (int)(gid % tn) * 4;
    float acc[4][4];
#pragma unroll
    for (int r = 0; r < 4; ++r)
#pragma unroll
        for (int c = 0; c < 4; ++c) acc[r][c] = 0.f;
    for (int k = 0; k < K; ++k) {
        const float sc = cs ? cs[k] : 1.0f;
        const float* bp = Bm + (long)k * ldb + n0;
        const float b0 = bp[0], b1 = bp[1], b2 = bp[2], b3 = bp[3];
#pragma unroll
        for (int r = 0; r < 4; ++r) {
            const float a = A[(long)(m0 + r) * lda + k] * sc;
            acc[r][0] += a * b0; acc[r][1] += a * b1; acc[r][2] += a * b2; acc[r][3] += a * b3;
        }
    }
#pragma unroll
    for (int r = 0; r < 4; ++r) {
        const float s = rs ? rs[m0 + r] : 1.0f;
#pragma unroll
        for (int c = 0; c < 4; ++c) {
            float v = acc[r][c] * s;
            if (Res) v += Res[(long)(m0 + r) * ldr + n0 + c];
            C[(long)(m0 + r) * ldc + n0 + c] = v;
        }
    }
}

__global__ void __launch_bounds__(256) k_postproj(float* __restrict__ proj, const int* __restrict__ positions, const float* __restrict__ b_gate,
                           const float* __restrict__ b_forget) {
    long gid = NV_GID(); if (gid >= (long)T_ * 14) return;
    const int tok = (int)(gid / 14), unit = (int)(gid % 14);
    float* row = proj + (long)tok * IN_COLS;
    if (unit < 12) {
        int off = unit < 8 ? OFF_QA + unit * 64 : (unit < 10 ? OFF_KS + (unit - 8) * 64 : OFF_KW + (unit - 10) * 64);
        const float pos = (float)positions[tok];
        for (int i = 0; i < 8; ++i) {
            const float inv = powf(500000.0f, -(float)i / 8.0f);
            const float ang = pos * inv, c = cosf(ang), s = sinf(ang);
            const float x1 = row[off + i], x2 = row[off + 8 + i];
            row[off + i] = x1 * c - x2 * s; row[off + 8 + i] = x2 * c + x1 * s;
        }
    } else if (unit == 12) {
        for (int i = 0; i < 24; ++i) row[OFF_GATE + i] = nv_sigmoid(row[OFF_GATE + i] + b_gate[i]);
    } else {
        for (int i = 0; i < 8; ++i) row[OFF_F + i] = nv_logsigmoid(row[OFF_F + i] + b_forget[i]);
    }
}

__global__ void __launch_bounds__(256) k_cumsum(const float* __restrict__ proj, float* __restrict__ cum) {
    long gid = NV_GID(); if (gid >= B_ * 8) return;
    const int b = (int)gid / 8, h = (int)gid % 8; double c = 0.0;
    for (int t = 0; t < S_; ++t) { c += (double)proj[((long)b * S_ + t) * IN_COLS + OFF_F + h]; cum[((long)b * 8 + h) * S_ + t] = (float)c; }
}

__global__ void __launch_bounds__(256) k_cmp_hidden(const float* __restrict__ proj, int coloff, const float* __restrict__ pe, const float* __restrict__ w1,
                             float* __restrict__ hid) {
    long gid = NV_GID(); if (gid >= (long)B_ * NCMP * 2 * 128) return;
    const int j = (int)(gid % 128); const int row = (int)(gid / 128); const int g = row % 2, n = (row / 2) % NCMP, b = row / (2 * NCMP);
    float acc = 0.f;
    for (int l = 0; l < 32; ++l) {
        const float* tp = proj + ((long)b * S_ + 16 * n + l) * IN_COLS + coloff + g * 64;
        for (int d = 0; d < 64; ++d) acc += (tp[d] + pe[l * 64 + d]) * w1[(long)(l * 64 + d) * 128 + j];
    }
    hid[(long)row * 128 + j] = nv_silu(acc);
}
__global__ void __launch_bounds__(256) k_cmp_out(const float* __restrict__ hid, const float* __restrict__ w2, float* __restrict__ out,
                          const int* __restrict__ positions, int dorope) {
    long gid = NV_GID(); if (gid >= (long)B_ * NCMP * 2 * 56) return;
    const int u = (int)(gid % 56); const int row = (int)(gid / 56); const int n = (row / 2) % NCMP, b = row / (2 * NCMP);
    const float* hp = hid + (long)row * 128;
    if (u < 8) {
        float a1 = 0.f, a2 = 0.f;
        for (int j = 0; j < 128; ++j) { a1 += hp[j] * w2[j * 64 + u]; a2 += hp[j] * w2[j * 64 + u + 8]; }
        if (dorope) {
            const float pos = (float)positions[(long)b * S_ + 16 * n + 31];
            const float inv = powf(500000.0f, -(float)u / 8.0f); const float ang = pos * inv, c = cosf(ang), s = sinf(ang);
            const float x1 = a1, x2 = a2; a1 = x1 * c - x2 * s; a2 = x2 * c + x1 * s;
        }
        out[(long)row * 64 + u] = a1; out[(long)row * 64 + u + 8] = a2;
    } else {
        const int d = u + 8; float a = 0.f;
        for (int j = 0; j < 128; ++j) a += hp[j] * w2[j * 64 + d];
        out[(long)row * 64 + d] = a;
    }
}

__global__ void __launch_bounds__(256) k_nsa_cmp(const float* __restrict__ proj, const float* __restrict__ kc, const float* __restrict__ vc,
                          float* __restrict__ imp, unsigned long long* __restrict__ selmask, float* __restrict__ omix) {
    long gid = NV_GID(); if (gid >= (long)T_ * 2) return;
    const int g = (int)(gid % 2); const int tok = (int)(gid / 2); const int b = tok / S_, t = tok % S_;
    const int nvis = t >= 31 ? (t - 31) / 16 + 1 : 0;
    float* ip = imp + ((long)(b * 2 + g) * S_ + t) * 64;
    for (int j = 0; j < NBLK; ++j) ip[j] = 0.f;
    const float* prow = proj + (long)tok * IN_COLS;
    for (int hh = 0; hh < 4; ++hh) {
        const int h = g * 4 + hh;
        float q[64], o[64];
#pragma unroll
        for (int d = 0; d < 64; ++d) { q[d] = prow[OFF_QA + h * 64 + d]; o[d] = 0.f; }
        float m = -1e30f;
        for (int n = 0; n < nvis; ++n) {
            const float* kp = kc + ((long)(b * NCMP + n) * 2 + g) * 64; float l = 0.f;
#pragma unroll
            for (int d = 0; d < 64; ++d) l += q[d] * kp[d];
            m = fmaxf(m, l * 0.125f);
        }
        float sum = 0.f;
        for (int n = 0; n < nvis; ++n) {
            const float* kp = kc + ((long)(b * NCMP + n) * 2 + g) * 64; float l = 0.f;
#pragma unroll
            for (int d = 0; d < 64; ++d) l += q[d] * kp[d];
            sum += expf(l * 0.125f - m);
        }
        for (int n = 0; n < nvis; ++n) {
            const float* kp = kc + ((long)(b * NCMP + n) * 2 + g) * 64; float l = 0.f;
#pragma unroll
            for (int d = 0; d < 64; ++d) l += q[d] * kp[d];
            const float p = expf(l * 0.125f - m) / sum;
            const float* vp = vc + ((long)(b * NCMP + n) * 2 + g) * 64;
#pragma unroll
            for (int d = 0; d < 64; ++d) o[d] += p * vp[d];
            const int j0 = n >> 2;
            if ((n & 3) < 3) ip[j0] += p; else { ip[j0] += 0.5f * p; if (j0 + 1 < NBLK) ip[j0 + 1] += 0.5f * p; }
        }
        const float g0 = prow[OFF_GATE + h * 3 + 0];
#pragma unroll
        for (int d = 0; d < 64; ++d) omix[(long)tok * DM + h * 64 + d] = g0 * o[d];
    }
    const int cur = t / 64; unsigned long long mask = 0ull;
    for (int s = 0; s < NSEL; ++s) {
        float best = -3e38f; int bj = -1;
        for (int j = 0; j < NBLK; ++j) {
            if ((mask >> j) & 1ull) continue;
            const bool forced = (j == 0) || (j == cur) || (j == cur - 1);
            const float sc = (j * 64 > t) ? -1.0f : ip[j] + (forced ? 1e4f : 0.0f);
            if (sc > best) { best = sc; bj = j; }
        }
        mask |= 1ull << bj;
    }
    selmask[(long)(b * 2 + g) * S_ + t] = mask;
}

__global__ void __launch_bounds__(256) k_nsa_selwin(const float* __restrict__ proj, const unsigned long long* __restrict__ selmask, float* __restrict__ omix) {
    long gid = NV_GID(); if (gid >= (long)T_ * 8) return;
    const int h = (int)(gid % 8); const int tok = (int)(gid / 8); const int b = tok / S_, t = tok % S_, g = h >> 2;
    const float* prow = proj + (long)tok * IN_COLS;
    float q[64], o[64];
#pragma unroll
    for (int d = 0; d < 64; ++d) { q[d] = prow[OFF_QA + h * 64 + d]; o[d] = 0.f; }
    const unsigned long long mask = selmask[(long)(b * 2 + g) * S_ + t];
    float m = -1e30f, l = 0.f;
    for (int j = 0; j < NBLK; ++j) {
        if (!((mask >> j) & 1ull)) continue;
        for (int kk = 0; kk < 64; ++kk) {
            const int kp = j * 64 + kk; if (kp > t) break;
            const float* kr = proj + ((long)b * S_ + kp) * IN_COLS; float s = 0.f;
#pragma unroll
            for (int d = 0; d < 64; ++d) s += q[d] * kr[OFF_KS + g * 64 + d];
            s *= 0.125f;
            const float mn = fmaxf(m, s), al = expf(m - mn), p = expf(s - mn);
            l = l * al + p;
#pragma unroll
            for (int d = 0; d < 64; ++d) o[d] = o[d] * al + p * kr[OFF_VS + g * 64 + d];
            m = mn;
        }
    }
    {
        const float g1 = prow[OFF_GATE + h * 3 + 1] / l;
#pragma unroll
        for (int d = 0; d < 64; ++d) { omix[(long)tok * DM + h * 64 + d] += g1 * o[d]; o[d] = 0.f; }
    }
    m = -1e30f; l = 0.f;
    const int lo = t - WIN + 1 > 0 ? t - WIN + 1 : 0;
    for (int kp = lo; kp <= t; ++kp) {
        const float* kr = proj + ((long)b * S_ + kp) * IN_COLS; float s = 0.f;
#pragma unroll
        for (int d = 0; d < 64; ++d) s += q[d] * kr[OFF_KW + g * 64 + d];
        s *= 0.125f;
        const float mn = fmaxf(m, s), al = expf(m - mn), p = expf(s - mn);
        l = l * al + p;
#pragma unroll
        for (int d = 0; d < 64; ++d) o[d] = o[d] * al + p * kr[OFF_VW + g * 64 + d];
        m = mn;
    }
    {
        const float g2 = prow[OFF_GATE + h * 3 + 2] / l;
#pragma unroll
        for (int d = 0; d < 64; ++d) omix[(long)tok * DM + h * 64 + d] += g2 * o[d];
    }
}

__global__ void __launch_bounds__(256) k_fox(const float* __restrict__ proj, const float* __restrict__ cum, float* __restrict__ omix) {
    long gid = NV_GID(); if (gid >= (long)T_ * 8) return;
    const int t = (int)(gid % S_); const int bh = (int)(gid / S_); const int b = bh / 8, h = bh % 8;
    const long tok = (long)b * S_ + t;
    const float* prow = proj + tok * IN_COLS;
    float q[64], o[64];
#pragma unroll
    for (int d = 0; d < 64; ++d) { q[d] = prow[OFF_QB + h * 64 + d]; o[d] = 0.f; }
    const float* cp = cum + ((long)b * 8 + h) * S_; const float cq = cp[t];
    float m = -1e30f, l = 0.f;
    for (int kp = 0; kp <= t; ++kp) {
        const float* kr = proj + ((long)b * S_ + kp) * IN_COLS; float s = 0.f;
#pragma unroll
        for (int d = 0; d < 64; ++d) s += q[d] * kr[OFF_KB + h * 64 + d];
        s = s * 0.125f + (cq - cp[kp]);
        const float mn = fmaxf(m, s), al = expf(m - mn), p = expf(s - mn);
        l = l * al + p;
#pragma unroll
        for (int d = 0; d < 64; ++d) o[d] = o[d] * al + p * kr[OFF_VB + h * 64 + d];
        m = mn;
    }
    const float il = 1.0f / l;
#pragma unroll
    for (int d = 0; d < 64; ++d) omix[tok * DM + 512 + h * 64 + d] = o[d] * il;
}

__global__ void __launch_bounds__(256) k_mixnorm(float* __restrict__ omix, const float* __restrict__ beta_nsa, const float* __restrict__ beta_fox) {
    long gid = NV_GID(); if (gid >= (long)T_ * 2) return;
    const int half = (int)(gid % 2); float* v = omix + (gid / 2) * DM + half * 512; const float* be = half ? beta_fox : beta_nsa;
    float s = 0.f; for (int k = 0; k < 512; ++k) s += v[k] * v[k];
    const float r = 1.0f / sqrtf(s / 512 + EPS);
    for (int k = 0; k < 512; ++k) v[k] = v[k] * r * be[k];
}

__global__ void __launch_bounds__(256) k_router(const float* __restrict__ H, const float* __restrict__ g_ffn, const float* __restrict__ w_group, const float* __restrict__ b_group,
                         const float* __restrict__ w_router, const float* __restrict__ b_router, float* __restrict__ U, int* __restrict__ eid, float* __restrict__ cw) {
    long tok = NV_GID(); if (tok >= T_) return;
    const float* hr = H + tok * DM; float ss = 0.f;
    for (int k = 0; k < DM; ++k) ss += hr[k] * hr[k];
    const float rstd = 1.0f / sqrtf(ss / DM + EPS);
    float gl[4], el[16];
#pragma unroll
    for (int c = 0; c < 4; ++c) gl[c] = 0.f;
#pragma unroll
    for (int e = 0; e < 16; ++e) el[e] = 0.f;
    for (int k = 0; k < DM; ++k) {
        const float u = hr[k] * rstd * g_ffn[k]; U[tok * DM + k] = u;
#pragma unroll
        for (int c = 0; c < 4; ++c) gl[c] += u * w_group[k * 4 + c];
#pragma unroll
        for (int e = 0; e < 16; ++e) el[e] += u * w_router[k * 16 + e];
    }
#pragma unroll
    for (int c = 0; c < 4; ++c) gl[c] += b_group[c];
#pragma unroll
    for (int e = 0; e < 16; ++e) el[e] += b_router[e];
    int gs = 0; float gm = gl[0];
#pragma unroll
    for (int c = 1; c < 4; ++c) if (gl[c] > gm) { gm = gl[c]; gs = c; }
    float gsum = 0.f;
#pragma unroll
    for (int c = 0; c < 4; ++c) gsum += expf(gl[c] - gm);
    const float gprob = 1.0f / gsum;
    float il[4] = {0.f, 0.f, 0.f, 0.f};
#pragma unroll
    for (int c = 0; c < 4; ++c)
#pragma unroll
        for (int e = 0; e < 4; ++e) if (gs == c) il[e] = el[c * 4 + e];
    float im = il[0];
#pragma unroll
    for (int e = 1; e < 4; ++e) im = fmaxf(im, il[e]);
    float ipr[4], isum = 0.f;
#pragma unroll
    for (int e = 0; e < 4; ++e) { ipr[e] = expf(il[e] - im); isum += ipr[e]; }
#pragma unroll
    for (int e = 0; e < 4; ++e) ipr[e] /= isum;
    int i0 = 0; float v0 = ipr[0];
#pragma unroll
    for (int e = 1; e < 4; ++e) if (ipr[e] > v0) { v0 = ipr[e]; i0 = e; }
    int i1 = -1; float v1 = -1.f;
#pragma unroll
    for (int e = 0; e < 4; ++e) if (e != i0 && ipr[e] > v1) { v1 = ipr[e]; i1 = e; }
    const float den = v0 + v1;
    eid[tok * 2 + 0] = gs * 4 + i0; eid[tok * 2 + 1] = gs * 4 + i1;
    cw[tok * 2 + 0] = gprob * (v0 / den); cw[tok * 2 + 1] = gprob * (v1 / den);
}

__global__ void __launch_bounds__(256) k_expert_up(const float* __restrict__ U, const int* __restrict__ eid, const float* __restrict__ wg, const float* __restrict__ wu, float* __restrict__ hid) {
    long gid = NV_GID(); if (gid >= (long)T_ * 2 * 128) return;
    const int jg = (int)(gid % 128); const long tk = gid / 128; const long tok = tk / 2; const int e = eid[tk];
    const float* ur = U + tok * DM; const float* gp = wg + (long)e * DM * 512 + jg * 4; const float* up = wu + (long)e * DM * 512 + jg * 4;
    float ga[4] = {0.f, 0.f, 0.f, 0.f}, ua[4] = {0.f, 0.f, 0.f, 0.f};
    for (int i = 0; i < DM; ++i) {
        const float u = ur[i];
#pragma unroll
        for (int c = 0; c < 4; ++c) { ga[c] += u * gp[(long)i * 512 + c]; ua[c] += u * up[(long)i * 512 + c]; }
    }
#pragma unroll
    for (int c = 0; c < 4; ++c) hid[tk * 512 + jg * 4 + c] = nv_silu(ga[c]) * ua[c];
}
__global__ void __launch_bounds__(256) k_expert_down(float* __restrict__ H, const int* __restrict__ eid, const float* __restrict__ cw, const float* __restrict__ wd, const float* __restrict__ hid) {
    long gid = NV_GID(); if (gid >= (long)T_ * 256) return;
    const int cg = (int)(gid % 256); const long tok = gid / 256;
    float acc[4] = {0.f, 0.f, 0.f, 0.f};
    for (int k = 0; k < 2; ++k) {
        const int e = eid[tok * 2 + k]; const float w = cw[tok * 2 + k];
        const float* hp = hid + (tok * 2 + k) * 512; const float* dp = wd + (long)e * 512 * DM + cg * 4;
        float tmp[4] = {0.f, 0.f, 0.f, 0.f};
        for (int j = 0; j < 512; ++j) {
            const float hv = hp[j];
#pragma unroll
            for (int c = 0; c < 4; ++c) tmp[c] += hv * dp[(long)j * DM + c];
        }
#pragma unroll
        for (int c = 0; c < 4; ++c) acc[c] += w * tmp[c];
    }
#pragma unroll
    for (int c = 0; c < 4; ++c) H[tok * DM + cg * 4 + c] += acc[c];
}

__global__ void __launch_bounds__(256) k_final(const float* __restrict__ H, float* __restrict__ G, const float* __restrict__ PP, const float* __restrict__ b_ple,
                        const float* __restrict__ g_final, float* __restrict__ out) {
    long tok = NV_GID(); if (tok >= T_) return;
    float ss = 0.f;
    for (int c = 0; c < DM; ++c) {
        const float h3 = H[tok * DM + c] + nv_sigmoid(G[tok * DM + c] + b_ple[c]) * PP[tok * DM + c];
        G[tok * DM + c] = h3; ss += h3 * h3;
    }
    const float r = 1.0f / sqrtf(ss / DM + EPS);
    for (int c = 0; c < DM; ++c) out[tok * DM + c] = G[tok * DM + c] * r * g_final[c];
}

constexpr size_t MiB = 1u << 20;
constexpr size_t SZ_PROJ = (size_t)T_ * IN_COLS * 4, SZ_ACT = (size_t)T_ * DM * 4;
constexpr size_t A16(size_t x) { return (x + 255) / 256 * 256; }
constexpr size_t W_PROJ = 0;
constexpr size_t W_RSTD1 = A16(W_PROJ + SZ_PROJ);
constexpr size_t W_CUM = A16(W_RSTD1 + (size_t)T_ * 4);
constexpr size_t W_KC = A16(W_CUM + (size_t)T_ * 8 * 4);
constexpr size_t W_VC = A16(W_KC + (size_t)B_ * NCMP * 2 * 64 * 4);
constexpr size_t W_CMPH = A16(W_VC + (size_t)B_ * NCMP * 2 * 64 * 4);
constexpr size_t W_IMP = A16(W_CMPH + (size_t)B_ * NCMP * 2 * 128 * 4 * 2);
constexpr size_t W_SELM = A16(W_IMP + (size_t)B_ * 2 * S_ * 64 * 4);
constexpr size_t W_END1 = A16(W_SELM + (size_t)B_ * 2 * S_ * 8);
constexpr size_t W_H = 0, W_U = SZ_ACT, W_HID = 2 * SZ_ACT, W_EID = 3 * SZ_ACT, W_CW = A16(W_EID + (size_t)T_ * 8), W_RS3 = A16(W_CW + (size_t)T_ * 8),
                 W_END2 = A16(W_RS3 + (size_t)T_ * 4);
constexpr size_t W_PP = W_U, W_G = W_HID;
constexpr size_t W_TOTAL = W_END1 > W_END2 ? W_END1 : W_END2;

#ifndef NV_DBG
#define NV_DBG(name)
#endif
#ifndef NV_LAUNCH
#define NV_LAUNCH(kern, n, ...) kern<<<(unsigned)(((long)(n) + 255) / 256), 256, 0, stream>>>(__VA_ARGS__)
#endif

template <class StreamT>
static void run_naive(void* const* d_in, void* d_out, void* d_ws, StreamT stream) {
    const float* x = (const float*)d_in[0]; const float* p = (const float*)d_in[1]; const int* positions = (const int*)d_in[2];
    const float* g_mix = (const float*)d_in[3]; const float* w_in = (const float*)d_in[4]; const float* b_gate = (const float*)d_in[5];
    const float* b_forget = (const float*)d_in[6]; const float* pe_k = (const float*)d_in[7]; const float* w_k1 = (const float*)d_in[8];
    const float* w_k2 = (const float*)d_in[9]; const float* pe_v = (const float*)d_in[10]; const float* w_v1 = (const float*)d_in[11];
    const float* w_v2 = (const float*)d_in[12]; const float* beta_nsa = (const float*)d_in[13]; const float* beta_fox = (const float*)d_in[14];
    const float* w_out = (const float*)d_in[15]; const float* g_ffn = (const float*)d_in[16]; const float* w_group = (const float*)d_in[17];
    const float* b_group = (const float*)d_in[18]; const float* w_router = (const float*)d_in[19]; const float* b_router = (const float*)d_in[20];
    const float* w_gate_e = (const float*)d_in[21]; const float* w_up_e = (const float*)d_in[22]; const float* w_down_e = (const float*)d_in[23];
    const float* g_ple = (const float*)d_in[24]; const float* w_ple_gate = (const float*)d_in[25]; const float* b_ple = (const float*)d_in[26];
    const float* w_ple_proj = (const float*)d_in[27]; const float* g_final = (const float*)d_in[28];
    char* ws = (char*)d_ws; float* out = (float*)d_out;
    float* PROJ = (float*)(ws + W_PROJ); float* RSTD1 = (float*)(ws + W_RSTD1); float* CUM = (float*)(ws + W_CUM);
    float* KC = (float*)(ws + W_KC); float* VC = (float*)(ws + W_VC); float* CMPH = (float*)(ws + W_CMPH); float* CMPH2 = CMPH + (size_t)B_ * NCMP * 2 * 128;
    float* IMP = (float*)(ws + W_IMP); unsigned long long* SELM = (unsigned long long*)(ws + W_SELM);
    float* OMIX = out;
    float* H = (float*)(ws + W_H); float* U = (float*)(ws + W_U); float* HID = (float*)(ws + W_HID); int* EID = (int*)(ws + W_EID);
    float* CW = (float*)(ws + W_CW); float* RS3 = (float*)(ws + W_RS3); float* PP = (float*)(ws + W_PP); float* G = (float*)(ws + W_G);

    NV_LAUNCH(k_rstd, T_, x, RSTD1, T_);
    NV_LAUNCH(k_gemm, (long)(T_ / 4) * (IN_COLS / 4), x, DM, RSTD1, g_mix, w_in, IN_COLS, PROJ, IN_COLS, T_, IN_COLS, DM, (const float*)nullptr, 0);
    NV_LAUNCH(k_postproj, (long)T_ * 14, PROJ, positions, b_gate, b_forget); NV_DBG("proj");
    NV_LAUNCH(k_cumsum, B_ * 8, PROJ, CUM);
    NV_LAUNCH(k_cmp_hidden, (long)B_ * NCMP * 2 * 128, PROJ, OFF_KC, pe_k, w_k1, CMPH);
    NV_LAUNCH(k_cmp_hidden, (long)B_ * NCMP * 2 * 128, PROJ, OFF_VC, pe_v, w_v1, CMPH2);
    NV_LAUNCH(k_cmp_out, (long)B_ * NCMP * 2 * 56, CMPH, w_k2, KC, positions, 1);
    NV_LAUNCH(k_cmp_out, (long)B_ * NCMP * 2 * 56, CMPH2, w_v2, VC, positions, 0); NV_DBG("cmp");
    NV_LAUNCH(k_nsa_cmp, (long)T_ * 2, PROJ, KC, VC, IMP, SELM, OMIX); NV_DBG("nsa_cmp");
    NV_LAUNCH(k_nsa_selwin, (long)T_ * 8, PROJ, SELM, OMIX);
    NV_LAUNCH(k_fox, (long)T_ * 8, PROJ, CUM, OMIX); NV_DBG("attn");
    NV_LAUNCH(k_mixnorm, (long)T_ * 2, OMIX, beta_nsa, beta_fox);
    NV_LAUNCH(k_gemm, (long)(T_ / 4) * (DM / 4), OMIX, DM, (const float*)nullptr, (const float*)nullptr, w_out, DM, H, DM, T_, DM, DM, x, DM); NV_DBG("h1");
    NV_LAUNCH(k_router, T_, H, g_ffn, w_group, b_group, w_router, b_router, U, EID, CW); NV_DBG("router");
    NV_LAUNCH(k_expert_up, (long)T_ * 2 * 128, U, EID, w_gate_e, w_up_e, HID);
    NV_LAUNCH(k_expert_down, (long)T_ * 256, H, EID, CW, w_down_e, HID); NV_DBG("h2");
    NV_LAUNCH(k_rstd, T_, H, RS3, T_);
    NV_LAUNCH(k_gemm, (long)(T_ / 4) * (DM / 4), p, 256, (const float*)nullptr, (const float*)nullptr, w_ple_proj, DM, PP, DM, T_, DM, 256, (const float*)nullptr, 0);
    NV_LAUNCH(k_gemm, (long)(T_ / 4) * (DM / 4), H, DM, RS3, g_ple, w_ple_gate, DM, G, DM, T_, DM, DM, (const float*)nullptr, 0);
    NV_LAUNCH(k_final, T_, H, G, PP, b_ple, g_final, out); NV_DBG("out");
}
}
extern "C" void kernel_launch(void* const* d_in, const int* in_sizes, int n_in, void* d_out, int out_size, void* d_ws, size_t ws_size, hipStream_t stream) {
    if (ws_size < nv::W_TOTAL) { fprintf(stderr, "kernel_launch: workspace too small: %zu < %zu\n", ws_size, (size_t)nv::W_TOTAL); return; }
    nv::run_naive(d_in, d_out, d_ws, stream);
}
```

```cpp
#define PROBE_DUP (-1)
#include <hip/hip_runtime.h>
#include <hip/hip_bf16.h>
#include <cstdio>
#include <cstdint>
#include <cmath>
namespace lx {
template <int M> __device__ __forceinline__ float xf(float v) { static_assert(M >= 1 && M < 32, "xf: within a 32-lane half"); return __builtin_bit_cast(float, __builtin_amdgcn_ds_swizzle(__builtin_bit_cast(int, v), (M << 10) | 0x1f)); }
template <int M> __device__ __forceinline__ int xi(int v) { static_assert(M >= 1 && M < 32, "xi: within a 32-lane half"); return __builtin_amdgcn_ds_swizzle(v, (M << 10) | 0x1f); }
__device__ __forceinline__ float x32f(float v, bool hi) { auto rr = __builtin_amdgcn_permlane32_swap(__float_as_uint(v), __float_as_uint(v), false, false); return __uint_as_float(hi ? rr[0] : rr[1]); }
__device__ __forceinline__ float sum64(float v) { v += xf<1>(v); v += xf<2>(v); v += xf<4>(v); v += xf<8>(v); v += xf<16>(v);
    auto rr = __builtin_amdgcn_permlane32_swap(__float_as_uint(v), __float_as_uint(v), false, false); return __uint_as_float(rr[0]) + __uint_as_float(rr[1]); }
__device__ __forceinline__ float max64(float v) { v = fmaxf(v, xf<1>(v)); v = fmaxf(v, xf<2>(v)); v = fmaxf(v, xf<4>(v)); v = fmaxf(v, xf<8>(v)); v = fmaxf(v, xf<16>(v));
    auto rr = __builtin_amdgcn_permlane32_swap(__float_as_uint(v), __float_as_uint(v), false, false); return fmaxf(__uint_as_float(rr[0]), __uint_as_float(rr[1])); }
}
#ifndef CFG_BATCH
#define CFG_BATCH 8
#endif
#ifndef CFG_SEQ
#define CFG_SEQ 4096
#endif
#ifndef CFG_NSEL
#define CFG_NSEL 16
#endif
#ifndef CFG_WINDOW
#define CFG_WINDOW 512
#endif
namespace nv {
constexpr int B_ = CFG_BATCH, S_ = CFG_SEQ, T_ = B_ * S_, DM = 1024, HD = 64;
constexpr int IN_COLS = 2848;
constexpr int OFF_QA = 0, OFF_KC = 512, OFF_VC = 640, OFF_KS = 768, OFF_VS = 896, OFF_KW = 1024, OFF_VW = 1152,
              OFF_GATE = 1280, OFF_QB = 1304, OFF_KB = 1816, OFF_VB = 2328, OFF_F = 2840;
constexpr int NCMP = (S_ - 32) / 16 + 1, NBLK = S_ / 64, NSEL = (CFG_NSEL < NBLK ? CFG_NSEL : NBLK), WIN = CFG_WINDOW;
constexpr float EPS = 1e-6f;
static_assert(NBLK <= 64, "selection mask is 64 bits");


__device__ __forceinline__ float nv_sigmoid(float x) { return 1.0f / (1.0f + expf(-x)); }
__device__ __forceinline__ float nv_silu(float x) { return x / (1.0f + expf(-x)); }
__device__ __forceinline__ float nv_logsigmoid(float x) { return fminf(x, 0.0f) - log1pf(expf(-fabsf(x))); }


constexpr float C2F = 0.125f * 1.4426950408889634f;
constexpr int PB_COLS = 2816;
struct ProjF32 { const float* p;
    __device__ __forceinline__ float operator()(long tok, int off, int i) const { return p[tok * IN_COLS + off + i]; } };
struct ProjB16 { const unsigned short* p; const float* gates; const float* logf;
    __device__ __forceinline__ float operator()(long tok, int off, int i) const {
        if (off == OFF_GATE) return gates[tok * 24 + i];
        if (off == OFF_F) return logf[tok * 8 + i];
        const int nb = off < OFF_GATE ? off : off - 24;
        const unsigned u = (unsigned)p[tok * PB_COLS + nb + i] << 16;
#ifdef CPU_EMU
        float v; memcpy(&v, &u, 4);
#else
        float v = __builtin_bit_cast(float, u);
#endif
        if (off == OFF_QA || off == OFF_QB) v *= (1.0f / C2F);
        return v; } };

__device__ __forceinline__ void d_rstd(long gid_, const float* __restrict__ x, float* __restrict__ rstd, int rows) {
    long r = gid_; if (r >= rows) return;
    const float* xr = x + r * DM; float s = 0.f;
    for (int k = 0; k < DM; ++k) s += xr[k] * xr[k];
    rstd[r] = 1.0f / sqrtf(s / DM + EPS);
}

__device__ __forceinline__ void d_gemm(long gid_, const float* __restrict__ A, int lda, const float* __restrict__ rs, const float* __restrict__ cs,
                       const float* __restrict__ Bm, int ldb, float* __restrict__ C, int ldc, int M, int N, int K,
                       const float* __restrict__ Res, int ldr) {
    long gid = gid_; const int tn = N / 4; long tiles = (long)(M / 4) * tn; if (gid >= tiles) return;
    const int m0 = (int)(gid / tn) * 4, n0 = (int)(gid % tn) * 4;
    float acc[4][4];
#pragma unroll
    for (int r = 0; r < 4; ++r)
#pragma unroll
        for (int c = 0; c < 4; ++c) acc[r][c] = 0.f;
    for (int k = 0; k < K; ++k) {
        const float sc = cs ? cs[k] : 1.0f;
        const float* bp = Bm + (long)k * ldb + n0;
        const float b0 = bp[0], b1 = bp[1], b2 = bp[2], b3 = bp[3];
#pragma unroll
        for (int r = 0; r < 4; ++r) {
            const float a = A[(long)(m0 + r) * lda + k] * sc;
            acc[r][0] += a * b0; acc[r][1] += a * b1; acc[r][2] += a * b2; acc[r][3] += a * b3;
        }
    }
#pragma unroll
    for (int r = 0; r < 4; ++r) {
        const float s = rs ? rs[m0 + r] : 1.0f;
#pragma unroll
        for (int c = 0; c < 4; ++c) {
            float v = acc[r][c] * s;
            if (Res) v += Res[(long)(m0 + r) * ldr + n0 + c];
            C[(long)(m0 + r) * ldc + n0 + c] = v;
        }
    }
}

__device__ __forceinline__ void d_postproj(long gid_, float* __restrict__ proj, const int* __restrict__ positions, const float* __restrict__ b_gate,
                           const float* __restrict__ b_forget) {
    long gid = gid_; if (gid >= (long)T_ * 14) return;
    const int tok = (int)(gid / 14), unit = (int)(gid % 14);
    float* row = proj + (long)tok * IN_COLS;
    if (unit < 12) {
        int off = unit < 8 ? OFF_QA + unit * 64 : (unit < 10 ? OFF_KS + (unit - 8) * 64 : OFF_KW + (unit - 10) * 64);
        const float pos = (float)positions[tok];
        for (int i = 0; i < 8; ++i) {
            const float inv = powf(500000.0f, -(float)i / 8.0f);
            const float ang = pos * inv, c = cosf(ang), s = sinf(ang);
            const float x1 = row[off + i], x2 = row[off + 8 + i];
            row[off + i] = x1 * c - x2 * s; row[off + 8 + i] = x2 * c + x1 * s;
        }
    } else if (unit == 12) {
        for (int i = 0; i < 24; ++i) row[OFF_GATE + i] = nv_sigmoid(row[OFF_GATE + i] + b_gate[i]);
    } else {
        for (int i = 0; i < 8; ++i) row[OFF_F + i] = nv_logsigmoid(row[OFF_F + i] + b_forget[i]);
    }
}

template <class PJ> __device__ __forceinline__ void d_cumsum(long gid_, const PJ proj, float* __restrict__ cum) {
    long gid = gid_; if (gid >= B_ * 8) return;
    const int b = (int)gid / 8, h = (int)gid % 8; double c = 0.0;
    for (int t = 0; t < S_; ++t) { c += (double)proj((long)b * S_ + t, OFF_F, h); cum[((long)b * 8 + h) * S_ + t] = (float)c; }
}

template <class PJ> __device__ __forceinline__ void d_cmp_hidden(long gid_, const PJ proj, int coloff, const float* __restrict__ pe, const float* __restrict__ w1,
                             float* __restrict__ hid) {
    long gid = gid_; if (gid >= (long)B_ * NCMP * 2 * 128) return;
    const int j = (int)(gid % 128); const int row = (int)(gid / 128); const int g = row % 2, n = (row / 2) % NCMP, b = row / (2 * NCMP);
    float acc = 0.f;
    for (int l = 0; l < 32; ++l) {
        const long tk = (long)b * S_ + 16 * n + l;
        for (int d = 0; d < 64; ++d) acc += (proj(tk, coloff, g * 64 + d) + pe[l * 64 + d]) * w1[(long)(l * 64 + d) * 128 + j];
    }
    hid[(long)row * 128 + j] = nv_silu(acc);
}
__device__ __forceinline__ void d_cmp_out(long gid_, const float* __restrict__ hid, const float* __restrict__ w2, float* __restrict__ out,
                          const int* __restrict__ positions, int dorope) {
    long gid = gid_; if (gid >= (long)B_ * NCMP * 2 * 56) return;
    const int u = (int)(gid % 56); const int row = (int)(gid / 56); const int n = (row / 2) % NCMP, b = row / (2 * NCMP);
    const float* hp = hid + (long)row * 128;
    if (u < 8) {
        float a1 = 0.f, a2 = 0.f;
        for (int j = 0; j < 128; ++j) { a1 += hp[j] * w2[j * 64 + u]; a2 += hp[j] * w2[j * 64 + u + 8]; }
        if (dorope) {
            const float pos = (float)positions[(long)b * S_ + 16 * n + 31];
            const float inv = powf(500000.0f, -(float)u / 8.0f); const float ang = pos * inv, c = cosf(ang), s = sinf(ang);
            const float x1 = a1, x2 = a2; a1 = x1 * c - x2 * s; a2 = x2 * c + x1 * s;
        }
        out[(long)row * 64 + u] = a1; out[(long)row * 64 + u + 8] = a2;
    } else {
        const int d = u + 8; float a = 0.f;
        for (int j = 0; j < 128; ++j) a += hp[j] * w2[j * 64 + d];
        out[(long)row * 64 + d] = a;
    }
}

template <class PJ> __device__ __forceinline__ void d_nsa_cmp(long gid_, const PJ proj, const float* __restrict__ kc, const float* __restrict__ vc,
                          float* __restrict__ imp, unsigned long long* __restrict__ selmask, float* __restrict__ omix) {
    long gid = gid_; if (gid >= (long)T_ * 2) return;
    const int g = (int)(gid % 2); const int tok = (int)(gid / 2); const int b = tok / S_, t = tok % S_;
    const int nvis = t >= 31 ? (t - 31) / 16 + 1 : 0;
    float* ip = imp + ((long)(b * 2 + g) * S_ + t) * 64;
    for (int j = 0; j < NBLK; ++j) ip[j] = 0.f;
#pragma unroll 1
    for (int hh = 0; hh < 4; ++hh) {
        const int h = g * 4 + hh;
        float m = -1e30f;
#pragma unroll 1
        for (int n = 0; n < nvis; ++n) {
            asm volatile("" ::: "memory");
            const float* kp = kc + ((long)(b * NCMP + n) * 2 + g) * 64; float l = 0.f;
#pragma unroll
            for (int d = 0; d < 64; ++d) l += proj(tok, OFF_QA, h * 64 + d) * kp[d];
            m = fmaxf(m, l * 0.125f);
        }
        float sum = 0.f;
#pragma unroll 1
        for (int n = 0; n < nvis; ++n) {
            asm volatile("" ::: "memory");
            const float* kp = kc + ((long)(b * NCMP + n) * 2 + g) * 64; float l = 0.f;
#pragma unroll
            for (int d = 0; d < 64; ++d) l += proj(tok, OFF_QA, h * 64 + d) * kp[d];
            sum += expf(l * 0.125f - m);
        }
        const float g0 = proj(tok, OFF_GATE, h * 3 + 0);
#pragma unroll 1
        for (int dh = 0; dh < 2; ++dh) {
            float o[32];
#pragma unroll
            for (int d = 0; d < 32; ++d) o[d] = 0.f;
#pragma unroll 1
            for (int n = 0; n < nvis; ++n) {
                asm volatile("" ::: "memory");
                const float* kp = kc + ((long)(b * NCMP + n) * 2 + g) * 64; float l = 0.f;
#pragma unroll
                for (int d = 0; d < 64; ++d) l += proj(tok, OFF_QA, h * 64 + d) * kp[d];
                const float p = expf(l * 0.125f - m) / sum;
                const float* vp = vc + ((long)(b * NCMP + n) * 2 + g) * 64 + dh * 32;
#pragma unroll
                for (int d = 0; d < 32; ++d) o[d] += p * vp[d];
                if (dh == 0) {
                    const int j0 = n >> 2;
                    if ((n & 3) < 3) ip[j0] += p; else { ip[j0] += 0.5f * p; if (j0 + 1 < NBLK) ip[j0 + 1] += 0.5f * p; }
                }
            }
#pragma unroll
            for (int d = 0; d < 32; ++d) omix[(long)tok * DM + h * 64 + dh * 32 + d] = g0 * o[d];
        }
    }
    const int cur = t / 64; unsigned long long mask = 0ull;
#pragma unroll 1
    for (int s = 0; s < NSEL; ++s) {
        float best = -3e38f; int bj = -1;
#pragma unroll 1
        for (int j = 0; j < NBLK; ++j) {
            if ((mask >> j) & 1ull) continue;
            const bool forced = (j == 0) || (j == cur) || (j == cur - 1);
            const float sc = (j * 64 > t) ? -1.0f : ip[j] + (forced ? 1e4f : 0.0f);
            if (sc > best) { best = sc; bj = j; }
        }
        mask |= 1ull << bj;
    }
    selmask[(long)(b * 2 + g) * S_ + t] = mask;
}

template <class PJ> __device__ __forceinline__ void d_nsa_selwin(long gid_, const PJ proj, const unsigned long long* __restrict__ selmask, float* __restrict__ omix) {
    long gid = gid_; if (gid >= (long)T_ * 8) return;
    const int h = (int)(gid % 8); const int tok = (int)(gid / 8); const int b = tok / S_, t = tok % S_, g = h >> 2;
    float q[64], o[64];
#pragma unroll
    for (int d = 0; d < 64; ++d) { q[d] = proj(tok, OFF_QA, h * 64 + d); o[d] = 0.f; }
    const unsigned long long mask = selmask[(long)(b * 2 + g) * S_ + t];
    float m = -1e30f, l = 0.f;
    for (int j = 0; j < NBLK; ++j) {
        if (!((mask >> j) & 1ull)) continue;
        for (int kk = 0; kk < 64; ++kk) {
            const int kp = j * 64 + kk; if (kp > t) break;
            const long kr = (long)b * S_ + kp; float s = 0.f;
#pragma unroll
            for (int d = 0; d < 64; ++d) s += q[d] * proj(kr, OFF_KS, g * 64 + d);
            s *= 0.125f;
            const float mn = fmaxf(m, s), al = expf(m - mn), p = expf(s - mn);
            l = l * al + p;
#pragma unroll
            for (int d = 0; d < 64; ++d) o[d] = o[d] * al + p * proj(kr, OFF_VS, g * 64 + d);
            m = mn;
        }
    }
    {
        const float g1 = proj(tok, OFF_GATE, h * 3 + 1) / l;
#pragma unroll
        for (int d = 0; d < 64; ++d) { omix[(long)tok * DM + h * 64 + d] += g1 * o[d]; o[d] = 0.f; }
    }
    m = -1e30f; l = 0.f;
    const int lo = t - WIN + 1 > 0 ? t - WIN + 1 : 0;
    for (int kp = lo; kp <= t; ++kp) {
        const long kr = (long)b * S_ + kp; float s = 0.f;
#pragma unroll
        for (int d = 0; d < 64; ++d) s += q[d] * proj(kr, OFF_KW, g * 64 + d);
        s *= 0.125f;
        const float mn = fmaxf(m, s), al = expf(m - mn), p = expf(s - mn);
        l = l * al + p;
#pragma unroll
        for (int d = 0; d < 64; ++d) o[d] = o[d] * al + p * proj(kr, OFF_VW, g * 64 + d);
        m = mn;
    }
    {
        const float g2 = proj(tok, OFF_GATE, h * 3 + 2) / l;
#pragma unroll
        for (int d = 0; d < 64; ++d) omix[(long)tok * DM + h * 64 + d] += g2 * o[d];
    }
}

template <class PJ> __device__ __forceinline__ void d_fox(long gid_, const PJ proj, const float* __restrict__ cum, float* __restrict__ omix) {
    long gid = gid_; if (gid >= (long)T_ * 8) return;
    const int t = (int)(gid % S_); const int bh = (int)(gid / S_); const int b = bh / 8, h = bh % 8;
    const long tok = (long)b * S_ + t;
    float q[64], o[64];
#pragma unroll
    for (int d = 0; d < 64; ++d) { q[d] = proj(tok, OFF_QB, h * 64 + d); o[d] = 0.f; }
    const float* cp = cum + ((long)b * 8 + h) * S_; const float cq = cp[t];
    float m = -1e30f, l = 0.f;
    for (int kp = 0; kp <= t; ++kp) {
        const long kr = (long)b * S_ + kp; float s = 0.f;
#pragma unroll
        for (int d = 0; d < 64; ++d) s += q[d] * proj(kr, OFF_KB, h * 64 + d);
        s = s * 0.125f + (cq - cp[kp]);
        const float mn = fmaxf(m, s), al = expf(m - mn), p = expf(s - mn);
        l = l * al + p;
#pragma unroll
        for (int d = 0; d < 64; ++d) o[d] = o[d] * al + p * proj(kr, OFF_VB, h * 64 + d);
        m = mn;
    }
    const float il = 1.0f / l;
#pragma unroll
    for (int d = 0; d < 64; ++d) omix[tok * DM + 512 + h * 64 + d] = o[d] * il;
}

__device__ __forceinline__ void d_mixnorm(long gid_, float* __restrict__ omix, const float* __restrict__ beta_nsa, const float* __restrict__ beta_fox) {
    long gid = gid_; if (gid >= (long)T_ * 2) return;
    const int half = (int)(gid % 2); float* v = omix + (gid / 2) * DM + half * 512; const float* be = half ? beta_fox : beta_nsa;
    float s = 0.f; for (int k = 0; k < 512; ++k) s += v[k] * v[k];
    const float r = 1.0f / sqrtf(s / 512 + EPS);
    for (int k = 0; k < 512; ++k) v[k] = v[k] * r * be[k];
}

__device__ __forceinline__ void d_router(long gid_, const float* __restrict__ H, const float* __restrict__ g_ffn, const float* __restrict__ w_group, const float* __restrict__ b_group,
                         const float* __restrict__ w_router, const float* __restrict__ b_router, float* __restrict__ U, int* __restrict__ eid, float* __restrict__ cw) {
    long tok = gid_; if (tok >= T_) return;
    const float* hr = H + tok * DM; float ss = 0.f;
    for (int k = 0; k < DM; ++k) ss += hr[k] * hr[k];
    const float rstd = 1.0f / sqrtf(ss / DM + EPS);
    float gl[4], el[16];
#pragma unroll
    for (int c = 0; c < 4; ++c) gl[c] = 0.f;
#pragma unroll
    for (int e = 0; e < 16; ++e) el[e] = 0.f;
    for (int k = 0; k < DM; ++k) {
        const float u = hr[k] * rstd * g_ffn[k]; U[tok * DM + k] = u;
#pragma unroll
        for (int c = 0; c < 4; ++c) gl[c] += u * w_group[k * 4 + c];
#pragma unroll
        for (int e = 0; e < 16; ++e) el[e] += u * w_router[k * 16 + e];
    }
#pragma unroll
    for (int c = 0; c < 4; ++c) gl[c] += b_group[c];
#pragma unroll
    for (int e = 0; e < 16; ++e) el[e] += b_router[e];
    int gs = 0; float gm = gl[0];
#pragma unroll
    for (int c = 1; c < 4; ++c) if (gl[c] > gm) { gm = gl[c]; gs = c; }
    float gsum = 0.f;
#pragma unroll
    for (int c = 0; c < 4; ++c) gsum += expf(gl[c] - gm);
    const float gprob = 1.0f / gsum;
    float il[4] = {0.f, 0.f, 0.f, 0.f};
#pragma unroll
    for (int c = 0; c < 4; ++c)
#pragma unroll
        for (int e = 0; e < 4; ++e) if (gs == c) il[e] = el[c * 4 + e];
    float im = il[0];
#pragma unroll
    for (int e = 1; e < 4; ++e) im = fmaxf(im, il[e]);
    float ipr[4], isum = 0.f;
#pragma unroll
    for (int e = 0; e < 4; ++e) { ipr[e] = expf(il[e] - im); isum += ipr[e]; }
#pragma unroll
    for (int e = 0; e < 4; ++e) ipr[e] /= isum;
    int i0 = 0; float v0 = ipr[0];
#pragma unroll
    for (int e = 1; e < 4; ++e) if (ipr[e] > v0) { v0 = ipr[e]; i0 = e; }
    int i1 = -1; float v1 = -1.f;
#pragma unroll
    for (int e = 0; e < 4; ++e) if (e != i0 && ipr[e] > v1) { v1 = ipr[e]; i1 = e; }
    const float den = v0 + v1;
    eid[tok * 2 + 0] = gs * 4 + i0; eid[tok * 2 + 1] = gs * 4 + i1;
    cw[tok * 2 + 0] = gprob * (v0 / den); cw[tok * 2 + 1] = gprob * (v1 / den);
}

__device__ __forceinline__ void d_expert_up(long gid_, const float* __restrict__ U, const int* __restrict__ eid, const float* __restrict__ wg, const float* __restrict__ wu, float* __restrict__ hid) {
    long gid = gid_; if (gid >= (long)T_ * 2 * 128) return;
    const int jg = (int)(gid % 128); const long tk = gid / 128; const long tok = tk / 2; const int e = eid[tk];
    const float* ur = U + tok * DM; const float* gp = wg + (long)e * DM * 512 + jg * 4; const float* up = wu + (long)e * DM * 512 + jg * 4;
    float ga[4] = {0.f, 0.f, 0.f, 0.f}, ua[4] = {0.f, 0.f, 0.f, 0.f};
    for (int i = 0; i < DM; ++i) {
        const float u = ur[i];
#pragma unroll
        for (int c = 0; c < 4; ++c) { ga[c] += u * gp[(long)i * 512 + c]; ua[c] += u * up[(long)i * 512 + c]; }
    }
#pragma unroll
    for (int c = 0; c < 4; ++c) hid[tk * 512 + jg * 4 + c] = nv_silu(ga[c]) * ua[c];
}
__device__ __forceinline__ void d_expert_down(long gid_, float* __restrict__ H, const int* __restrict__ eid, const float* __restrict__ cw, const float* __restrict__ wd, const float* __restrict__ hid) {
    long gid = gid_; if (gid >= (long)T_ * 256) return;
    const int cg = (int)(gid % 256); const long tok = gid / 256;
    float acc[4] = {0.f, 0.f, 0.f, 0.f};
    for (int k = 0; k < 2; ++k) {
        const int e = eid[tok * 2 + k]; const float w = cw[tok * 2 + k];
        const float* hp = hid + (tok * 2 + k) * 512; const float* dp = wd + (long)e * 512 * DM + cg * 4;
        float tmp[4] = {0.f, 0.f, 0.f, 0.f};
        for (int j = 0; j < 512; ++j) {
            const float hv = hp[j];
#pragma unroll
            for (int c = 0; c < 4; ++c) tmp[c] += hv * dp[(long)j * DM + c];
        }
#pragma unroll
        for (int c = 0; c < 4; ++c) acc[c] += w * tmp[c];
    }
#pragma unroll
    for (int c = 0; c < 4; ++c) H[tok * DM + cg * 4 + c] += acc[c];
}

__device__ __forceinline__ void d_final(long gid_, const float* __restrict__ H, float* __restrict__ G, const float* __restrict__ PP, const float* __restrict__ b_ple,
                        const float* __restrict__ g_final, float* __restrict__ out) {
    long tok = gid_; if (tok >= T_) return;
    float ss = 0.f;
    for (int c = 0; c < DM; ++c) {
        const float h3 = H[tok * DM + c] + nv_sigmoid(G[tok * DM + c] + b_ple[c]) * PP[tok * DM + c];
        G[tok * DM + c] = h3; ss += h3 * h3;
    }
    const float r = 1.0f / sqrtf(ss / DM + EPS);
    for (int c = 0; c < DM; ++c) out[tok * DM + c] = G[tok * DM + c] * r * g_final[c];
}

constexpr size_t MiB = 1u << 20;
constexpr size_t SZ_PROJ = (size_t)T_ * IN_COLS * 4, SZ_ACT = (size_t)T_ * DM * 4;
constexpr size_t A16(size_t x) { return (x + 255) / 256 * 256; }
constexpr size_t W_PROJ = 0;
constexpr size_t W_RSTD1 = A16(W_PROJ + SZ_PROJ);
constexpr size_t W_CUM = A16(W_RSTD1 + (size_t)T_ * 4);
constexpr size_t W_KC = A16(W_CUM + (size_t)T_ * 8 * 4);
constexpr size_t W_VC = A16(W_KC + (size_t)B_ * NCMP * 2 * 64 * 4);
constexpr size_t W_CMPH = A16(W_VC + (size_t)B_ * NCMP * 2 * 64 * 4);
constexpr size_t W_IMP = A16(W_CMPH + (size_t)B_ * NCMP * 2 * 128 * 4 * 2);
constexpr size_t W_SELM = A16(W_IMP + (size_t)B_ * 2 * S_ * 64 * 4);
constexpr size_t W_END1 = A16(W_SELM + (size_t)B_ * 2 * S_ * 8);
constexpr size_t W_H = 0, W_U = SZ_ACT, W_HID = 2 * SZ_ACT, W_EID = 3 * SZ_ACT, W_CW = A16(W_EID + (size_t)T_ * 8), W_RS3 = A16(W_CW + (size_t)T_ * 8),
                 W_END2 = A16(W_RS3 + (size_t)T_ * 4);
constexpr size_t W_PP = W_U, W_G = W_HID;
constexpr size_t W_TOTAL = W_END1 > W_END2 ? W_END1 : W_END2;


#ifndef NV_DBG
#define NV_DBG(name)
#endif
#ifndef CPU_EMU
template <auto F, class... A> __global__ void __launch_bounds__(256) k_wrap(long n, A... a) {
    const long gid = (long)blockIdx.x * (long)blockDim.x + (long)threadIdx.x; if (gid < n) F(gid, a...);
}
#endif
}
namespace pg8 {
#define PG8_LAS __attribute__((address_space(3)))
typedef unsigned short bf16_t;
typedef short bf16x8 __attribute__((ext_vector_type(8)));
typedef float f32x4 __attribute__((ext_vector_type(4)));
typedef unsigned u32x4 __attribute__((ext_vector_type(4)));
constexpr int BM = 256, BK = 64, HALF = 128, HTB = HALF * BK * 2  , STAGE_BYTES = 8 * HTB, NXCD = 8, WGM = 8;

__host__ __device__ __forceinline__ int lds_byte(int r, int c) { const int st = (r >> 4) * 2 + (c >> 5), rr = r & 15, cc = c & 31, ob = rr * 64 + cc * 2; return st * 1024 + (ob ^ (((ob >> 9) & 1) << 5)); }
__host__ __device__ __forceinline__ void stage_rc(int b, int& R, int& C) { const int st = b / 1024, sb = b % 1024, swz = sb ^ (((sb >> 9) & 1) << 5); R = (st >> 1) * 16 + swz / 64; C = (st & 1) * 32 + (swz % 64) / 2; }
__host__ __device__ __forceinline__ int perm32(int rho) { const int n = rho >> 4, i = rho & 15; return 8 * (i >> 2) + 4 * n + (i & 3); }

struct Unit { int pm, pn, be; };
struct Gemm { const bf16_t* A; const bf16_t* Bt; int M, N, K; size_t bstride; const int* rowidx; };

struct StaticOrder {
    int nM, nN, nwg, G, c;
    __host__ __device__ void init(int M, int N, int G_, int c_) { nM = M / BM; nN = N / BM; nwg = nM * nN; G = G_; c = c_; }
    __host__ __device__ bool next(int i, Unit& u) const {
        const long L = (long)i * G + c; if (L >= nwg) return false;
        int wgid = (int)L; { const int q = nwg / NXCD, r = nwg % NXCD, xcd = wgid % NXCD, off = wgid / NXCD; wgid = (xcd < r ? xcd * (q + 1) : r * (q + 1) + (xcd - r) * q) + off; }
        const int nig = WGM * nN, gid = wgid / nig, fm = gid * WGM, gsz = (nM - fm) < WGM ? (nM - fm) : WGM;
        u.pm = fm + ((wgid % nig) % gsz); u.pn = (wgid % nig) / gsz; u.be = 0; return true;
    }
    __device__ __forceinline__ void a_ready(const Unit&) const {}
    __device__ __forceinline__ void done(const Unit&) const {}
};

#define EPI_LANE_IDS() int t__ = threadIdx.x; asm volatile("" : "+v"(t__)); const int wid__ = __builtin_amdgcn_readfirstlane(t__ >> 6), lane__ = t__ & 63, wr = wid__ >> 2, wc = wid__ & 3, fr = lane__ & 15, fq = lane__ >> 4; (void)wr_; (void)wc_; (void)fr_; (void)fq_
__device__ __forceinline__ unsigned cvt_pk_bf16(float lo, float hi) { unsigned r; asm volatile("v_cvt_pk_bf16_f32 %0, %1, %2" : "=v"(r) : "v"(lo), "v"(hi)); return r; }
constexpr float C2 = 0.125f * 1.4426950408889634f;
constexpr int PB_COLS = 2816;
struct EpiInProj {
    static constexpr bool PERM = true, AFTER_DRAIN = false;
    bf16_t* O; const float* rope; float* gates; float* logf; const float* b_gate; const float* b_forget; float* hm; int dbg;
    __device__ __forceinline__ void operator()(const f32x4 (&acc)[2][2][4][2], const Unit& u, int wr_, int wc_, int fr_, int fq_) const {
        EPI_LANE_IDS();
        const int pn = u.pn, row0 = u.pm * BM + wr * 64 + fr;
        if (pn == 11) {
            if (wc != 0) return;
#pragma unroll
            for (int ai = 0; ai < 2; ++ai)
#pragma unroll
                for (int m = 0; m < 4; ++m) { const size_t row = (size_t)(row0 + ai * HALF + m * 16);
                    const f32x4 v0 = acc[ai][0][m][0], v1 = acc[ai][0][m][1];
                    float o[8] = {v0[0], v0[1], v0[2], v0[3], v1[0], v1[1], v1[2], v1[3]};
                    if (fq < 3) {
#pragma unroll
                        for (int i = 0; i < 8; ++i) { const float z = o[i] + b_gate[8 * fq + i]; o[i] = __builtin_amdgcn_rcpf(1.0f + __builtin_amdgcn_exp2f(-1.4426950408889634f * z)); }
                        *(f32x4*)(gates + row * 24 + 8 * fq) = (f32x4){o[0], o[1], o[2], o[3]}; *(f32x4*)(gates + row * 24 + 8 * fq + 4) = (f32x4){o[4], o[5], o[6], o[7]};
                    } else {
#pragma unroll
                        for (int i = 0; i < 8; ++i) { const float z = o[i] + b_forget[i]; o[i] = fminf(z, 0.f) - 0.6931471805599453f * __builtin_amdgcn_logf(1.0f + __builtin_amdgcn_exp2f(-1.4426950408889634f * fabsf(z))); }
                        *(f32x4*)(logf + row * 8) = (f32x4){o[0], o[1], o[2], o[3]}; *(f32x4*)(logf + row * 8 + 4) = (f32x4){o[4], o[5], o[6], o[7]};
                    } }
            return;
        }
        const int head = pn * 4 + wc;
        const bool roped = !(dbg & 2) && (head < 8 || head == 12 || head == 13 || head == 16 || head == 17);
        const int j = (dbg & 1) ? -1 : head < 8 ? head : head == 12 || head == 13 ? head - 4 : head == 16 || head == 17 ? head - 6 : head >= 20 && head < 36 ? head - 8 : -1;
        const float sc = (pn <= 1 || pn == 5 || pn == 6) ? C2 : 1.0f;
        const int col0 = head * 64 + 8 * fq; float nmax = 0.f;
#pragma unroll
        for (int ai = 0; ai < 2; ++ai) {
            f32x4 rc[4][4];
            if (roped && fq < 2) {
#pragma unroll
                for (int m = 0; m < 4; ++m) { const f32x4* rp = (const f32x4*)(rope + (size_t)(row0 + ai * HALF + m * 16) * 16); rc[m][0] = rp[0]; rc[m][1] = rp[1]; rc[m][2] = rp[2]; rc[m][3] = rp[3]; } }
#pragma unroll
            for (int m = 0; m < 4; ++m) { const size_t row = (size_t)(row0 + ai * HALF + m * 16); bf16_t* rowp = O + row * PB_COLS + col0; float q = 0.f;
#pragma unroll
                for (int bj = 0; bj < 2; ++bj) { f32x4 v0 = acc[ai][bj][m][0], v1 = acc[ai][bj][m][1];
                    if (bj == 0 && roped) {
                        f32x4 p0, p1;
#pragma unroll
                        for (int i = 0; i < 4; ++i) { p0[i] = lx::xf<16>(v0[i]); p1[i] = lx::xf<16>(v1[i]); }
                        if (fq < 2) {
                            const f32x4 a = rc[m][0], b = rc[m][1], c = rc[m][2], d = rc[m][3]; const float sg = fq == 0 ? -1.0f : 1.0f;
                            v0[0] = v0[0] * a[0] + sg * p0[0] * a[1]; v0[1] = v0[1] * a[2] + sg * p0[1] * a[3];
                            v0[2] = v0[2] * b[0] + sg * p0[2] * b[1]; v0[3] = v0[3] * b[2] + sg * p0[3] * b[3];
                            v1[0] = v1[0] * c[0] + sg * p1[0] * c[1]; v1[1] = v1[1] * c[2] + sg * p1[1] * c[3];
                            v1[2] = v1[2] * d[0] + sg * p1[2] * d[1]; v1[3] = v1[3] * d[2] + sg * p1[3] * d[3];
                        }
                    }
                    v0 = v0 * sc; v1 = v1 * sc; u32x4 w; w.x = cvt_pk_bf16(v0[0], v0[1]); w.y = cvt_pk_bf16(v0[2], v0[3]); w.z = cvt_pk_bf16(v1[0], v1[1]); w.w = cvt_pk_bf16(v1[2], v1[3]);
                    *(u32x4*)(rowp + bj * 32) = w;
                    if (j >= 0) q += (v0[0] * v0[0] + v0[1] * v0[1]) + (v0[2] * v0[2] + v0[3] * v0[3]) + (v1[0] * v1[0] + v1[1] * v1[1]) + (v1[2] * v1[2] + v1[3] * v1[3]); }
                if (j >= 0) { q += lx::xf<16>(q); { auto rr = __builtin_amdgcn_permlane32_swap(__float_as_uint(q), __float_as_uint(q), false, false); q = __uint_as_float(rr[0]) + __uint_as_float(rr[1]); }
                    nmax = fmaxf(nmax, q); } } }
        if (j >= 0) { float q = nmax; q = fmaxf(q, lx::xf<1>(q)); q = fmaxf(q, lx::xf<2>(q)); q = fmaxf(q, lx::xf<4>(q)); q = fmaxf(q, lx::xf<8>(q));
            if (lane__ == 0) hm[((size_t)u.pm * 2 + wr) * 28 + j] = q * 1.02f; }
    }
};

struct EpiResF32 {
    static constexpr bool PERM = false, AFTER_DRAIN = false;
    const float* res; float* out; int ldc;
    __device__ __forceinline__ void operator()(const f32x4 (&acc)[2][2][4][2], const Unit& u, int wr_, int wc_, int fr_, int fq_) const {
        EPI_LANE_IDS();
        const int col0 = u.pn * BM + wc * 32 + 4 * fq;
#pragma unroll
        for (int ai = 0; ai < 2; ++ai) {
            f32x4 r[4][2][2];
#pragma unroll
            for (int m = 0; m < 4; ++m) { const size_t off = (size_t)(u.pm * BM + ai * HALF + wr * 64 + m * 16 + fr) * ldc + col0;
#pragma unroll
                for (int bj = 0; bj < 2; ++bj)
#pragma unroll
                    for (int n = 0; n < 2; ++n) r[m][bj][n] = *(const f32x4*)(res + off + bj * HALF + n * 16); }
#pragma unroll
            for (int m = 0; m < 4; ++m) { const size_t off = (size_t)(u.pm * BM + ai * HALF + wr * 64 + m * 16 + fr) * ldc + col0;
#pragma unroll
                for (int bj = 0; bj < 2; ++bj)
#pragma unroll
                    for (int n = 0; n < 2; ++n) *(f32x4*)(out + off + bj * HALF + n * 16) = acc[ai][bj][m][n] + r[m][bj][n]; } }
    }
};
struct EpiPleGate {
    static constexpr bool PERM = false, AFTER_DRAIN = false;
    float* io; const bf16_t* pp; const float* bias; int ldc;
    __device__ __forceinline__ void operator()(const f32x4 (&acc)[2][2][4][2], const Unit& u, int wr_, int wc_, int fr_, int fq_) const {
        EPI_LANE_IDS();
        typedef unsigned u32x2v __attribute__((ext_vector_type(2)));
        const int col0 = u.pn * BM + wc * 32 + 4 * fq;
#pragma unroll
        for (int ai = 0; ai < 2; ++ai)
#pragma unroll
            for (int m = 0; m < 4; ++m) { const size_t off = (size_t)(u.pm * BM + ai * HALF + wr * 64 + m * 16 + fr) * ldc + col0;
#pragma unroll
                for (int bj = 0; bj < 2; ++bj)
#pragma unroll
                    for (int n = 0; n < 2; ++n) { const size_t o = off + bj * HALF + n * 16; const f32x4 h = *(const f32x4*)(io + o); const u32x2v pw = *(const u32x2v*)(pp + o);
                        const f32x4 bv = *(const f32x4*)(bias + col0 + bj * HALF + n * 16); const f32x4 z = acc[ai][bj][m][n] + bv; f32x4 r;
                        r[0] = h[0] + __builtin_bit_cast(float, pw.x << 16) * __builtin_amdgcn_rcpf(1.0f + __builtin_amdgcn_exp2f(-1.4426950408889634f * z[0])); r[1] = h[1] + __builtin_bit_cast(float, pw.x & 0xffff0000u) * __builtin_amdgcn_rcpf(1.0f + __builtin_amdgcn_exp2f(-1.4426950408889634f * z[1]));
                        r[2] = h[2] + __builtin_bit_cast(float, pw.y << 16) * __builtin_amdgcn_rcpf(1.0f + __builtin_amdgcn_exp2f(-1.4426950408889634f * z[2])); r[3] = h[3] + __builtin_bit_cast(float, pw.y & 0xffff0000u) * __builtin_amdgcn_rcpf(1.0f + __builtin_amdgcn_exp2f(-1.4426950408889634f * z[3]));
                        *(f32x4*)(io + o) = r; } }
    }
};

struct EpiBf16Plain {
    static constexpr bool PERM = true, AFTER_DRAIN = false;
    bf16_t* O; int ldc;
    __device__ __forceinline__ void operator()(const f32x4 (&acc)[2][2][4][2], const Unit& u, int wr_, int wc_, int fr_, int fq_) const {
        EPI_LANE_IDS();
        const int row0 = u.pm * BM + wr * 64 + fr, col0 = u.pn * BM + wc * 32 + 8 * fq;
#pragma unroll
        for (int ai = 0; ai < 2; ++ai)
#pragma unroll
            for (int m = 0; m < 4; ++m) { bf16_t* rowp = O + (size_t)(row0 + ai * HALF + m * 16) * ldc + col0;
#pragma unroll
                for (int bj = 0; bj < 2; ++bj) { const f32x4 v0 = acc[ai][bj][m][0], v1 = acc[ai][bj][m][1];
                    u32x4 w; w.x = cvt_pk_bf16(v0[0], v0[1]); w.y = cvt_pk_bf16(v0[2], v0[3]); w.z = cvt_pk_bf16(v1[0], v1[1]); w.w = cvt_pk_bf16(v1[2], v1[3]);
                    *(u32x4*)(rowp + bj * HALF) = w; } }
    }
};

struct EpiSwiGlu {
    static constexpr bool PERM = true, AFTER_DRAIN = false;
    bf16_t* O;
    __device__ __forceinline__ void operator()(const f32x4 (&acc)[2][2][4][2], const Unit& u, int wr_, int wc_, int fr_, int fq_) const {
        EPI_LANE_IDS();
        typedef unsigned u32x2v __attribute__((ext_vector_type(2)));
        const int row0 = u.pm * BM + wr * 64 + fr, col0 = u.pn * 128 + wc * 16 + 4 * fq;
#pragma unroll
        for (int ai = 0; ai < 2; ++ai)
#pragma unroll
            for (int m = 0; m < 4; ++m) { bf16_t* rowp = O + (size_t)(row0 + ai * HALF + m * 16) * 512 + col0;
#pragma unroll
                for (int bj = 0; bj < 2; ++bj) { const f32x4 g = acc[ai][bj][m][0], v = acc[ai][bj][m][1]; float h[4];
#pragma unroll
                    for (int i = 0; i < 4; ++i) h[i] = g[i] * __builtin_amdgcn_rcpf(1.0f + __builtin_amdgcn_exp2f(-1.4426950408889634f * g[i])) * v[i];
                    u32x2v w; w.x = cvt_pk_bf16(h[0], h[1]); w.y = cvt_pk_bf16(h[2], h[3]); *(u32x2v*)(rowp + bj * 64) = w; } }
    }
};
struct GroupOrder {
    int nM, nN, nwg, G, c; const int* tile_e;
    __device__ void init(int nM_, int nN_, int G_, int c_, const int* te) { nM = nM_; nN = nN_; nwg = nM * nN; G = G_; c = c_; tile_e = te; }
    __device__ bool next(int i, Unit& u) const {
        const long L = (long)i * G + c; if (L >= nwg) return false;
        int wgid = (int)L; { const int q = nwg / NXCD, r = nwg % NXCD, xcd = wgid % NXCD, off = wgid / NXCD; wgid = (xcd < r ? xcd * (q + 1) : r * (q + 1) + (xcd - r) * q) + off; }
        const int nig = WGM * nN, gid = wgid / nig, fm = gid * WGM, gsz = (nM - fm) < WGM ? (nM - fm) : WGM;
        u.pm = fm + ((wgid % nig) % gsz); u.pn = (wgid % nig) / gsz; u.be = __builtin_amdgcn_readfirstlane(tile_e[u.pm]); return true;
    }
    __device__ __forceinline__ void a_ready(const Unit&) const {}
    __device__ __forceinline__ void done(const Unit&) const {}
};

struct EpiPleGateNorm {
    static constexpr bool PERM = false, AFTER_DRAIN = false;
    float* io; const bf16_t* pp; const float* bias; const float* gfin; float* xs; unsigned* cnt; PG8_LAS unsigned char* scr; int ldc;
    __device__ __forceinline__ void operator()(f32x4 (&acc)[2][2][4][2], const Unit& u, int wr_, int wc_, int fr_, int fq_) const {
        typedef unsigned u32x2v __attribute__((ext_vector_type(2)));
        int t__ = threadIdx.x; asm volatile("" : "+v"(t__)); const int tid = t__, wid = __builtin_amdgcn_readfirstlane(tid >> 6), lane = tid & 63, wr = wid >> 2, wc = wid & 3, fr = lane & 15, fq = lane >> 4; (void)wr_; (void)wc_; (void)fr_; (void)fq_;
        PG8_LAS float* P = (PG8_LAS float*)scr; PG8_LAS float* S = (PG8_LAS float*)(scr + 4096); PG8_LAS unsigned* flag = (PG8_LAS unsigned*)(scr + 5120);
        const int col0 = u.pn * BM + wc * 32 + 4 * fq;
#pragma unroll
        for (int ai = 0; ai < 2; ++ai)
#pragma unroll
            for (int m = 0; m < 4; ++m) { const int rl = ai * HALF + wr * 64 + m * 16 + fr; const size_t off = (size_t)(u.pm * BM + rl) * ldc + col0; float q = 0.f;
#pragma unroll
                for (int bj = 0; bj < 2; ++bj)
#pragma unroll
                    for (int n = 0; n < 2; ++n) { const size_t o = off + bj * HALF + n * 16; const f32x4 h = *(const f32x4*)(io + o); const u32x2v pw = *(const u32x2v*)(pp + o);
                        const f32x4 bv = *(const f32x4*)(bias + col0 + bj * HALF + n * 16); const f32x4 z = acc[ai][bj][m][n] + bv; f32x4 r;
                        r[0] = h[0] + __builtin_bit_cast(float, pw.x << 16) * __builtin_amdgcn_rcpf(1.0f + __builtin_amdgcn_exp2f(-1.4426950408889634f * z[0])); r[1] = h[1] + __builtin_bit_cast(float, pw.x & 0xffff0000u) * __builtin_amdgcn_rcpf(1.0f + __builtin_amdgcn_exp2f(-1.4426950408889634f * z[1]));
                        r[2] = h[2] + __builtin_bit_cast(float, pw.y << 16) * __builtin_amdgcn_rcpf(1.0f + __builtin_amdgcn_exp2f(-1.4426950408889634f * z[2])); r[3] = h[3] + __builtin_bit_cast(float, pw.y & 0xffff0000u) * __builtin_amdgcn_rcpf(1.0f + __builtin_amdgcn_exp2f(-1.4426950408889634f * z[3]));
                        acc[ai][bj][m][n] = r; q += (r[0] * r[0] + r[1] * r[1]) + (r[2] * r[2] + r[3] * r[3]); }
                q += lx::xf<16>(q); { auto rr = __builtin_amdgcn_permlane32_swap(__float_as_uint(q), __float_as_uint(q), false, false); q = __uint_as_float(rr[0]) + __uint_as_float(rr[1]); }
                if (fq == 0) P[rl * 4 + wc] = q; }
        asm volatile("s_waitcnt lgkmcnt(0)\n\ts_barrier" ::: "memory");
        unsigned* cw = cnt + 64 * u.pm;
        if (tid < 256) { const float tot = (P[tid * 4] + P[tid * 4 + 1]) + (P[tid * 4 + 2] + P[tid * 4 + 3]);
            __hip_atomic_store(xs + (size_t)(u.pm * BM + tid) * 4 + u.pn, tot, __ATOMIC_RELAXED, __HIP_MEMORY_SCOPE_AGENT);
            asm volatile("s_waitcnt vmcnt(0)" ::: "memory");
            if (lane == 0) __hip_atomic_fetch_add(cw, 1u, __ATOMIC_RELAXED, __HIP_MEMORY_SCOPE_AGENT); }
        if (wid == 0) { unsigned sp = 0;
            while ((unsigned)__builtin_amdgcn_readfirstlane(__hip_atomic_load(cw, __ATOMIC_RELAXED, __HIP_MEMORY_SCOPE_AGENT)) < 16u && ++sp < (1u << 24)) __builtin_amdgcn_s_sleep(2);
            __builtin_amdgcn_fence(__ATOMIC_ACQUIRE, "agent");
            if (lane == 0) flag[0] = sp; }
        asm volatile("s_waitcnt vmcnt(0) lgkmcnt(0)\n\ts_barrier" ::: "memory");
        if (tid < 256) { const float* sl = xs + (size_t)(u.pm * BM + tid) * 4; float s4[4];
#pragma unroll
            for (int t = 0; t < 4; ++t) s4[t] = __hip_atomic_load(sl + t, __ATOMIC_RELAXED, __HIP_MEMORY_SCOPE_AGENT);
            S[tid] = 1.0f / sqrtf(((s4[0] + s4[1]) + (s4[2] + s4[3])) * (1.0f / 1024.0f) + 1e-6f); }
        asm volatile("s_waitcnt lgkmcnt(0)\n\ts_barrier" ::: "memory");
#pragma unroll
        for (int ai = 0; ai < 2; ++ai)
#pragma unroll
            for (int m = 0; m < 4; ++m) { const int rl = ai * HALF + wr * 64 + m * 16 + fr; const size_t off = (size_t)(u.pm * BM + rl) * ldc + col0; const float rs = S[rl];
#pragma unroll
                for (int bj = 0; bj < 2; ++bj)
#pragma unroll
                    for (int n = 0; n < 2; ++n) { const f32x4 g = *(const f32x4*)(gfin + col0 + bj * HALF + n * 16); *(f32x4*)(io + off + bj * HALF + n * 16) = acc[ai][bj][m][n] * rs * g; } }
    }
};

struct EpiNull {
    static constexpr bool PERM = true, AFTER_DRAIN = false;
    __device__ __forceinline__ void operator()(const f32x4 (&acc)[2][2][4][2], const Unit&, int, int, int, int) const {
#pragma unroll
        for (int a = 0; a < 2; ++a)
#pragma unroll
            for (int b = 0; b < 2; ++b)
#pragma unroll
                for (int m = 0; m < 4; ++m) asm volatile("" :: "v"(acc[a][b][m][0]), "v"(acc[a][b][m][1]));
    }
};
template <class Epi, class Sched, bool ALIGN_EPI = false, bool SP2 = false, bool GATHER = false>
__device__ __forceinline__ void gemm_phase(PG8_LAS unsigned char* lds, const Gemm g, const Sched& S, const Epi& E) {
    int tid_ = threadIdx.x; asm volatile("" : "+v"(tid_));
    const int tid = tid_, wid = __builtin_amdgcn_readfirstlane(tid >> 6), lane = tid & 63, wr = wid >> 2, wc = wid & 3, fr = lane & 15, fq = lane >> 4;
    const int K = g.K, nt = K / BK;
    unsigned voffA[2], voffB[2];
#pragma unroll
    for (int i = 0; i < 2; ++i) { int R, C; stage_rc(tid * 16 + i * 8192, R, C); const int Rb = Epi::PERM ? ((R & ~31) + perm32(R & 31)) : R;
        voffA[i] = (unsigned)(R * K + C) * 2u; voffB[i] = (unsigned)(Rb * K + C) * 2u; }
    static_assert(!GATHER || SP2, "GATHER is wired into the two-super-phase loop only");
    unsigned gC[2][2] = {{0u, 0u}, {0u, 0u}}, gN[2][2] = {{0u, 0u}, {0u, 0u}};
#define PG8_GOFF(dst, u_) do { _Pragma("unroll") for (int h_ = 0; h_ < 2; ++h_) _Pragma("unroll") for (int i_ = 0; i_ < 2; ++i_) { int R_, C_; stage_rc(tid * 16 + i_ * 8192, R_, C_); \
        dst[h_][i_] = (unsigned)g.rowidx[(u_).pm * BM + h_ * HALF + R_] * (unsigned)(K * 2) + (unsigned)(C_ * 2); } } while (0)
    const size_t kstep = (size_t)(BK * 2);
    const size_t hstep = (size_t)HALF * K * 2;
    const size_t hstepA = GATHER ? 0 : hstep;
    const size_t tstep = 2 * hstep;
    const unsigned ldsw = (unsigned)wid * 1024u;
    const int aoff = lds_byte(wr * 64 + fr, fq * 8), boff = lds_byte(wc * 32 + fr, fq * 8);
#define PG8_SA(b, h) (((b) * 2 + (h)) * HTB)
#define PG8_SB(b, h) ((4 + (b) * 2 + (h)) * HTB)
#define PG8_STAGE(bufoff, gbase, voff) do { _Pragma("unroll") for (int _i = 0; _i < 2; ++_i) \
        __builtin_amdgcn_global_load_lds((const unsigned*)((const char*)(gbase) + (voff)[_i]), (PG8_LAS unsigned*)(lds + (bufoff) + ldsw + _i * 8192), 16, 0, 0); } while (0)
#define PG8_LDA(dst, b, h) do { _Pragma("unroll") for (int m = 0; m < 4; ++m) _Pragma("unroll") for (int k = 0; k < 2; ++k) dst[m][k] = *(const PG8_LAS bf16x8*)(lds + PG8_SA(b, h) + aoff + m * 2048 + k * 1024); } while (0)
#define PG8_LDB(dst, b, h) do { _Pragma("unroll") for (int n = 0; n < 2; ++n) _Pragma("unroll") for (int k = 0; k < 2; ++k) dst[n][k] = *(const PG8_LAS bf16x8*)(lds + PG8_SB(b, h) + boff + n * 2048 + k * 1024); } while (0)
#define PG8_MMA(ai, bj, At, Bt) do { __builtin_amdgcn_s_setprio(1); _Pragma("unroll") for (int m = 0; m < 4; ++m) _Pragma("unroll") for (int n = 0; n < 2; ++n) _Pragma("unroll") for (int k = 0; k < 2; ++k) \
        acc[ai][bj][m][n] = __builtin_amdgcn_mfma_f32_16x16x32_bf16(Bt[n][k], At[m][k], acc[ai][bj][m][n], 0, 0, 0); __builtin_amdgcn_s_setprio(0); } while (0)
#define PG8_WAIT_V(n) asm volatile("s_waitcnt vmcnt(" #n ")" ::: "memory")
#define PG8_WAIT_L(n) asm volatile("s_waitcnt lgkmcnt(" #n ")" ::: "memory")
#define PG8_BAR __builtin_amdgcn_s_barrier()
#define PG8_SCHED __builtin_amdgcn_sched_barrier(0)
    Unit cur, nxt; int ui = 0;
    if (!S.next(0, cur)) return;
    f32x4 acc[2][2][4][2];
#pragma unroll
    for (int a = 0; a < 2; ++a)
#pragma unroll
        for (int b = 0; b < 2; ++b)
#pragma unroll
            for (int m = 0; m < 4; ++m)
#pragma unroll
                for (int n = 0; n < 2; ++n) acc[a][b][m][n] = (f32x4){0.f, 0.f, 0.f, 0.f};
    bf16x8 At[4][2], B0[2][2], B1[2][2];
    const char* cA = (const char*)g.A + (GATHER ? (size_t)0 : (size_t)cur.pm * tstep); if (GATHER) PG8_GOFF(gC, cur);
    const char* cB = (const char*)g.Bt + (size_t)cur.pn * tstep + (size_t)cur.be * g.bstride;
    S.a_ready(cur);
    if constexpr (SP2) {
        PG8_STAGE(PG8_SB(0, 0), cB, voffB); PG8_STAGE(PG8_SB(0, 1), cB + hstep, voffB); PG8_STAGE(PG8_SA(0, 0), cA, (GATHER ? gC[0] : voffA)); PG8_STAGE(PG8_SA(0, 1), cA + hstepA, (GATHER ? gC[1] : voffA));
        if (wr == 1) PG8_BAR;
        PG8_WAIT_V(2); PG8_BAR;
        PG8_STAGE(PG8_SB(1, 0), cB + kstep, voffB); PG8_STAGE(PG8_SA(1, 0), cA + kstep, (GATHER ? gC[0] : voffA)); PG8_STAGE(PG8_SB(1, 1), cB + hstep + kstep, voffB);
        PG8_WAIT_V(6); PG8_BAR;
    } else {
        PG8_STAGE(PG8_SB(0, 0), cB, voffB); PG8_STAGE(PG8_SA(0, 0), cA, voffA); PG8_STAGE(PG8_SB(0, 1), cB + hstep, voffB); PG8_STAGE(PG8_SA(0, 1), cA + hstep, voffA);
        if (wr == 1) PG8_BAR;
        PG8_WAIT_V(4); PG8_BAR;
        PG8_STAGE(PG8_SB(1, 0), cB + kstep, voffB); PG8_STAGE(PG8_SA(1, 0), cA + kstep, voffA); PG8_STAGE(PG8_SB(1, 1), cB + hstep + kstep, voffB);
        PG8_WAIT_V(6); PG8_BAR;
    }
    for (;;) {
        const bool has_next = S.next(ui + 1, nxt);
        if (GATHER) { if (has_next) PG8_GOFF(gN, nxt); else { gN[0][0] = gC[0][0]; gN[0][1] = gC[0][1]; gN[1][0] = gC[1][0]; gN[1][1] = gC[1][1]; } }
        const char* nA = (has_next && !GATHER) ? (const char*)g.A + (size_t)nxt.pm * tstep : cA; const char* nB = has_next ? (const char*)g.Bt + (size_t)nxt.pn * tstep + (size_t)nxt.be * g.bstride : cB;
        for (int t = 0; t < nt; t += 2) {
            const bool last = (t == nt - 2);
            const char* a1 = cA + (size_t)(t + 1) * kstep;
            const char* a2 = last ? nA : cA + (size_t)(t + 2) * kstep; const char* b2 = last ? nB : cB + (size_t)(t + 2) * kstep;
            const char* a3 = a2 + kstep; const char* b3 = b2 + kstep;
            if (last && has_next) S.a_ready(nxt);
            if constexpr (SP2) {
            unsigned g2[2][2];
            if (GATHER) { g2[0][0] = last ? gN[0][0] : gC[0][0]; g2[0][1] = last ? gN[0][1] : gC[0][1]; g2[1][0] = last ? gN[1][0] : gC[1][0]; g2[1][1] = last ? gN[1][1] : gC[1][1]; }
            PG8_LDB(B0, 0, 0); PG8_LDB(B1, 0, 1); PG8_SCHED; PG8_LDA(At, 0, 0); PG8_STAGE(PG8_SA(1, 1), a1 + hstepA, (GATHER ? gC[1] : voffA));
            PG8_WAIT_V(8); PG8_WAIT_L(0); PG8_BAR; PG8_MMA(0, 0, At, B0); PG8_MMA(0, 1, At, B1); PG8_BAR; PG8_SCHED;
            PG8_LDA(At, 0, 1); PG8_STAGE(PG8_SB(0, 0), b2, voffB); PG8_STAGE(PG8_SB(0, 1), b2 + hstep, voffB); PG8_STAGE(PG8_SA(0, 0), a2, (GATHER ? g2[0] : voffA));
            PG8_WAIT_V(8); PG8_WAIT_L(0); PG8_BAR; PG8_MMA(1, 0, At, B0); PG8_MMA(1, 1, At, B1); PG8_BAR; PG8_SCHED;
            PG8_LDB(B0, 1, 0); PG8_LDB(B1, 1, 1); PG8_SCHED; PG8_LDA(At, 1, 0); PG8_STAGE(PG8_SA(0, 1), a2 + hstepA, (GATHER ? g2[1] : voffA));
            PG8_WAIT_V(8); PG8_WAIT_L(0); PG8_BAR; PG8_MMA(0, 0, At, B0); PG8_MMA(0, 1, At, B1); PG8_BAR; PG8_SCHED;
            PG8_LDA(At, 1, 1); PG8_STAGE(PG8_SB(1, 0), b3, voffB); PG8_STAGE(PG8_SB(1, 1), b3 + hstep, voffB); PG8_STAGE(PG8_SA(1, 0), a3, (GATHER ? g2[0] : voffA));
            PG8_WAIT_V(8); PG8_WAIT_L(0); PG8_BAR; PG8_MMA(1, 0, At, B0); PG8_MMA(1, 1, At, B1); PG8_BAR; PG8_SCHED;
            } else {
            PG8_LDB(B0, 0, 0); PG8_SCHED; PG8_LDA(At, 0, 0); PG8_STAGE(PG8_SA(1, 1), a1 + hstep, voffA);
            PG8_WAIT_L(8); PG8_BAR; PG8_WAIT_L(0); PG8_MMA(0, 0, At, B0); PG8_BAR; PG8_SCHED;
            PG8_LDB(B1, 0, 1); PG8_STAGE(PG8_SB(0, 0), b2, voffB);
            PG8_BAR; PG8_WAIT_L(0); PG8_MMA(0, 1, At, B1); PG8_BAR;
            PG8_LDA(At, 0, 1); PG8_STAGE(PG8_SA(0, 0), a2, voffA);
            PG8_BAR; PG8_WAIT_L(0); PG8_MMA(1, 0, At, B0); PG8_BAR; PG8_SCHED;
            PG8_STAGE(PG8_SB(0, 1), b2 + hstep, voffB);
            PG8_WAIT_V(6); PG8_BAR; PG8_MMA(1, 1, At, B1); PG8_BAR;
            PG8_LDB(B0, 1, 0); PG8_SCHED; PG8_LDA(At, 1, 0); PG8_STAGE(PG8_SA(0, 1), a2 + hstep, voffA);
            PG8_WAIT_L(8); PG8_BAR; PG8_WAIT_L(0); PG8_MMA(0, 0, At, B0); PG8_BAR; PG8_SCHED;
            PG8_LDB(B1, 1, 1); PG8_STAGE(PG8_SB(1, 0), b3, voffB);
            PG8_BAR; PG8_WAIT_L(0); PG8_MMA(0, 1, At, B1); PG8_BAR;
            PG8_LDA(At, 1, 1); PG8_STAGE(PG8_SA(1, 0), a3, voffA);
            PG8_BAR; PG8_WAIT_L(0); PG8_MMA(1, 0, At, B0); PG8_BAR; PG8_SCHED;
            PG8_STAGE(PG8_SB(1, 1), b3 + hstep, voffB);
            PG8_WAIT_V(6); PG8_BAR; PG8_MMA(1, 1, At, B1); PG8_BAR;
            }
        }
        if constexpr (ALIGN_EPI) { if (wr == 0) PG8_BAR; }
        if constexpr (!Epi::AFTER_DRAIN) { E(acc, cur, wr, wc, fr, fq); S.done(cur); }
        if (!has_next) break;
#pragma unroll
        for (int a = 0; a < 2; ++a)
#pragma unroll
            for (int b = 0; b < 2; ++b)
#pragma unroll
                for (int m = 0; m < 4; ++m)
#pragma unroll
                    for (int n = 0; n < 2; ++n) acc[a][b][m][n] = (f32x4){0.f, 0.f, 0.f, 0.f};
        cur = nxt; cA = nA; cB = nB; ++ui; if (GATHER) { gC[0][0] = gN[0][0]; gC[0][1] = gN[0][1]; gC[1][0] = gN[1][0]; gC[1][1] = gN[1][1]; }
        if constexpr (ALIGN_EPI) { if (wr == 1) PG8_BAR; }
    }
    PG8_WAIT_V(0);
    if constexpr (!ALIGN_EPI) { if (wr == 0) PG8_BAR; }
    PG8_BAR;
    if constexpr (Epi::AFTER_DRAIN) { E.fused(acc, cur, wr, wc, fr, fq, lds, wid, lane); S.done(cur); }
#undef PG8_GOFF
#undef PG8_SA
#undef PG8_SB
#undef PG8_STAGE
#undef PG8_LDA
#undef PG8_LDB
#undef PG8_MMA
#undef PG8_WAIT_V
#undef PG8_WAIT_L
#undef PG8_BAR
#undef PG8_SCHED
}
}
namespace at {
using bf16x8 = __attribute__((ext_vector_type(8))) short;
using s16x4 = __attribute__((ext_vector_type(4))) short;
using f32x16 = __attribute__((ext_vector_type(16))) float;
using f32x4 = __attribute__((ext_vector_type(4))) float;
using u32x4 = __attribute__((ext_vector_type(4))) unsigned;
typedef unsigned short bf16;
constexpr int PITCH = 2816;
constexpr int NSLOT = 4, SLOTB = 8192;
constexpr int NVSLOT = 5;
constexpr int LDS_K = 0, LDS_V = NSLOT * SLOTB, LDS_WS = LDS_V + NVSLOT * SLOTB, LDS_CK = LDS_WS + 8 * 256, LDS_END = LDS_CK + 16384;
constexpr float NEG = -1e30f;
constexpr float THR = 8.0f;
typedef __attribute__((address_space(3))) const char* lds_cptr;
typedef short v4i16_t __attribute__((ext_vector_type(4)));
__device__ __forceinline__ int crow(int r, int hi) { return (r & 3) + 8 * (r >> 2) + 4 * hi; }
__device__ __forceinline__ void glds16(const void* gsrc, unsigned lds_dst) { unsigned keep;
    asm volatile("s_mov_b32 %0, m0\n\ts_mov_b32 m0, %2\n\ts_nop 0\n\tglobal_load_lds_dwordx4 %1, off\n\ts_mov_b32 m0, %0" : "=&s"(keep) : "v"(gsrc), "s"(lds_dst) : "memory"); }
typedef float f32x2_t __attribute__((ext_vector_type(2))); typedef __bf16 bf16x2_t __attribute__((ext_vector_type(2)));
__device__ __forceinline__ unsigned cvtpk(float lo, float hi) { f32x2_t v = {lo, hi}; bf16x2_t b = __builtin_convertvector(v, bf16x2_t); return __builtin_bit_cast(unsigned, b); }
__device__ __forceinline__ s16x4 vtr(lds_cptr p) { return __builtin_bit_cast(s16x4, __builtin_amdgcn_ds_read_tr16_b64_v4i16((__attribute__((address_space(3))) v4i16_t*)p)); }
#define AT_WAIT_BAR(N) asm volatile("s_waitcnt vmcnt(" #N ") lgkmcnt(0)\n\ts_barrier" ::: "memory")

enum { M_FOX = 0, M_SEL = 1, M_WIN = 2 };
struct UnitIO {
    const bf16* Qw;
    const bf16* Kh;
    const bf16* Vh;
    int t_hi, t_lo;
    int t_first;
    int qpos;
    unsigned long long selm;
    int win;
    float sbound, c2q0;
    float cq;
};
template <int MODE, bool FAST, int ABL = 0>
__device__ __forceinline__ void attn_tiles(const UnitIO& U, char* shm, f32x16 (&o)[2], float& l_out, f32x16& osum) {
    int tid_ = threadIdx.x; asm volatile("" : "+v"(tid_));
    const int tid = tid_, lane = tid & 63, r32 = lane & 31, hi = lane >> 5; const int wid = __builtin_amdgcn_readfirstlane(tid >> 6);
    const unsigned lds0 = (unsigned)(uintptr_t)shm;
    float* wsf = (float*)(shm + LDS_WS) + wid * 64;
    const bf16* ksrc = U.Kh + (long)lane * PITCH + wid * 8;
    const bf16* vsrc = U.Vh + (long)(16 * (wid & 3) + (lane >> 2)) * PITCH + (wid >> 2) * 32 + (lane & 3) * 8;
    const unsigned kdst = lds0 + LDS_K + wid * 1024, vdst = lds0 + LDS_V + wid * 1024;
#define AT_DMA(t, kslot, vslot) do { glds16(ksrc + (long)(t) * 64 * PITCH, (unsigned)__builtin_amdgcn_readfirstlane(kdst + (kslot) * SLOTB)); \
                                     glds16(vsrc + (long)(t) * 64 * PITCH, (unsigned)__builtin_amdgcn_readfirstlane(vdst + (vslot) * SLOTB)); } while (0)
    const lds_cptr shm3 = (lds_cptr)shm;
    const lds_cptr kp0 = shm3 + LDS_K + hi * 1024 + r32 * 16;
    const lds_cptr vp0 = shm3 + LDS_V + ((lane >> 4) & 1) * 32 + (lane & 3) * 8 + (4 * hi + ((lane & 15) >> 2)) * 64;
    const int n = U.t_hi - U.t_lo + 1;
    AT_DMA(U.t_hi, 0, 0); if (n > 1) AT_DMA(U.t_hi - 1, 1, 1); if (n > 2) AT_DMA(U.t_hi - 2, 2, 2);
    bf16x8 qr[4];
#pragma unroll
    for (int d0 = 0; d0 < 4; ++d0) qr[d0] = *reinterpret_cast<const bf16x8*>(&U.Qw[(long)r32 * PITCH + d0 * 16 + hi * 8]);
    float mref = 0.f, l = 0.f; o[0] = f32x16{}; o[1] = f32x16{};
    f32x16 negm = f32x16{};
    if (FAST && MODE == M_FOX) {
#pragma unroll
        for (int r = 0; r < 16; ++r) negm[r] = U.cq; }
    osum = f32x16{};
    const bool lag = FAST && ABL == 0 && wid >= 4;
    u32x4 pw0, pw1, pw2, pw3; bool pend = false; int vslot_pend = 0;
#define AT_PV(vslot_) do { const lds_cptr vp = vp0 + (vslot_) * SLOTB; \
        _Pragma("unroll") for (int d0 = 0; d0 < 2; ++d0) { s16x4 lo[4], hh[4]; \
            _Pragma("unroll") for (int ks = 0; ks < 4; ++ks) { lo[ks] = vtr(vp + d0 * 4096 + ks * 1024); hh[ks] = vtr(vp + d0 * 4096 + ks * 1024 + 512); } \
            o[d0] = __builtin_amdgcn_mfma_f32_32x32x16_bf16(__builtin_bit_cast(bf16x8, pw0), AT_PK(0), o[d0], 0, 0, 0); \
            o[d0] = __builtin_amdgcn_mfma_f32_32x32x16_bf16(__builtin_bit_cast(bf16x8, pw1), AT_PK(1), o[d0], 0, 0, 0); \
            o[d0] = __builtin_amdgcn_mfma_f32_32x32x16_bf16(__builtin_bit_cast(bf16x8, pw2), AT_PK(2), o[d0], 0, 0, 0); \
            o[d0] = __builtin_amdgcn_mfma_f32_32x32x16_bf16(__builtin_bit_cast(bf16x8, pw3), AT_PK(3), o[d0], 0, 0, 0); } } while (0)
#define AT_PK(k) (bf16x8){lo[k][0], lo[k][1], lo[k][2], lo[k][3], hh[k][0], hh[k][1], hh[k][2], hh[k][3]}
#define AT_ONES() do { const bf16x8 ones_ = (bf16x8){0x3F80, 0x3F80, 0x3F80, 0x3F80, 0x3F80, 0x3F80, 0x3F80, 0x3F80}; \
        osum = __builtin_amdgcn_mfma_f32_32x32x16_bf16(__builtin_bit_cast(bf16x8, pw0), ones_, osum, 0, 0, 0); osum = __builtin_amdgcn_mfma_f32_32x32x16_bf16(__builtin_bit_cast(bf16x8, pw1), ones_, osum, 0, 0, 0); \
        osum = __builtin_amdgcn_mfma_f32_32x32x16_bf16(__builtin_bit_cast(bf16x8, pw2), ones_, osum, 0, 0, 0); osum = __builtin_amdgcn_mfma_f32_32x32x16_bf16(__builtin_bit_cast(bf16x8, pw3), ones_, osum, 0, 0, 0); } while (0)
    int kslot = 0, vslot = 0;
    for (int i = 0; i < n; ++i) {
        const int t = U.t_hi - i;
        if (i + 2 < n) AT_WAIT_BAR(4); else if (i + 1 < n) AT_WAIT_BAR(2); else AT_WAIT_BAR(0);
        if (i + 3 < n) { const int k3 = (kslot + 3) & 3, v3 = vslot >= 2 ? vslot - 2 : vslot + 3; AT_DMA(t - 3, k3, v3); }
        if (pend) { AT_PV(vslot_pend); if (FAST) AT_ONES(); pend = false; }
        if (FAST && ABL != 1 && t <= U.t_first) {
            const lds_cptr kp = kp0 + kslot * SLOTB;
            f32x16 p0, p1;
#pragma unroll
            for (int d0 = 0; d0 < 4; ++d0) {
                const bf16x8 b0 = *(const __attribute__((address_space(3))) bf16x8*)(kp + d0 * 2048);
                const bf16x8 b1 = *(const __attribute__((address_space(3))) bf16x8*)(kp + d0 * 2048 + 512);
                if (d0 == 0) { p0 = __builtin_amdgcn_mfma_f32_32x32x16_bf16(b0, qr[0], negm, 0, 0, 0); p1 = __builtin_amdgcn_mfma_f32_32x32x16_bf16(b1, qr[0], negm, 0, 0, 0); }
                else { p0 = __builtin_amdgcn_mfma_f32_32x32x16_bf16(b0, qr[d0], p0, 0, 0, 0); p1 = __builtin_amdgcn_mfma_f32_32x32x16_bf16(b1, qr[d0], p1, 0, 0, 0); }
            }
            if (ABL == 2) { asm volatile("" :: "v"(p0), "v"(p1)); } else {
            if (MODE == M_FOX) {
                const __attribute__((address_space(3))) f32x4* ck = (const __attribute__((address_space(3))) f32x4*)(shm3 + LDS_CK + (64 * t + 4 * hi) * 4);
#pragma unroll
                for (int a = 0; a < 4; ++a) { const f32x4 c0 = ck[2 * a], c1 = ck[2 * a + 8];
#pragma unroll
                    for (int j = 0; j < 4; ++j) { p0[4 * a + j] -= c0[j]; p1[4 * a + j] -= c1[j]; } }
            }
            if (t == U.t_first) {
                const int kb = 64 * t + 4 * hi;
#pragma unroll
                for (int r = 0; r < 16; ++r) { const int kv = kb + (r & 3) + 8 * (r >> 2); if (kv > U.qpos) p0[r] = NEG; if (kv + 32 > U.qpos) p1[r] = NEG; }
            }
            if (MODE == M_WIN && t == U.t_lo) {
                const int kb = 64 * t + 4 * hi, lim = U.qpos - U.win;
#pragma unroll
                for (int r = 0; r < 16; ++r) { const int kv = kb + (r & 3) + 8 * (r >> 2); if (kv <= lim) p0[r] = NEG; if (kv + 32 <= lim) p1[r] = NEG; }
            }
#pragma unroll
            for (int r = 0; r < 16; ++r) { p0[r] = __builtin_amdgcn_exp2f(p0[r]); p1[r] = __builtin_amdgcn_exp2f(p1[r]); }
            pw0 = (u32x4){cvtpk(p0[0], p0[1]), cvtpk(p0[2], p0[3]), cvtpk(p0[4], p0[5]), cvtpk(p0[6], p0[7])};
            pw1 = (u32x4){cvtpk(p0[8], p0[9]), cvtpk(p0[10], p0[11]), cvtpk(p0[12], p0[13]), cvtpk(p0[14], p0[15])};
            pw2 = (u32x4){cvtpk(p1[0], p1[1]), cvtpk(p1[2], p1[3]), cvtpk(p1[4], p1[5]), cvtpk(p1[6], p1[7])};
            pw3 = (u32x4){cvtpk(p1[8], p1[9]), cvtpk(p1[10], p1[11]), cvtpk(p1[12], p1[13]), cvtpk(p1[14], p1[15])};
            if (MODE == M_SEL) { const bool sel = (U.selm >> t) & 1ull;
#pragma unroll
                for (int j = 0; j < 4; ++j) { pw0[j] = sel ? pw0[j] : 0u; pw1[j] = sel ? pw1[j] : 0u; pw2[j] = sel ? pw2[j] : 0u; pw3[j] = sel ? pw3[j] : 0u; } }
            if (ABL == 3) { asm volatile("" :: "v"(pw0), "v"(pw1), "v"(pw2), "v"(pw3)); } else {
            if (lag) { pend = true; vslot_pend = vslot; } else { AT_PV(vslot); AT_ONES(); }
            } }
        }
        if (!FAST && t <= U.t_first) {
        const lds_cptr kp = kp0 + kslot * SLOTB;
        const f32x16& cinit = negm;
        f32x16 p0, p1;
#pragma unroll
        for (int d0 = 0; d0 < 4; ++d0) {
            const bf16x8 b0 = *(const __attribute__((address_space(3))) bf16x8*)(kp + d0 * 2048);
            const bf16x8 b1 = *(const __attribute__((address_space(3))) bf16x8*)(kp + d0 * 2048 + 512);
            if (d0 == 0) { p0 = __builtin_amdgcn_mfma_f32_32x32x16_bf16(b0, qr[0], cinit, 0, 0, 0); p1 = __builtin_amdgcn_mfma_f32_32x32x16_bf16(b1, qr[0], cinit, 0, 0, 0); }
            else { p0 = __builtin_amdgcn_mfma_f32_32x32x16_bf16(b0, qr[d0], p0, 0, 0, 0); p1 = __builtin_amdgcn_mfma_f32_32x32x16_bf16(b1, qr[d0], p1, 0, 0, 0); }
        }
        if (MODE == M_SEL) { const bool sel = (U.selm >> t) & 1ull;
#pragma unroll
            for (int r = 0; r < 16; ++r) { p0[r] = sel ? p0[r] : NEG; p1[r] = sel ? p1[r] : NEG; } }
        if (MODE == M_FOX) {
            const __attribute__((address_space(3))) f32x4* ck = (const __attribute__((address_space(3))) f32x4*)(shm3 + LDS_CK + (64 * t + 4 * hi) * 4);
#pragma unroll
            for (int a = 0; a < 4; ++a) { const f32x4 c0 = ck[2 * a], c1 = ck[2 * a + 8];
#pragma unroll
                for (int j = 0; j < 4; ++j) { p0[4 * a + j] -= c0[j]; p1[4 * a + j] -= c1[j]; } }
        }
        if (t == U.t_first) {
            const int kb = 64 * t + 4 * hi;
#pragma unroll
            for (int r = 0; r < 16; ++r) { const int kv = kb + (r & 3) + 8 * (r >> 2); if (kv > U.qpos) p0[r] = NEG; if (kv + 32 > U.qpos) p1[r] = NEG; }
        }
        if (MODE == M_WIN && t == U.t_lo) {
            const int kb = 64 * t + 4 * hi, lim = U.qpos - U.win;
#pragma unroll
            for (int r = 0; r < 16; ++r) { const int kv = kb + (r & 3) + 8 * (r >> 2); if (kv <= lim) p0[r] = NEG; if (kv + 32 <= lim) p1[r] = NEG; }
        }
        float rm = fmaxf(p0[0], p1[0]);
#pragma unroll
        for (int r = 1; r < 16; ++r) rm = fmaxf(rm, fmaxf(p0[r], p1[r]));
        { auto rr = __builtin_amdgcn_permlane32_swap(__float_as_uint(rm), __float_as_uint(rm), false, false); rm = fmaxf(__uint_as_float(rr[0]), __uint_as_float(rr[1])); }
        const bool first = (t == U.t_first);
        if (first || __any(rm > THR)) {
            const float dl = first ? rm : fmaxf(rm, 0.f); mref += dl;
#pragma unroll
            for (int r = 0; r < 16; ++r) { p0[r] -= dl; p1[r] -= dl; negm[r] = -mref; }
            if (!first) { const float f = __builtin_amdgcn_exp2f(-dl); l *= f; if (hi == 0) wsf[r32] = f;
                asm volatile("s_waitcnt lgkmcnt(0)" ::: "memory");
#pragma unroll
                for (int a = 0; a < 4; ++a) { const f32x4 fv = *(const f32x4*)(wsf + 8 * a + 4 * hi);
#pragma unroll
                    for (int j = 0; j < 4; ++j) { o[0][4 * a + j] *= fv[j]; o[1][4 * a + j] *= fv[j]; } }
            }
        }
        float sacc = 0.f;
#pragma unroll
        for (int r = 0; r < 16; ++r) { p0[r] = __builtin_amdgcn_exp2f(p0[r]); p1[r] = __builtin_amdgcn_exp2f(p1[r]); sacc += p0[r] + p1[r]; }
        l += sacc;
        pw0 = (u32x4){cvtpk(p0[0], p0[1]), cvtpk(p0[2], p0[3]), cvtpk(p0[4], p0[5]), cvtpk(p0[6], p0[7])};
        pw1 = (u32x4){cvtpk(p0[8], p0[9]), cvtpk(p0[10], p0[11]), cvtpk(p0[12], p0[13]), cvtpk(p0[14], p0[15])};
        pw2 = (u32x4){cvtpk(p1[0], p1[1]), cvtpk(p1[2], p1[3]), cvtpk(p1[4], p1[5]), cvtpk(p1[6], p1[7])};
        pw3 = (u32x4){cvtpk(p1[8], p1[9]), cvtpk(p1[10], p1[11]), cvtpk(p1[12], p1[13]), cvtpk(p1[14], p1[15])};
        if (lag) { pend = true; vslot_pend = vslot; } else { AT_PV(vslot); }
        }
        kslot = (kslot + 1) & 3; vslot = vslot == 4 ? 0 : vslot + 1;
    }
    if (pend) { AT_PV(vslot_pend); if (FAST) AT_ONES(); }
#undef AT_PV
#undef AT_ONES
#undef AT_PK
    asm volatile("s_waitcnt vmcnt(0) lgkmcnt(0)\n\ts_barrier" ::: "memory");
    l_out = l;
#undef AT_DMA
}
__device__ __forceinline__ void row_inv(float l, char* shm, float (&rli)[16]) {
    int tid_ = threadIdx.x; asm volatile("" : "+v"(tid_));
    const int lane = tid_ & 63, r32 = lane & 31, hi = lane >> 5; const int wid = __builtin_amdgcn_readfirstlane(tid_ >> 6);
    float* wsf = (float*)(shm + LDS_WS) + wid * 64;
    { auto rr = __builtin_amdgcn_permlane32_swap(__float_as_uint(l), __float_as_uint(l), false, false); l = __uint_as_float(rr[0]) + __uint_as_float(rr[1]); }
    if (hi == 0) wsf[32 + r32] = l;
    asm volatile("s_waitcnt lgkmcnt(0)" ::: "memory");
#pragma unroll
    for (int a = 0; a < 4; ++a) { const f32x4 lv = *(const f32x4*)(wsf + 32 + 8 * a + 4 * hi);
#pragma unroll
        for (int j = 0; j < 4; ++j) rli[4 * a + j] = lv[j] > 0.f ? 1.0f / lv[j] : 0.f; }
    asm volatile("s_waitcnt lgkmcnt(0)" ::: "memory");
}
}
namespace at {
constexpr int CMP_K = 0, CMP_V = 32768, CMP_IMP = LDS_CK, CMP_SELM = LDS_CK + 65536;
constexpr int KCP = 128;
__device__ __forceinline__ int imp_idx(int j, int q) { return j * 64 + (q ^ ((j >> 3) << 3)); }
__device__ __forceinline__ void cmp_scores(f32x16& p0, f32x16& p1, lds_cptr kp, const bf16x8 (&qr)[4], const f32x16& cinit, int tt, int hi, int nlim) {
#pragma unroll
    for (int d0 = 0; d0 < 4; ++d0) {
        const bf16x8 b0 = *(const __attribute__((address_space(3))) bf16x8*)(kp + d0 * 2048);
        const bf16x8 b1 = *(const __attribute__((address_space(3))) bf16x8*)(kp + d0 * 2048 + 512);
        if (d0 == 0) { p0 = __builtin_amdgcn_mfma_f32_32x32x16_bf16(b0, qr[0], cinit, 0, 0, 0); p1 = __builtin_amdgcn_mfma_f32_32x32x16_bf16(b1, qr[0], cinit, 0, 0, 0); }
        else { p0 = __builtin_amdgcn_mfma_f32_32x32x16_bf16(b0, qr[d0], p0, 0, 0, 0); p1 = __builtin_amdgcn_mfma_f32_32x32x16_bf16(b1, qr[d0], p1, 0, 0, 0); }
    }
    const int nb = 64 * tt + 4 * hi;
#pragma unroll
    for (int r = 0; r < 16; ++r) { const int n = nb + (r & 3) + 8 * (r >> 2); if (n > nlim) p0[r] = NEG; if (n + 32 > nlim) p1[r] = NEG; }
}
__device__ __forceinline__ void cmp_stage(const bf16* Qw, const bf16* Kc, const bf16* Vc, int c, int nsel, char* shm, f32x16 (&o)[2]) {
    int tid_ = threadIdx.x; asm volatile("" : "+v"(tid_));
    const int tid = tid_, lane = tid & 63, r32 = lane & 31, hi = lane >> 5; const int wid = __builtin_amdgcn_readfirstlane(tid >> 6);
    const unsigned lds0 = (unsigned)(uintptr_t)shm; const lds_cptr shm3 = (lds_cptr)shm;
    asm volatile("s_waitcnt lgkmcnt(0)\n\ts_barrier" ::: "memory");
    const int ntc = (4 * c + 2) / 64 + 1;
    const int tq = 64 * c + 32 * (wid & 1) + r32, nlim = tq >= 31 ? (tq - 31) >> 4 : -1;
    bf16x8 qr[4];
#pragma unroll
    for (int d0 = 0; d0 < 4; ++d0) qr[d0] = *reinterpret_cast<const bf16x8*>(&Qw[(long)r32 * PITCH + d0 * 16 + hi * 8]);
    float* slab = (float*)(shm + CMP_IMP) + (wid >> 1) * 4096; const int qloc = 32 * (wid & 1) + r32;
#ifdef PROBE_DUP
    for (int pr_ = 0; pr_ < (PROBE_DUP == 33 ? 2 : 1); ++pr_)
#endif
    {   if (PROBE_DUP == 33) asm volatile("s_waitcnt vmcnt(0) lgkmcnt(0)\n\ts_barrier" ::: "memory");
        const bf16* ksrc = Kc + (long)lane * KCP + wid * 8;
        const bf16* vsrc = Vc + (long)(16 * (wid & 3) + (lane >> 2)) * KCP + (wid >> 2) * 32 + (lane & 3) * 8;
        for (int tt = 0; tt < ntc; ++tt) { glds16(ksrc + (long)tt * 64 * KCP, (unsigned)__builtin_amdgcn_readfirstlane(lds0 + CMP_K + tt * SLOTB + wid * 1024));
                                           glds16(vsrc + (long)tt * 64 * KCP, (unsigned)__builtin_amdgcn_readfirstlane(lds0 + CMP_V + tt * SLOTB + wid * 1024)); }
        AT_WAIT_BAR(0);
    }
    const lds_cptr kp0 = shm3 + CMP_K + hi * 1024 + r32 * 16;
    const lds_cptr vp0 = shm3 + CMP_V + ((lane >> 4) & 1) * 32 + (lane & 3) * 8 + (4 * hi + ((lane & 15) >> 2)) * 64;
    float m = NEG, l = 0.f; const f32x16 zero = f32x16{};
#ifdef PROBE_DUP
    for (int pr_ = 0; pr_ < (PROBE_DUP == 30 ? 2 : 1); ++pr_)
#endif
    for (int tt = 0; tt < ntc; ++tt) {
        f32x16 p0, p1; cmp_scores(p0, p1, kp0 + tt * SLOTB, qr, zero, tt, hi, nlim);
        float rm = fmaxf(p0[0], p1[0]);
#pragma unroll
        for (int r = 1; r < 16; ++r) rm = fmaxf(rm, fmaxf(p0[r], p1[r]));
        { auto rr = __builtin_amdgcn_permlane32_swap(__float_as_uint(rm), __float_as_uint(rm), false, false); rm = fmaxf(__uint_as_float(rr[0]), __uint_as_float(rr[1])); }
        const float mn = fmaxf(m, rm); float s = 0.f;
#pragma unroll
        for (int r = 0; r < 16; ++r) s += __builtin_amdgcn_exp2f(p0[r] - mn) + __builtin_amdgcn_exp2f(p1[r] - mn);
        l = l * __builtin_amdgcn_exp2f(m - mn) + s; m = mn;
    }
    { auto rr = __builtin_amdgcn_permlane32_swap(__float_as_uint(l), __float_as_uint(l), false, false); l = __uint_as_float(rr[0]) + __uint_as_float(rr[1]); }
    const float rl = nlim >= 0 ? 1.0f / l : 0.f;
    f32x16 negm;
#pragma unroll
    for (int r = 0; r < 16; ++r) negm[r] = -m;
    o[0] = f32x16{}; o[1] = f32x16{}; float carry = 0.f;
    for (int tt = 0; tt < ntc; ++tt) {
        f32x16 p0, p1; cmp_scores(p0, p1, kp0 + tt * SLOTB, qr, negm, tt, hi, nlim);
#pragma unroll
        for (int r = 0; r < 16; ++r) { p0[r] = __builtin_amdgcn_exp2f(p0[r]) * rl; p1[r] = __builtin_amdgcn_exp2f(p1[r]) * rl; }
        {   float own[8], sp[8];
#pragma unroll
            for (int a = 0; a < 4; ++a) { sp[a] = 0.5f * p0[4 * a + 3]; sp[4 + a] = 0.5f * p1[4 * a + 3];
                own[a] = (p0[4 * a] + p0[4 * a + 1]) + (p0[4 * a + 2] + sp[a]); own[4 + a] = (p1[4 * a] + p1[4 * a + 1]) + (p1[4 * a + 2] + sp[4 + a]); }
            float rc[8];
#pragma unroll
            for (int k = 0; k < 8; ++k) rc[k] = lx::x32f(sp[k], hi != 0);
            if (hi) {
#pragma unroll
                for (int k = 0; k < 8; ++k) own[k] += rc[k];
            } else { own[0] += carry;
#pragma unroll
                for (int k = 0; k < 7; ++k) own[k + 1] += rc[k];
                carry = rc[7]; }
#pragma unroll
            for (int a = 0; a < 4; ++a) { slab[imp_idx(16 * tt + 2 * a + hi, qloc)] = own[a]; slab[imp_idx(16 * tt + 8 + 2 * a + hi, qloc)] = own[4 + a]; }
        }
        const lds_cptr vp = vp0 + tt * SLOTB;
        u32x4 pw0, pw1, pw2, pw3;
        pw0 = (u32x4){cvtpk(p0[0], p0[1]), cvtpk(p0[2], p0[3]), cvtpk(p0[4], p0[5]), cvtpk(p0[6], p0[7])};
        pw1 = (u32x4){cvtpk(p0[8], p0[9]), cvtpk(p0[10], p0[11]), cvtpk(p0[12], p0[13]), cvtpk(p0[14], p0[15])};
        pw2 = (u32x4){cvtpk(p1[0], p1[1]), cvtpk(p1[2], p1[3]), cvtpk(p1[4], p1[5]), cvtpk(p1[6], p1[7])};
        pw3 = (u32x4){cvtpk(p1[8], p1[9]), cvtpk(p1[10], p1[11]), cvtpk(p1[12], p1[13]), cvtpk(p1[14], p1[15])};
#pragma unroll
        for (int d0 = 0; d0 < 2; ++d0) {
            s16x4 lo[4], hh[4];
#pragma unroll
            for (int ks = 0; ks < 4; ++ks) { lo[ks] = vtr(vp + d0 * 4096 + ks * 1024); hh[ks] = vtr(vp + d0 * 4096 + ks * 1024 + 512); }
#define AT_PK(k) (bf16x8){lo[k][0], lo[k][1], lo[k][2], lo[k][3], hh[k][0], hh[k][1], hh[k][2], hh[k][3]}
            o[d0] = __builtin_amdgcn_mfma_f32_32x32x16_bf16(__builtin_bit_cast(bf16x8, pw0), AT_PK(0), o[d0], 0, 0, 0);
            o[d0] = __builtin_amdgcn_mfma_f32_32x32x16_bf16(__builtin_bit_cast(bf16x8, pw1), AT_PK(1), o[d0], 0, 0, 0);
            o[d0] = __builtin_amdgcn_mfma_f32_32x32x16_bf16(__builtin_bit_cast(bf16x8, pw2), AT_PK(2), o[d0], 0, 0, 0);
            o[d0] = __builtin_amdgcn_mfma_f32_32x32x16_bf16(__builtin_bit_cast(bf16x8, pw3), AT_PK(3), o[d0], 0, 0, 0);
#undef AT_PK
        }
    }
    asm volatile("s_waitcnt lgkmcnt(0)\n\ts_barrier" ::: "memory");
#ifdef PROBE_DUP
    for (int pr_ = 0; pr_ < (PROBE_DUP == 32 ? 2 : 1); ++pr_)
#endif
    {   const int q = tid >> 3, part = tid & 7; const float* s0 = (const float*)(shm + CMP_IMP);
        const int t = 64 * c + q, cur = c;
        unsigned key[8];
#pragma unroll
        for (int i = 0; i < 8; ++i) { const int j = part * 8 + i; const int ix = imp_idx(j, q); const float imp = ((s0[ix] + s0[4096 + ix]) + s0[8192 + ix]) + s0[12288 + ix];
            const bool forced = (j == 0) || (j == cur) || (j == cur - 1);
            const float sc = imp + (forced ? 1e4f : 0.0f);
            key[i] = (j * 64 > t) ? (unsigned)(63 - j) : ((__float_as_uint(sc) & ~63u) | (unsigned)(63 - j)) + 64u; }
        unsigned sel8 = 0u;
        for (int s = 0; s < nsel; ++s) {
            unsigned best = key[0];
#pragma unroll
            for (int i = 1; i < 8; ++i) best = best > key[i] ? best : key[i];
            { const unsigned o1 = (unsigned)__builtin_amdgcn_update_dpp(0, (int)best, 0xB1, 0xF, 0xF, false); best = best > o1 ? best : o1; }
            { const unsigned o2 = (unsigned)__builtin_amdgcn_update_dpp(0, (int)best, 0x4E, 0xF, 0xF, false); best = best > o2 ? best : o2; }
            { const unsigned o3 = (unsigned)__builtin_amdgcn_update_dpp(0, (int)best, 0x141, 0xF, 0xF, false); best = best > o3 ? best : o3; }
#pragma unroll
            for (int i = 0; i < 8; ++i) { const bool hit = key[i] == best; sel8 |= hit ? (1u << i) : 0u; key[i] = hit ? 0u : key[i]; }
        }
        unsigned mlo = part < 4 ? sel8 << (8 * part) : 0u, mhi = part >= 4 ? sel8 << (8 * (part - 4)) : 0u;
        mlo |= (unsigned)__builtin_amdgcn_update_dpp(0, (int)mlo, 0xB1, 0xF, 0xF, false); mhi |= (unsigned)__builtin_amdgcn_update_dpp(0, (int)mhi, 0xB1, 0xF, 0xF, false);
        mlo |= (unsigned)__builtin_amdgcn_update_dpp(0, (int)mlo, 0x4E, 0xF, 0xF, false); mhi |= (unsigned)__builtin_amdgcn_update_dpp(0, (int)mhi, 0x4E, 0xF, 0xF, false);
        mlo |= (unsigned)__builtin_amdgcn_update_dpp(0, (int)mlo, 0x141, 0xF, 0xF, false); mhi |= (unsigned)__builtin_amdgcn_update_dpp(0, (int)mhi, 0x141, 0xF, 0xF, false);
        const unsigned long long mk = ((unsigned long long)mhi << 32) | mlo;
        if (part == 0) ((unsigned long long*)(shm + CMP_SELM))[q] = mk;
    }
    asm volatile("s_waitcnt lgkmcnt(0)\n\ts_barrier" ::: "memory");
}
}

namespace at {
__device__ __forceinline__ void compress_unit(const bf16* tokb  , int n0, int ncmp, const float* pe, const bf16* W1T, const bf16* W2T,
                                              const float* ropeb  , bf16* outb  , char* shm) {
    int tid_ = threadIdx.x; asm volatile("" : "+v"(tid_));
    const int tid = tid_, lane = tid & 63, r32 = lane & 31, hi = lane >> 5; const int wid = __builtin_amdgcn_readfirstlane(tid >> 6);
    const int cb = wid & 3, kh = wid >> 2;
    const int n = n0 + r32, nc = n < ncmp ? n : ncmp - 1;
    f32x16 acc = f32x16{};
    const bf16* wrow = W1T + (long)(32 * cb + r32) * 2048 + 8 * hi;
#pragma unroll 16
    for (int s = 64 * kh; s < 64 * kh + 64; ++s) {
        const int l = s >> 2, d = 16 * (s & 3) + 8 * hi;
        const u32x4 tv = *(const u32x4*)(tokb + (long)(16 * nc + l) * PITCH + d);
        const f32x4 pa = *(const f32x4*)(pe + l * 64 + d), pb = *(const f32x4*)(pe + l * 64 + d + 4);
        u32x4 av;
        av.x = cvtpk(__builtin_bit_cast(float, tv.x << 16) + pa[0], __builtin_bit_cast(float, tv.x & 0xffff0000u) + pa[1]);
        av.y = cvtpk(__builtin_bit_cast(float, tv.y << 16) + pa[2], __builtin_bit_cast(float, tv.y & 0xffff0000u) + pa[3]);
        av.z = cvtpk(__builtin_bit_cast(float, tv.z << 16) + pb[0], __builtin_bit_cast(float, tv.z & 0xffff0000u) + pb[1]);
        av.w = cvtpk(__builtin_bit_cast(float, tv.w << 16) + pb[2], __builtin_bit_cast(float, tv.w & 0xffff0000u) + pb[3]);
        const bf16x8 bv = *(const bf16x8*)(wrow + 16 * s);
        acc = __builtin_amdgcn_mfma_f32_32x32x16_bf16(__builtin_bit_cast(bf16x8, av), bv, acc, 0, 0, 0);
    }
    float* red = (float*)shm;
    unsigned short* hb = (unsigned short*)(shm + 16384);
    asm volatile("s_waitcnt lgkmcnt(0)\n\ts_barrier" ::: "memory");
    if (kh == 1) {
#pragma unroll
        for (int r = 0; r < 16; ++r) red[(cb * 16 + r) * 64 + lane] = acc[r];
    }
    asm volatile("s_waitcnt lgkmcnt(0)\n\ts_barrier" ::: "memory");
    if (kh == 0) {
#pragma unroll
        for (int r = 0; r < 16; ++r) { const float v = acc[r] + red[(cb * 16 + r) * 64 + lane]; const float hsl = v / (1.0f + __expf(-v));
            hb[crow(r, hi) * 136 + 32 * cb + r32] = (unsigned short)(cvtpk(hsl, 0.f) & 0xffffu); }
    }
    asm volatile("s_waitcnt lgkmcnt(0)\n\ts_barrier" ::: "memory");
    if (wid < 2) {
        f32x16 o2 = f32x16{};
#pragma unroll
        for (int s = 0; s < 8; ++s) { const bf16x8 a = *(const bf16x8*)(hb + r32 * 136 + 16 * s + 8 * hi); const bf16x8 b = *(const bf16x8*)(W2T + (long)(32 * wid + r32) * 128 + 16 * s + 8 * hi);
            o2 = __builtin_amdgcn_mfma_f32_32x32x16_bf16(a, b, o2, 0, 0, 0); }
#pragma unroll
        for (int r = 0; r < 16; ++r) { const int nn = n0 + crow(r, hi); float v = o2[r];
            if (ropeb != nullptr && wid == 0) {
                const float pv = lx::xf<8>(v);
                if (r32 < 16 && nn < ncmp) { const float* cs = ropeb + ((long)(16 * nn + 31) * 8 + (r32 & 7)) * 2; const float cc = cs[0], sn = cs[1]; v = r32 < 8 ? v * cc - pv * sn : v * cc + pv * sn; }
            }
            if (nn < 256) outb[(long)nn * 128 + 32 * wid + r32] = nn < ncmp ? (unsigned short)(cvtpk(v, 0.f) & 0xffffu) : (unsigned short)0; }
    }
    asm volatile("s_waitcnt lgkmcnt(0)\n\ts_barrier" ::: "memory");
}
}

namespace at {
template <bool ACCUM>
__device__ __forceinline__ void store_rows(const f32x16 (&o)[2], const float* rli  , unsigned short* obase  , int ldo,
                                           const float* gbase  , int ldg) {
    static_assert(!ACCUM, "the mixer outputs are written once, as bf16");
    int t_ = threadIdx.x; asm volatile("" : "+v"(t_)); const int lane = t_ & 63, r32 = lane & 31, hi = lane >> 5;
    unsigned short* ob = obase + r32;
#pragma unroll
    for (int r = 0; r < 16; ++r) { const int row = crow(r, hi); float sc = rli ? rli[r] : 1.0f; if (gbase) sc *= gbase[(size_t)row * ldg];
        unsigned short* p = ob + (size_t)row * ldo; const unsigned w = cvtpk(o[0][r] * sc, o[1][r] * sc);
        p[0] = (unsigned short)(w & 0xffffu); p[32] = (unsigned short)(w >> 16); }
}
}

namespace at {
template <bool INIT, bool LAST>
__device__ __forceinline__ void fold_rows(float* accw  , f32x16 (&o)[2], const float* rli  , const float* gbase, int ldg) {
    int t_ = threadIdx.x; asm volatile("" : "+v"(t_)); const int lane = t_ & 63, hi = lane >> 5;
#pragma unroll
    for (int r = 0; r < 16; ++r) { float sc = gbase[(size_t)crow(r, hi) * ldg]; if (rli) sc *= rli[r];
        float v0 = o[0][r] * sc, v1 = o[1][r] * sc;
        if (!INIT) { v0 += accw[r * 64 + lane]; v1 += accw[(16 + r) * 64 + lane]; }
        if (LAST) { o[0][r] = v0; o[1][r] = v1; } else { accw[r * 64 + lane] = v0; accw[(16 + r) * 64 + lane] = v1; } }
    asm volatile("s_waitcnt lgkmcnt(0)" ::: "memory");
}
}
namespace at {
template <int MODE>
__device__ __forceinline__ void attn_tiles_pipe(const UnitIO& U, char* shm, f32x16 (&o)[2], f32x16& osum) {
    int tid_ = threadIdx.x; asm volatile("" : "+v"(tid_));
    const int tid = tid_, lane = tid & 63, r32 = lane & 31, hi = lane >> 5; const int wid = __builtin_amdgcn_readfirstlane(tid >> 6);
    const unsigned lds0 = (unsigned)(uintptr_t)shm;
    const bf16* ksrc = U.Kh + (long)lane * PITCH + wid * 8;
    const bf16* vsrc = U.Vh + (long)(16 * (wid & 3) + (lane >> 2)) * PITCH + (wid >> 2) * 32 + (lane & 3) * 8;
    const unsigned kdst = lds0 + LDS_K + wid * 1024, vdst = lds0 + LDS_V + wid * 1024;
#define PP_DMA_K(step, slot) glds16(ksrc + (long)(U.t_hi - (step)) * 64 * PITCH, (unsigned)__builtin_amdgcn_readfirstlane(kdst + (slot) * SLOTB))
#define PP_DMA_V(step, slot) glds16(vsrc + (long)(U.t_hi - (step)) * 64 * PITCH, (unsigned)__builtin_amdgcn_readfirstlane(vdst + (slot) * SLOTB))
    const lds_cptr shm3 = (lds_cptr)shm;
    const lds_cptr kp0 = shm3 + LDS_K + hi * 1024 + r32 * 16;
    const lds_cptr vp0 = shm3 + LDS_V + ((lane >> 4) & 1) * 32 + (lane & 3) * 8 + (4 * hi + ((lane & 15) >> 2)) * 64;
    const int n = U.t_hi - U.t_lo + 1, i0 = U.t_hi - U.t_first;
    bf16x8 qr[4];
#pragma unroll
    for (int d0 = 0; d0 < 4; ++d0) qr[d0] = *reinterpret_cast<const bf16x8*>(&U.Qw[(long)r32 * PITCH + d0 * 16 + hi * 8]);
    asm volatile("" ::: "memory");
    PP_DMA_K(0, 0); if (n > 1) PP_DMA_K(1, 1); PP_DMA_V(0, 0); if (n > 2) PP_DMA_K(2, 2); if (n > 1) PP_DMA_V(1, 1);
    f32x16 cini = f32x16{};
    if (MODE == M_FOX) {
#pragma unroll
        for (int r = 0; r < 16; ++r) cini[r] = U.cq; }
    o[0] = f32x16{}; o[1] = f32x16{}; osum = f32x16{};
    const bf16x8 ones = (bf16x8){0x3F80, 0x3F80, 0x3F80, 0x3F80, 0x3F80, 0x3F80, 0x3F80, 0x3F80};
    if (n > 2) asm volatile("s_waitcnt vmcnt(4) lgkmcnt(0)\n\ts_barrier" ::: "memory"); else if (n == 2) asm volatile("s_waitcnt vmcnt(3) lgkmcnt(0)\n\ts_barrier" ::: "memory");
    else asm volatile("s_waitcnt vmcnt(1) lgkmcnt(0)\n\ts_barrier" ::: "memory");
#define PP_QK(S0, S1, slot) do { const lds_cptr kp = kp0 + (slot) * SLOTB; \
        _Pragma("unroll") for (int d0 = 0; d0 < 4; ++d0) { \
            const bf16x8 b0 = *(const __attribute__((address_space(3))) bf16x8*)(kp + d0 * 2048); \
            const bf16x8 b1 = *(const __attribute__((address_space(3))) bf16x8*)(kp + d0 * 2048 + 512); \
            if (d0 == 0) { S0 = __builtin_amdgcn_mfma_f32_32x32x16_bf16(b0, qr[0], cini, 0, 0, 0); S1 = __builtin_amdgcn_mfma_f32_32x32x16_bf16(b1, qr[0], cini, 0, 0, 0); } \
            else { S0 = __builtin_amdgcn_mfma_f32_32x32x16_bf16(b0, qr[d0], S0, 0, 0, 0); S1 = __builtin_amdgcn_mfma_f32_32x32x16_bf16(b1, qr[d0], S1, 0, 0, 0); } } } while (0)
    f32x16 s0 = f32x16{}, s1 = f32x16{};
    if (i0 == 0) PP_QK(s0, s1, 0);
    int ks = 0;
    for (int i = 0; i < n; ++i) {
        const int t = U.t_hi - i;
        if (i + 2 < n) asm volatile("s_waitcnt vmcnt(2) lgkmcnt(0)\n\ts_barrier" ::: "memory");
        else if (i + 1 < n) asm volatile("s_waitcnt vmcnt(1) lgkmcnt(0)\n\ts_barrier" ::: "memory");
        else asm volatile("s_waitcnt vmcnt(0) lgkmcnt(0)\n\ts_barrier" ::: "memory");
        const int ks1 = ks == 2 ? 0 : ks + 1, ks2 = ks == 0 ? 2 : ks - 1;
        if (i + 3 < n) PP_DMA_K(i + 3, ks);
        if (i + 2 < n) PP_DMA_V(i + 2, ks2);
        const bool act = i >= i0, actn = (i + 1 >= i0) && (i + 1 < n);
        f32x16 n0 = f32x16{}, n1 = f32x16{};
        u32x4 pw0, pw1, pw2, pw3;
#define PP_SOFT(DIAG, WLO) do { \
            if (MODE == M_FOX) { const __attribute__((address_space(3))) f32x4* ck = (const __attribute__((address_space(3))) f32x4*)(shm3 + LDS_CK + (64 * t + 4 * hi) * 4); \
                _Pragma("unroll") for (int a = 0; a < 4; ++a) { const f32x4 c0 = ck[2 * a], c1 = ck[2 * a + 8]; \
                    _Pragma("unroll") for (int j = 0; j < 4; ++j) { s0[4 * a + j] -= c0[j]; s1[4 * a + j] -= c1[j]; } } } \
            if (DIAG) { const int kb = 64 * t + 4 * hi; \
                _Pragma("unroll") for (int r = 0; r < 16; ++r) { const int kv = kb + (r & 3) + 8 * (r >> 2); if (kv > U.qpos) s0[r] = NEG; if (kv + 32 > U.qpos) s1[r] = NEG; } } \
            if (WLO) { const int kb = 64 * t + 4 * hi, lim = U.qpos - U.win; \
                _Pragma("unroll") for (int r = 0; r < 16; ++r) { const int kv = kb + (r & 3) + 8 * (r >> 2); if (kv <= lim) s0[r] = NEG; if (kv + 32 <= lim) s1[r] = NEG; } } \
            _Pragma("unroll") for (int r = 0; r < 16; ++r) { s0[r] = __builtin_amdgcn_exp2f(s0[r]); s1[r] = __builtin_amdgcn_exp2f(s1[r]); } \
            pw0 = (u32x4){cvtpk(s0[0], s0[1]), cvtpk(s0[2], s0[3]), cvtpk(s0[4], s0[5]), cvtpk(s0[6], s0[7])}; \
            pw1 = (u32x4){cvtpk(s0[8], s0[9]), cvtpk(s0[10], s0[11]), cvtpk(s0[12], s0[13]), cvtpk(s0[14], s0[15])}; \
            pw2 = (u32x4){cvtpk(s1[0], s1[1]), cvtpk(s1[2], s1[3]), cvtpk(s1[4], s1[5]), cvtpk(s1[6], s1[7])}; \
            pw3 = (u32x4){cvtpk(s1[8], s1[9]), cvtpk(s1[10], s1[11]), cvtpk(s1[12], s1[13]), cvtpk(s1[14], s1[15])}; \
            if (MODE == M_SEL) { const bool sel = (U.selm >> t) & 1ull; \
                _Pragma("unroll") for (int j = 0; j < 4; ++j) { pw0[j] = sel ? pw0[j] : 0u; pw1[j] = sel ? pw1[j] : 0u; pw2[j] = sel ? pw2[j] : 0u; pw3[j] = sel ? pw3[j] : 0u; } } } while (0)
#define PP_HINT() do { _Pragma("unroll") for (int k_ = 0; k_ < 8; ++k_) { __builtin_amdgcn_sched_group_barrier(0x100, 1, 0); __builtin_amdgcn_sched_group_barrier(0x008, 1, 0); \
            __builtin_amdgcn_sched_group_barrier(0x400, 4, 0); __builtin_amdgcn_sched_group_barrier(0x002, 6, 0); } } while (0)
        if (act) {
            const bool diag = (i == i0), wlo = (MODE == M_WIN) && (i == n - 1);
            if (diag) { if (actn) { PP_QK(n0, n1, ks1); PP_SOFT(true, false); PP_HINT(); } else { PP_SOFT(true, (MODE == M_WIN) && wlo); } }
            else if (wlo) { PP_SOFT(false, true); }
            else if (actn) { PP_QK(n0, n1, ks1); PP_SOFT(false, false); PP_HINT(); }
            else { PP_SOFT(false, false); }
            const lds_cptr vp = vp0 + ks * SLOTB;
#pragma unroll
            for (int d0 = 0; d0 < 2; ++d0) { s16x4 lo[4], hh[4];
#pragma unroll
                for (int q4 = 0; q4 < 4; ++q4) { lo[q4] = vtr(vp + d0 * 4096 + q4 * 1024); hh[q4] = vtr(vp + d0 * 4096 + q4 * 1024 + 512); }
#define PP_PK(k) (bf16x8){lo[k][0], lo[k][1], lo[k][2], lo[k][3], hh[k][0], hh[k][1], hh[k][2], hh[k][3]}
                o[d0] = __builtin_amdgcn_mfma_f32_32x32x16_bf16(__builtin_bit_cast(bf16x8, pw0), PP_PK(0), o[d0], 0, 0, 0);
                o[d0] = __builtin_amdgcn_mfma_f32_32x32x16_bf16(__builtin_bit_cast(bf16x8, pw1), PP_PK(1), o[d0], 0, 0, 0);
                o[d0] = __builtin_amdgcn_mfma_f32_32x32x16_bf16(__builtin_bit_cast(bf16x8, pw2), PP_PK(2), o[d0], 0, 0, 0);
                o[d0] = __builtin_amdgcn_mfma_f32_32x32x16_bf16(__builtin_bit_cast(bf16x8, pw3), PP_PK(3), o[d0], 0, 0, 0);
#undef PP_PK
            }
            osum = __builtin_amdgcn_mfma_f32_32x32x16_bf16(__builtin_bit_cast(bf16x8, pw0), ones, osum, 0, 0, 0);
            osum = __builtin_amdgcn_mfma_f32_32x32x16_bf16(__builtin_bit_cast(bf16x8, pw1), ones, osum, 0, 0, 0);
            osum = __builtin_amdgcn_mfma_f32_32x32x16_bf16(__builtin_bit_cast(bf16x8, pw2), ones, osum, 0, 0, 0);
            osum = __builtin_amdgcn_mfma_f32_32x32x16_bf16(__builtin_bit_cast(bf16x8, pw3), ones, osum, 0, 0, 0);
        } else if (actn) { PP_QK(n0, n1, ks1); }
        s0 = n0; s1 = n1; ks = ks1;
    }
    asm volatile("s_waitcnt lgkmcnt(0)\n\ts_barrier" ::: "memory");
#undef PP_SOFT
#undef PP_HINT
#undef PP_QK
#undef PP_DMA_K
#undef PP_DMA_V
}
}
namespace mk {
#define GAS __attribute__((address_space(1)))
#define LAS __attribute__((address_space(3)))
typedef unsigned short bf16;
typedef unsigned v4u __attribute__((ext_vector_type(4)));
typedef float f32x4 __attribute__((ext_vector_type(4)));
typedef short bf16x8 __attribute__((ext_vector_type(8)));
typedef GAS unsigned gu32;
typedef GAS unsigned long long gu64;
#define RLX_AGENT __ATOMIC_RELAXED, __HIP_MEMORY_SCOPE_AGENT
#define LDS_WAIT() asm volatile("s_waitcnt lgkmcnt(0)" ::: "memory")
#define VM_WAIT() asm volatile("s_waitcnt vmcnt(0)" ::: "memory")
__device__ __forceinline__ unsigned long long rt() { return __builtin_amdgcn_s_memrealtime(); }
__device__ __forceinline__ unsigned f2bf(float f) { unsigned u = __builtin_bit_cast(unsigned, f); return (u + 0x7fffu + ((u >> 16) & 1u)) >> 16; }
__device__ __forceinline__ unsigned pk2(float lo, float hi) { return f2bf(lo) | (f2bf(hi) << 16); }

#define XB_TMO      128
#define XB_XCNT(j)  (256  + 64 * (j))
#define XB_XSUB(j)  (1280 + 64 * (j))
#define XB_XGEN(j)  (2304 + 64 * (j))
#define XB_TOP      3328
#define XB_TOPGEN   3392
#define XCD_BAR_WORDS 3456
#ifndef XB_SPIN_CAP
#define XB_SPIN_CAP (1u << 24)
#endif

__device__ __forceinline__ unsigned xb_ld(unsigned* p)              { return __hip_atomic_load(p, __ATOMIC_RELAXED, __HIP_MEMORY_SCOPE_AGENT); }
__device__ __forceinline__ unsigned xb_add(unsigned* p, unsigned v) { return __hip_atomic_fetch_add(p, v, __ATOMIC_RELAXED, __HIP_MEMORY_SCOPE_AGENT); }
__device__ __forceinline__ unsigned xb_xcc_id() { return (unsigned)__builtin_amdgcn_s_getreg((3 << 11) | 20) & 0xFu; }
#define XB_SPIN(cond, bar) do { unsigned _sp = 0; while (cond) { __builtin_amdgcn_s_sleep(1); \
    if ((++_sp & 255u) == 0u) { if (xb_ld(&(bar)[XB_TMO])) break; if (_sp > XB_SPIN_CAP) { atomicAdd(&(bar)[XB_TMO], 1u); break; } } } } while (0)

struct XcdBarrier {
    unsigned* bar; unsigned x;
    volatile LAS unsigned* st;
};

__device__ __forceinline__ XcdBarrier xcd_barrier_post(unsigned* bar, volatile LAS unsigned* st) {
    XcdBarrier b; b.bar = bar; b.x = xb_xcc_id(); b.st = st;
    if (threadIdx.x == 0) (void)xb_add(&bar[XB_XCNT(b.x)], 1u);
    return b;
}
__device__ __forceinline__ void xcd_barrier_complete(unsigned* bar, unsigned x, unsigned& nloc, unsigned& nx) {
    const unsigned G = gridDim.x * gridDim.y * gridDim.z;
    unsigned sum, cnt, mine, sp = 0u;
    for (;;) {
        sum = 0u; cnt = 0u; mine = 0u;
#pragma unroll
        for (unsigned j = 0; j < 16; ++j) { const unsigned c = xb_ld(&bar[XB_XCNT(j)]); sum += c; cnt += (c > 0u) ? 1u : 0u; mine = (j == x) ? c : mine; }
        if (sum == G) break;
        __builtin_amdgcn_s_sleep(1);
        if ((++sp & 255u) == 0u) { if (xb_ld(&bar[XB_TMO])) break; if (sp > XB_SPIN_CAP) { atomicAdd(&bar[XB_TMO], 1u); break; } }
    }
    nloc = mine > 0u ? mine : 1u; nx = cnt > 0u ? cnt : 1u;
}

__device__ __forceinline__ void xcd_barrier(const XcdBarrier& b) {
    asm volatile("s_waitcnt vmcnt(0)" ::: "memory");
    __syncthreads();
    if (threadIdx.x == 0) {
        unsigned* bar = b.bar;
        __builtin_amdgcn_s_waitcnt(0);
        unsigned nloc = b.st[0], nx = b.st[1];
        if (nloc == 0u) { xcd_barrier_complete(bar, b.x, nloc, nx); b.st[0] = nloc; b.st[1] = nx; }
        const unsigned old = xb_add(&bar[XB_XSUB(b.x)], 1u);
        const unsigned gen = old / nloc;
        if (old + 1u == (gen + 1u) * nloc) {
            __builtin_amdgcn_fence(__ATOMIC_RELEASE, "agent");
            asm volatile("s_waitcnt vmcnt(0)" ::: "memory");
            const unsigned og = xb_add(&bar[XB_TOP], 1u);
            const unsigned tg = og / nx;
            if (og + 1u == (tg + 1u) * nx) xb_add(&bar[XB_TOPGEN], 1u);
            else XB_SPIN(xb_ld(&bar[XB_TOPGEN]) == tg, bar);
            __builtin_amdgcn_fence(__ATOMIC_ACQUIRE, "agent");
            xb_add(&bar[XB_XGEN(b.x)], 1u);
            asm volatile("s_waitcnt vmcnt(0)" ::: "memory");
        } else {
            XB_SPIN(xb_ld(&bar[XB_XGEN(b.x)]) == gen, bar);
            __builtin_amdgcn_fence(__ATOMIC_ACQUIRE, "agent");
            asm volatile("s_waitcnt vmcnt(0)" ::: "memory");
        }
    }
    __syncthreads();
}
using nv::B_; using nv::S_; using nv::T_; using nv::DM; using nv::NCMP; using nv::NBLK;
constexpr int NWAVES = 8, NTHREADS = NWAVES * 64;
constexpr int RING_OFF = 0, RING_BYTES = 131072, LDS_BYTES = 147456, LDSCTL_OFF = LDS_BYTES - 1024, MISC_OFF = LDSCTL_OFF + 320;
constexpr int CW_BAR = 4096, CW_FOXQ = 8192, CW_PANEL = 16384, CW_HM = 24576;
constexpr int NIN = 3072;
constexpr size_t MiB = (size_t)1 << 20;
constexpr size_t WS_CTL = 0, CTL_ZERO_BYTES = 1 * MiB;
constexpr size_t WS_WIN = 2 * MiB;
constexpr size_t WS_WOUT = 8 * MiB, WS_WPG = 10 * MiB, WS_WPP = 12 * MiB, WS_CMPW = 13 * MiB;
constexpr size_t WS_ROPE = 15 * MiB;
constexpr size_t WS_GATES = 17 * MiB;
constexpr size_t WS_LOGF = 20 * MiB, WS_CUM = 21 * MiB;
constexpr size_t WS_KC = 22 * MiB, WS_VC = 23 * MiB, WS_SELM = 24 * MiB, WS_EID = 25 * MiB, WS_CW = 26 * MiB, WS_RS3 = 27 * MiB, WS_CMPH = 28 * MiB;
constexpr size_t WS_WGU = 40 * MiB, WS_WD = 72 * MiB;
constexpr size_t WS_XN = 88 * MiB;
constexpr size_t WS_PROJB = 152 * MiB;
constexpr size_t WS_TAB = 1 * MiB;
constexpr size_t WS_ROPEH = 38 * MiB;
constexpr size_t WS_ROWIDX = 37 * MiB;
constexpr size_t WS_XS = 36 * MiB;
constexpr size_t WS_POS = 34 * MiB, WS_NRM = 35 * MiB;
constexpr size_t WS_USORT = 152 * MiB, WS_HIDB = 288 * MiB, WS_YB = 356 * MiB;
constexpr size_t WS_PB = 496 * MiB;
constexpr size_t WS_IMP = 328 * MiB;
constexpr size_t WS_NH = 88 * MiB, WS_NU = 216 * MiB, WS_NHID = 344 * MiB;
static_assert(WS_NHID + (size_t)T_ * 1024 * 4 <= 512 * MiB && WS_PROJB + (size_t)T_ * 2816 * 2 <= WS_IMP, "d_ws map");

__device__ __forceinline__ float wave_sum(float v) { return lx::sum64(v); }
template <int MODE>
__device__ __forceinline__ void p0_transpose_item(const float* W, int ldw, int col0, int K, int nblk, bf16* WT, int row_off, LAS float* scr, int item, int lane) {
    const int kb = item / nblk, nb = item % nblk, k0 = 64 * kb, n0 = 32 * nb;
#pragma unroll 8
    for (int i = 0; i < 32; ++i) { const int kk = 2 * i + (lane >> 5); const int cl = lane & 31; const int sc = (MODE == 2 && cl >= 24) ? col0 + 1536 + cl : col0 + n0 + cl; scr[kk * 33 + cl] = W[(size_t)(k0 + kk) * ldw + sc]; }
    LDS_WAIT(); asm volatile("" ::: "memory");
    const int c = lane & 7;
#pragma unroll
    for (int j = 0; j < 4; ++j) { const int n = (lane >> 3) + 8 * j; const LAS float* s = scr + (8 * c) * 33 + n;
        v4u o; o.x = pk2(s[0 * 33], s[1 * 33]); o.y = pk2(s[2 * 33], s[3 * 33]); o.z = pk2(s[4 * 33], s[5 * 33]); o.w = pk2(s[6 * 33], s[7 * 33]);
        const int nn = n0 + n; const int ln = row_off + nn;
        const int drow = MODE == 3 ? (ln & ~255) + 128 * ((ln >> 5) & 1) + 32 * ((ln >> 6) & 3) + (ln & 31) : MODE != 1 ? row_off + nn : (nn >> 2) * 8 + (nn & 3) + row_off;
        *(GAS v4u*)(WT + (size_t)drow * K + k0 + 8 * c) = o; }
    LDS_WAIT(); asm volatile("" ::: "memory");
}
__device__ __forceinline__ void rms_row_to_bf16(const float* xrow, const float* gain, bf16* orow, int lane) {
    const GAS f32x4* xr = (const GAS f32x4*)xrow + lane; const GAS f32x4* gr = (const GAS f32x4*)gain + lane;
    f32x4 v[4]; float s = 0.f;
#pragma unroll
    for (int j = 0; j < 4; ++j) { v[j] = xr[64 * j]; s += (v[j].x * v[j].x + v[j].y * v[j].y) + (v[j].z * v[j].z + v[j].w * v[j].w); }
    const float rstd = 1.f / sqrtf(wave_sum(s) * (1.f / 1024.f) + 1e-6f);
    GAS unsigned long long* o8 = (GAS unsigned long long*)orow + lane;
#pragma unroll
    for (int j = 0; j < 4; ++j) { const f32x4 g = gr[64 * j];
        o8[64 * j] = (unsigned long long)pk2(v[j].x * rstd * g.x, v[j].y * rstd * g.y) | ((unsigned long long)pk2(v[j].z * rstd * g.z, v[j].w * rstd * g.w) << 32); }
}

#ifndef PROBE_DUP
#define PROBE_DUP (-1)
#endif
#define REP(k) for (int rep_ = 0; rep_ < ((PROBE_DUP == (k)) ? 2 : 1); ++rep_)
struct Args { const void* in[29]; void* out; void* ws; };
#define LDP_(k) ((uintptr_t)args.in[k])
#define PHASE_PTRS() size_t zo_ = 0; asm volatile("" : "+s"(zo_)); char* ws = ws0_ + zo_; float* out = out0_ + zo_;     volatile LAS unsigned* LPV_ = (volatile LAS unsigned*)(ldsp + LDSCTL_OFF + 512); (void)LPV_; \
    const float* in_x = (const float*)LDP_(0); const float* in_p = (const float*)LDP_(1); const int* positions = (const int*)LDP_(2); const float* g_mix = (const float*)LDP_(3); const float* w_in = (const float*)LDP_(4); const float* b_gate = (const float*)LDP_(5); const float* b_forget = (const float*)LDP_(6); const float* pe_k = (const float*)LDP_(7); const float* w_k1 = (const float*)LDP_(8); const float* w_k2 = (const float*)LDP_(9); const float* pe_v = (const float*)LDP_(10); const float* w_v1 = (const float*)LDP_(11); const float* w_v2 = (const float*)LDP_(12); const float* beta_nsa = (const float*)LDP_(13); const float* beta_fox = (const float*)LDP_(14); const float* w_out = (const float*)LDP_(15); const float* g_ffn = (const float*)LDP_(16); const float* w_group = (const float*)LDP_(17); const float* b_group = (const float*)LDP_(18); const float* w_router = (const float*)LDP_(19); const float* b_router = (const float*)LDP_(20); const float* w_gate_e = (const float*)LDP_(21); const float* w_up_e = (const float*)LDP_(22); const float* w_down_e = (const float*)LDP_(23); const float* g_ple = (const float*)LDP_(24); const float* w_ple_gate = (const float*)LDP_(25); const float* b_ple = (const float*)LDP_(26); const float* w_ple_proj = (const float*)LDP_(27); const float* g_final = (const float*)LDP_(28); \
    bf16* WIN_T = (bf16*)(ws + WS_WIN); bf16* WOUT_T = (bf16*)(ws + WS_WOUT); bf16* WPG_T = (bf16*)(ws + WS_WPG); bf16* WPP_T = (bf16*)(ws + WS_WPP); bf16* WGU_T = (bf16*)(ws + WS_WGU); bf16* WD_T = (bf16*)(ws + WS_WD); bf16* XN = (bf16*)(ws + WS_XN); bf16* PROJB = (bf16*)(ws + WS_PROJB); bf16* W1KT = (bf16*)(ws + WS_CMPW); bf16* W1VT = W1KT + 128 * 2048; bf16* W2KT = W1VT + 128 * 2048; bf16* W2VT = W2KT + 64 * 128; bf16* KCB = (bf16*)(ws + WS_KC); bf16* VCB = (bf16*)(ws + WS_VC); bf16* PB = (bf16*)(ws + WS_PB); bf16* PPB = XN; bf16* VPLE = (bf16*)(ws + WS_USORT); float* ROPE = (float*)(ws + WS_ROPE); float* GATES = (float*)(ws + WS_GATES); float* LOGF = (float*)(ws + WS_LOGF); unsigned short* OMIX = (unsigned short*)out; float* HB = out;   float* CUM2 = (float*)(ws + WS_CUM); int* EIDB = (int*)(ws + WS_EID); float* CWB = (float*)(ws + WS_CW); float* RSTD2 = (float*)(ws + WS_RS3); int* LC = (int*)(ws + WS_TAB); int* TILE_E = LC + 1024 * 16; int* NTILES = TILE_E + 1024; int* POS = (int*)(ws + WS_POS); int* ROWIDX = (int*)(ws + WS_ROWIDX); bf16* USORT = (bf16*)(ws + WS_USORT); bf16* HIDB = (bf16*)(ws + WS_HIDB); bf16* YB = (bf16*)(ws + WS_YB); \
    const int chunk = (T_ + NG - 1) / NG, tok0 = (int)blockIdx.x * chunk, ntok = (tok0 + chunk <= T_) ? chunk : (T_ > tok0 ? T_ - tok0 : 0); (void)chunk; (void)tok0; (void)ntok;
__global__ void __launch_bounds__(NTHREADS, 2) mk_fwd(Args args) {
    using namespace nv;
    extern __shared__ __attribute__((aligned(16))) unsigned char lds[];
    LAS unsigned char* ldsp = (LAS unsigned char*)lds;
    volatile LAS unsigned* MISC = (volatile LAS unsigned*)(ldsp + MISC_OFF);
    for (int u = threadIdx.x; u < (LDS_BYTES - LDSCTL_OFF) / 4; u += NTHREADS) ((LAS unsigned*)(ldsp + LDSCTL_OFF))[u] = 0u;
    __syncthreads();
    char* const ws0_ = (char*)args.ws; float* const out0_ = (float*)args.out;
    { LAS unsigned long long* LP_ = (LAS unsigned long long*)(ldsp + LDSCTL_OFF + 512); if (threadIdx.x < 29) LP_[threadIdx.x] = (unsigned long long)(uintptr_t)args.in[threadIdx.x]; }
    __syncthreads();
    XcdBarrier bar = xcd_barrier_post((unsigned*)(ws0_ + WS_CTL) + CW_BAR, MISC + 8);
    const int wave = __builtin_amdgcn_readfirstlane((int)threadIdx.x >> 6);
#define PHASE_IDS() int tid = threadIdx.x; asm volatile("" : "+v"(tid)); const int lane = tid & 63; (void)lane
    const int NG = gridDim.x; const int vcu = (NG % 8 == 0) ? ((int)blockIdx.x % 8) * (NG / 8) + (int)blockIdx.x / 8 : (int)blockIdx.x;
    {   PHASE_PTRS();
    REP(0)
    {
        PHASE_IDS();
        LAS float* scr = (LAS float*)(ldsp + RING_OFF + wave * 16384);
        const int gw = vcu * NWAVES + wave, NGW = NG * NWAVES;
        constexpr int I_IN_A = 16 * 40, I_IN_B = 16 * 48, I_IN_C = 16 * 1, I_SQ = 16 * 32, I_PP = 4 * 32, I_EG = 16 * 16, I_ED = 8 * 32;
        constexpr int I_C1 = 32 * 4, I_C2 = 2 * 2;
        constexpr int NITEMS = I_IN_A + I_IN_B + I_IN_C + 2 * I_SQ + I_PP + 2 * (I_C1 + I_C2) + 16 * (2 * I_EG + I_ED);
        for (int it = gw; it < NITEMS; it += NGW) {
            int r = it;
            if (r < I_IN_A) { p0_transpose_item<3>(w_in, IN_COLS, 0, 1024, 40, WIN_T, 0, scr, r, lane); continue; } r -= I_IN_A;
            if (r < I_IN_B) { p0_transpose_item<3>(w_in, IN_COLS, OFF_QB, 1024, 48, WIN_T, 1280, scr, r, lane); continue; } r -= I_IN_B;
            if (r < I_IN_C) { p0_transpose_item<2>(w_in, IN_COLS, OFF_GATE, 1024, 1, WIN_T, 2816, scr, r, lane); continue; } r -= I_IN_C;
            if (r < I_SQ) { p0_transpose_item<0>(w_out, 1024, 0, 1024, 32, WOUT_T, 0, scr, r, lane); continue; } r -= I_SQ;
            if (r < I_SQ) { p0_transpose_item<0>(w_ple_gate, 1024, 0, 1024, 32, WPG_T, 0, scr, r, lane); continue; } r -= I_SQ;
            if (r < I_PP) { p0_transpose_item<0>(w_ple_proj, 1024, 0, 256, 32, WPP_T, 0, scr, r, lane); continue; } r -= I_PP;
            if (r < I_C1) { p0_transpose_item<0>(w_k1, 128, 0, 2048, 4, W1KT, 0, scr, r, lane); continue; } r -= I_C1;
            if (r < I_C1) { p0_transpose_item<0>(w_v1, 128, 0, 2048, 4, W1VT, 0, scr, r, lane); continue; } r -= I_C1;
            if (r < I_C2) { p0_transpose_item<0>(w_k2, 64, 0, 128, 2, W2KT, 0, scr, r, lane); continue; } r -= I_C2;
            if (r < I_C2) { p0_transpose_item<0>(w_v2, 64, 0, 128, 2, W2VT, 0, scr, r, lane); continue; } r -= I_C2;
            const int e = r / (2 * I_EG + I_ED); r -= e * (2 * I_EG + I_ED);
            if (r < I_EG) { p0_transpose_item<1>(w_gate_e + (size_t)e * 1024 * 512, 512, 0, 1024, 16, WGU_T + (size_t)e * 1024 * 1024, 0, scr, r, lane); continue; } r -= I_EG;
            if (r < I_EG) { p0_transpose_item<1>(w_up_e + (size_t)e * 1024 * 512, 512, 0, 1024, 16, WGU_T + (size_t)e * 1024 * 1024, 4, scr, r, lane); continue; } r -= I_EG;
            p0_transpose_item<0>(w_down_e + (size_t)e * 512 * 1024, 1024, 0, 512, 32, WD_T + (size_t)e * 1024 * 512, 0, scr, r, lane);
        }
        for (int i = (int)blockIdx.x * NTHREADS + tid; i < T_ * 8; i += NG * NTHREADS) { const int tok = i >> 3, j = i & 7;
            const float inv = powf(500000.0f, -(float)j / 8.0f); const float ang = (float)positions[tok] * inv; const float cv = cosf(ang), sv = sinf(ang); ROPE[(size_t)i * 2] = cv; ROPE[(size_t)i * 2 + 1] = sv;
            typedef _Float16 h2_t __attribute__((ext_vector_type(2))); const h2_t hv = {(_Float16)cv, (_Float16)sv}; ((unsigned*)(ws + WS_ROPEH))[i] = __builtin_bit_cast(unsigned, hv); }
        for (int m = gw; m < T_; m += 2 * NGW) {
            const bool hasB = m + NGW < T_; const int mB = hasB ? m + NGW : m;
            const GAS f32x4* xa = (const GAS f32x4*)(in_x + (size_t)m * DM) + lane; const GAS f32x4* xb = (const GAS f32x4*)(in_x + (size_t)mB * DM) + lane;
            f32x4 va[4], vb[4]; float sa = 0.f, sb = 0.f;
#pragma unroll
            for (int j = 0; j < 4; ++j) { va[j] = xa[64 * j]; vb[j] = xb[64 * j]; }
            const f32x4 pa = ((const GAS f32x4*)(in_p + (size_t)m * 256))[lane], pb = ((const GAS f32x4*)(in_p + (size_t)mB * 256))[lane];
#pragma unroll
            for (int j = 0; j < 4; ++j) { sa += (va[j].x * va[j].x + va[j].y * va[j].y) + (va[j].z * va[j].z + va[j].w * va[j].w); sb += (vb[j].x * vb[j].x + vb[j].y * vb[j].y) + (vb[j].z * vb[j].z + vb[j].w * vb[j].w); }
            const float ra = 1.f / sqrtf(wave_sum(sa) * (1.f / 1024.f) + 1e-6f), rb = 1.f / sqrtf(wave_sum(sb) * (1.f / 1024.f) + 1e-6f);
            GAS unsigned long long* oa = (GAS unsigned long long*)(XN + (size_t)m * DM) + lane; GAS unsigned long long* ob = (GAS unsigned long long*)(XN + (size_t)mB * DM) + lane;
#pragma unroll
            for (int j = 0; j < 4; ++j) { const f32x4 g = ((const GAS f32x4*)g_mix)[lane + 64 * j];
                oa[64 * j] = (unsigned long long)pk2(va[j].x * ra * g.x, va[j].y * ra * g.y) | ((unsigned long long)pk2(va[j].z * ra * g.z, va[j].w * ra * g.w) << 32);
                if (hasB) ob[64 * j] = (unsigned long long)pk2(vb[j].x * rb * g.x, vb[j].y * rb * g.y) | ((unsigned long long)pk2(vb[j].z * rb * g.z, vb[j].w * rb * g.w) << 32); }
            ((GAS unsigned long long*)(PB + (size_t)m * 256))[lane] = (unsigned long long)pk2(pa.x, pa.y) | ((unsigned long long)pk2(pa.z, pa.w) << 32);
            if (hasB) ((GAS unsigned long long*)(PB + (size_t)mB * 256))[lane] = (unsigned long long)pk2(pb.x, pb.y) | ((unsigned long long)pk2(pb.z, pb.w) << 32); }
    }
    }
    xcd_barrier(bar); if (PROBE_DUP == 60) xcd_barrier(bar);
    {   PHASE_PTRS();

    REP(1)
    {
        pg8::Gemm g{XN, WIN_T, T_, NIN, DM, 0}; pg8::StaticOrder S; S.init(T_, NIN, NG, (int)blockIdx.x);
        pg8::EpiInProj E{PROJB, ROPE, GATES, LOGF, b_gate, b_forget, (float*)(ws + WS_NRM), 0};
        if (PROBE_DUP >= 64 && PROBE_DUP <= 66) { pg8::EpiInProj E2 = E; E2.dbg = PROBE_DUP - 63; pg8::gemm_phase<pg8::EpiInProj, pg8::StaticOrder, false, true>(ldsp + RING_OFF, g, S, E2); }
        if (PROBE_DUP == 63) { pg8::EpiBf16Plain EP{PROJB, at::PITCH}; pg8::Gemm g2{XN, WIN_T, T_, 2816, DM, 0}; pg8::StaticOrder S2; S2.init(T_, 2816, NG, (int)blockIdx.x); pg8::gemm_phase<pg8::EpiBf16Plain, pg8::StaticOrder, false, true>(ldsp + RING_OFF, g2, S2, EP); }
        pg8::gemm_phase<pg8::EpiInProj, pg8::StaticOrder, false, true>(ldsp + RING_OFF, g, S, E);
        if (PROBE_DUP == 61) { pg8::EpiNull EN; pg8::gemm_phase<pg8::EpiNull, pg8::StaticOrder, true, true>(ldsp + RING_OFF, g, S, EN); }
    }
    }
    xcd_barrier(bar); if (PROBE_DUP == 60) xcd_barrier(bar);
    {   PHASE_PTRS();

    REP(3)
    { char* shm = (char*)lds + RING_OFF; constexpr int NT8 = (NCMP + 31) / 32; const int nunits = 2 * B_ * 2 * NT8;
      for (int uid = (int)blockIdx.x; uid < nunits; uid += NG) { const int nt = uid % NT8, g = (uid / NT8) & 1, b = (uid / (2 * NT8)) % B_, which = uid / (2 * NT8 * B_);
          at::compress_unit(PROJB + (size_t)b * S_ * at::PITCH + (which ? 640 : 512) + g * 64, 32 * nt, NCMP, which ? pe_v : pe_k, which ? W1VT : W1KT, which ? W2VT : W2KT,
                            which ? (const float*)nullptr : ROPE + (size_t)b * S_ * 16, (which ? VCB : KCB) + (size_t)b * 256 * 128 + g * 64, shm); }
      PHASE_IDS(); const int gw = vcu * NWAVES + wave, NGW = NG * NWAVES; constexpr int PER = S_ / 64; constexpr int NCH = S_ / 64;
      for (int task = gw; task < B_ * 8; task += NGW) {
          if (task < B_ * 8) { const int bh = task, b = bh >> 3, h = bh & 7; const float* lf = LOGF + ((size_t)b * S_ + (size_t)PER * lane) * 8 + h;
              float vals[PER]; float s = 0.f;
#pragma unroll
              for (int j = 0; j < PER; ++j) { vals[j] = lf[j * 8]; s += vals[j]; }
              float incl = s;
#pragma unroll
              for (int o = 1; o < 64; o <<= 1) { const float v = __builtin_bit_cast(float, __builtin_amdgcn_ds_bpermute((lane - o) << 2, __builtin_bit_cast(int, incl))); if (lane >= o) incl += v; }
              float run = incl - s; float* cp = CUM2 + (size_t)bh * S_ + PER * lane;
#pragma unroll
              for (int j = 0; j < PER; ++j) { run += vals[j]; cp[j] = run * 1.4426950408889634f; }
          } } }
    }
    xcd_barrier(bar); if (PROBE_DUP == 60) xcd_barrier(bar);
    {   PHASE_PTRS();
    REP(4)
    { PHASE_IDS(); const int r32 = lane & 31, hi = lane >> 5;
      char* shm = (char*)lds + RING_OFF;
      const int nunits = B_ * 2 * NBLK;
      for (int it = 0;; ++it) {
          int bg, c;
          if (NG == 256 && S_ == 4096 && B_ == 8) { if (it >= 4) break; const int s = vcu & 15; bg = vcu >> 4; c = it == 0 ? s : it == 1 ? 31 - s : it == 2 ? 32 + s : 63 - s; }
          else { const int uid = it * NG + (int)blockIdx.x; if (uid >= nunits) break; bg = uid / NBLK; c = uid % NBLK; }
          const int b = bg >> 1, g = bg & 1, h = g * 4 + (wave >> 1), tq0 = c * 64 + 32 * (wave & 1);
          const size_t tokb = (size_t)b * S_ + tq0;
          at::UnitIO U; U.Qw = PROJB + tokb * at::PITCH + h * 64; U.t_hi = c; U.t_first = c; U.qpos = tq0 + r32;
          unsigned short* ob = OMIX + tokb * DM + h * 64; const float* gp = GATES + tokb * 24 + h * 3;
          at::f32x16 o[2], osum; float l; float rli[16];
          bool fast_sel, fast_win;
          { const float* hmt = (const float*)(ws + WS_NRM) + ((size_t)b * (S_ / 256) * 2 + (lane & 31)) * 28; float q2 = 0.f;
#pragma unroll
            for (int hh = 0; hh < 4; ++hh) q2 = fmaxf(q2, lx::max64(hmt[g * 4 + hh]));
            const float qmax = sqrtf(q2), ksm = sqrtf(lx::max64(hmt[8 + g])), kwm = sqrtf(lx::max64(hmt[10 + g]));
            fast_sel = __builtin_amdgcn_readfirstlane((int)(qmax * ksm <= 60.0f)) != 0; fast_win = __builtin_amdgcn_readfirstlane((int)(qmax * kwm <= 60.0f)) != 0; }
          for (int pr_ = 0; pr_ < (PROBE_DUP == 22 ? 2 : 1); ++pr_)
          at::cmp_stage(U.Qw, KCB + (size_t)b * 256 * 128 + g * 64, VCB + (size_t)b * 256 * 128 + g * 64, c, nv::NSEL, shm, o);
          float* accw = (float*)(shm + at::CMP_IMP) + wave * 2048; static_assert(at::CMP_SELM + 512 <= LDSCTL_OFF, "NSA LDS map"); at::fold_rows<true, false>(accw, o, nullptr, gp, 24);
          U.Kh = PROJB + (size_t)b * S_ * at::PITCH + 768 + g * 64; U.Vh = PROJB + (size_t)b * S_ * at::PITCH + 896 + g * 64; U.t_lo = 0; U.win = 0;
          U.selm = ((const unsigned long long*)(shm + at::CMP_SELM))[32 * (wave & 1) + r32];
          if (PROBE_DUP >= 41 && PROBE_DUP <= 43) { at::f32x16 o_[2], os_; float l_; at::attn_tiles<at::M_SEL, true, PROBE_DUP - 40>(U, shm, o_, l_, os_); asm volatile("" :: "v"(o_[0]), "v"(o_[1]), "v"(os_)); }
          for (int pr_ = 0; pr_ < (PROBE_DUP == 20 ? 2 : 1); ++pr_)
          if (fast_sel) { at::attn_tiles<at::M_SEL, true>(U, shm, o, l, osum);
#pragma unroll
              for (int r = 0; r < 16; ++r) rli[r] = 1.0f / osum[r]; }
          else { at::attn_tiles<at::M_SEL, false>(U, shm, o, l, osum); at::row_inv(l, shm, rli); }
          at::fold_rows<false, false>(accw, o, rli, gp + 1, 24);
          U.Kh = PROJB + (size_t)b * S_ * at::PITCH + 1024 + g * 64; U.Vh = PROJB + (size_t)b * S_ * at::PITCH + 1152 + g * 64; U.t_lo = c > (nv::WIN / 64) ? c - (nv::WIN / 64) : 0; U.win = nv::WIN; U.selm = 0ull;
          for (int pr_ = 0; pr_ < (PROBE_DUP == 21 ? 2 : 1); ++pr_)
          if (fast_win) { at::attn_tiles<at::M_WIN, true>(U, shm, o, l, osum);
#pragma unroll
              for (int r = 0; r < 16; ++r) rli[r] = 1.0f / osum[r]; }
          else { at::attn_tiles<at::M_WIN, false>(U, shm, o, l, osum); at::row_inv(l, shm, rli); }
          at::fold_rows<false, true>(accw, o, rli, gp + 2, 24);
          at::store_rows<false>(o, nullptr, ob, DM, nullptr, 0);
      } }
    REP(5)
    { PHASE_IDS(); const int r32 = lane & 31;
      char* shm = (char*)lds + RING_OFF; (void)r32;
      const int nunits = B_ * 8 * (S_ / 256); gu32* qctr = (gu32*)(ws + WS_CTL) + CW_FOXQ + 64 * rep_;
      for (;;) {
          if (tid == 0) MISC[4] = __hip_atomic_fetch_add(qctr, 1u, RLX_AGENT);
          __syncthreads();
          const int uid = __builtin_amdgcn_readfirstlane((int)MISC[4]);
          __syncthreads();
          if (uid >= nunits) break;
          const int qb = (S_ / 256 - 1) - uid / (B_ * 8), bh = uid % (B_ * 8);
          const int b = bh >> 3, h = bh & 7, q0 = qb * 256;
          int t_lo; float sbnd;
          bool fast;
          { const float* c2 = CUM2 + (size_t)bh * S_; const float* hmb = (const float*)(ws + WS_NRM) + (size_t)b * (S_ / 256) * 2 * 28;
            const float qn = sqrtf(fmaxf(hmb[(qb * 2) * 28 + 12 + h], hmb[(qb * 2 + 1) * 28 + 12 + h]));
            const float knu = sqrtf(fmaxf(hmb[(qb * 2) * 28 + 20 + h], hmb[(qb * 2 + 1) * 28 + 20 + h]));
            const float knt = sqrtf(hmb[(lane >> 1) * 28 + 20 + h]);
            const bool skip = (lane < 4 * qb) && (qn * (knt + knu) + (c2[q0] - c2[64 * lane + 63]) < -30.0f);
            const unsigned long long sk = __ballot(skip); t_lo = sk == ~0ull ? 64 : __builtin_ctzll(~sk); if (t_lo > 4 * qb) t_lo = 4 * qb; t_lo = __builtin_amdgcn_readfirstlane(t_lo);
            const float kmax = sqrtf(lx::max64(hmb[(lane & 31) * 28 + 20 + h]));
            fast = __builtin_amdgcn_readfirstlane((int)(qn * kmax <= 60.0f)) != 0; sbnd = qn * kmax; }
          { LAS float* ck = (LAS float*)(ldsp + RING_OFF + at::LDS_CK); const float* src = CUM2 + (size_t)bh * S_; const int nk = q0 + 256;
            for (int k = 64 * t_lo + tid; k < nk; k += NTHREADS) ck[k] = src[k]; }
          __syncthreads();
          at::UnitIO U; U.Qw = PROJB + ((size_t)b * S_ + q0 + 32 * wave) * at::PITCH + 1280 + h * 64; U.Kh = PROJB + (size_t)b * S_ * at::PITCH + 1792 + h * 64; U.Vh = PROJB + (size_t)b * S_ * at::PITCH + 2304 + h * 64;
          U.t_hi = 4 * qb + 3; U.t_lo = t_lo; U.t_first = 4 * qb + (wave >> 1); U.qpos = q0 + 32 * wave + r32; U.selm = 0ull; U.win = 0; U.cq = CUM2[(size_t)bh * S_ + U.qpos]; U.sbound = sbnd; U.c2q0 = CUM2[(size_t)bh * S_ + q0];
          at::f32x16 o[2], osum; float l; float rli[16];
          if (fast) { at::attn_tiles<at::M_FOX, true>(U, shm, o, l, osum);
#pragma unroll
              for (int r = 0; r < 16; ++r) rli[r] = 1.0f / osum[r]; }
          else { at::attn_tiles<at::M_FOX, false>(U, shm, o, l, osum); at::row_inv(l, shm, rli); }
          at::store_rows<false>(o, rli, OMIX + ((size_t)b * S_ + q0 + 32 * wave) * DM + 512 + h * 64, DM, nullptr, 0);
      } }
    }
    xcd_barrier(bar); if (PROBE_DUP == 60) xcd_barrier(bar);
    {   PHASE_PTRS();
    REP(6)
    { PHASE_IDS(); const int gw = vcu * NWAVES + wave, NGW = NG * NWAVES;
      for (int m = gw; m < T_; m += NGW) {
          typedef unsigned u32x2m __attribute__((ext_vector_type(2))); const GAS u32x2m* xr = (const GAS u32x2m*)(OMIX + (size_t)m * DM) + lane; f32x4 v[4]; float s0 = 0.f, s1 = 0.f;
#pragma unroll
          for (int j = 0; j < 4; ++j) { const u32x2m w = xr[64 * j]; v[j] = (f32x4){__builtin_bit_cast(float, w.x << 16), __builtin_bit_cast(float, w.x & 0xffff0000u), __builtin_bit_cast(float, w.y << 16), __builtin_bit_cast(float, w.y & 0xffff0000u)};
              const float q = (v[j].x * v[j].x + v[j].y * v[j].y) + (v[j].z * v[j].z + v[j].w * v[j].w); if (j < 2) s0 += q; else s1 += q; }
          const float r0 = 1.f / sqrtf(wave_sum(s0) * (1.f / 512.f) + 1e-6f), r1 = 1.f / sqrtf(wave_sum(s1) * (1.f / 512.f) + 1e-6f);
          GAS unsigned long long* o8 = (GAS unsigned long long*)(XN + (size_t)m * DM) + lane;
#pragma unroll
          for (int j = 0; j < 4; ++j) { const f32x4 g = j < 2 ? ((const GAS f32x4*)beta_nsa)[lane + 64 * j] : ((const GAS f32x4*)beta_fox)[lane + 64 * (j - 2)]; const float r = j < 2 ? r0 : r1;
              o8[64 * j] = (unsigned long long)pk2(v[j].x * r * g.x, v[j].y * r * g.y) | ((unsigned long long)pk2(v[j].z * r * g.z, v[j].w * r * g.w) << 32); }
      } }
    }
    xcd_barrier(bar); if (PROBE_DUP == 60) xcd_barrier(bar);
    {   PHASE_PTRS();
    REP(7)
    { pg8::Gemm g{XN, WOUT_T, T_, DM, DM, 0}; pg8::StaticOrder S; S.init(T_, DM, NG, (int)blockIdx.x);
      pg8::EpiResF32 E{in_x, HB, DM};
      pg8::gemm_phase<pg8::EpiResF32, pg8::StaticOrder, true, true>(ldsp + RING_OFF, g, S, E); }
    }
    xcd_barrier(bar); if (PROBE_DUP == 60) xcd_barrier(bar);
    {   PHASE_PTRS();
    REP(8)
    { PHASE_IDS();
      LAS float* WR = (LAS float*)(ldsp + RING_OFF); LAS int* LCNT = (LAS int*)(ldsp + RING_OFF + 81920); LAS float* RS = (LAS float*)(ldsp + RING_OFF + 81920 + 64) + wave * (16 * 24);
#pragma unroll
      for (int kk = 0; kk < 1024 / NTHREADS; ++kk) { const int k = tid + kk * NTHREADS; const float gk = g_ffn[k];
          const f32x4 wg4 = *(const GAS f32x4*)(w_group + k * 4); const GAS f32x4* wr4 = (const GAS f32x4*)(w_router + k * 16); const f32x4 r0 = wr4[0], r1 = wr4[1], r2 = wr4[2], r3 = wr4[3];
          LAS f32x4* dst = (LAS f32x4*)(WR + ((((k >> 8) * 4 + (k & 3)) * 64) + ((k >> 2) & 63)) * 20);   dst[0] = wg4 * gk; dst[1] = r0 * gk; dst[2] = r1 * gk; dst[3] = r2 * gk; dst[4] = r3 * gk; }
      if (tid < 16) LCNT[tid] = 0;
      __syncthreads();
      for (int pa_ = 0; pa_ < (PROBE_DUP == 50 ? 2 : 1); ++pa_)
      {
      f32x4 na[4], nb[4];
      { const int tA = tok0 + (wave < ntok ? wave : 0), tB = (wave + NWAVES < ntok) ? tA + NWAVES : tA;
        const GAS f32x4* xa = (const GAS f32x4*)(HB + (size_t)tA * DM) + lane; const GAS f32x4* xb = (const GAS f32x4*)(HB + (size_t)tB * DM) + lane;
#pragma unroll
        for (int j = 0; j < 4; ++j) { na[j] = xa[64 * j]; nb[j] = xb[64 * j]; } }
      for (int tt = wave; tt < ntok; tt += 2 * NWAVES) { const int tokA = tok0 + tt; const bool hasB = tt + NWAVES < ntok; const int tokB = hasB ? tokA + NWAVES : tokA;
          f32x4 ha[4], hb[4];
#pragma unroll
          for (int j = 0; j < 4; ++j) { ha[j] = na[j]; hb[j] = nb[j]; }
          if (tt + 2 * NWAVES < ntok) { const int tA = tokA + 2 * NWAVES, tB = (tt + 3 * NWAVES < ntok) ? tA + NWAVES : tA;
              const GAS f32x4* xa = (const GAS f32x4*)(HB + (size_t)tA * DM) + lane; const GAS f32x4* xb = (const GAS f32x4*)(HB + (size_t)tB * DM) + lane;
#pragma unroll
              for (int j = 0; j < 4; ++j) { na[j] = xa[64 * j]; nb[j] = xb[64 * j]; } }
          float va[32], vb[32];
#pragma unroll
          for (int c = 0; c < 32; ++c) { va[c] = 0.f; vb[c] = 0.f; }
#pragma unroll
          for (int m = 0; m < 16; ++m) { const float a_ = ha[m >> 2][m & 3], b_ = hb[m >> 2][m & 3]; va[20] += a_ * a_; vb[20] += b_ * b_; const LAS f32x4* wp = (const LAS f32x4*)(WR + (64 * m + lane) * 20);
#pragma unroll
              for (int q = 0; q < 5; ++q) { const f32x4 w = wp[q];
                  va[4 * q] += a_ * w[0]; va[4 * q + 1] += a_ * w[1]; va[4 * q + 2] += a_ * w[2]; va[4 * q + 3] += a_ * w[3];
                  vb[4 * q] += b_ * w[0]; vb[4 * q + 1] += b_ * w[1]; vb[4 * q + 2] += b_ * w[2]; vb[4 * q + 3] += b_ * w[3]; } }
#define RT_BFLY(v) do { \
          _Pragma("unroll") for (int c = 0; c < 16; ++c) { const bool hi = lane & 32; const float keep = hi ? v[c + 16] : v[c], send = hi ? v[c] : v[c + 16]; v[c] = keep + lx::x32f(send, hi); } \
          _Pragma("unroll") for (int c = 0; c < 8; ++c) { const bool hi = lane & 16; const float keep = hi ? v[c + 8] : v[c], send = hi ? v[c] : v[c + 8]; v[c] = keep + lx::xf<16>(send); } \
          _Pragma("unroll") for (int c = 0; c < 4; ++c) { const bool hi = lane & 8; const float keep = hi ? v[c + 4] : v[c], send = hi ? v[c] : v[c + 4]; v[c] = keep + lx::xf<8>(send); } \
          _Pragma("unroll") for (int c = 0; c < 2; ++c) { const bool hi = lane & 4; const float keep = hi ? v[c + 2] : v[c], send = hi ? v[c] : v[c + 2]; v[c] = keep + lx::xf<4>(send); } \
          { const bool hi = lane & 2; const float keep = hi ? v[1] : v[0], send = hi ? v[0] : v[1]; v[0] = keep + lx::xf<2>(send); } \
          v[0] += lx::xf<1>(v[0]); } while (0)
          RT_BFLY(va); RT_BFLY(vb);
#undef RT_BFLY
          if (!(lane & 1) && (lane >> 1) < 21) { RS[(tt >> 3) * 24 + (lane >> 1)] = va[0]; if (hasB) RS[((tt >> 3) + 1) * 24 + (lane >> 1)] = vb[0]; }
          const float ra = 1.0f / sqrtf(__builtin_bit_cast(float, __builtin_amdgcn_readlane(__builtin_bit_cast(int, va[0]), 40)) * (1.f / 1024.f) + 1e-6f);
          const float rb = 1.0f / sqrtf(__builtin_bit_cast(float, __builtin_amdgcn_readlane(__builtin_bit_cast(int, vb[0]), 40)) * (1.f / 1024.f) + 1e-6f);
          const GAS f32x4* gr = (const GAS f32x4*)g_ffn + lane;
          GAS unsigned long long* oa = (GAS unsigned long long*)(XN + (size_t)tokA * DM) + lane; GAS unsigned long long* ob = (GAS unsigned long long*)(XN + (size_t)tokB * DM) + lane;
#pragma unroll
          for (int j = 0; j < 4; ++j) { const f32x4 gg = gr[64 * j];
              oa[64 * j] = (unsigned long long)pk2(ha[j].x * ra * gg.x, ha[j].y * ra * gg.y) | ((unsigned long long)pk2(ha[j].z * ra * gg.z, ha[j].w * ra * gg.w) << 32);
              if (hasB) ob[64 * j] = (unsigned long long)pk2(hb[j].x * rb * gg.x, hb[j].y * rb * gg.y) | ((unsigned long long)pk2(hb[j].z * rb * gg.z, hb[j].w * rb * gg.w) << 32); }
      }
      }
      asm volatile("s_waitcnt lgkmcnt(0)" ::: "memory");
      { const int tt = wave + NWAVES * lane; const bool have = lane < 16 && tt < ntok; const int tok = tok0 + (have ? tt : 0);
          float s[21];
#pragma unroll
          for (int c = 0; c < 21; ++c) s[c] = RS[(lane & 15) * 24 + c];
          const float rstd = 1.0f / sqrtf(s[20] * (1.f / 1024.f) + 1e-6f);
          float gl[4], el[16];
#pragma unroll
          for (int c = 0; c < 4; ++c) gl[c] = s[c] * rstd + b_group[c];
#pragma unroll
          for (int e = 0; e < 16; ++e) el[e] = s[4 + e] * rstd + b_router[e];
          int gs = 0; float gm = gl[0];
#pragma unroll
          for (int c = 1; c < 4; ++c) if (gl[c] > gm) { gm = gl[c]; gs = c; }
          float gsum = 0.f;
#pragma unroll
          for (int c = 0; c < 4; ++c) gsum += expf(gl[c] - gm);
          const float gprob = 1.0f / gsum;
          float il[4] = {0.f, 0.f, 0.f, 0.f};
#pragma unroll
          for (int c = 0; c < 4; ++c)
#pragma unroll
              for (int e = 0; e < 4; ++e) if (gs == c) il[e] = el[c * 4 + e];
          float im = fmaxf(fmaxf(il[0], il[1]), fmaxf(il[2], il[3])); float ipr[4], isum = 0.f;
#pragma unroll
          for (int e = 0; e < 4; ++e) { ipr[e] = expf(il[e] - im); isum += ipr[e]; }
#pragma unroll
          for (int e = 0; e < 4; ++e) ipr[e] /= isum;
          int i0 = 0; float v0 = ipr[0];
#pragma unroll
          for (int e = 1; e < 4; ++e) if (ipr[e] > v0) { v0 = ipr[e]; i0 = e; }
          int i1 = -1; float v1 = -1.f;
#pragma unroll
          for (int e = 0; e < 4; ++e) if (e != i0 && ipr[e] > v1) { v1 = ipr[e]; i1 = e; }
          const float den = v0 + v1;
          if (have) { const int e0 = gs * 4 + i0, e1 = gs * 4 + i1; EIDB[tok * 2] = e0; EIDB[tok * 2 + 1] = e1; CWB[tok * 2] = gprob * (v0 / den); CWB[tok * 2 + 1] = gprob * (v1 / den); RSTD2[tok] = rstd;
              atomicAdd((int*)&LCNT[e0], 1); atomicAdd((int*)&LCNT[e1], 1); }
      }
      __syncthreads();
      if (tid < 16) LC[(int)blockIdx.x * 16 + tid] = LCNT[tid];
    }
    }
    xcd_barrier(bar); if (PROBE_DUP == 60) xcd_barrier(bar);
    {   PHASE_PTRS();
    REP(9)
    { PHASE_IDS();
      LAS int* L = (LAS int*)(ldsp + RING_OFF); LAS int* TOT = L + 1024 * 16; LAS int* MINE = TOT + 16; LAS int* BASE = MINE + 16; LAS int* ME = BASE + 32; LAS int* MPOS = ME + 2 * 512;
      for (int i = tid; i < NG * 16; i += NTHREADS) L[i] = LC[i];
      for (int i = tid; i < 2 * ntok; i += NTHREADS) ME[i] = EIDB[tok0 * 2 + i];
      __syncthreads();
      for (int e = wave; e < 16; e += NWAVES) {
          int tot = 0, mine = 0; for (int w = lane; w < NG; w += 64) { const int c = L[w * 16 + e]; tot += c; if (w < (int)blockIdx.x) mine += c; }
          tot = (int)lx::sum64((float)tot); mine = (int)lx::sum64((float)mine);
          if (lane == 0) { TOT[e] = tot; MINE[e] = mine; } }
      __syncthreads();
      if (tid == 0) { int base = 0; for (int e = 0; e < 16; ++e) { BASE[e] = base; base += (TOT[e] + 255) / 256 * 256; } BASE[16] = base; }
      __syncthreads();
      if (blockIdx.x == 0) { const int nt = BASE[16] / 256; for (int pm = tid; pm < nt; pm += NTHREADS) { int e = 0; for (int q = 1; q < 16; ++q) if (BASE[q] <= pm * 256) e = q; TILE_E[pm] = e; } if (tid == 0) NTILES[0] = nt; }
      for (int e = wave; e < 16; e += NWAVES) { int pos = BASE[e] + MINE[e];
          for (int i0 = 0; i0 < 2 * ntok; i0 += 64) { const int i = i0 + lane; const bool mine_ = i < 2 * ntok && ME[i] == e; const unsigned long long bm = __ballot(mine_);
              if (mine_) MPOS[i] = pos + __builtin_popcountll(bm & ((1ull << lane) - 1ull)); pos += __builtin_popcountll(bm); } }
      __syncthreads();
      for (int i = tid; i < 2 * ntok; i += NTHREADS) { POS[tok0 * 2 + i] = MPOS[i]; ROWIDX[MPOS[i]] = tok0 + (i >> 1); }
      if (blockIdx.x == 0) for (int e = wave; e < 16; e += NWAVES) for (int s = BASE[e] + TOT[e] + lane; s < BASE[e + 1]; s += 64) ROWIDX[s] = 0;
    }
    }
    xcd_barrier(bar); if (PROBE_DUP == 60) xcd_barrier(bar);
    {   PHASE_PTRS();
    REP(10)
    { const int NT = __builtin_amdgcn_readfirstlane(__hip_atomic_load(NTILES, __ATOMIC_RELAXED, __HIP_MEMORY_SCOPE_AGENT));
      pg8::Gemm g{XN, WGU_T, NT * 256, DM, DM, (size_t)1024 * 1024 * 2, ROWIDX}; pg8::GroupOrder S; S.init(NT, 4, NG, (int)blockIdx.x, TILE_E);
      pg8::EpiSwiGlu E{HIDB};
      pg8::gemm_phase<pg8::EpiSwiGlu, pg8::GroupOrder, true, true, true>(ldsp + RING_OFF, g, S, E); }
    }
    xcd_barrier(bar); if (PROBE_DUP == 60) xcd_barrier(bar);
    {   PHASE_PTRS();
    REP(11)
    { const int NT = __builtin_amdgcn_readfirstlane(__hip_atomic_load(NTILES, __ATOMIC_RELAXED, __HIP_MEMORY_SCOPE_AGENT));
      pg8::Gemm g{HIDB, WD_T, NT * 256, DM, 512, (size_t)1024 * 512 * 2}; pg8::GroupOrder S; S.init(NT, 4, NG, (int)blockIdx.x, TILE_E);
      pg8::EpiBf16Plain E{YB, DM};
      pg8::gemm_phase<pg8::EpiBf16Plain, pg8::GroupOrder, true, true>(ldsp + RING_OFF, g, S, E); }
    REP(13)
    { pg8::Gemm g{PB, WPP_T, T_, DM, 256, 0}; pg8::StaticOrder S; S.init(T_, DM, NG, (int)blockIdx.x);
      pg8::EpiBf16Plain E{PPB, DM};
      pg8::gemm_phase<pg8::EpiBf16Plain, pg8::StaticOrder, true, true>(ldsp + RING_OFF, g, S, E); }
    }
    xcd_barrier(bar); if (PROBE_DUP == 60) xcd_barrier(bar);
    {   PHASE_PTRS();
    for (int rep_ = 0; rep_ < (PROBE_DUP == 12 ? 2 : 1); ++rep_)
    { PHASE_IDS(); const int gw = vcu * NWAVES + wave, NGW = NG * NWAVES; const float wsc = rep_ ? 0.f : 1.f;
      typedef unsigned u32x2v __attribute__((ext_vector_type(2))); typedef int i32x2v __attribute__((ext_vector_type(2))); typedef float f32x2v __attribute__((ext_vector_type(2)));
      i32x2v npA, npB; f32x2v nwA, nwB;
      { const int mA = gw < T_ ? gw : 0, mB = gw + NGW < T_ ? gw + NGW : mA; npA = ((const GAS i32x2v*)POS)[mA]; npB = ((const GAS i32x2v*)POS)[mB]; nwA = ((const GAS f32x2v*)CWB)[mA]; nwB = ((const GAS f32x2v*)CWB)[mB]; }
      for (int m = gw; m < T_; m += 2 * NGW) { const bool hasB = m + NGW < T_; const int mA = m, mB = hasB ? m + NGW : m;
          const i32x2v pA = npA, pB = npB; const f32x2v wA = nwA * wsc, wB = nwB * wsc;
          GAS f32x4* xa = (GAS f32x4*)(HB + (size_t)mA * DM) + lane; GAS f32x4* xb = (GAS f32x4*)(HB + (size_t)mB * DM) + lane;
          const GAS u32x2v* ya0 = (const GAS u32x2v*)(YB + (size_t)pA.x * DM) + lane; const GAS u32x2v* ya1 = (const GAS u32x2v*)(YB + (size_t)pA.y * DM) + lane;
          const GAS u32x2v* yb0 = (const GAS u32x2v*)(YB + (size_t)pB.x * DM) + lane; const GAS u32x2v* yb1 = (const GAS u32x2v*)(YB + (size_t)pB.y * DM) + lane;
          f32x4 va[4], vb[4]; u32x2v a0[4], a1[4], b0[4], b1[4];
#pragma unroll
          for (int j = 0; j < 4; ++j) { va[j] = xa[64 * j]; vb[j] = xb[64 * j]; a0[j] = ya0[64 * j]; a1[j] = ya1[64 * j]; b0[j] = yb0[64 * j]; b1[j] = yb1[64 * j]; }
          if (m + 2 * NGW < T_) { const int nA = m + 2 * NGW, nB = m + 3 * NGW < T_ ? m + 3 * NGW : nA; npA = ((const GAS i32x2v*)POS)[nA]; npB = ((const GAS i32x2v*)POS)[nB]; nwA = ((const GAS f32x2v*)CWB)[nA]; nwB = ((const GAS f32x2v*)CWB)[nB]; }
          float sa = 0.f, sb = 0.f;
#define CB_ADD(V_, Y0_, Y1_, W_) do { V_[0] += W_[0] * __builtin_bit_cast(float, Y0_[0] << 16) + W_[1] * __builtin_bit_cast(float, Y1_[0] << 16); V_[1] += W_[0] * __builtin_bit_cast(float, Y0_[0] & 0xffff0000u) + W_[1] * __builtin_bit_cast(float, Y1_[0] & 0xffff0000u); \
              V_[2] += W_[0] * __builtin_bit_cast(float, Y0_[1] << 16) + W_[1] * __builtin_bit_cast(float, Y1_[1] << 16); V_[3] += W_[0] * __builtin_bit_cast(float, Y0_[1] & 0xffff0000u) + W_[1] * __builtin_bit_cast(float, Y1_[1] & 0xffff0000u); } while (0)
#pragma unroll
          for (int j = 0; j < 4; ++j) { CB_ADD(va[j], a0[j], a1[j], wA); CB_ADD(vb[j], b0[j], b1[j], wB);
              xa[64 * j] = va[j]; if (hasB) xb[64 * j] = vb[j];
              sa += (va[j].x * va[j].x + va[j].y * va[j].y) + (va[j].z * va[j].z + va[j].w * va[j].w); sb += (vb[j].x * vb[j].x + vb[j].y * vb[j].y) + (vb[j].z * vb[j].z + vb[j].w * vb[j].w); }
#undef CB_ADD
          const float ra = 1.f / sqrtf(wave_sum(sa) * (1.f / 1024.f) + 1e-6f), rb = 1.f / sqrtf(wave_sum(sb) * (1.f / 1024.f) + 1e-6f);
          GAS unsigned long long* oa = (GAS unsigned long long*)(VPLE + (size_t)mA * DM) + lane; GAS unsigned long long* ob = (GAS unsigned long long*)(VPLE + (size_t)mB * DM) + lane;
#pragma unroll
          for (int j = 0; j < 4; ++j) { const f32x4 g = ((const GAS f32x4*)g_ple)[lane + 64 * j];
              oa[64 * j] = (unsigned long long)pk2(va[j].x * ra * g.x, va[j].y * ra * g.y) | ((unsigned long long)pk2(va[j].z * ra * g.z, va[j].w * ra * g.w) << 32);
              if (hasB) ob[64 * j] = (unsigned long long)pk2(vb[j].x * rb * g.x, vb[j].y * rb * g.y) | ((unsigned long long)pk2(vb[j].z * rb * g.z, vb[j].w * rb * g.w) << 32); }
      } }
    }
    xcd_barrier(bar); if (PROBE_DUP == 60) xcd_barrier(bar);
    {   PHASE_PTRS();
    if (NG == 256 && T_ == 32768) {
      pg8::Gemm g{VPLE, WPG_T, T_, DM, DM, 0}; pg8::StaticOrder S; S.init(T_, DM, NG, (int)blockIdx.x);
      pg8::EpiPleGateNorm E{HB, PPB, b_ple, g_final, (float*)(ws + WS_XS), (unsigned*)(ws + WS_CTL) + CW_PANEL, ldsp + RING_BYTES, DM};
      pg8::gemm_phase<pg8::EpiPleGateNorm, pg8::StaticOrder, true, true>(ldsp + RING_OFF, g, S, E);
    } else {
    { pg8::Gemm g{VPLE, WPG_T, T_, DM, DM, 0}; pg8::StaticOrder S; S.init(T_, DM, NG, (int)blockIdx.x);
      pg8::EpiPleGate E{HB, PPB, b_ple, DM};
      pg8::gemm_phase<pg8::EpiPleGate, pg8::StaticOrder, true, true>(ldsp + RING_OFF, g, S, E); }
      xcd_barrier(bar);
    { PHASE_IDS(); const int gw = vcu * NWAVES + wave, NGW = NG * NWAVES;
      for (int m = gw; m < T_; m += NGW) {
          GAS f32x4* xr = (GAS f32x4*)(HB + (size_t)m * DM) + lane; f32x4 v[4]; float s = 0.f;
#pragma unroll
          for (int j = 0; j < 4; ++j) { v[j] = xr[64 * j]; s += (v[j].x * v[j].x + v[j].y * v[j].y) + (v[j].z * v[j].z + v[j].w * v[j].w); }
          const float r = 1.f / sqrtf(wave_sum(s) * (1.f / 1024.f) + 1e-6f);
#pragma unroll
          for (int j = 0; j < 4; ++j) { const f32x4 g = ((const GAS f32x4*)g_final)[lane + 64 * j]; xr[64 * j] = (f32x4){v[j].x * r * g.x, v[j].y * r * g.y, v[j].z * r * g.z, v[j].w * r * g.w}; }
      } }
    }
    }
}
}
extern "C" void kernel_launch(void* const* d_in, const int* in_sizes, int n_in, void* d_out, int out_size, void* d_ws, size_t ws_size, hipStream_t stream) {
    static int grid = 0;
    if (grid == 0) {
        int dev = 0, cus = 0;
        if (n_in != 29 || ws_size < ((size_t)512 << 20)) { fprintf(stderr, "kernel_launch: unexpected n_in %d or ws_size %zu\n", n_in, ws_size); grid = -1; return; }
        if (hipGetDevice(&dev) != hipSuccess || hipDeviceGetAttribute(&cus, hipDeviceAttributeMultiprocessorCount, dev) != hipSuccess) { grid = -1; return; }
        if (hipFuncSetAttribute((const void*)mk::mk_fwd, hipFuncAttributeMaxDynamicSharedMemorySize, mk::LDS_BYTES) != hipSuccess) { fprintf(stderr, "kernel_launch: hipFuncSetAttribute failed\n"); grid = -1; return; }
        int per_cu = 0;
        if (hipOccupancyMaxActiveBlocksPerMultiprocessor(&per_cu, (const void*)mk::mk_fwd, mk::NTHREADS, mk::LDS_BYTES) != hipSuccess || per_cu < 1) { fprintf(stderr, "kernel_launch: occupancy query says %d\n", per_cu); }
        (void)hipGetLastError();
        grid = cus;
    }
    if (grid < 0) return;
    (void)hipMemsetAsync((char*)d_ws + mk::WS_CTL, 0, mk::CTL_ZERO_BYTES, stream);
    mk::Args a{};
    for (int i = 0; i < 29; ++i) a.in[i] = d_in[i];
    a.out = d_out; a.ws = d_ws;
    hipLaunchKernelGGL(mk::mk_fwd, dim3(grid), dim3(mk::NTHREADS), mk::LDS_BYTES, stream, a);
}
```

```cpp
#define PROBE_DUP (-1)
#include <hip/hip_runtime.h>
#include <hip/hip_bf16.h>
#include <cstdio>
#include <cstdint>
#include <cmath>
namespace lx {
template <int M> __device__ __forceinline__ float xf(float v) { static_assert(M >= 1 && M < 32, "xf: within a 32-lane half"); return __builtin_bit_cast(float, __builtin_amdgcn_ds_swizzle(__builtin_bit_cast(int, v), (M << 10) | 0x1f)); }
template <int M> __device__ __forceinline__ int xi(int v) { static_assert(M >= 1 && M < 32, "xi: within a 32-lane half"); return __builtin_amdgcn_ds_swizzle(v, (M << 10) | 0x1f); }
__device__ __forceinline__ float x32f(float v, bool hi) { auto rr = __builtin_amdgcn_permlane32_swap(__float_as_uint(v), __float_as_uint(v), false, false); return __uint_as_float(hi ? rr[0] : rr[1]); }
__device__ __forceinline__ float sum64(float v) { v += xf<1>(v); v += xf<2>(v); v += xf<4>(v); v += xf<8>(v); v += xf<16>(v);
    auto rr = __builtin_amdgcn_permlane32_swap(__float_as_uint(v), __float_as_uint(v), false, false); return __uint_as_float(rr[0]) + __uint_as_float(rr[1]); }
__device__ __forceinline__ float max64(float v) { v = fmaxf(v, xf<1>(v)); v = fmaxf(v, xf<2>(v)); v = fmaxf(v, xf<4>(v)); v = fmaxf(v, xf<8>(v)); v = fmaxf(v, xf<16>(v));
    auto rr = __builtin_amdgcn_permlane32_swap(__float_as_uint(v), __float_as_uint(v), false, false); return fmaxf(__uint_as_float(rr[0]), __uint_as_float(rr[1])); }
}
#ifndef CFG_BATCH
#define CFG_BATCH 8
#endif
#ifndef CFG_SEQ
#define CFG_SEQ 4096
#endif
#ifndef CFG_NSEL
#define CFG_NSEL 16
#endif
#ifndef CFG_WINDOW
#define CFG_WINDOW 512
#endif
namespace nv {
constexpr int B_ = CFG_BATCH, S_ = CFG_SEQ, T_ = B_ * S_, DM = 1024, HD = 64;
constexpr int IN_COLS = 2848;
constexpr int OFF_QA = 0, OFF_KC = 512, OFF_VC = 640, OFF_KS = 768, OFF_VS = 896, OFF_KW = 1024, OFF_VW = 1152,
              OFF_GATE = 1280, OFF_QB = 1304, OFF_KB = 1816, OFF_VB = 2328, OFF_F = 2840;
constexpr int NCMP = (S_ - 32) / 16 + 1, NBLK = S_ / 64, NSEL = (CFG_NSEL < NBLK ? CFG_NSEL : NBLK), WIN = CFG_WINDOW;
constexpr float EPS = 1e-6f;
static_assert(NBLK <= 64, "selection mask is 64 bits");


__device__ __forceinline__ float nv_sigmoid(float x) { return 1.0f / (1.0f + expf(-x)); }
__device__ __forceinline__ float nv_silu(float x) { return x / (1.0f + expf(-x)); }
__device__ __forceinline__ float nv_logsigmoid(float x) { return fminf(x, 0.0f) - log1pf(expf(-fabsf(x))); }


constexpr float C2F = 0.125f * 1.4426950408889634f;
constexpr int PB_COLS = 2816;
struct ProjF32 { const float* p;
    __device__ __forceinline__ float operator()(long tok, int off, int i) const { return p[tok * IN_COLS + off + i]; } };
struct ProjB16 { const unsigned short* p; const float* gates; const float* logf;
    __device__ __forceinline__ float operator()(long tok, int off, int i) const {
        if (off == OFF_GATE) return gates[tok * 24 + i];
        if (off == OFF_F) return logf[tok * 8 + i];
        const int nb = off < OFF_GATE ? off : off - 24;
        const unsigned u = (unsigned)p[tok * PB_COLS + nb + i] << 16;
#ifdef CPU_EMU
        float v; memcpy(&v, &u, 4);
#else
        float v = __builtin_bit_cast(float, u);
#endif
        if (off == OFF_QA || off == OFF_QB) v *= (1.0f / C2F);
        return v; } };

__device__ __forceinline__ void d_rstd(long gid_, const float* __restrict__ x, float* __restrict__ rstd, int rows) {
    long r = gid_; if (r >= rows) return;
    const float* xr = x + r * DM; float s = 0.f;
    for (int k = 0; k < DM; ++k) s += xr[k] * xr[k];
    rstd[r] = 1.0f / sqrtf(s / DM + EPS);
}

__device__ __forceinline__ void d_gemm(long gid_, const float* __restrict__ A, int lda, const float* __restrict__ rs, const float* __restrict__ cs,
                       const float* __restrict__ Bm, int ldb, float* __restrict__ C, int ldc, int M, int N, int K,
                       const float* __restrict__ Res, int ldr) {
    long gid = gid_; const int tn = N / 4; long tiles = (long)(M / 4) * tn; if (gid >= tiles) return;
    const int m0 = (int)(gid / tn) * 4, n0 = (int)(gid % tn) * 4;
    float acc[4][4];
#pragma unroll
    for (int r = 0; r < 4; ++r)
#pragma unroll
        for (int c = 0; c < 4; ++c) acc[r][c] = 0.f;
    for (int k = 0; k < K; ++k) {
        const float sc = cs ? cs[k] : 1.0f;
        const float* bp = Bm + (long)k * ldb + n0;
        const float b0 = bp[0], b1 = bp[1], b2 = bp[2], b3 = bp[3];
#pragma unroll
        for (int r = 0; r < 4; ++r) {
            const float a = A[(long)(m0 + r) * lda + k] * sc;
            acc[r][0] += a * b0; acc[r][1] += a * b1; acc[r][2] += a * b2; acc[r][3] += a * b3;
        }
    }
#pragma unroll
    for (int r = 0; r < 4; ++r) {
        const float s = rs ? rs[m0 + r] : 1.0f;
#pragma unroll
        for (int c = 0; c < 4; ++c) {
            float v = acc[r][c] * s;
            if (Res) v += Res[(long)(m0 + r) * ldr + n0 + c];
            C[(long)(m0 + r) * ldc + n0 + c] = v;
        }
    }
}

__device__ __forceinline__ void d_postproj(long gid_, float* __restrict__ proj, const int* __restrict__ positions, const float* __restrict__ b_gate,
                           const float* __restrict__ b_forget) {
    long gid = gid_; if (gid >= (long)T_ * 14) return;
    const int tok = (int)(gid / 14), unit = (int)(gid % 14);
    float* row = proj + (long)tok * IN_COLS;
    if (unit < 12) {
        int off = unit < 8 ? OFF_QA + unit * 64 : (unit < 10 ? OFF_KS + (unit - 8) * 64 : OFF_KW + (unit - 10) * 64);
        const float pos = (float)positions[tok];
        for (int i = 0; i < 8; ++i) {
            const float inv = powf(500000.0f, -(float)i / 8.0f);
            const float ang = pos * inv, c = cosf(ang), s = sinf(ang);
            const float x1 = row[off + i], x2 = row[off + 8 + i];
            row[off + i] = x1 * c - x2 * s; row[off + 8 + i] = x2 * c + x1 * s;
        }
    } else if (unit == 12) {
        for (int i = 0; i < 24; ++i) row[OFF_GATE + i] = nv_sigmoid(row[OFF_GATE + i] + b_gate[i]);
    } else {
        for (int i = 0; i < 8; ++i) row[OFF_F + i] = nv_logsigmoid(row[OFF_F + i] + b_forget[i]);
    }
}

template <class PJ> __device__ __forceinline__ void d_cumsum(long gid_, const PJ proj, float* __restrict__ cum) {
    long gid = gid_; if (gid >= B_ * 8) return;
    const int b = (int)gid / 8, h = (int)gid % 8; double c = 0.0;
    for (int t = 0; t < S_; ++t) { c += (double)proj((long)b * S_ + t, OFF_F, h); cum[((long)b * 8 + h) * S_ + t] = (float)c; }
}

template <class PJ> __device__ __forceinline__ void d_cmp_hidden(long gid_, const PJ proj, int coloff, const float* __restrict__ pe, const float* __restrict__ w1,
                             float* __restrict__ hid) {
    long gid = gid_; if (gid >= (long)B_ * NCMP * 2 * 128) return;
    const int j = (int)(gid % 128); const int row = (int)(gid / 128); const int g = row % 2, n = (row / 2) % NCMP, b = row / (2 * NCMP);
    float acc = 0.f;
    for (int l = 0; l < 32; ++l) {
        const long tk = (long)b * S_ + 16 * n + l;
        for (int d = 0; d < 64; ++d) acc += (proj(tk, coloff, g * 64 + d) + pe[l * 64 + d]) * w1[(long)(l * 64 + d) * 128 + j];
    }
    hid[(long)row * 128 + j] = nv_silu(acc);
}
__device__ __forceinline__ void d_cmp_out(long gid_, const float* __restrict__ hid, const float* __restrict__ w2, float* __restrict__ out,
                          const int* __restrict__ positions, int dorope) {
    long gid = gid_; if (gid >= (long)B_ * NCMP * 2 * 56) return;
    const int u = (int)(gid % 56); const int row = (int)(gid / 56); const int n = (row / 2) % NCMP, b = row / (2 * NCMP);
    const float* hp = hid + (long)row * 128;
    if (u < 8) {
        float a1 = 0.f, a2 = 0.f;
        for (int j = 0; j < 128; ++j) { a1 += hp[j] * w2[j * 64 + u]; a2 += hp[j] * w2[j * 64 + u + 8]; }
        if (dorope) {
            const float pos = (float)positions[(long)b * S_ + 16 * n + 31];
            const float inv = powf(500000.0f, -(float)u / 8.0f); const float ang = pos * inv, c = cosf(ang), s = sinf(ang);
            const float x1 = a1, x2 = a2; a1 = x1 * c - x2 * s; a2 = x2 * c + x1 * s;
        }
        out[(long)row * 64 + u] = a1; out[(long)row * 64 + u + 8] = a2;
    } else {
        const int d = u + 8; float a = 0.f;
        for (int j = 0; j < 128; ++j) a += hp[j] * w2[j * 64 + d];
        out[(long)row * 64 + d] = a;
    }
}

template <class PJ> __device__ __forceinline__ void d_nsa_cmp(long gid_, const PJ proj, const float* __restrict__ kc, const float* __restrict__ vc,
                          float* __restrict__ imp, unsigned long long* __restrict__ selmask, float* __restrict__ omix) {
    long gid = gid_; if (gid >= (long)T_ * 2) return;
    const int g = (int)(gid % 2); const int tok = (int)(gid / 2); const int b = tok / S_, t = tok % S_;
    const int nvis = t >= 31 ? (t - 31) / 16 + 1 : 0;
    float* ip = imp + ((long)(b * 2 + g) * S_ + t) * 64;
    for (int j = 0; j < NBLK; ++j) ip[j] = 0.f;
#pragma unroll 1
    for (int hh = 0; hh < 4; ++hh) {
        const int h = g * 4 + hh;
        float m = -1e30f;
#pragma unroll 1
        for (int n = 0; n < nvis; ++n) {
            asm volatile("" ::: "memory");
            const float* kp = kc + ((long)(b * NCMP + n) * 2 + g) * 64; float l = 0.f;
#pragma unroll
            for (int d = 0; d < 64; ++d) l += proj(tok, OFF_QA, h * 64 + d) * kp[d];
            m = fmaxf(m, l * 0.125f);
        }
        float sum = 0.f;
#pragma unroll 1
        for (int n = 0; n < nvis; ++n) {
            asm volatile("" ::: "memory");
            const float* kp = kc + ((long)(b * NCMP + n) * 2 + g) * 64; float l = 0.f;
#pragma unroll
            for (int d = 0; d < 64; ++d) l += proj(tok, OFF_QA, h * 64 + d) * kp[d];
            sum += expf(l * 0.125f - m);
        }
        const float g0 = proj(tok, OFF_GATE, h * 3 + 0);
#pragma unroll 1
        for (int dh = 0; dh < 2; ++dh) {
            float o[32];
#pragma unroll
            for (int d = 0; d < 32; ++d) o[d] = 0.f;
#pragma unroll 1
            for (int n = 0; n < nvis; ++n) {
                asm volatile("" ::: "memory");
                const float* kp = kc + ((long)(b * NCMP + n) * 2 + g) * 64; float l = 0.f;
#pragma unroll
                for (int d = 0; d < 64; ++d) l += proj(tok, OFF_QA, h * 64 + d) * kp[d];
                const float p = expf(l * 0.125f - m) / sum;
                const float* vp = vc + ((long)(b * NCMP + n) * 2 + g) * 64 + dh * 32;
#pragma unroll
                for (int d = 0; d < 32; ++d) o[d] += p * vp[d];
                if (dh == 0) {
                    const int j0 = n >> 2;
                    if ((n & 3) < 3) ip[j0] += p; else { ip[j0] += 0.5f * p; if (j0 + 1 < NBLK) ip[j0 + 1] += 0.5f * p; }
                }
            }
#pragma unroll
            for (int d = 0; d < 32; ++d) omix[(long)tok * DM + h * 64 + dh * 32 + d] = g0 * o[d];
        }
    }
    const int cur = t / 64; unsigned long long mask = 0ull;
#pragma unroll 1
    for (int s = 0; s < NSEL; ++s) {
        float best = -3e38f; int bj = -1;
#pragma unroll 1
        for (int j = 0; j < NBLK; ++j) {
            if ((mask >> j) & 1ull) continue;
            const bool forced = (j == 0) || (j == cur) || (j == cur - 1);
            const float sc = (j * 64 > t) ? -1.0f : ip[j] + (forced ? 1e4f : 0.0f);
            if (sc > best) { best = sc; bj = j; }
        }
        mask |= 1ull << bj;
    }
    selmask[(long)(b * 2 + g) * S_ + t] = mask;
}

template <class PJ> __device__ __forceinline__ void d_nsa_selwin(long gid_, const PJ proj, const unsigned long long* __restrict__ selmask, float* __restrict__ omix) {
    long gid = gid_; if (gid >= (long)T_ * 8) return;
    const int h = (int)(gid % 8); const int tok = (int)(gid / 8); const int b = tok / S_, t = tok % S_, g = h >> 2;
    float q[64], o[64];
#pragma unroll
    for (int d = 0; d < 64; ++d) { q[d] = proj(tok, OFF_QA, h * 64 + d); o[d] = 0.f; }
    const unsigned long long mask = selmask[(long)(b * 2 + g) * S_ + t];
    float m = -1e30f, l = 0.f;
    for (int j = 0; j < NBLK; ++j) {
        if (!((mask >> j) & 1ull)) continue;
        for (int kk = 0; kk < 64; ++kk) {
            const int kp = j * 64 + kk; if (kp > t) break;
            const long kr = (long)b * S_ + kp; float s = 0.f;
#pragma unroll
            for (int d = 0; d < 64; ++d) s += q[d] * proj(kr, OFF_KS, g * 64 + d);
            s *= 0.125f;
            const float mn = fmaxf(m, s), al = expf(m - mn), p = expf(s - mn);
            l = l * al + p;
#pragma unroll
            for (int d = 0; d < 64; ++d) o[d] = o[d] * al + p * proj(kr, OFF_VS, g * 64 + d);
            m = mn;
        }
    }
    {
        const float g1 = proj(tok, OFF_GATE, h * 3 + 1) / l;
#pragma unroll
        for (int d = 0; d < 64; ++d) { omix[(long)tok * DM + h * 64 + d] += g1 * o[d]; o[d] = 0.f; }
    }
    m = -1e30f; l = 0.f;
    const int lo = t - WIN + 1 > 0 ? t - WIN + 1 : 0;
    for (int kp = lo; kp <= t; ++kp) {
        const long kr = (long)b * S_ + kp; float s = 0.f;
#pragma unroll
        for (int d = 0; d < 64; ++d) s += q[d] * proj(kr, OFF_KW, g * 64 + d);
        s *= 0.125f;
        const float mn = fmaxf(m, s), al = expf(m - mn), p = expf(s - mn);
        l = l * al + p;
#pragma unroll
        for (int d = 0; d < 64; ++d) o[d] = o[d] * al + p * proj(kr, OFF_VW, g * 64 + d);
        m = mn;
    }
    {
        const float g2 = proj(tok, OFF_GATE, h * 3 + 2) / l;
#pragma unroll
        for (int d = 0; d < 64; ++d) omix[(long)tok * DM + h * 64 + d] += g2 * o[d];
    }
}

template <class PJ> __device__ __forceinline__ void d_fox(long gid_, const PJ proj, const float* __restrict__ cum, float* __restrict__ omix) {
    long gid = gid_; if (gid >= (long)T_ * 8) return;
    const int t = (int)(gid % S_); const int bh = (int)(gid / S_); const int b = bh / 8, h = bh % 8;
    const long tok = (long)b * S_ + t;
    float q[64], o[64];
#pragma unroll
    for (int d = 0; d < 64; ++d) { q[d] = proj(tok, OFF_QB, h * 64 + d); o[d] = 0.f; }
    const float* cp = cum + ((long)b * 8 + h) * S_; const float cq = cp[t];
    float m = -1e30f, l = 0.f;
    for (int kp = 0; kp <= t; ++kp) {
        const long kr = (long)b * S_ + kp; float s = 0.f;
#pragma unroll
        for (int d = 0; d < 64; ++d) s += q[d] * proj(kr, OFF_KB, h * 64 + d);
        s = s * 0.125f + (cq - cp[kp]);
        const float mn = fmaxf(m, s), al = expf(m - mn), p = expf(s - mn);
        l = l * al + p;
#pragma unroll
        for (int d = 0; d < 64; ++d) o[d] = o[d] * al + p * proj(kr, OFF_VB, h * 64 + d);
        m = mn;
    }
    const float il = 1.0f / l;
#pragma unroll
    for (int d = 0; d < 64; ++d) omix[tok * DM + 512 + h * 64 + d] = o[d] * il;
}

__device__ __forceinline__ void d_mixnorm(long gid_, float* __restrict__ omix, const float* __restrict__ beta_nsa, const float* __restrict__ beta_fox) {
    long gid = gid_; if (gid >= (long)T_ * 2) return;
    const int half = (int)(gid % 2); float* v = omix + (gid / 2) * DM + half * 512; const float* be = half ? beta_fox : beta_nsa;
    float s = 0.f; for (int k = 0; k < 512; ++k) s += v[k] * v[k];
    const float r = 1.0f / sqrtf(s / 512 + EPS);
    for (int k = 0; k < 512; ++k) v[k] = v[k] * r * be[k];
}

__device__ __forceinline__ void d_router(long gid_, const float* __restrict__ H, const float* __restrict__ g_ffn, const float* __restrict__ w_group, const float* __restrict__ b_group,
                         const float* __restrict__ w_router, const float* __restrict__ b_router, float* __restrict__ U, int* __restrict__ eid, float* __restrict__ cw) {
    long tok = gid_; if (tok >= T_) return;
    const float* hr = H + tok * DM; float ss = 0.f;
    for (int k = 0; k < DM; ++k) ss += hr[k] * hr[k];
    const float rstd = 1.0f / sqrtf(ss / DM + EPS);
    float gl[4], el[16];
#pragma unroll
    for (int c = 0; c < 4; ++c) gl[c] = 0.f;
#pragma unroll
    for (int e = 0; e < 16; ++e) el[e] = 0.f;
    for (int k = 0; k < DM; ++k) {
        const float u = hr[k] * rstd * g_ffn[k]; U[tok * DM + k] = u;
#pragma unroll
        for (int c = 0; c < 4; ++c) gl[c] += u * w_group[k * 4 + c];
#pragma unroll
        for (int e = 0; e < 16; ++e) el[e] += u * w_router[k * 16 + e];
    }
#pragma unroll
    for (int c = 0; c < 4; ++c) gl[c] += b_group[c];
#pragma unroll
    for (int e = 0; e < 16; ++e) el[e] += b_router[e];
    int gs = 0; float gm = gl[0];
#pragma unroll
    for (int c = 1; c < 4; ++c) if (gl[c] > gm) { gm = gl[c]; gs = c; }
    float gsum = 0.f;
#pragma unroll
    for (int c = 0; c < 4; ++c) gsum += expf(gl[c] - gm);
    const float gprob = 1.0f / gsum;
    float il[4] = {0.f, 0.f, 0.f, 0.f};
#pragma unroll
    for (int c = 0; c < 4; ++c)
#pragma unroll
        for (int e = 0; e < 4; ++e) if (gs == c) il[e] = el[c * 4 + e];
    float im = il[0];
#pragma unroll
    for (int e = 1; e < 4; ++e) im = fmaxf(im, il[e]);
    float ipr[4], isum = 0.f;
#pragma unroll
    for (int e = 0; e < 4; ++e) { ipr[e] = expf(il[e] - im); isum += ipr[e]; }
#pragma unroll
    for (int e = 0; e < 4; ++e) ipr[e] /= isum;
    int i0 = 0; float v0 = ipr[0];
#pragma unroll
    for (int e = 1; e < 4; ++e) if (ipr[e] > v0) { v0 = ipr[e]; i0 = e; }
    int i1 = -1; float v1 = -1.f;
#pragma unroll
    for (int e = 0; e < 4; ++e) if (e != i0 && ipr[e] > v1) { v1 = ipr[e]; i1 = e; }
    const float den = v0 + v1;
    eid[tok * 2 + 0] = gs * 4 + i0; eid[tok * 2 + 1] = gs * 4 + i1;
    cw[tok * 2 + 0] = gprob * (v0 / den); cw[tok * 2 + 1] = gprob * (v1 / den);
}

__device__ __forceinline__ void d_expert_up(long gid_, const float* __restrict__ U, const int* __restrict__ eid, const float* __restrict__ wg, const float* __restrict__ wu, float* __restrict__ hid) {
    long gid = gid_; if (gid >= (long)T_ * 2 * 128) return;
    const int jg = (int)(gid % 128); const long tk = gid / 128; const long tok = tk / 2; const int e = eid[tk];
    const float* ur = U + tok * DM; const float* gp = wg + (long)e * DM * 512 + jg * 4; const float* up = wu + (long)e * DM * 512 + jg * 4;
    float ga[4] = {0.f, 0.f, 0.f, 0.f}, ua[4] = {0.f, 0.f, 0.f, 0.f};
    for (int i = 0; i < DM; ++i) {
        const float u = ur[i];
#pragma unroll
        for (int c = 0; c < 4; ++c) { ga[c] += u * gp[(long)i * 512 + c]; ua[c] += u * up[(long)i * 512 + c]; }
    }
#pragma unroll
    for (int c = 0; c < 4; ++c) hid[tk * 512 + jg * 4 + c] = nv_silu(ga[c]) * ua[c];
}
__device__ __forceinline__ void d_expert_down(long gid_, float* __restrict__ H, const int* __restrict__ eid, const float* __restrict__ cw, const float* __restrict__ wd, const float* __restrict__ hid) {
    long gid = gid_; if (gid >= (long)T_ * 256) return;
    const int cg = (int)(gid % 256); const long tok = gid / 256;
    float acc[4] = {0.f, 0.f, 0.f, 0.f};
    for (int k = 0; k < 2; ++k) {
        const int e = eid[tok * 2 + k]; const float w = cw[tok * 2 + k];
        const float* hp = hid + (tok * 2 + k) * 512; const float* dp = wd + (long)e * 512 * DM + cg * 4;
        float tmp[4] = {0.f, 0.f, 0.f, 0.f};
        for (int j = 0; j < 512; ++j) {
            const float hv = hp[j];
#pragma unroll
            for (int c = 0; c < 4; ++c) tmp[c] += hv * dp[(long)j * DM + c];
        }
#pragma unroll
        for (int c = 0; c < 4; ++c) acc[c] += w * tmp[c];
    }
#pragma unroll
    for (int c = 0; c < 4; ++c) H[tok * DM + cg * 4 + c] += acc[c];
}

__device__ __forceinline__ void d_final(long gid_, const float* __restrict__ H, float* __restrict__ G, const float* __restrict__ PP, const float* __restrict__ b_ple,
                        const float* __restrict__ g_final, float* __restrict__ out) {
    long tok = gid_; if (tok >= T_) return;
    float ss = 0.f;
    for (int c = 0; c < DM; ++c) {
        const float h3 = H[tok * DM + c] + nv_sigmoid(G[tok * DM + c] + b_ple[c]) * PP[tok * DM + c];
        G[tok * DM + c] = h3; ss += h3 * h3;
    }
    const float r = 1.0f / sqrtf(ss / DM + EPS);
    for (int c = 0; c < DM; ++c) out[tok * DM + c] = G[tok * DM + c] * r * g_final[c];
}

constexpr size_t MiB = 1u << 20;
constexpr size_t SZ_PROJ = (size_t)T_ * IN_COLS * 4, SZ_ACT = (size_t)T_ * DM * 4;
constexpr size_t A16(size_t x) { return (x + 255) / 256 * 256; }
constexpr size_t W_PROJ = 0;
constexpr size_t W_RSTD1 = A16(W_PROJ + SZ_PROJ);
constexpr size_t W_CUM = A16(W_RSTD1 + (size_t)T_ * 4);
constexpr size_t W_KC = A16(W_CUM + (size_t)T_ * 8 * 4);
constexpr size_t W_VC = A16(W_KC + (size_t)B_ * NCMP * 2 * 64 * 4);
constexpr size_t W_CMPH = A16(W_VC + (size_t)B_ * NCMP * 2 * 64 * 4);
constexpr size_t W_IMP = A16(W_CMPH + (size_t)B_ * NCMP * 2 * 128 * 4 * 2);
constexpr size_t W_SELM = A16(W_IMP + (size_t)B_ * 2 * S_ * 64 * 4);
constexpr size_t W_END1 = A16(W_SELM + (size_t)B_ * 2 * S_ * 8);
constexpr size_t W_H = 0, W_U = SZ_ACT, W_HID = 2 * SZ_ACT, W_EID = 3 * SZ_ACT, W_CW = A16(W_EID + (size_t)T_ * 8), W_RS3 = A16(W_CW + (size_t)T_ * 8),
                 W_END2 = A16(W_RS3 + (size_t)T_ * 4);
constexpr size_t W_PP = W_U, W_G = W_HID;
constexpr size_t W_TOTAL = W_END1 > W_END2 ? W_END1 : W_END2;


#ifndef NV_DBG
#define NV_DBG(name)
#endif
#ifndef CPU_EMU
template <auto F, class... A> __global__ void __launch_bounds__(256) k_wrap(long n, A... a) {
    const long gid = (long)blockIdx.x * (long)blockDim.x + (long)threadIdx.x; if (gid < n) F(gid, a...);
}
#endif
}
namespace pg8 {
#define PG8_LAS __attribute__((address_space(3)))
typedef unsigned short bf16_t;
typedef short bf16x8 __attribute__((ext_vector_type(8)));
typedef float f32x4 __attribute__((ext_vector_type(4)));
typedef unsigned u32x4 __attribute__((ext_vector_type(4)));
constexpr int BM = 256, BK = 64, HALF = 128, HTB = HALF * BK * 2  , STAGE_BYTES = 8 * HTB, NXCD = 8, WGM = 8;

__host__ __device__ __forceinline__ int lds_byte(int r, int c) { const int st = (r >> 4) * 2 + (c >> 5), rr = r & 15, cc = c & 31, ob = rr * 64 + cc * 2; return st * 1024 + (ob ^ (((ob >> 9) & 1) << 5)); }
__host__ __device__ __forceinline__ void stage_rc(int b, int& R, int& C) { const int st = b / 1024, sb = b % 1024, swz = sb ^ (((sb >> 9) & 1) << 5); R = (st >> 1) * 16 + swz / 64; C = (st & 1) * 32 + (swz % 64) / 2; }
__host__ __device__ __forceinline__ int perm32(int rho) { const int n = rho >> 4, i = rho & 15; return 8 * (i >> 2) + 4 * n + (i & 3); }

struct Unit { int pm, pn, be; };
struct Gemm { const bf16_t* A; const bf16_t* Bt; int M, N, K; size_t bstride; const int* rowidx; };

struct StaticOrder {
    int nM, nN, nwg, G, c;
    __host__ __device__ void init(int M, int N, int G_, int c_) { nM = M / BM; nN = N / BM; nwg = nM * nN; G = G_; c = c_; }
    __host__ __device__ bool next(int i, Unit& u) const {
        const long L = (long)i * G + c; if (L >= nwg) return false;
        int wgid = (int)L; { const int q = nwg / NXCD, r = nwg % NXCD, xcd = wgid % NXCD, off = wgid / NXCD; wgid = (xcd < r ? xcd * (q + 1) : r * (q + 1) + (xcd - r) * q) + off; }
        const int nig = WGM * nN, gid = wgid / nig, fm = gid * WGM, gsz = (nM - fm) < WGM ? (nM - fm) : WGM;
        u.pm = fm + ((wgid % nig) % gsz); u.pn = (wgid % nig) / gsz; u.be = 0; return true;
    }
    __device__ __forceinline__ void a_ready(const Unit&) const {}
    __device__ __forceinline__ void done(const Unit&) const {}
};

#define EPI_LANE_IDS() int t__ = threadIdx.x; asm volatile("" : "+v"(t__)); const int wid__ = __builtin_amdgcn_readfirstlane(t__ >> 6), lane__ = t__ & 63, wr = wid__ >> 2, wc = wid__ & 3, fr = lane__ & 15, fq = lane__ >> 4; (void)wr_; (void)wc_; (void)fr_; (void)fq_
__device__ __forceinline__ unsigned cvt_pk_bf16(float lo, float hi) { unsigned r; asm volatile("v_cvt_pk_bf16_f32 %0, %1, %2" : "=v"(r) : "v"(lo), "v"(hi)); return r; }
constexpr float C2 = 0.125f * 1.4426950408889634f;
constexpr int PB_COLS = 2816;
struct EpiInProj {
    static constexpr bool PERM = true, AFTER_DRAIN = false;
    bf16_t* O; const float* rope; float* gates; float* logf; const float* b_gate; const float* b_forget; float* hm; int dbg;
    __device__ __forceinline__ void operator()(const f32x4 (&acc)[2][2][4][2], const Unit& u, int wr_, int wc_, int fr_, int fq_) const {
        EPI_LANE_IDS();
        const int pn = u.pn, row0 = u.pm * BM + wr * 64 + fr;
        if (pn == 11) {
            if (wc != 0) return;
#pragma unroll
            for (int ai = 0; ai < 2; ++ai)
#pragma unroll
                for (int m = 0; m < 4; ++m) { const size_t row = (size_t)(row0 + ai * HALF + m * 16);
                    const f32x4 v0 = acc[ai][0][m][0], v1 = acc[ai][0][m][1];
                    float o[8] = {v0[0], v0[1], v0[2], v0[3], v1[0], v1[1], v1[2], v1[3]};
                    if (fq < 3) {
#pragma unroll
                        for (int i = 0; i < 8; ++i) { const float z = o[i] + b_gate[8 * fq + i]; o[i] = __builtin_amdgcn_rcpf(1.0f + __builtin_amdgcn_exp2f(-1.4426950408889634f * z)); }
                        *(f32x4*)(gates + row * 24 + 8 * fq) = (f32x4){o[0], o[1], o[2], o[3]}; *(f32x4*)(gates + row * 24 + 8 * fq + 4) = (f32x4){o[4], o[5], o[6], o[7]};
                    } else {
#pragma unroll
                        for (int i = 0; i < 8; ++i) { const float z = o[i] + b_forget[i]; o[i] = fminf(z, 0.f) - 0.6931471805599453f * __builtin_amdgcn_logf(1.0f + __builtin_amdgcn_exp2f(-1.4426950408889634f * fabsf(z))); }
                        *(f32x4*)(logf + row * 8) = (f32x4){o[0], o[1], o[2], o[3]}; *(f32x4*)(logf + row * 8 + 4) = (f32x4){o[4], o[5], o[6], o[7]};
                    } }
            return;
        }
        const int head = pn * 4 + wc;
        const bool roped = !(dbg & 2) && (head < 8 || head == 12 || head == 13 || head == 16 || head == 17);
        const int j = (dbg & 1) ? -1 : head < 8 ? head : head == 12 || head == 13 ? head - 4 : head == 16 || head == 17 ? head - 6 : head >= 20 && head < 36 ? head - 8 : -1;
        const float sc = (pn <= 1 || pn == 5 || pn == 6) ? C2 : 1.0f;
        const int col0 = head * 64 + 8 * fq; float nmax = 0.f;
#pragma unroll
        for (int ai = 0; ai < 2; ++ai) {
            f32x4 rc[4][4];
            if (roped && fq < 2) {
#pragma unroll
                for (int m = 0; m < 4; ++m) { const f32x4* rp = (const f32x4*)(rope + (size_t)(row0 + ai * HALF + m * 16) * 16); rc[m][0] = rp[0]; rc[m][1] = rp[1]; rc[m][2] = rp[2]; rc[m][3] = rp[3]; } }
#pragma unroll
            for (int m = 0; m < 4; ++m) { const size_t row = (size_t)(row0 + ai * HALF + m * 16); bf16_t* rowp = O + row * PB_COLS + col0; float q = 0.f;
#pragma unroll
                for (int bj = 0; bj < 2; ++bj) { f32x4 v0 = acc[ai][bj][m][0], v1 = acc[ai][bj][m][1];
                    if (bj == 0 && roped) {
                        f32x4 p0, p1;
#pragma unroll
                        for (int i = 0; i < 4; ++i) { p0[i] = lx::xf<16>(v0[i]); p1[i] = lx::xf<16>(v1[i]); }
                        if (fq < 2) {
                            const f32x4 a = rc[m][0], b = rc[m][1], c = rc[m][2], d = rc[m][3]; const float sg = fq == 0 ? -1.0f : 1.0f;
                            v0[0] = v0[0] * a[0] + sg * p0[0] * a[1]; v0[1] = v0[1] * a[2] + sg * p0[1] * a[3];
                            v0[2] = v0[2] * b[0] + sg * p0[2] * b[1]; v0[3] = v0[3] * b[2] + sg * p0[3] * b[3];
                            v1[0] = v1[0] * c[0] + sg * p1[0] * c[1]; v1[1] = v1[1] * c[2] + sg * p1[1] * c[3];
                            v1[2] = v1[2] * d[0] + sg * p1[2] * d[1]; v1[3] = v1[3] * d[2] + sg * p1[3] * d[3];
                        }
                    }
                    v0 = v0 * sc; v1 = v1 * sc; u32x4 w; w.x = cvt_pk_bf16(v0[0], v0[1]); w.y = cvt_pk_bf16(v0[2], v0[3]); w.z = cvt_pk_bf16(v1[0], v1[1]); w.w = cvt_pk_bf16(v1[2], v1[3]);
                    *(u32x4*)(rowp + bj * 32) = w;
                    if (j >= 0) q += (v0[0] * v0[0] + v0[1] * v0[1]) + (v0[2] * v0[2] + v0[3] * v0[3]) + (v1[0] * v1[0] + v1[1] * v1[1]) + (v1[2] * v1[2] + v1[3] * v1[3]); }
                if (j >= 0) { q += lx::xf<16>(q); { auto rr = __builtin_amdgcn_permlane32_swap(__float_as_uint(q), __float_as_uint(q), false, false); q = __uint_as_float(rr[0]) + __uint_as_float(rr[1]); }
                    nmax = fmaxf(nmax, q); } } }
        if (j >= 0) { float q = nmax; q = fmaxf(q, lx::xf<1>(q)); q = fmaxf(q, lx::xf<2>(q)); q = fmaxf(q, lx::xf<4>(q)); q = fmaxf(q, lx::xf<8>(q));
            if (lane__ == 0) hm[((size_t)u.pm * 2 + wr) * 28 + j] = q * 1.02f; }
    }
};

struct EpiResF32 {
    static constexpr bool PERM = false, AFTER_DRAIN = false;
    const float* res; float* out; int ldc;
    __device__ __forceinline__ void operator()(const f32x4 (&acc)[2][2][4][2], const Unit& u, int wr_, int wc_, int fr_, int fq_) const {
        EPI_LANE_IDS();
        const int col0 = u.pn * BM + wc * 32 + 4 * fq;
#pragma unroll
        for (int ai = 0; ai < 2; ++ai) {
            f32x4 r[4][2][2];
#pragma unroll
            for (int m = 0; m < 4; ++m) { const size_t off = (size_t)(u.pm * BM + ai * HALF + wr * 64 + m * 16 + fr) * ldc + col0;
#pragma unroll
                for (int bj = 0; bj < 2; ++bj)
#pragma unroll
                    for (int n = 0; n < 2; ++n) r[m][bj][n] = *(const f32x4*)(res + off + bj * HALF + n * 16); }
#pragma unroll
            for (int m = 0; m < 4; ++m) { const size_t off = (size_t)(u.pm * BM + ai * HALF + wr * 64 + m * 16 + fr) * ldc + col0;
#pragma unroll
                for (int bj = 0; bj < 2; ++bj)
#pragma unroll
                    for (int n = 0; n < 2; ++n) *(f32x4*)(out + off + bj * HALF + n * 16) = acc[ai][bj][m][n] + r[m][bj][n]; } }
    }
};
struct EpiResBf16 {
    static constexpr bool PERM = true, AFTER_DRAIN = false;
    const float* res; bf16_t* O; int ldc;
    __device__ __forceinline__ void operator()(const f32x4 (&acc)[2][2][4][2], const Unit& u, int wr_, int wc_, int fr_, int fq_) const {
        EPI_LANE_IDS();
        const int row0 = u.pm * BM + wr * 64 + fr, col0 = u.pn * BM + wc * 32 + 8 * fq;
#pragma unroll
        for (int ai = 0; ai < 2; ++ai) {
            f32x4 r[4][2][2];
#pragma unroll
            for (int m = 0; m < 4; ++m)
#pragma unroll
                for (int bj = 0; bj < 2; ++bj) { const float* p = res + (size_t)(row0 + ai * HALF + m * 16) * ldc + col0 + bj * HALF; r[m][bj][0] = *(const f32x4*)p; r[m][bj][1] = *(const f32x4*)(p + 4); }
#pragma unroll
            for (int m = 0; m < 4; ++m) { bf16_t* rowp = O + (size_t)(row0 + ai * HALF + m * 16) * ldc + col0;
#pragma unroll
                for (int bj = 0; bj < 2; ++bj) { const f32x4 v0 = acc[ai][bj][m][0] + r[m][bj][0], v1 = acc[ai][bj][m][1] + r[m][bj][1];
                    u32x4 w; w.x = cvt_pk_bf16(v0[0], v0[1]); w.y = cvt_pk_bf16(v0[2], v0[3]); w.z = cvt_pk_bf16(v1[0], v1[1]); w.w = cvt_pk_bf16(v1[2], v1[3]);
                    *(u32x4*)(rowp + bj * HALF) = w; } } }
    }
};
struct EpiPleGate {
    static constexpr bool PERM = false, AFTER_DRAIN = false;
    float* io; const bf16_t* hb; const float* ra; const bf16_t* pp; const float* bias; int ldc;
    __device__ __forceinline__ void operator()(const f32x4 (&acc)[2][2][4][2], const Unit& u, int wr_, int wc_, int fr_, int fq_) const {
        EPI_LANE_IDS();
        typedef unsigned u32x2v __attribute__((ext_vector_type(2)));
        const int col0 = u.pn * BM + wc * 32 + 4 * fq;
#pragma unroll
        for (int ai = 0; ai < 2; ++ai)
#pragma unroll
            for (int m = 0; m < 4; ++m) { const int row = u.pm * BM + ai * HALF + wr * 64 + m * 16 + fr; const size_t off = (size_t)row * ldc + col0; const float rr_ = ra[row];
#pragma unroll
                for (int bj = 0; bj < 2; ++bj)
#pragma unroll
                    for (int n = 0; n < 2; ++n) { const size_t o = off + bj * HALF + n * 16; const u32x2v hw = *(const u32x2v*)(hb + o); const u32x2v pw = *(const u32x2v*)(pp + o);
                        const f32x4 h = {__builtin_bit_cast(float, hw.x << 16), __builtin_bit_cast(float, hw.x & 0xffff0000u), __builtin_bit_cast(float, hw.y << 16), __builtin_bit_cast(float, hw.y & 0xffff0000u)};
                        const f32x4 bv = *(const f32x4*)(bias + col0 + bj * HALF + n * 16); const f32x4 z = acc[ai][bj][m][n] * rr_ + bv; f32x4 r;
                        r[0] = h[0] + __builtin_bit_cast(float, pw.x << 16) * __builtin_amdgcn_rcpf(1.0f + __builtin_amdgcn_exp2f(-1.4426950408889634f * z[0])); r[1] = h[1] + __builtin_bit_cast(float, pw.x & 0xffff0000u) * __builtin_amdgcn_rcpf(1.0f + __builtin_amdgcn_exp2f(-1.4426950408889634f * z[1]));
                        r[2] = h[2] + __builtin_bit_cast(float, pw.y << 16) * __builtin_amdgcn_rcpf(1.0f + __builtin_amdgcn_exp2f(-1.4426950408889634f * z[2])); r[3] = h[3] + __builtin_bit_cast(float, pw.y & 0xffff0000u) * __builtin_amdgcn_rcpf(1.0f + __builtin_amdgcn_exp2f(-1.4426950408889634f * z[3]));
                        *(f32x4*)(io + o) = r; } }
    }
};

struct EpiBf16Plain {
    static constexpr bool PERM = true, AFTER_DRAIN = false;
    bf16_t* O; int ldc;
    __device__ __forceinline__ void operator()(const f32x4 (&acc)[2][2][4][2], const Unit& u, int wr_, int wc_, int fr_, int fq_) const {
        EPI_LANE_IDS();
        const int row0 = u.pm * BM + wr * 64 + fr, col0 = u.pn * BM + wc * 32 + 8 * fq;
#pragma unroll
        for (int ai = 0; ai < 2; ++ai)
#pragma unroll
            for (int m = 0; m < 4; ++m) { bf16_t* rowp = O + (size_t)(row0 + ai * HALF + m * 16) * ldc + col0;
#pragma unroll
                for (int bj = 0; bj < 2; ++bj) { const f32x4 v0 = acc[ai][bj][m][0], v1 = acc[ai][bj][m][1];
                    u32x4 w; w.x = cvt_pk_bf16(v0[0], v0[1]); w.y = cvt_pk_bf16(v0[2], v0[3]); w.z = cvt_pk_bf16(v1[0], v1[1]); w.w = cvt_pk_bf16(v1[2], v1[3]);
                    *(u32x4*)(rowp + bj * HALF) = w; } }
    }
};

struct EpiSwiGlu {
    static constexpr bool PERM = true, AFTER_DRAIN = false;
    bf16_t* O; const float* rss;
    __device__ __forceinline__ void operator()(const f32x4 (&acc)[2][2][4][2], const Unit& u, int wr_, int wc_, int fr_, int fq_) const {
        EPI_LANE_IDS();
        typedef unsigned u32x2v __attribute__((ext_vector_type(2)));
        const int row0 = u.pm * BM + wr * 64 + fr, col0 = u.pn * 128 + wc * 16 + 4 * fq;
#pragma unroll
        for (int ai = 0; ai < 2; ++ai)
#pragma unroll
            for (int m = 0; m < 4; ++m) { bf16_t* rowp = O + (size_t)(row0 + ai * HALF + m * 16) * 512 + col0; const float rs = rss[row0 + ai * HALF + m * 16];
#pragma unroll
                for (int bj = 0; bj < 2; ++bj) { const f32x4 g = acc[ai][bj][m][0] * rs, v = acc[ai][bj][m][1] * rs; float h[4];
#pragma unroll
                    for (int i = 0; i < 4; ++i) h[i] = g[i] * __builtin_amdgcn_rcpf(1.0f + __builtin_amdgcn_exp2f(-1.4426950408889634f * g[i])) * v[i];
                    u32x2v w; w.x = cvt_pk_bf16(h[0], h[1]); w.y = cvt_pk_bf16(h[2], h[3]); *(u32x2v*)(rowp + bj * 64) = w; } }
    }
};
struct GroupOrder {
    int nM, nN, nwg, G, c; const int* tile_e;
    __device__ void init(int nM_, int nN_, int G_, int c_, const int* te) { nM = nM_; nN = nN_; nwg = nM * nN; G = G_; c = c_; tile_e = te; }
    __device__ bool next(int i, Unit& u) const {
        const long L = (long)i * G + c; if (L >= nwg) return false;
        int wgid = (int)L; { const int q = nwg / NXCD, r = nwg % NXCD, xcd = wgid % NXCD, off = wgid / NXCD; wgid = (xcd < r ? xcd * (q + 1) : r * (q + 1) + (xcd - r) * q) + off; }
        const int nig = WGM * nN, gid = wgid / nig, fm = gid * WGM, gsz = (nM - fm) < WGM ? (nM - fm) : WGM;
        u.pm = fm + ((wgid % nig) % gsz); u.pn = (wgid % nig) / gsz; u.be = __builtin_amdgcn_readfirstlane(tile_e[u.pm]); return true;
    }
    __device__ __forceinline__ void a_ready(const Unit&) const {}
    __device__ __forceinline__ void done(const Unit&) const {}
};

struct EpiPleGateNorm {
    static constexpr bool PERM = false, AFTER_DRAIN = false;
    float* io; const bf16_t* hb; const float* ra; const bf16_t* pp; const float* bias; const float* gfin; float* xs; unsigned* cnt; PG8_LAS unsigned char* scr; int ldc;
    __device__ __forceinline__ void operator()(f32x4 (&acc)[2][2][4][2], const Unit& u, int wr_, int wc_, int fr_, int fq_) const {
        typedef unsigned u32x2v __attribute__((ext_vector_type(2)));
        int t__ = threadIdx.x; asm volatile("" : "+v"(t__)); const int tid = t__, wid = __builtin_amdgcn_readfirstlane(tid >> 6), lane = tid & 63, wr = wid >> 2, wc = wid & 3, fr = lane & 15, fq = lane >> 4; (void)wr_; (void)wc_; (void)fr_; (void)fq_;
        PG8_LAS float* P = (PG8_LAS float*)scr; PG8_LAS float* S = (PG8_LAS float*)(scr + 4096); PG8_LAS unsigned* flag = (PG8_LAS unsigned*)(scr + 5120);
        const int col0 = u.pn * BM + wc * 32 + 4 * fq;
#pragma unroll
        for (int ai = 0; ai < 2; ++ai)
#pragma unroll
            for (int m = 0; m < 4; ++m) { const int rl = ai * HALF + wr * 64 + m * 16 + fr; const size_t off = (size_t)(u.pm * BM + rl) * ldc + col0; float q = 0.f; const float rr_ = ra[u.pm * BM + rl];
#pragma unroll
                for (int bj = 0; bj < 2; ++bj)
#pragma unroll
                    for (int n = 0; n < 2; ++n) { const size_t o = off + bj * HALF + n * 16; const u32x2v hw = *(const u32x2v*)(hb + o); const u32x2v pw = *(const u32x2v*)(pp + o);
                        const f32x4 h = {__builtin_bit_cast(float, hw.x << 16), __builtin_bit_cast(float, hw.x & 0xffff0000u), __builtin_bit_cast(float, hw.y << 16), __builtin_bit_cast(float, hw.y & 0xffff0000u)};
                        const f32x4 bv = *(const f32x4*)(bias + col0 + bj * HALF + n * 16); const f32x4 z = acc[ai][bj][m][n] * rr_ + bv; f32x4 r;
                        r[0] = h[0] + __builtin_bit_cast(float, pw.x << 16) * __builtin_amdgcn_rcpf(1.0f + __builtin_amdgcn_exp2f(-1.4426950408889634f * z[0])); r[1] = h[1] + __builtin_bit_cast(float, pw.x & 0xffff0000u) * __builtin_amdgcn_rcpf(1.0f + __builtin_amdgcn_exp2f(-1.4426950408889634f * z[1]));
                        r[2] = h[2] + __builtin_bit_cast(float, pw.y << 16) * __builtin_amdgcn_rcpf(1.0f + __builtin_amdgcn_exp2f(-1.4426950408889634f * z[2])); r[3] = h[3] + __builtin_bit_cast(float, pw.y & 0xffff0000u) * __builtin_amdgcn_rcpf(1.0f + __builtin_amdgcn_exp2f(-1.4426950408889634f * z[3]));
                        acc[ai][bj][m][n] = r; q += (r[0] * r[0] + r[1] * r[1]) + (r[2] * r[2] + r[3] * r[3]); }
                q += lx::xf<16>(q); { auto rr = __builtin_amdgcn_permlane32_swap(__float_as_uint(q), __float_as_uint(q), false, false); q = __uint_as_float(rr[0]) + __uint_as_float(rr[1]); }
                if (fq == 0) P[rl * 4 + wc] = q; }
        asm volatile("s_waitcnt lgkmcnt(0)\n\ts_barrier" ::: "memory");
        unsigned* cw = cnt + 64 * u.pm;
        if (tid < 256) { const float tot = (P[tid * 4] + P[tid * 4 + 1]) + (P[tid * 4 + 2] + P[tid * 4 + 3]);
            __hip_atomic_store(xs + (size_t)(u.pm * BM + tid) * 4 + u.pn, tot, __ATOMIC_RELAXED, __HIP_MEMORY_SCOPE_AGENT);
            asm volatile("s_waitcnt vmcnt(0)" ::: "memory");
            if (lane == 0) __hip_atomic_fetch_add(cw, 1u, __ATOMIC_RELAXED, __HIP_MEMORY_SCOPE_AGENT); }
        if (wid == 0) { unsigned sp = 0;
            while ((unsigned)__builtin_amdgcn_readfirstlane(__hip_atomic_load(cw, __ATOMIC_RELAXED, __HIP_MEMORY_SCOPE_AGENT)) < 16u && ++sp < (1u << 24)) __builtin_amdgcn_s_sleep(2);
            __builtin_amdgcn_fence(__ATOMIC_ACQUIRE, "agent");
            if (lane == 0) flag[0] = sp; }
        asm volatile("s_waitcnt vmcnt(0) lgkmcnt(0)\n\ts_barrier" ::: "memory");
        if (tid < 256) { const float* sl = xs + (size_t)(u.pm * BM + tid) * 4; float s4[4];
#pragma unroll
            for (int t = 0; t < 4; ++t) s4[t] = __hip_atomic_load(sl + t, __ATOMIC_RELAXED, __HIP_MEMORY_SCOPE_AGENT);
            S[tid] = 1.0f / sqrtf(((s4[0] + s4[1]) + (s4[2] + s4[3])) * (1.0f / 1024.0f) + 1e-6f); }
        asm volatile("s_waitcnt lgkmcnt(0)\n\ts_barrier" ::: "memory");
#pragma unroll
        for (int ai = 0; ai < 2; ++ai)
#pragma unroll
            for (int m = 0; m < 4; ++m) { const int rl = ai * HALF + wr * 64 + m * 16 + fr; const size_t off = (size_t)(u.pm * BM + rl) * ldc + col0; const float rs = S[rl];
#pragma unroll
                for (int bj = 0; bj < 2; ++bj)
#pragma unroll
                    for (int n = 0; n < 2; ++n) { const f32x4 g = *(const f32x4*)(gfin + col0 + bj * HALF + n * 16); *(f32x4*)(io + off + bj * HALF + n * 16) = acc[ai][bj][m][n] * rs * g; } }
    }
};

struct EpiNull {
    static constexpr bool PERM = true, AFTER_DRAIN = false;
    __device__ __forceinline__ void operator()(const f32x4 (&acc)[2][2][4][2], const Unit&, int, int, int, int) const {
#pragma unroll
        for (int a = 0; a < 2; ++a)
#pragma unroll
            for (int b = 0; b < 2; ++b)
#pragma unroll
                for (int m = 0; m < 4; ++m) asm volatile("" :: "v"(acc[a][b][m][0]), "v"(acc[a][b][m][1]));
    }
};
template <class Epi, class Sched, bool ALIGN_EPI = false, bool SP2 = false, bool GATHER = false>
__device__ __forceinline__ void gemm_phase(PG8_LAS unsigned char* lds, const Gemm g, const Sched& S, const Epi& E) {
    int tid_ = threadIdx.x; asm volatile("" : "+v"(tid_));
    const int tid = tid_, wid = __builtin_amdgcn_readfirstlane(tid >> 6), lane = tid & 63, wr = wid >> 2, wc = wid & 3, fr = lane & 15, fq = lane >> 4;
    const int K = g.K, nt = K / BK;
    unsigned voffA[2], voffB[2];
#pragma unroll
    for (int i = 0; i < 2; ++i) { int R, C; stage_rc(tid * 16 + i * 8192, R, C); const int Rb = Epi::PERM ? ((R & ~31) + perm32(R & 31)) : R;
        voffA[i] = (unsigned)(R * K + C) * 2u; voffB[i] = (unsigned)(Rb * K + C) * 2u; }
    static_assert(!GATHER || SP2, "GATHER is wired into the two-super-phase loop only");
    unsigned gC[2][2] = {{0u, 0u}, {0u, 0u}}, gN[2][2] = {{0u, 0u}, {0u, 0u}};
#define PG8_GOFF(dst, u_) do { _Pragma("unroll") for (int h_ = 0; h_ < 2; ++h_) _Pragma("unroll") for (int i_ = 0; i_ < 2; ++i_) { int R_, C_; stage_rc(tid * 16 + i_ * 8192, R_, C_); \
        dst[h_][i_] = (unsigned)g.rowidx[(u_).pm * BM + h_ * HALF + R_] * (unsigned)(K * 2) + (unsigned)(C_ * 2); } } while (0)
    const size_t kstep = (size_t)(BK * 2);
    const size_t hstep = (size_t)HALF * K * 2;
    const size_t hstepA = GATHER ? 0 : hstep;
    const size_t tstep = 2 * hstep;
    const unsigned ldsw = (unsigned)wid * 1024u;
    const int aoff = lds_byte(wr * 64 + fr, fq * 8), boff = lds_byte(wc * 32 + fr, fq * 8);
#define PG8_SA(b, h) (((b) * 2 + (h)) * HTB)
#define PG8_SB(b, h) ((4 + (b) * 2 + (h)) * HTB)
#define PG8_STAGE(bufoff, gbase, voff) do { _Pragma("unroll") for (int _i = 0; _i < 2; ++_i) \
        __builtin_amdgcn_global_load_lds((const unsigned*)((const char*)(gbase) + (voff)[_i]), (PG8_LAS unsigned*)(lds + (bufoff) + ldsw + _i * 8192), 16, 0, 0); } while (0)
#define PG8_LDA(dst, b, h) do { _Pragma("unroll") for (int m = 0; m < 4; ++m) _Pragma("unroll") for (int k = 0; k < 2; ++k) dst[m][k] = *(const PG8_LAS bf16x8*)(lds + PG8_SA(b, h) + aoff + m * 2048 + k * 1024); } while (0)
#define PG8_LDB(dst, b, h) do { _Pragma("unroll") for (int n = 0; n < 2; ++n) _Pragma("unroll") for (int k = 0; k < 2; ++k) dst[n][k] = *(const PG8_LAS bf16x8*)(lds + PG8_SB(b, h) + boff + n * 2048 + k * 1024); } while (0)
#define PG8_MMA(ai, bj, At, Bt) do { __builtin_amdgcn_s_setprio(1); _Pragma("unroll") for (int m = 0; m < 4; ++m) _Pragma("unroll") for (int n = 0; n < 2; ++n) _Pragma("unroll") for (int k = 0; k < 2; ++k) \
        acc[ai][bj][m][n] = __builtin_amdgcn_mfma_f32_16x16x32_bf16(Bt[n][k], At[m][k], acc[ai][bj][m][n], 0, 0, 0); __builtin_amdgcn_s_setprio(0); } while (0)
#define PG8_WAIT_V(n) asm volatile("s_waitcnt vmcnt(" #n ")" ::: "memory")
#define PG8_WAIT_L(n) asm volatile("s_waitcnt lgkmcnt(" #n ")" ::: "memory")
#define PG8_BAR __builtin_amdgcn_s_barrier()
#define PG8_SCHED __builtin_amdgcn_sched_barrier(0)
    Unit cur, nxt; int ui = 0;
    if (!S.next(0, cur)) return;
    f32x4 acc[2][2][4][2];
#pragma unroll
    for (int a = 0; a < 2; ++a)
#pragma unroll
        for (int b = 0; b < 2; ++b)
#pragma unroll
            for (int m = 0; m < 4; ++m)
#pragma unroll
                for (int n = 0; n < 2; ++n) acc[a][b][m][n] = (f32x4){0.f, 0.f, 0.f, 0.f};
    bf16x8 At[4][2], B0[2][2], B1[2][2];
    const char* cA = (const char*)g.A + (GATHER ? (size_t)0 : (size_t)cur.pm * tstep); if (GATHER) PG8_GOFF(gC, cur);
    const char* cB = (const char*)g.Bt + (size_t)cur.pn * tstep + (size_t)cur.be * g.bstride;
    S.a_ready(cur);
    if constexpr (SP2) {
        PG8_STAGE(PG8_SB(0, 0), cB, voffB); PG8_STAGE(PG8_SB(0, 1), cB + hstep, voffB); PG8_STAGE(PG8_SA(0, 0), cA, (GATHER ? gC[0] : voffA)); PG8_STAGE(PG8_SA(0, 1), cA + hstepA, (GATHER ? gC[1] : voffA));
        if (wr == 1) PG8_BAR;
        PG8_WAIT_V(2); PG8_BAR;
        PG8_STAGE(PG8_SB(1, 0), cB + kstep, voffB); PG8_STAGE(PG8_SA(1, 0), cA + kstep, (GATHER ? gC[0] : voffA)); PG8_STAGE(PG8_SB(1, 1), cB + hstep + kstep, voffB);
        PG8_WAIT_V(6); PG8_BAR;
    } else {
        PG8_STAGE(PG8_SB(0, 0), cB, voffB); PG8_STAGE(PG8_SA(0, 0), cA, voffA); PG8_STAGE(PG8_SB(0, 1), cB + hstep, voffB); PG8_STAGE(PG8_SA(0, 1), cA + hstep, voffA);
        if (wr == 1) PG8_BAR;
        PG8_WAIT_V(4); PG8_BAR;
        PG8_STAGE(PG8_SB(1, 0), cB + kstep, voffB); PG8_STAGE(PG8_SA(1, 0), cA + kstep, voffA); PG8_STAGE(PG8_SB(1, 1), cB + hstep + kstep, voffB);
        PG8_WAIT_V(6); PG8_BAR;
    }
    for (;;) {
        const bool has_next = S.next(ui + 1, nxt);
        if (GATHER) { if (has_next) PG8_GOFF(gN, nxt); else { gN[0][0] = gC[0][0]; gN[0][1] = gC[0][1]; gN[1][0] = gC[1][0]; gN[1][1] = gC[1][1]; } }
        const char* nA = (has_next && !GATHER) ? (const char*)g.A + (size_t)nxt.pm * tstep : cA; const char* nB = has_next ? (const char*)g.Bt + (size_t)nxt.pn * tstep + (size_t)nxt.be * g.bstride : cB;
        for (int t = 0; t < nt; t += 2) {
            const bool last = (t == nt - 2);
            const char* a1 = cA + (size_t)(t + 1) * kstep;
            const char* a2 = last ? nA : cA + (size_t)(t + 2) * kstep; const char* b2 = last ? nB : cB + (size_t)(t + 2) * kstep;
            const char* a3 = a2 + kstep; const char* b3 = b2 + kstep;
            if (last && has_next) S.a_ready(nxt);
            if constexpr (SP2) {
            unsigned g2[2][2];
            if (GATHER) { g2[0][0] = last ? gN[0][0] : gC[0][0]; g2[0][1] = last ? gN[0][1] : gC[0][1]; g2[1][0] = last ? gN[1][0] : gC[1][0]; g2[1][1] = last ? gN[1][1] : gC[1][1]; }
            PG8_LDB(B0, 0, 0); PG8_LDB(B1, 0, 1); PG8_SCHED; PG8_LDA(At, 0, 0); PG8_STAGE(PG8_SA(1, 1), a1 + hstepA, (GATHER ? gC[1] : voffA));
            PG8_WAIT_V(8); PG8_WAIT_L(0); PG8_BAR; PG8_MMA(0, 0, At, B0); PG8_MMA(0, 1, At, B1); PG8_BAR; PG8_SCHED;
            PG8_LDA(At, 0, 1); PG8_STAGE(PG8_SB(0, 0), b2, voffB); PG8_STAGE(PG8_SB(0, 1), b2 + hstep, voffB); PG8_STAGE(PG8_SA(0, 0), a2, (GATHER ? g2[0] : voffA));
            PG8_WAIT_V(8); PG8_WAIT_L(0); PG8_BAR; PG8_MMA(1, 0, At, B0); PG8_MMA(1, 1, At, B1); PG8_BAR; PG8_SCHED;
            PG8_LDB(B0, 1, 0); PG8_LDB(B1, 1, 1); PG8_SCHED; PG8_LDA(At, 1, 0); PG8_STAGE(PG8_SA(0, 1), a2 + hstepA, (GATHER ? g2[1] : voffA));
            PG8_WAIT_V(8); PG8_WAIT_L(0); PG8_BAR; PG8_MMA(0, 0, At, B0); PG8_MMA(0, 1, At, B1); PG8_BAR; PG8_SCHED;
            PG8_LDA(At, 1, 1); PG8_STAGE(PG8_SB(1, 0), b3, voffB); PG8_STAGE(PG8_SB(1, 1), b3 + hstep, voffB); PG8_STAGE(PG8_SA(1, 0), a3, (GATHER ? g2[0] : voffA));
            PG8_WAIT_V(8); PG8_WAIT_L(0); PG8_BAR; PG8_MMA(1, 0, At, B0); PG8_MMA(1, 1, At, B1); PG8_BAR; PG8_SCHED;
            } else {
            PG8_LDB(B0, 0, 0); PG8_SCHED; PG8_LDA(At, 0, 0); PG8_STAGE(PG8_SA(1, 1), a1 + hstep, voffA);
            PG8_WAIT_L(8); PG8_BAR; PG8_WAIT_L(0); PG8_MMA(0, 0, At, B0); PG8_BAR; PG8_SCHED;
            PG8_LDB(B1, 0, 1); PG8_STAGE(PG8_SB(0, 0), b2, voffB);
            PG8_BAR; PG8_WAIT_L(0); PG8_MMA(0, 1, At, B1); PG8_BAR;
            PG8_LDA(At, 0, 1); PG8_STAGE(PG8_SA(0, 0), a2, voffA);
            PG8_BAR; PG8_WAIT_L(0); PG8_MMA(1, 0, At, B0); PG8_BAR; PG8_SCHED;
            PG8_STAGE(PG8_SB(0, 1), b2 + hstep, voffB);
            PG8_WAIT_V(6); PG8_BAR; PG8_MMA(1, 1, At, B1); PG8_BAR;
            PG8_LDB(B0, 1, 0); PG8_SCHED; PG8_LDA(At, 1, 0); PG8_STAGE(PG8_SA(0, 1), a2 + hstep, voffA);
            PG8_WAIT_L(8); PG8_BAR; PG8_WAIT_L(0); PG8_MMA(0, 0, At, B0); PG8_BAR; PG8_SCHED;
            PG8_LDB(B1, 1, 1); PG8_STAGE(PG8_SB(1, 0), b3, voffB);
            PG8_BAR; PG8_WAIT_L(0); PG8_MMA(0, 1, At, B1); PG8_BAR;
            PG8_LDA(At, 1, 1); PG8_STAGE(PG8_SA(1, 0), a3, voffA);
            PG8_BAR; PG8_WAIT_L(0); PG8_MMA(1, 0, At, B0); PG8_BAR; PG8_SCHED;
            PG8_STAGE(PG8_SB(1, 1), b3 + hstep, voffB);
            PG8_WAIT_V(6); PG8_BAR; PG8_MMA(1, 1, At, B1); PG8_BAR;
            }
        }
        if constexpr (ALIGN_EPI) { if (wr == 0) PG8_BAR; }
        if constexpr (!Epi::AFTER_DRAIN) { E(acc, cur, wr, wc, fr, fq); S.done(cur); }
        if (!has_next) break;
#pragma unroll
        for (int a = 0; a < 2; ++a)
#pragma unroll
            for (int b = 0; b < 2; ++b)
#pragma unroll
                for (int m = 0; m < 4; ++m)
#pragma unroll
                    for (int n = 0; n < 2; ++n) acc[a][b][m][n] = (f32x4){0.f, 0.f, 0.f, 0.f};
        cur = nxt; cA = nA; cB = nB; ++ui; if (GATHER) { gC[0][0] = gN[0][0]; gC[0][1] = gN[0][1]; gC[1][0] = gN[1][0]; gC[1][1] = gN[1][1]; }
        if constexpr (ALIGN_EPI) { if (wr == 1) PG8_BAR; }
    }
    PG8_WAIT_V(0);
    if constexpr (!ALIGN_EPI) { if (wr == 0) PG8_BAR; }
    PG8_BAR;
    if constexpr (Epi::AFTER_DRAIN) { E.fused(acc, cur, wr, wc, fr, fq, lds, wid, lane); S.done(cur); }
#undef PG8_GOFF
#undef PG8_SA
#undef PG8_SB
#undef PG8_STAGE
#undef PG8_LDA
#undef PG8_LDB
#undef PG8_MMA
#undef PG8_WAIT_V
#undef PG8_WAIT_L
#undef PG8_BAR
#undef PG8_SCHED
}
}
namespace at {
using bf16x8 = __attribute__((ext_vector_type(8))) short;
using s16x4 = __attribute__((ext_vector_type(4))) short;
using f32x16 = __attribute__((ext_vector_type(16))) float;
using f32x4 = __attribute__((ext_vector_type(4))) float;
using u32x4 = __attribute__((ext_vector_type(4))) unsigned;
typedef unsigned short bf16;
constexpr int PITCH = 2816;
constexpr int NSLOT = 4, SLOTB = 8192;
constexpr int NVSLOT = 5;
constexpr int LDS_K = 0, LDS_V = NSLOT * SLOTB, LDS_WS = LDS_V + NVSLOT * SLOTB, LDS_CK = LDS_WS + 8 * 256, LDS_END = LDS_CK + 16384;
constexpr float NEG = -1e30f;
constexpr float THR = 8.0f;
typedef __attribute__((address_space(3))) const char* lds_cptr;
typedef short v4i16_t __attribute__((ext_vector_type(4)));
__device__ __forceinline__ int crow(int r, int hi) { return (r & 3) + 8 * (r >> 2) + 4 * hi; }
__device__ __forceinline__ void glds16(const void* gsrc, unsigned lds_dst) { unsigned keep;
    asm volatile("s_mov_b32 %0, m0\n\ts_mov_b32 m0, %2\n\ts_nop 0\n\tglobal_load_lds_dwordx4 %1, off\n\ts_mov_b32 m0, %0" : "=&s"(keep) : "v"(gsrc), "s"(lds_dst) : "memory"); }
typedef float f32x2_t __attribute__((ext_vector_type(2))); typedef __bf16 bf16x2_t __attribute__((ext_vector_type(2)));
__device__ __forceinline__ unsigned cvtpk(float lo, float hi) { f32x2_t v = {lo, hi}; bf16x2_t b = __builtin_convertvector(v, bf16x2_t); return __builtin_bit_cast(unsigned, b); }
__device__ __forceinline__ s16x4 vtr(lds_cptr p) { return __builtin_bit_cast(s16x4, __builtin_amdgcn_ds_read_tr16_b64_v4i16((__attribute__((address_space(3))) v4i16_t*)p)); }
#define AT_WAIT_BAR(N) asm volatile("s_waitcnt vmcnt(" #N ") lgkmcnt(0)\n\ts_barrier" ::: "memory")

enum { M_FOX = 0, M_SEL = 1, M_WIN = 2 };
struct UnitIO {
    const bf16* Qw;
    const bf16* Kh;
    const bf16* Vh;
    int t_hi, t_lo;
    int t_first;
    int qpos;
    unsigned long long selm;
    int win;
    float sbound, c2q0;
    float cq;
};
template <int MODE, bool FAST, int ABL = 0>
__device__ __forceinline__ void attn_tiles(const UnitIO& U, char* shm, f32x16 (&o)[2], float& l_out, f32x16& osum) {
    int tid_ = threadIdx.x; asm volatile("" : "+v"(tid_));
    const int tid = tid_, lane = tid & 63, r32 = lane & 31, hi = lane >> 5; const int wid = __builtin_amdgcn_readfirstlane(tid >> 6);
    const unsigned lds0 = (unsigned)(uintptr_t)shm;
    float* wsf = (float*)(shm + LDS_WS) + wid * 64;
    const bf16* ksrc = U.Kh + (long)lane * PITCH + wid * 8;
    const bf16* vsrc = U.Vh + (long)(16 * (wid & 3) + (lane >> 2)) * PITCH + (wid >> 2) * 32 + (lane & 3) * 8;
    const unsigned kdst = lds0 + LDS_K + wid * 1024, vdst = lds0 + LDS_V + wid * 1024;
#define AT_DMA(t, kslot, vslot) do { glds16(ksrc + (long)(t) * 64 * PITCH, (unsigned)__builtin_amdgcn_readfirstlane(kdst + (kslot) * SLOTB)); \
                                     glds16(vsrc + (long)(t) * 64 * PITCH, (unsigned)__builtin_amdgcn_readfirstlane(vdst + (vslot) * SLOTB)); } while (0)
    const lds_cptr shm3 = (lds_cptr)shm;
    const lds_cptr kp0 = shm3 + LDS_K + hi * 1024 + r32 * 16;
    const lds_cptr vp0 = shm3 + LDS_V + ((lane >> 4) & 1) * 32 + (lane & 3) * 8 + (4 * hi + ((lane & 15) >> 2)) * 64;
    const int n = U.t_hi - U.t_lo + 1;
    AT_DMA(U.t_hi, 0, 0); if (n > 1) AT_DMA(U.t_hi - 1, 1, 1); if (n > 2) AT_DMA(U.t_hi - 2, 2, 2);
    bf16x8 qr[4];
#pragma unroll
    for (int d0 = 0; d0 < 4; ++d0) qr[d0] = *reinterpret_cast<const bf16x8*>(&U.Qw[(long)r32 * PITCH + d0 * 16 + hi * 8]);
    float mref = 0.f, l = 0.f; o[0] = f32x16{}; o[1] = f32x16{};
    f32x16 negm = f32x16{};
    if (FAST && MODE == M_FOX) {
#pragma unroll
        for (int r = 0; r < 16; ++r) negm[r] = U.cq; }
    osum = f32x16{};
    const bool lag = FAST && ABL == 0 && wid >= 4;
    u32x4 pw0, pw1, pw2, pw3; bool pend = false; int vslot_pend = 0;
#define AT_PV(vslot_) do { const lds_cptr vp = vp0 + (vslot_) * SLOTB; \
        _Pragma("unroll") for (int d0 = 0; d0 < 2; ++d0) { s16x4 lo[4], hh[4]; \
            _Pragma("unroll") for (int ks = 0; ks < 4; ++ks) { lo[ks] = vtr(vp + d0 * 4096 + ks * 1024); hh[ks] = vtr(vp + d0 * 4096 + ks * 1024 + 512); } \
            o[d0] = __builtin_amdgcn_mfma_f32_32x32x16_bf16(__builtin_bit_cast(bf16x8, pw0), AT_PK(0), o[d0], 0, 0, 0); \
            o[d0] = __builtin_amdgcn_mfma_f32_32x32x16_bf16(__builtin_bit_cast(bf16x8, pw1), AT_PK(1), o[d0], 0, 0, 0); \
            o[d0] = __builtin_amdgcn_mfma_f32_32x32x16_bf16(__builtin_bit_cast(bf16x8, pw2), AT_PK(2), o[d0], 0, 0, 0); \
            o[d0] = __builtin_amdgcn_mfma_f32_32x32x16_bf16(__builtin_bit_cast(bf16x8, pw3), AT_PK(3), o[d0], 0, 0, 0); } } while (0)
#define AT_PK(k) (bf16x8){lo[k][0], lo[k][1], lo[k][2], lo[k][3], hh[k][0], hh[k][1], hh[k][2], hh[k][3]}
#define AT_ONES() do { const bf16x8 ones_ = (bf16x8){0x3F80, 0x3F80, 0x3F80, 0x3F80, 0x3F80, 0x3F80, 0x3F80, 0x3F80}; \
        osum = __builtin_amdgcn_mfma_f32_32x32x16_bf16(__builtin_bit_cast(bf16x8, pw0), ones_, osum, 0, 0, 0); osum = __builtin_amdgcn_mfma_f32_32x32x16_bf16(__builtin_bit_cast(bf16x8, pw1), ones_, osum, 0, 0, 0); \
        osum = __builtin_amdgcn_mfma_f32_32x32x16_bf16(__builtin_bit_cast(bf16x8, pw2), ones_, osum, 0, 0, 0); osum = __builtin_amdgcn_mfma_f32_32x32x16_bf16(__builtin_bit_cast(bf16x8, pw3), ones_, osum, 0, 0, 0); } while (0)
    int kslot = 0, vslot = 0;
    for (int i = 0; i < n; ++i) {
        const int t = U.t_hi - i;
        if (i + 2 < n) AT_WAIT_BAR(4); else if (i + 1 < n) AT_WAIT_BAR(2); else AT_WAIT_BAR(0);
        if (i + 3 < n) { const int k3 = (kslot + 3) & 3, v3 = vslot >= 2 ? vslot - 2 : vslot + 3; AT_DMA(t - 3, k3, v3); }
        if (pend) { AT_PV(vslot_pend); if (FAST) AT_ONES(); pend = false; }
        if (FAST && ABL != 1 && t <= U.t_first) {
            const lds_cptr kp = kp0 + kslot * SLOTB;
            f32x16 p0, p1;
#pragma unroll
            for (int d0 = 0; d0 < 4; ++d0) {
                const bf16x8 b0 = *(const __attribute__((address_space(3))) bf16x8*)(kp + d0 * 2048);
                const bf16x8 b1 = *(const __attribute__((address_space(3))) bf16x8*)(kp + d0 * 2048 + 512);
                if (d0 == 0) { p0 = __builtin_amdgcn_mfma_f32_32x32x16_bf16(b0, qr[0], negm, 0, 0, 0); p1 = __builtin_amdgcn_mfma_f32_32x32x16_bf16(b1, qr[0], negm, 0, 0, 0); }
                else { p0 = __builtin_amdgcn_mfma_f32_32x32x16_bf16(b0, qr[d0], p0, 0, 0, 0); p1 = __builtin_amdgcn_mfma_f32_32x32x16_bf16(b1, qr[d0], p1, 0, 0, 0); }
            }
            if (ABL == 2) { asm volatile("" :: "v"(p0), "v"(p1)); } else {
            if (MODE == M_FOX) {
                const __attribute__((address_space(3))) f32x4* ck = (const __attribute__((address_space(3))) f32x4*)(shm3 + LDS_CK + (64 * t + 4 * hi) * 4);
#pragma unroll
                for (int a = 0; a < 4; ++a) { const f32x4 c0 = ck[2 * a], c1 = ck[2 * a + 8];
#pragma unroll
                    for (int j = 0; j < 4; ++j) { p0[4 * a + j] -= c0[j]; p1[4 * a + j] -= c1[j]; } }
            }
            if (t == U.t_first) {
                const int kb = 64 * t + 4 * hi;
#pragma unroll
                for (int r = 0; r < 16; ++r) { const int kv = kb + (r & 3) + 8 * (r >> 2); if (kv > U.qpos) p0[r] = NEG; if (kv + 32 > U.qpos) p1[r] = NEG; }
            }
            if (MODE == M_WIN && t == U.t_lo) {
                const int kb = 64 * t + 4 * hi, lim = U.qpos - U.win;
#pragma unroll
                for (int r = 0; r < 16; ++r) { const int kv = kb + (r & 3) + 8 * (r >> 2); if (kv <= lim) p0[r] = NEG; if (kv + 32 <= lim) p1[r] = NEG; }
            }
#pragma unroll
            for (int r = 0; r < 16; ++r) { p0[r] = __builtin_amdgcn_exp2f(p0[r]); p1[r] = __builtin_amdgcn_exp2f(p1[r]); }
            pw0 = (u32x4){cvtpk(p0[0], p0[1]), cvtpk(p0[2], p0[3]), cvtpk(p0[4], p0[5]), cvtpk(p0[6], p0[7])};
            pw1 = (u32x4){cvtpk(p0[8], p0[9]), cvtpk(p0[10], p0[11]), cvtpk(p0[12], p0[13]), cvtpk(p0[14], p0[15])};
            pw2 = (u32x4){cvtpk(p1[0], p1[1]), cvtpk(p1[2], p1[3]), cvtpk(p1[4], p1[5]), cvtpk(p1[6], p1[7])};
            pw3 = (u32x4){cvtpk(p1[8], p1[9]), cvtpk(p1[10], p1[11]), cvtpk(p1[12], p1[13]), cvtpk(p1[14], p1[15])};
            if (MODE == M_SEL) { const bool sel = (U.selm >> t) & 1ull;
#pragma unroll
                for (int j = 0; j < 4; ++j) { pw0[j] = sel ? pw0[j] : 0u; pw1[j] = sel ? pw1[j] : 0u; pw2[j] = sel ? pw2[j] : 0u; pw3[j] = sel ? pw3[j] : 0u; } }
            if (ABL == 3) { asm volatile("" :: "v"(pw0), "v"(pw1), "v"(pw2), "v"(pw3)); } else {
            if (lag) { pend = true; vslot_pend = vslot; } else { AT_PV(vslot); AT_ONES(); }
            } }
        }
        if (!FAST && t <= U.t_first) {
        const lds_cptr kp = kp0 + kslot * SLOTB;
        const f32x16& cinit = negm;
        f32x16 p0, p1;
#pragma unroll
        for (int d0 = 0; d0 < 4; ++d0) {
            const bf16x8 b0 = *(const __attribute__((address_space(3))) bf16x8*)(kp + d0 * 2048);
            const bf16x8 b1 = *(const __attribute__((address_space(3))) bf16x8*)(kp + d0 * 2048 + 512);
            if (d0 == 0) { p0 = __builtin_amdgcn_mfma_f32_32x32x16_bf16(b0, qr[0], cinit, 0, 0, 0); p1 = __builtin_amdgcn_mfma_f32_32x32x16_bf16(b1, qr[0], cinit, 0, 0, 0); }
            else { p0 = __builtin_amdgcn_mfma_f32_32x32x16_bf16(b0, qr[d0], p0, 0, 0, 0); p1 = __builtin_amdgcn_mfma_f32_32x32x16_bf16(b1, qr[d0], p1, 0, 0, 0); }
        }
        if (MODE == M_SEL) { const bool sel = (U.selm >> t) & 1ull;
#pragma unroll
            for (int r = 0; r < 16; ++r) { p0[r] = sel ? p0[r] : NEG; p1[r] = sel ? p1[r] : NEG; } }
        if (MODE == M_FOX) {
            const __attribute__((address_space(3))) f32x4* ck = (const __attribute__((address_space(3))) f32x4*)(shm3 + LDS_CK + (64 * t + 4 * hi) * 4);
#pragma unroll
            for (int a = 0; a < 4; ++a) { const f32x4 c0 = ck[2 * a], c1 = ck[2 * a + 8];
#pragma unroll
                for (int j = 0; j < 4; ++j) { p0[4 * a + j] -= c0[j]; p1[4 * a + j] -= c1[j]; } }
        }
        if (t == U.t_first) {
            const int kb = 64 * t + 4 * hi;
#pragma unroll
            for (int r = 0; r < 16; ++r) { const int kv = kb + (r & 3) + 8 * (r >> 2); if (kv > U.qpos) p0[r] = NEG; if (kv + 32 > U.qpos) p1[r] = NEG; }
        }
        if (MODE == M_WIN && t == U.t_lo) {
            const int kb = 64 * t + 4 * hi, lim = U.qpos - U.win;
#pragma unroll
            for (int r = 0; r < 16; ++r) { const int kv = kb + (r & 3) + 8 * (r >> 2); if (kv <= lim) p0[r] = NEG; if (kv + 32 <= lim) p1[r] = NEG; }
        }
        float rm = fmaxf(p0[0], p1[0]);
#pragma unroll
        for (int r = 1; r < 16; ++r) rm = fmaxf(rm, fmaxf(p0[r], p1[r]));
        { auto rr = __builtin_amdgcn_permlane32_swap(__float_as_uint(rm), __float_as_uint(rm), false, false); rm = fmaxf(__uint_as_float(rr[0]), __uint_as_float(rr[1])); }
        const bool first = (t == U.t_first);
        if (first || __any(rm > THR)) {
            const float dl = first ? rm : fmaxf(rm, 0.f); mref += dl;
#pragma unroll
            for (int r = 0; r < 16; ++r) { p0[r] -= dl; p1[r] -= dl; negm[r] = -mref; }
            if (!first) { const float f = __builtin_amdgcn_exp2f(-dl); l *= f; if (hi == 0) wsf[r32] = f;
                asm volatile("s_waitcnt lgkmcnt(0)" ::: "memory");
#pragma unroll
                for (int a = 0; a < 4; ++a) { const f32x4 fv = *(const f32x4*)(wsf + 8 * a + 4 * hi);
#pragma unroll
                    for (int j = 0; j < 4; ++j) { o[0][4 * a + j] *= fv[j]; o[1][4 * a + j] *= fv[j]; } }
            }
        }
        float sacc = 0.f;
#pragma unroll
        for (int r = 0; r < 16; ++r) { p0[r] = __builtin_amdgcn_exp2f(p0[r]); p1[r] = __builtin_amdgcn_exp2f(p1[r]); sacc += p0[r] + p1[r]; }
        l += sacc;
        pw0 = (u32x4){cvtpk(p0[0], p0[1]), cvtpk(p0[2], p0[3]), cvtpk(p0[4], p0[5]), cvtpk(p0[6], p0[7])};
        pw1 = (u32x4){cvtpk(p0[8], p0[9]), cvtpk(p0[10], p0[11]), cvtpk(p0[12], p0[13]), cvtpk(p0[14], p0[15])};
        pw2 = (u32x4){cvtpk(p1[0], p1[1]), cvtpk(p1[2], p1[3]), cvtpk(p1[4], p1[5]), cvtpk(p1[6], p1[7])};
        pw3 = (u32x4){cvtpk(p1[8], p1[9]), cvtpk(p1[10], p1[11]), cvtpk(p1[12], p1[13]), cvtpk(p1[14], p1[15])};
        if (lag) { pend = true; vslot_pend = vslot; } else { AT_PV(vslot); }
        }
        kslot = (kslot + 1) & 3; vslot = vslot == 4 ? 0 : vslot + 1;
    }
    if (pend) { AT_PV(vslot_pend); if (FAST) AT_ONES(); }
#undef AT_PV
#undef AT_ONES
#undef AT_PK
    asm volatile("s_waitcnt vmcnt(0) lgkmcnt(0)\n\ts_barrier" ::: "memory");
    l_out = l;
#undef AT_DMA
}
__device__ __forceinline__ void row_inv(float l, char* shm, float (&rli)[16]) {
    int tid_ = threadIdx.x; asm volatile("" : "+v"(tid_));
    const int lane = tid_ & 63, r32 = lane & 31, hi = lane >> 5; const int wid = __builtin_amdgcn_readfirstlane(tid_ >> 6);
    float* wsf = (float*)(shm + LDS_WS) + wid * 64;
    { auto rr = __builtin_amdgcn_permlane32_swap(__float_as_uint(l), __float_as_uint(l), false, false); l = __uint_as_float(rr[0]) + __uint_as_float(rr[1]); }
    if (hi == 0) wsf[32 + r32] = l;
    asm volatile("s_waitcnt lgkmcnt(0)" ::: "memory");
#pragma unroll
    for (int a = 0; a < 4; ++a) { const f32x4 lv = *(const f32x4*)(wsf + 32 + 8 * a + 4 * hi);
#pragma unroll
        for (int j = 0; j < 4; ++j) rli[4 * a + j] = lv[j] > 0.f ? 1.0f / lv[j] : 0.f; }
    asm volatile("s_waitcnt lgkmcnt(0)" ::: "memory");
}
}
namespace at {
constexpr int CMP_K = 0, CMP_V = 32768, CMP_IMP = LDS_CK, CMP_SELM = LDS_CK + 65536;
constexpr int KCP = 128;
__device__ __forceinline__ int imp_idx(int j, int q) { return j * 64 + (q ^ ((j >> 3) << 3)); }
__device__ __forceinline__ void cmp_scores(f32x16& p0, f32x16& p1, lds_cptr kp, const bf16x8 (&qr)[4], const f32x16& cinit, int tt, int hi, int nlim) {
#pragma unroll
    for (int d0 = 0; d0 < 4; ++d0) {
        const bf16x8 b0 = *(const __attribute__((address_space(3))) bf16x8*)(kp + d0 * 2048);
        const bf16x8 b1 = *(const __attribute__((address_space(3))) bf16x8*)(kp + d0 * 2048 + 512);
        if (d0 == 0) { p0 = __builtin_amdgcn_mfma_f32_32x32x16_bf16(b0, qr[0], cinit, 0, 0, 0); p1 = __builtin_amdgcn_mfma_f32_32x32x16_bf16(b1, qr[0], cinit, 0, 0, 0); }
        else { p0 = __builtin_amdgcn_mfma_f32_32x32x16_bf16(b0, qr[d0], p0, 0, 0, 0); p1 = __builtin_amdgcn_mfma_f32_32x32x16_bf16(b1, qr[d0], p1, 0, 0, 0); }
    }
    const int nb = 64 * tt + 4 * hi;
#pragma unroll
    for (int r = 0; r < 16; ++r) { const int n = nb + (r & 3) + 8 * (r >> 2); if (n > nlim) p0[r] = NEG; if (n + 32 > nlim) p1[r] = NEG; }
}
__device__ __forceinline__ void cmp_stage(const bf16* Qw, const bf16* Kc, const bf16* Vc, int c, int nsel, char* shm, f32x16 (&o)[2]) {
    int tid_ = threadIdx.x; asm volatile("" : "+v"(tid_));
    const int tid = tid_, lane = tid & 63, r32 = lane & 31, hi = lane >> 5; const int wid = __builtin_amdgcn_readfirstlane(tid >> 6);
    const unsigned lds0 = (unsigned)(uintptr_t)shm; const lds_cptr shm3 = (lds_cptr)shm;
    asm volatile("s_waitcnt lgkmcnt(0)\n\ts_barrier" ::: "memory");
    const int ntc = (4 * c + 2) / 64 + 1;
    const int tq = 64 * c + 32 * (wid & 1) + r32, nlim = tq >= 31 ? (tq - 31) >> 4 : -1;
    bf16x8 qr[4];
#pragma unroll
    for (int d0 = 0; d0 < 4; ++d0) qr[d0] = *reinterpret_cast<const bf16x8*>(&Qw[(long)r32 * PITCH + d0 * 16 + hi * 8]);
    float* slab = (float*)(shm + CMP_IMP) + (wid >> 1) * 4096; const int qloc = 32 * (wid & 1) + r32;
#ifdef PROBE_DUP
    for (int pr_ = 0; pr_ < (PROBE_DUP == 33 ? 2 : 1); ++pr_)
#endif
    {   if (PROBE_DUP == 33) asm volatile("s_waitcnt vmcnt(0) lgkmcnt(0)\n\ts_barrier" ::: "memory");
        const bf16* ksrc = Kc + (long)lane * KCP + wid * 8;
        const bf16* vsrc = Vc + (long)(16 * (wid & 3) + (lane >> 2)) * KCP + (wid >> 2) * 32 + (lane & 3) * 8;
        for (int tt = 0; tt < ntc; ++tt) { glds16(ksrc + (long)tt * 64 * KCP, (unsigned)__builtin_amdgcn_readfirstlane(lds0 + CMP_K + tt * SLOTB + wid * 1024));
                                           glds16(vsrc + (long)tt * 64 * KCP, (unsigned)__builtin_amdgcn_readfirstlane(lds0 + CMP_V + tt * SLOTB + wid * 1024)); }
        AT_WAIT_BAR(0);
    }
    const lds_cptr kp0 = shm3 + CMP_K + hi * 1024 + r32 * 16;
    const lds_cptr vp0 = shm3 + CMP_V + ((lane >> 4) & 1) * 32 + (lane & 3) * 8 + (4 * hi + ((lane & 15) >> 2)) * 64;
    float m = NEG, l = 0.f; const f32x16 zero = f32x16{};
#ifdef PROBE_DUP
    for (int pr_ = 0; pr_ < (PROBE_DUP == 30 ? 2 : 1); ++pr_)
#endif
    for (int tt = 0; tt < ntc; ++tt) {
        f32x16 p0, p1; cmp_scores(p0, p1, kp0 + tt * SLOTB, qr, zero, tt, hi, nlim);
        float rm = fmaxf(p0[0], p1[0]);
#pragma unroll
        for (int r = 1; r < 16; ++r) rm = fmaxf(rm, fmaxf(p0[r], p1[r]));
        { auto rr = __builtin_amdgcn_permlane32_swap(__float_as_uint(rm), __float_as_uint(rm), false, false); rm = fmaxf(__uint_as_float(rr[0]), __uint_as_float(rr[1])); }
        const float mn = fmaxf(m, rm); float s = 0.f;
#pragma unroll
        for (int r = 0; r < 16; ++r) s += __builtin_amdgcn_exp2f(p0[r] - mn) + __builtin_amdgcn_exp2f(p1[r] - mn);
        l = l * __builtin_amdgcn_exp2f(m - mn) + s; m = mn;
    }
    { auto rr = __builtin_amdgcn_permlane32_swap(__float_as_uint(l), __float_as_uint(l), false, false); l = __uint_as_float(rr[0]) + __uint_as_float(rr[1]); }
    const float rl = nlim >= 0 ? 1.0f / l : 0.f;
    f32x16 negm;
#pragma unroll
    for (int r = 0; r < 16; ++r) negm[r] = -m;
    o[0] = f32x16{}; o[1] = f32x16{}; float carry = 0.f;
    for (int tt = 0; tt < ntc; ++tt) {
        f32x16 p0, p1; cmp_scores(p0, p1, kp0 + tt * SLOTB, qr, negm, tt, hi, nlim);
#pragma unroll
        for (int r = 0; r < 16; ++r) { p0[r] = __builtin_amdgcn_exp2f(p0[r]) * rl; p1[r] = __builtin_amdgcn_exp2f(p1[r]) * rl; }
        {   float own[8], sp[8];
#pragma unroll
            for (int a = 0; a < 4; ++a) { sp[a] = 0.5f * p0[4 * a + 3]; sp[4 + a] = 0.5f * p1[4 * a + 3];
                own[a] = (p0[4 * a] + p0[4 * a + 1]) + (p0[4 * a + 2] + sp[a]); own[4 + a] = (p1[4 * a] + p1[4 * a + 1]) + (p1[4 * a + 2] + sp[4 + a]); }
            float rc[8];
#pragma unroll
            for (int k = 0; k < 8; ++k) rc[k] = lx::x32f(sp[k], hi != 0);
            if (hi) {
#pragma unroll
                for (int k = 0; k < 8; ++k) own[k] += rc[k];
            } else { own[0] += carry;
#pragma unroll
                for (int k = 0; k < 7; ++k) own[k + 1] += rc[k];
                carry = rc[7]; }
#pragma unroll
            for (int a = 0; a < 4; ++a) { slab[imp_idx(16 * tt + 2 * a + hi, qloc)] = own[a]; slab[imp_idx(16 * tt + 8 + 2 * a + hi, qloc)] = own[4 + a]; }
        }
        const lds_cptr vp = vp0 + tt * SLOTB;
        u32x4 pw0, pw1, pw2, pw3;
        pw0 = (u32x4){cvtpk(p0[0], p0[1]), cvtpk(p0[2], p0[3]), cvtpk(p0[4], p0[5]), cvtpk(p0[6], p0[7])};
        pw1 = (u32x4){cvtpk(p0[8], p0[9]), cvtpk(p0[10], p0[11]), cvtpk(p0[12], p0[13]), cvtpk(p0[14], p0[15])};
        pw2 = (u32x4){cvtpk(p1[0], p1[1]), cvtpk(p1[2], p1[3]), cvtpk(p1[4], p1[5]), cvtpk(p1[6], p1[7])};
        pw3 = (u32x4){cvtpk(p1[8], p1[9]), cvtpk(p1[10], p1[11]), cvtpk(p1[12], p1[13]), cvtpk(p1[14], p1[15])};
#pragma unroll
        for (int d0 = 0; d0 < 2; ++d0) {
            s16x4 lo[4], hh[4];
#pragma unroll
            for (int ks = 0; ks < 4; ++ks) { lo[ks] = vtr(vp + d0 * 4096 + ks * 1024); hh[ks] = vtr(vp + d0 * 4096 + ks * 1024 + 512); }
#define AT_PK(k) (bf16x8){lo[k][0], lo[k][1], lo[k][2], lo[k][3], hh[k][0], hh[k][1], hh[k][2], hh[k][3]}
            o[d0] = __builtin_amdgcn_mfma_f32_32x32x16_bf16(__builtin_bit_cast(bf16x8, pw0), AT_PK(0), o[d0], 0, 0, 0);
            o[d0] = __builtin_amdgcn_mfma_f32_32x32x16_bf16(__builtin_bit_cast(bf16x8, pw1), AT_PK(1), o[d0], 0, 0, 0);
            o[d0] = __builtin_amdgcn_mfma_f32_32x32x16_bf16(__builtin_bit_cast(bf16x8, pw2), AT_PK(2), o[d0], 0, 0, 0);
            o[d0] = __builtin_amdgcn_mfma_f32_32x32x16_bf16(__builtin_bit_cast(bf16x8, pw3), AT_PK(3), o[d0], 0, 0, 0);
#undef AT_PK
        }
    }
    asm volatile("s_waitcnt lgkmcnt(0)\n\ts_barrier" ::: "memory");
#ifdef PROBE_DUP
    for (int pr_ = 0; pr_ < (PROBE_DUP == 32 ? 2 : 1); ++pr_)
#endif
    {   const int q = tid >> 3, part = tid & 7; const float* s0 = (const float*)(shm + CMP_IMP);
        const int t = 64 * c + q, cur = c;
        unsigned key[8];
#pragma unroll
        for (int i = 0; i < 8; ++i) { const int j = part * 8 + i; const int ix = imp_idx(j, q); const float imp = ((s0[ix] + s0[4096 + ix]) + s0[8192 + ix]) + s0[12288 + ix];
            const bool forced = (j == 0) || (j == cur) || (j == cur - 1);
            const float sc = imp + (forced ? 1e4f : 0.0f);
            key[i] = (j * 64 > t) ? (unsigned)(63 - j) : ((__float_as_uint(sc) & ~63u) | (unsigned)(63 - j)) + 64u; }
        unsigned sel8 = 0u;
        for (int s = 0; s < nsel; ++s) {
            unsigned best = key[0];
#pragma unroll
            for (int i = 1; i < 8; ++i) best = best > key[i] ? best : key[i];
            { const unsigned o1 = (unsigned)__builtin_amdgcn_update_dpp(0, (int)best, 0xB1, 0xF, 0xF, false); best = best > o1 ? best : o1; }
            { const unsigned o2 = (unsigned)__builtin_amdgcn_update_dpp(0, (int)best, 0x4E, 0xF, 0xF, false); best = best > o2 ? best : o2; }
            { const unsigned o3 = (unsigned)__builtin_amdgcn_update_dpp(0, (int)best, 0x141, 0xF, 0xF, false); best = best > o3 ? best : o3; }
#pragma unroll
            for (int i = 0; i < 8; ++i) { const bool hit = key[i] == best; sel8 |= hit ? (1u << i) : 0u; key[i] = hit ? 0u : key[i]; }
        }
        unsigned mlo = part < 4 ? sel8 << (8 * part) : 0u, mhi = part >= 4 ? sel8 << (8 * (part - 4)) : 0u;
        mlo |= (unsigned)__builtin_amdgcn_update_dpp(0, (int)mlo, 0xB1, 0xF, 0xF, false); mhi |= (unsigned)__builtin_amdgcn_update_dpp(0, (int)mhi, 0xB1, 0xF, 0xF, false);
        mlo |= (unsigned)__builtin_amdgcn_update_dpp(0, (int)mlo, 0x4E, 0xF, 0xF, false); mhi |= (unsigned)__builtin_amdgcn_update_dpp(0, (int)mhi, 0x4E, 0xF, 0xF, false);
        mlo |= (unsigned)__builtin_amdgcn_update_dpp(0, (int)mlo, 0x141, 0xF, 0xF, false); mhi |= (unsigned)__builtin_amdgcn_update_dpp(0, (int)mhi, 0x141, 0xF, 0xF, false);
        const unsigned long long mk = ((unsigned long long)mhi << 32) | mlo;
        if (part == 0) ((unsigned long long*)(shm + CMP_SELM))[q] = mk;
    }
    asm volatile("s_waitcnt lgkmcnt(0)\n\ts_barrier" ::: "memory");
}
}

namespace at {
__device__ __forceinline__ void compress_unit(const bf16* tokb  , int n0, int ncmp, const float* pe, const bf16* W1T, const bf16* W2T,
                                              const float* ropeb  , bf16* outb  , char* shm) {
    int tid_ = threadIdx.x; asm volatile("" : "+v"(tid_));
    const int tid = tid_, lane = tid & 63, r32 = lane & 31, hi = lane >> 5; const int wid = __builtin_amdgcn_readfirstlane(tid >> 6);
    const int cb = wid & 3, kh = wid >> 2;
    const int n = n0 + r32, nc = n < ncmp ? n : ncmp - 1;
    f32x16 acc = f32x16{};
    const bf16* wrow = W1T + (long)(32 * cb + r32) * 2048 + 8 * hi;
#pragma unroll 16
    for (int s = 64 * kh; s < 64 * kh + 64; ++s) {
        const int l = s >> 2, d = 16 * (s & 3) + 8 * hi;
        const u32x4 tv = *(const u32x4*)(tokb + (long)(16 * nc + l) * PITCH + d);
        const f32x4 pa = *(const f32x4*)(pe + l * 64 + d), pb = *(const f32x4*)(pe + l * 64 + d + 4);
        u32x4 av;
        av.x = cvtpk(__builtin_bit_cast(float, tv.x << 16) + pa[0], __builtin_bit_cast(float, tv.x & 0xffff0000u) + pa[1]);
        av.y = cvtpk(__builtin_bit_cast(float, tv.y << 16) + pa[2], __builtin_bit_cast(float, tv.y & 0xffff0000u) + pa[3]);
        av.z = cvtpk(__builtin_bit_cast(float, tv.z << 16) + pb[0], __builtin_bit_cast(float, tv.z & 0xffff0000u) + pb[1]);
        av.w = cvtpk(__builtin_bit_cast(float, tv.w << 16) + pb[2], __builtin_bit_cast(float, tv.w & 0xffff0000u) + pb[3]);
        const bf16x8 bv = *(const bf16x8*)(wrow + 16 * s);
        acc = __builtin_amdgcn_mfma_f32_32x32x16_bf16(__builtin_bit_cast(bf16x8, av), bv, acc, 0, 0, 0);
    }
    float* red = (float*)shm;
    unsigned short* hb = (unsigned short*)(shm + 16384);
    asm volatile("s_waitcnt lgkmcnt(0)\n\ts_barrier" ::: "memory");
    if (kh == 1) {
#pragma unroll
        for (int r = 0; r < 16; ++r) red[(cb * 16 + r) * 64 + lane] = acc[r];
    }
    asm volatile("s_waitcnt lgkmcnt(0)\n\ts_barrier" ::: "memory");
    if (kh == 0) {
#pragma unroll
        for (int r = 0; r < 16; ++r) { const float v = acc[r] + red[(cb * 16 + r) * 64 + lane]; const float hsl = v / (1.0f + __expf(-v));
            hb[crow(r, hi) * 136 + 32 * cb + r32] = (unsigned short)(cvtpk(hsl, 0.f) & 0xffffu); }
    }
    asm volatile("s_waitcnt lgkmcnt(0)\n\ts_barrier" ::: "memory");
    if (wid < 2) {
        f32x16 o2 = f32x16{};
#pragma unroll
        for (int s = 0; s < 8; ++s) { const bf16x8 a = *(const bf16x8*)(hb + r32 * 136 + 16 * s + 8 * hi); const bf16x8 b = *(const bf16x8*)(W2T + (long)(32 * wid + r32) * 128 + 16 * s + 8 * hi);
            o2 = __builtin_amdgcn_mfma_f32_32x32x16_bf16(a, b, o2, 0, 0, 0); }
#pragma unroll
        for (int r = 0; r < 16; ++r) { const int nn = n0 + crow(r, hi); float v = o2[r];
            if (ropeb != nullptr && wid == 0) {
                const float pv = lx::xf<8>(v);
                if (r32 < 16 && nn < ncmp) { const float* cs = ropeb + ((long)(16 * nn + 31) * 8 + (r32 & 7)) * 2; const float cc = cs[0], sn = cs[1]; v = r32 < 8 ? v * cc - pv * sn : v * cc + pv * sn; }
            }
            if (nn < 256) outb[(long)nn * 128 + 32 * wid + r32] = nn < ncmp ? (unsigned short)(cvtpk(v, 0.f) & 0xffffu) : (unsigned short)0; }
    }
    asm volatile("s_waitcnt lgkmcnt(0)\n\ts_barrier" ::: "memory");
}
}

namespace at {
template <bool ACCUM>
__device__ __forceinline__ void store_rows(const f32x16 (&o)[2], const float* rli  , unsigned short* obase  , int ldo,
                                           const float* gbase  , int ldg) {
    static_assert(!ACCUM, "the mixer outputs are written once, as bf16");
    int t_ = threadIdx.x; asm volatile("" : "+v"(t_)); const int lane = t_ & 63, r32 = lane & 31, hi = lane >> 5;
    unsigned short* ob = obase + r32;
#pragma unroll
    for (int r = 0; r < 16; ++r) { const int row = crow(r, hi); float sc = rli ? rli[r] : 1.0f; if (gbase) sc *= gbase[(size_t)row * ldg];
        unsigned short* p = ob + (size_t)row * ldo; const unsigned w = cvtpk(o[0][r] * sc, o[1][r] * sc);
        p[0] = (unsigned short)(w & 0xffffu); p[32] = (unsigned short)(w >> 16); }
}
}

namespace at {
template <bool INIT, bool LAST>
__device__ __forceinline__ void fold_rows(float* accw  , f32x16 (&o)[2], const float* rli  , const float* gbase, int ldg) {
    int t_ = threadIdx.x; asm volatile("" : "+v"(t_)); const int lane = t_ & 63, hi = lane >> 5;
#pragma unroll
    for (int r = 0; r < 16; ++r) { float sc = gbase[(size_t)crow(r, hi) * ldg]; if (rli) sc *= rli[r];
        float v0 = o[0][r] * sc, v1 = o[1][r] * sc;
        if (!INIT) { v0 += accw[r * 64 + lane]; v1 += accw[(16 + r) * 64 + lane]; }
        if (LAST) { o[0][r] = v0; o[1][r] = v1; } else { accw[r * 64 + lane] = v0; accw[(16 + r) * 64 + lane] = v1; } }
    asm volatile("s_waitcnt lgkmcnt(0)" ::: "memory");
}
}
namespace at {
template <int MODE>
__device__ __forceinline__ void attn_tiles_pipe(const UnitIO& U, char* shm, f32x16 (&o)[2], f32x16& osum) {
    int tid_ = threadIdx.x; asm volatile("" : "+v"(tid_));
    const int tid = tid_, lane = tid & 63, r32 = lane & 31, hi = lane >> 5; const int wid = __builtin_amdgcn_readfirstlane(tid >> 6);
    const unsigned lds0 = (unsigned)(uintptr_t)shm;
    const bf16* ksrc = U.Kh + (long)lane * PITCH + wid * 8;
    const bf16* vsrc = U.Vh + (long)(16 * (wid & 3) + (lane >> 2)) * PITCH + (wid >> 2) * 32 + (lane & 3) * 8;
    const unsigned kdst = lds0 + LDS_K + wid * 1024, vdst = lds0 + LDS_V + wid * 1024;
#define PP_DMA_K(step, slot) glds16(ksrc + (long)(U.t_hi - (step)) * 64 * PITCH, (unsigned)__builtin_amdgcn_readfirstlane(kdst + (slot) * SLOTB))
#define PP_DMA_V(step, slot) glds16(vsrc + (long)(U.t_hi - (step)) * 64 * PITCH, (unsigned)__builtin_amdgcn_readfirstlane(vdst + (slot) * SLOTB))
    const lds_cptr shm3 = (lds_cptr)shm;
    const lds_cptr kp0 = shm3 + LDS_K + hi * 1024 + r32 * 16;
    const lds_cptr vp0 = shm3 + LDS_V + ((lane >> 4) & 1) * 32 + (lane & 3) * 8 + (4 * hi + ((lane & 15) >> 2)) * 64;
    const int n = U.t_hi - U.t_lo + 1, i0 = U.t_hi - U.t_first;
    bf16x8 qr[4];
#pragma unroll
    for (int d0 = 0; d0 < 4; ++d0) qr[d0] = *reinterpret_cast<const bf16x8*>(&U.Qw[(long)r32 * PITCH + d0 * 16 + hi * 8]);
    asm volatile("" ::: "memory");
    PP_DMA_K(0, 0); if (n > 1) PP_DMA_K(1, 1); PP_DMA_V(0, 0); if (n > 2) PP_DMA_K(2, 2); if (n > 1) PP_DMA_V(1, 1);
    f32x16 cini = f32x16{};
    if (MODE == M_FOX) {
#pragma unroll
        for (int r = 0; r < 16; ++r) cini[r] = U.cq; }
    o[0] = f32x16{}; o[1] = f32x16{}; osum = f32x16{};
    const bf16x8 ones = (bf16x8){0x3F80, 0x3F80, 0x3F80, 0x3F80, 0x3F80, 0x3F80, 0x3F80, 0x3F80};
    if (n > 2) asm volatile("s_waitcnt vmcnt(4) lgkmcnt(0)\n\ts_barrier" ::: "memory"); else if (n == 2) asm volatile("s_waitcnt vmcnt(3) lgkmcnt(0)\n\ts_barrier" ::: "memory");
    else asm volatile("s_waitcnt vmcnt(1) lgkmcnt(0)\n\ts_barrier" ::: "memory");
#define PP_QK(S0, S1, slot) do { const lds_cptr kp = kp0 + (slot) * SLOTB; \
        _Pragma("unroll") for (int d0 = 0; d0 < 4; ++d0) { \
            const bf16x8 b0 = *(const __attribute__((address_space(3))) bf16x8*)(kp + d0 * 2048); \
            const bf16x8 b1 = *(const __attribute__((address_space(3))) bf16x8*)(kp + d0 * 2048 + 512); \
            if (d0 == 0) { S0 = __builtin_amdgcn_mfma_f32_32x32x16_bf16(b0, qr[0], cini, 0, 0, 0); S1 = __builtin_amdgcn_mfma_f32_32x32x16_bf16(b1, qr[0], cini, 0, 0, 0); } \
            else { S0 = __builtin_amdgcn_mfma_f32_32x32x16_bf16(b0, qr[d0], S0, 0, 0, 0); S1 = __builtin_amdgcn_mfma_f32_32x32x16_bf16(b1, qr[d0], S1, 0, 0, 0); } } } while (0)
    f32x16 s0 = f32x16{}, s1 = f32x16{};
    if (i0 == 0) PP_QK(s0, s1, 0);
    int ks = 0;
    for (int i = 0; i < n; ++i) {
        const int t = U.t_hi - i;
        if (i + 2 < n) asm volatile("s_waitcnt vmcnt(2) lgkmcnt(0)\n\ts_barrier" ::: "memory");
        else if (i + 1 < n) asm volatile("s_waitcnt vmcnt(1) lgkmcnt(0)\n\ts_barrier" ::: "memory");
        else asm volatile("s_waitcnt vmcnt(0) lgkmcnt(0)\n\ts_barrier" ::: "memory");
        const int ks1 = ks == 2 ? 0 : ks + 1, ks2 = ks == 0 ? 2 : ks - 1;
        if (i + 3 < n) PP_DMA_K(i + 3, ks);
        if (i + 2 < n) PP_DMA_V(i + 2, ks2);
        const bool act = i >= i0, actn = (i + 1 >= i0) && (i + 1 < n);
        f32x16 n0 = f32x16{}, n1 = f32x16{};
        u32x4 pw0, pw1, pw2, pw3;
#define PP_SOFT(DIAG, WLO) do { \
            if (MODE == M_FOX) { const __attribute__((address_space(3))) f32x4* ck = (const __attribute__((address_space(3))) f32x4*)(shm3 + LDS_CK + (64 * t + 4 * hi) * 4); \
                _Pragma("unroll") for (int a = 0; a < 4; ++a) { const f32x4 c0 = ck[2 * a], c1 = ck[2 * a + 8]; \
                    _Pragma("unroll") for (int j = 0; j < 4; ++j) { s0[4 * a + j] -= c0[j]; s1[4 * a + j] -= c1[j]; } } } \
            if (DIAG) { const int kb = 64 * t + 4 * hi; \
                _Pragma("unroll") for (int r = 0; r < 16; ++r) { const int kv = kb + (r & 3) + 8 * (r >> 2); if (kv > U.qpos) s0[r] = NEG; if (kv + 32 > U.qpos) s1[r] = NEG; } } \
            if (WLO) { const int kb = 64 * t + 4 * hi, lim = U.qpos - U.win; \
                _Pragma("unroll") for (int r = 0; r < 16; ++r) { const int kv = kb + (r & 3) + 8 * (r >> 2); if (kv <= lim) s0[r] = NEG; if (kv + 32 <= lim) s1[r] = NEG; } } \
            _Pragma("unroll") for (int r = 0; r < 16; ++r) { s0[r] = __builtin_amdgcn_exp2f(s0[r]); s1[r] = __builtin_amdgcn_exp2f(s1[r]); } \
            pw0 = (u32x4){cvtpk(s0[0], s0[1]), cvtpk(s0[2], s0[3]), cvtpk(s0[4], s0[5]), cvtpk(s0[6], s0[7])}; \
            pw1 = (u32x4){cvtpk(s0[8], s0[9]), cvtpk(s0[10], s0[11]), cvtpk(s0[12], s0[13]), cvtpk(s0[14], s0[15])}; \
            pw2 = (u32x4){cvtpk(s1[0], s1[1]), cvtpk(s1[2], s1[3]), cvtpk(s1[4], s1[5]), cvtpk(s1[6], s1[7])}; \
            pw3 = (u32x4){cvtpk(s1[8], s1[9]), cvtpk(s1[10], s1[11]), cvtpk(s1[12], s1[13]), cvtpk(s1[14], s1[15])}; \
            if (MODE == M_SEL) { const bool sel = (U.selm >> t) & 1ull; \
                _Pragma("unroll") for (int j = 0; j < 4; ++j) { pw0[j] = sel ? pw0[j] : 0u; pw1[j] = sel ? pw1[j] : 0u; pw2[j] = sel ? pw2[j] : 0u; pw3[j] = sel ? pw3[j] : 0u; } } } while (0)
#define PP_HINT() do { _Pragma("unroll") for (int k_ = 0; k_ < 8; ++k_) { __builtin_amdgcn_sched_group_barrier(0x100, 1, 0); __builtin_amdgcn_sched_group_barrier(0x008, 1, 0); \
            __builtin_amdgcn_sched_group_barrier(0x400, 4, 0); __builtin_amdgcn_sched_group_barrier(0x002, 6, 0); } } while (0)
        if (act) {
            const bool diag = (i == i0), wlo = (MODE == M_WIN) && (i == n - 1);
            if (diag) { if (actn) { PP_QK(n0, n1, ks1); PP_SOFT(true, false); PP_HINT(); } else { PP_SOFT(true, (MODE == M_WIN) && wlo); } }
            else if (wlo) { PP_SOFT(false, true); }
            else if (actn) { PP_QK(n0, n1, ks1); PP_SOFT(false, false); PP_HINT(); }
            else { PP_SOFT(false, false); }
            const lds_cptr vp = vp0 + ks * SLOTB;
#pragma unroll
            for (int d0 = 0; d0 < 2; ++d0) { s16x4 lo[4], hh[4];
#pragma unroll
                for (int q4 = 0; q4 < 4; ++q4) { lo[q4] = vtr(vp + d0 * 4096 + q4 * 1024); hh[q4] = vtr(vp + d0 * 4096 + q4 * 1024 + 512); }
#define PP_PK(k) (bf16x8){lo[k][0], lo[k][1], lo[k][2], lo[k][3], hh[k][0], hh[k][1], hh[k][2], hh[k][3]}
                o[d0] = __builtin_amdgcn_mfma_f32_32x32x16_bf16(__builtin_bit_cast(bf16x8, pw0), PP_PK(0), o[d0], 0, 0, 0);
                o[d0] = __builtin_amdgcn_mfma_f32_32x32x16_bf16(__builtin_bit_cast(bf16x8, pw1), PP_PK(1), o[d0], 0, 0, 0);
                o[d0] = __builtin_amdgcn_mfma_f32_32x32x16_bf16(__builtin_bit_cast(bf16x8, pw2), PP_PK(2), o[d0], 0, 0, 0);
                o[d0] = __builtin_amdgcn_mfma_f32_32x32x16_bf16(__builtin_bit_cast(bf16x8, pw3), PP_PK(3), o[d0], 0, 0, 0);
#undef PP_PK
            }
            osum = __builtin_amdgcn_mfma_f32_32x32x16_bf16(__builtin_bit_cast(bf16x8, pw0), ones, osum, 0, 0, 0);
            osum = __builtin_amdgcn_mfma_f32_32x32x16_bf16(__builtin_bit_cast(bf16x8, pw1), ones, osum, 0, 0, 0);
            osum = __builtin_amdgcn_mfma_f32_32x32x16_bf16(__builtin_bit_cast(bf16x8, pw2), ones, osum, 0, 0, 0);
            osum = __builtin_amdgcn_mfma_f32_32x32x16_bf16(__builtin_bit_cast(bf16x8, pw3), ones, osum, 0, 0, 0);
        } else if (actn) { PP_QK(n0, n1, ks1); }
        s0 = n0; s1 = n1; ks = ks1;
    }
    asm volatile("s_waitcnt lgkmcnt(0)\n\ts_barrier" ::: "memory");
#undef PP_SOFT
#undef PP_HINT
#undef PP_QK
#undef PP_DMA_K
#undef PP_DMA_V
}
}
namespace mk {
#define GAS __attribute__((address_space(1)))
#define LAS __attribute__((address_space(3)))
typedef unsigned short bf16;
typedef unsigned v4u __attribute__((ext_vector_type(4)));
typedef float f32x4 __attribute__((ext_vector_type(4)));
typedef short bf16x8 __attribute__((ext_vector_type(8)));
typedef GAS unsigned gu32;
typedef GAS unsigned long long gu64;
#define RLX_AGENT __ATOMIC_RELAXED, __HIP_MEMORY_SCOPE_AGENT
#define LDS_WAIT() asm volatile("s_waitcnt lgkmcnt(0)" ::: "memory")
#define VM_WAIT() asm volatile("s_waitcnt vmcnt(0)" ::: "memory")
__device__ __forceinline__ unsigned long long rt() { return __builtin_amdgcn_s_memrealtime(); }
__device__ __forceinline__ unsigned f2bf(float f) { unsigned u = __builtin_bit_cast(unsigned, f); return (u + 0x7fffu + ((u >> 16) & 1u)) >> 16; }
__device__ __forceinline__ unsigned pk2(float lo, float hi) { return f2bf(lo) | (f2bf(hi) << 16); }

#define XB_TMO      128
#define XB_XCNT(j)  (256  + 64 * (j))
#define XB_XSUB(j)  (1280 + 64 * (j))
#define XB_XGEN(j)  (2304 + 64 * (j))
#define XB_TOP      3328
#define XB_TOPGEN   3392
#define XCD_BAR_WORDS 3456
#ifndef XB_SPIN_CAP
#define XB_SPIN_CAP (1u << 24)
#endif

__device__ __forceinline__ unsigned xb_ld(unsigned* p)              { return __hip_atomic_load(p, __ATOMIC_RELAXED, __HIP_MEMORY_SCOPE_AGENT); }
__device__ __forceinline__ unsigned xb_add(unsigned* p, unsigned v) { return __hip_atomic_fetch_add(p, v, __ATOMIC_RELAXED, __HIP_MEMORY_SCOPE_AGENT); }
__device__ __forceinline__ unsigned xb_xcc_id() { return (unsigned)__builtin_amdgcn_s_getreg((3 << 11) | 20) & 0xFu; }
#define XB_SPIN(cond, bar) do { unsigned _sp = 0; while (cond) { __builtin_amdgcn_s_sleep(1); \
    if ((++_sp & 255u) == 0u) { if (xb_ld(&(bar)[XB_TMO])) break; if (_sp > XB_SPIN_CAP) { atomicAdd(&(bar)[XB_TMO], 1u); break; } } } } while (0)

struct XcdBarrier {
    unsigned* bar; unsigned x;
    volatile LAS unsigned* st;
};

__device__ __forceinline__ XcdBarrier xcd_barrier_post(unsigned* bar, volatile LAS unsigned* st) {
    XcdBarrier b; b.bar = bar; b.x = xb_xcc_id(); b.st = st;
    if (threadIdx.x == 0) (void)xb_add(&bar[XB_XCNT(b.x)], 1u);
    return b;
}
__device__ __forceinline__ void xcd_barrier_complete(unsigned* bar, unsigned x, unsigned& nloc, unsigned& nx) {
    const unsigned G = gridDim.x * gridDim.y * gridDim.z;
    unsigned sum, cnt, mine, sp = 0u;
    for (;;) {
        sum = 0u; cnt = 0u; mine = 0u;
#pragma unroll
        for (unsigned j = 0; j < 16; ++j) { const unsigned c = xb_ld(&bar[XB_XCNT(j)]); sum += c; cnt += (c > 0u) ? 1u : 0u; mine = (j == x) ? c : mine; }
        if (sum == G) break;
        __builtin_amdgcn_s_sleep(1);
        if ((++sp & 255u) == 0u) { if (xb_ld(&bar[XB_TMO])) break; if (sp > XB_SPIN_CAP) { atomicAdd(&bar[XB_TMO], 1u); break; } }
    }
    nloc = mine > 0u ? mine : 1u; nx = cnt > 0u ? cnt : 1u;
}

__device__ __forceinline__ void xcd_barrier(const XcdBarrier& b) {
    asm volatile("s_waitcnt vmcnt(0)" ::: "memory");
    __syncthreads();
    if (threadIdx.x == 0) {
        unsigned* bar = b.bar;
        __builtin_amdgcn_s_waitcnt(0);
        unsigned nloc = b.st[0], nx = b.st[1];
        if (nloc == 0u) { xcd_barrier_complete(bar, b.x, nloc, nx); b.st[0] = nloc; b.st[1] = nx; }
        const unsigned old = xb_add(&bar[XB_XSUB(b.x)], 1u);
        const unsigned gen = old / nloc;
        if (old + 1u == (gen + 1u) * nloc) {
            __builtin_amdgcn_fence(__ATOMIC_RELEASE, "agent");
            asm volatile("s_waitcnt vmcnt(0)" ::: "memory");
            const unsigned og = xb_add(&bar[XB_TOP], 1u);
            const unsigned tg = og / nx;
            if (og + 1u == (tg + 1u) * nx) xb_add(&bar[XB_TOPGEN], 1u);
            else XB_SPIN(xb_ld(&bar[XB_TOPGEN]) == tg, bar);
            __builtin_amdgcn_fence(__ATOMIC_ACQUIRE, "agent");
            xb_add(&bar[XB_XGEN(b.x)], 1u);
            asm volatile("s_waitcnt vmcnt(0)" ::: "memory");
        } else {
            XB_SPIN(xb_ld(&bar[XB_XGEN(b.x)]) == gen, bar);
            __builtin_amdgcn_fence(__ATOMIC_ACQUIRE, "agent");
            asm volatile("s_waitcnt vmcnt(0)" ::: "memory");
        }
    }
    __syncthreads();
}
using nv::B_; using nv::S_; using nv::T_; using nv::DM; using nv::NCMP; using nv::NBLK;
constexpr int NWAVES = 8, NTHREADS = NWAVES * 64;
constexpr int RING_OFF = 0, RING_BYTES = 131072, LDS_BYTES = 147456, LDSCTL_OFF = LDS_BYTES - 1024, MISC_OFF = LDSCTL_OFF + 320;
constexpr int CW_BAR = 4096, CW_FOXQ = 8192, CW_PANEL = 16384, CW_HM = 24576;
constexpr int NIN = 3072;
constexpr size_t MiB = (size_t)1 << 20;
constexpr size_t WS_CTL = 0, CTL_ZERO_BYTES = 1 * MiB;
constexpr size_t WS_WIN = 2 * MiB;
constexpr size_t WS_WOUT = 8 * MiB, WS_WPG = 10 * MiB, WS_WPP = 12 * MiB, WS_CMPW = 13 * MiB;
constexpr size_t WS_ROPE = 15 * MiB;
constexpr size_t WS_GATES = 17 * MiB;
constexpr size_t WS_LOGF = 20 * MiB, WS_CUM = 21 * MiB;
constexpr size_t WS_KC = 22 * MiB, WS_VC = 23 * MiB, WS_SELM = 24 * MiB, WS_EID = 25 * MiB, WS_CW = 26 * MiB, WS_RS3 = 27 * MiB, WS_CMPH = 28 * MiB;
constexpr size_t WS_WGU = 40 * MiB, WS_WD = 72 * MiB;
constexpr size_t WS_RA = 39 * MiB;
constexpr size_t WS_XN = 88 * MiB;
constexpr size_t WS_PROJB = 152 * MiB;
constexpr size_t WS_TAB = 1 * MiB;
constexpr size_t WS_ROPEH = 38 * MiB;
constexpr size_t WS_ROWIDX = 37 * MiB;
constexpr size_t WS_XS = 36 * MiB;
constexpr size_t WS_POS = 34 * MiB, WS_NRM = 35 * MiB;
constexpr size_t WS_USORT = 152 * MiB, WS_HIDB = 288 * MiB, WS_YB = 356 * MiB;
constexpr size_t WS_PB = 496 * MiB;
constexpr size_t WS_IMP = 328 * MiB;
constexpr size_t WS_NH = 88 * MiB, WS_NU = 216 * MiB, WS_NHID = 344 * MiB;
static_assert(WS_NHID + (size_t)T_ * 1024 * 4 <= 512 * MiB && WS_PROJB + (size_t)T_ * 2816 * 2 <= WS_IMP, "d_ws map");

__device__ __forceinline__ float wave_sum(float v) { return lx::sum64(v); }
template <int MODE, bool SC = false>
__device__ __forceinline__ void p0_transpose_item(const float* W, int ldw, int col0, int K, int nblk, bf16* WT, int row_off, LAS float* scr, int item, int lane, const float* ksc = nullptr) {
    const int kb = item / nblk, nb = item % nblk, k0 = 64 * kb, n0 = 32 * nb;
#pragma unroll 8
    for (int i = 0; i < 32; ++i) { const int kk = 2 * i + (lane >> 5); const int cl = lane & 31; const int sc = (MODE == 2 && cl >= 24) ? col0 + 1536 + cl : col0 + n0 + cl; scr[kk * 33 + cl] = SC ? W[(size_t)(k0 + kk) * ldw + sc] * ksc[k0 + kk] : W[(size_t)(k0 + kk) * ldw + sc]; }
    LDS_WAIT(); asm volatile("" ::: "memory");
    const int c = lane & 7;
#pragma unroll
    for (int j = 0; j < 4; ++j) { const int n = (lane >> 3) + 8 * j; const LAS float* s = scr + (8 * c) * 33 + n;
        v4u o; o.x = pk2(s[0 * 33], s[1 * 33]); o.y = pk2(s[2 * 33], s[3 * 33]); o.z = pk2(s[4 * 33], s[5 * 33]); o.w = pk2(s[6 * 33], s[7 * 33]);
        const int nn = n0 + n; const int ln = row_off + nn;
        const int drow = MODE == 3 ? (ln & ~255) + 128 * ((ln >> 5) & 1) + 32 * ((ln >> 6) & 3) + (ln & 31) : MODE != 1 ? row_off + nn : (nn >> 2) * 8 + (nn & 3) + row_off;
        *(GAS v4u*)(WT + (size_t)drow * K + k0 + 8 * c) = o; }
    LDS_WAIT(); asm volatile("" ::: "memory");
}
__device__ __forceinline__ void rms_row_to_bf16(const float* xrow, const float* gain, bf16* orow, int lane) {
    const GAS f32x4* xr = (const GAS f32x4*)xrow + lane; const GAS f32x4* gr = (const GAS f32x4*)gain + lane;
    f32x4 v[4]; float s = 0.f;
#pragma unroll
    for (int j = 0; j < 4; ++j) { v[j] = xr[64 * j]; s += (v[j].x * v[j].x + v[j].y * v[j].y) + (v[j].z * v[j].z + v[j].w * v[j].w); }
    const float rstd = 1.f / sqrtf(wave_sum(s) * (1.f / 1024.f) + 1e-6f);
    GAS unsigned long long* o8 = (GAS unsigned long long*)orow + lane;
#pragma unroll
    for (int j = 0; j < 4; ++j) { const f32x4 g = gr[64 * j];
        o8[64 * j] = (unsigned long long)pk2(v[j].x * rstd * g.x, v[j].y * rstd * g.y) | ((unsigned long long)pk2(v[j].z * rstd * g.z, v[j].w * rstd * g.w) << 32); }
}

#ifndef PROBE_DUP
#define PROBE_DUP (-1)
#endif
#define REP(k) for (int rep_ = 0; rep_ < ((PROBE_DUP == (k)) ? 2 : 1); ++rep_)
struct Args { const void* in[29]; void* out; void* ws; };
#define LDP_(k) ((uintptr_t)args.in[k])
#define PHASE_PTRS() size_t zo_ = 0; asm volatile("" : "+s"(zo_)); char* ws = ws0_ + zo_; float* out = out0_ + zo_;     volatile LAS unsigned* LPV_ = (volatile LAS unsigned*)(ldsp + LDSCTL_OFF + 512); (void)LPV_; \
    const float* in_x = (const float*)LDP_(0); const float* in_p = (const float*)LDP_(1); const int* positions = (const int*)LDP_(2); const float* g_mix = (const float*)LDP_(3); const float* w_in = (const float*)LDP_(4); const float* b_gate = (const float*)LDP_(5); const float* b_forget = (const float*)LDP_(6); const float* pe_k = (const float*)LDP_(7); const float* w_k1 = (const float*)LDP_(8); const float* w_k2 = (const float*)LDP_(9); const float* pe_v = (const float*)LDP_(10); const float* w_v1 = (const float*)LDP_(11); const float* w_v2 = (const float*)LDP_(12); const float* beta_nsa = (const float*)LDP_(13); const float* beta_fox = (const float*)LDP_(14); const float* w_out = (const float*)LDP_(15); const float* g_ffn = (const float*)LDP_(16); const float* w_group = (const float*)LDP_(17); const float* b_group = (const float*)LDP_(18); const float* w_router = (const float*)LDP_(19); const float* b_router = (const float*)LDP_(20); const float* w_gate_e = (const float*)LDP_(21); const float* w_up_e = (const float*)LDP_(22); const float* w_down_e = (const float*)LDP_(23); const float* g_ple = (const float*)LDP_(24); const float* w_ple_gate = (const float*)LDP_(25); const float* b_ple = (const float*)LDP_(26); const float* w_ple_proj = (const float*)LDP_(27); const float* g_final = (const float*)LDP_(28); \
    bf16* WIN_T = (bf16*)(ws + WS_WIN); bf16* WOUT_T = (bf16*)(ws + WS_WOUT); bf16* WPG_T = (bf16*)(ws + WS_WPG); bf16* WPP_T = (bf16*)(ws + WS_WPP); bf16* WGU_T = (bf16*)(ws + WS_WGU); bf16* WD_T = (bf16*)(ws + WS_WD); bf16* XN = (bf16*)(ws + WS_XN); bf16* PROJB = (bf16*)(ws + WS_PROJB); bf16* W1KT = (bf16*)(ws + WS_CMPW); bf16* W1VT = W1KT + 128 * 2048; bf16* W2KT = W1VT + 128 * 2048; bf16* W2VT = W2KT + 64 * 128; bf16* KCB = (bf16*)(ws + WS_KC); bf16* VCB = (bf16*)(ws + WS_VC); bf16* PB = (bf16*)(ws + WS_PB); bf16* PPB = XN; bf16* VPLE = (bf16*)(ws + WS_USORT); float* ROPE = (float*)(ws + WS_ROPE); float* GATES = (float*)(ws + WS_GATES); float* LOGF = (float*)(ws + WS_LOGF); unsigned short* OMIX = (unsigned short*)out; float* HB = out;   float* CUM2 = (float*)(ws + WS_CUM); float* RA = (float*)(ws + WS_RA); float* RSS = (float*)(ws + WS_RA + 512 * 1024); bf16* H1B = (bf16*)out;   int* EIDB = (int*)(ws + WS_EID); float* CWB = (float*)(ws + WS_CW); float* RSTD2 = (float*)(ws + WS_RS3); int* LC = (int*)(ws + WS_TAB); int* TILE_E = LC + 1024 * 16; int* NTILES = TILE_E + 1024; int* POS = (int*)(ws + WS_POS); int* ROWIDX = (int*)(ws + WS_ROWIDX); bf16* USORT = (bf16*)(ws + WS_USORT); bf16* HIDB = (bf16*)(ws + WS_HIDB); bf16* YB = (bf16*)(ws + WS_YB); \
    const int chunk = (T_ + NG - 1) / NG, tok0 = (int)blockIdx.x * chunk, ntok = (tok0 + chunk <= T_) ? chunk : (T_ > tok0 ? T_ - tok0 : 0); (void)chunk; (void)tok0; (void)ntok;
__global__ void __launch_bounds__(NTHREADS, 2) mk_fwd(Args args) {
    using namespace nv;
    extern __shared__ __attribute__((aligned(16))) unsigned char lds[];
    LAS unsigned char* ldsp = (LAS unsigned char*)lds;
    volatile LAS unsigned* MISC = (volatile LAS unsigned*)(ldsp + MISC_OFF);
    for (int u = threadIdx.x; u < (LDS_BYTES - LDSCTL_OFF) / 4; u += NTHREADS) ((LAS unsigned*)(ldsp + LDSCTL_OFF))[u] = 0u;
    __syncthreads();
    char* const ws0_ = (char*)args.ws; float* const out0_ = (float*)args.out;
    { LAS unsigned long long* LP_ = (LAS unsigned long long*)(ldsp + LDSCTL_OFF + 512); if (threadIdx.x < 29) LP_[threadIdx.x] = (unsigned long long)(uintptr_t)args.in[threadIdx.x]; }
    __syncthreads();
    XcdBarrier bar = xcd_barrier_post((unsigned*)(ws0_ + WS_CTL) + CW_BAR, MISC + 8);
    const int wave = __builtin_amdgcn_readfirstlane((int)threadIdx.x >> 6);
#define PHASE_IDS() int tid = threadIdx.x; asm volatile("" : "+v"(tid)); const int lane = tid & 63; (void)lane
    const int NG = gridDim.x; const int vcu = (NG % 8 == 0) ? ((int)blockIdx.x % 8) * (NG / 8) + (int)blockIdx.x / 8 : (int)blockIdx.x;
    {   PHASE_PTRS();
    REP(0)
    {
        PHASE_IDS();
        LAS float* scr = (LAS float*)(ldsp + RING_OFF + wave * 16384);
        const int gw = vcu * NWAVES + wave, NGW = NG * NWAVES;
        constexpr int I_IN_A = 16 * 40, I_IN_B = 16 * 48, I_IN_C = 16 * 1, I_SQ = 16 * 32, I_PP = 4 * 32, I_EG = 16 * 16, I_ED = 8 * 32;
        constexpr int I_C1 = 32 * 4, I_C2 = 2 * 2;
        constexpr int NITEMS = I_IN_A + I_IN_B + I_IN_C + 2 * I_SQ + I_PP + 2 * (I_C1 + I_C2) + 16 * (2 * I_EG + I_ED);
        for (int it = gw; it < NITEMS; it += NGW) {
            int r = it;
            if (r < I_IN_A) { p0_transpose_item<3>(w_in, IN_COLS, 0, 1024, 40, WIN_T, 0, scr, r, lane); continue; } r -= I_IN_A;
            if (r < I_IN_B) { p0_transpose_item<3>(w_in, IN_COLS, OFF_QB, 1024, 48, WIN_T, 1280, scr, r, lane); continue; } r -= I_IN_B;
            if (r < I_IN_C) { p0_transpose_item<2>(w_in, IN_COLS, OFF_GATE, 1024, 1, WIN_T, 2816, scr, r, lane); continue; } r -= I_IN_C;
            if (r < I_SQ) { p0_transpose_item<0>(w_out, 1024, 0, 1024, 32, WOUT_T, 0, scr, r, lane); continue; } r -= I_SQ;
            if (r < I_SQ) { p0_transpose_item<0, true>(w_ple_gate, 1024, 0, 1024, 32, WPG_T, 0, scr, r, lane, g_ple); continue; }     r -= I_SQ;
            if (r < I_PP) { p0_transpose_item<0>(w_ple_proj, 1024, 0, 256, 32, WPP_T, 0, scr, r, lane); continue; } r -= I_PP;
            if (r < I_C1) { p0_transpose_item<0>(w_k1, 128, 0, 2048, 4, W1KT, 0, scr, r, lane); continue; } r -= I_C1;
            if (r < I_C1) { p0_transpose_item<0>(w_v1, 128, 0, 2048, 4, W1VT, 0, scr, r, lane); continue; } r -= I_C1;
            if (r < I_C2) { p0_transpose_item<0>(w_k2, 64, 0, 128, 2, W2KT, 0, scr, r, lane); continue; } r -= I_C2;
            if (r < I_C2) { p0_transpose_item<0>(w_v2, 64, 0, 128, 2, W2VT, 0, scr, r, lane); continue; } r -= I_C2;
            const int e = r / (2 * I_EG + I_ED); r -= e * (2 * I_EG + I_ED);
            if (r < I_EG) { p0_transpose_item<1, true>(w_gate_e + (size_t)e * 1024 * 512, 512, 0, 1024, 16, WGU_T + (size_t)e * 1024 * 1024, 0, scr, r, lane, g_ffn); continue; } r -= I_EG;
            if (r < I_EG) { p0_transpose_item<1, true>(w_up_e + (size_t)e * 1024 * 512, 512, 0, 1024, 16, WGU_T + (size_t)e * 1024 * 1024, 4, scr, r, lane, g_ffn);     continue; } r -= I_EG;
            p0_transpose_item<0>(w_down_e + (size_t)e * 512 * 1024, 1024, 0, 512, 32, WD_T + (size_t)e * 1024 * 512, 0, scr, r, lane);
        }
        for (int i = (int)blockIdx.x * NTHREADS + tid; i < T_ * 8; i += NG * NTHREADS) { const int tok = i >> 3, j = i & 7;
            const float inv = powf(500000.0f, -(float)j / 8.0f); const float ang = (float)positions[tok] * inv; const float cv = cosf(ang), sv = sinf(ang); ROPE[(size_t)i * 2] = cv; ROPE[(size_t)i * 2 + 1] = sv;
            typedef _Float16 h2_t __attribute__((ext_vector_type(2))); const h2_t hv = {(_Float16)cv, (_Float16)sv}; ((unsigned*)(ws + WS_ROPEH))[i] = __builtin_bit_cast(unsigned, hv); }
        for (int m = gw; m < T_; m += 2 * NGW) {
            const bool hasB = m + NGW < T_; const int mB = hasB ? m + NGW : m;
            const GAS f32x4* xa = (const GAS f32x4*)(in_x + (size_t)m * DM) + lane; const GAS f32x4* xb = (const GAS f32x4*)(in_x + (size_t)mB * DM) + lane;
            f32x4 va[4], vb[4]; float sa = 0.f, sb = 0.f;
#pragma unroll
            for (int j = 0; j < 4; ++j) { va[j] = xa[64 * j]; vb[j] = xb[64 * j]; }
            const f32x4 pa = ((const GAS f32x4*)(in_p + (size_t)m * 256))[lane], pb = ((const GAS f32x4*)(in_p + (size_t)mB * 256))[lane];
#pragma unroll
            for (int j = 0; j < 4; ++j) { sa += (va[j].x * va[j].x + va[j].y * va[j].y) + (va[j].z * va[j].z + va[j].w * va[j].w); sb += (vb[j].x * vb[j].x + vb[j].y * vb[j].y) + (vb[j].z * vb[j].z + vb[j].w * vb[j].w); }
            const float ra = 1.f / sqrtf(wave_sum(sa) * (1.f / 1024.f) + 1e-6f), rb = 1.f / sqrtf(wave_sum(sb) * (1.f / 1024.f) + 1e-6f);
            GAS unsigned long long* oa = (GAS unsigned long long*)(XN + (size_t)m * DM) + lane; GAS unsigned long long* ob = (GAS unsigned long long*)(XN + (size_t)mB * DM) + lane;
#pragma unroll
            for (int j = 0; j < 4; ++j) { const f32x4 g = ((const GAS f32x4*)g_mix)[lane + 64 * j];
                oa[64 * j] = (unsigned long long)pk2(va[j].x * ra * g.x, va[j].y * ra * g.y) | ((unsigned long long)pk2(va[j].z * ra * g.z, va[j].w * ra * g.w) << 32);
                if (hasB) ob[64 * j] = (unsigned long long)pk2(vb[j].x * rb * g.x, vb[j].y * rb * g.y) | ((unsigned long long)pk2(vb[j].z * rb * g.z, vb[j].w * rb * g.w) << 32); }
            ((GAS unsigned long long*)(PB + (size_t)m * 256))[lane] = (unsigned long long)pk2(pa.x, pa.y) | ((unsigned long long)pk2(pa.z, pa.w) << 32);
            if (hasB) ((GAS unsigned long long*)(PB + (size_t)mB * 256))[lane] = (unsigned long long)pk2(pb.x, pb.y) | ((unsigned long long)pk2(pb.z, pb.w) << 32); }
    }
    }
    xcd_barrier(bar); if (PROBE_DUP == 60) xcd_barrier(bar);
    {   PHASE_PTRS();

    REP(1)
    {
        pg8::Gemm g{XN, WIN_T, T_, NIN, DM, 0}; pg8::StaticOrder S; S.init(T_, NIN, NG, (int)blockIdx.x);
        pg8::EpiInProj E{PROJB, ROPE, GATES, LOGF, b_gate, b_forget, (float*)(ws + WS_NRM), 0};
        if (PROBE_DUP >= 64 && PROBE_DUP <= 66) { pg8::EpiInProj E2 = E; E2.dbg = PROBE_DUP - 63; pg8::gemm_phase<pg8::EpiInProj, pg8::StaticOrder, false, true>(ldsp + RING_OFF, g, S, E2); }
        if (PROBE_DUP == 63) { pg8::EpiBf16Plain EP{PROJB, at::PITCH}; pg8::Gemm g2{XN, WIN_T, T_, 2816, DM, 0}; pg8::StaticOrder S2; S2.init(T_, 2816, NG, (int)blockIdx.x); pg8::gemm_phase<pg8::EpiBf16Plain, pg8::StaticOrder, false, true>(ldsp + RING_OFF, g2, S2, EP); }
        pg8::gemm_phase<pg8::EpiInProj, pg8::StaticOrder, false, true>(ldsp + RING_OFF, g, S, E);
        if (PROBE_DUP == 61) { pg8::EpiNull EN; pg8::gemm_phase<pg8::EpiNull, pg8::StaticOrder, true, true>(ldsp + RING_OFF, g, S, EN); }
    }
    }
    xcd_barrier(bar); if (PROBE_DUP == 60) xcd_barrier(bar);
    {   PHASE_PTRS();

    REP(3)
    { char* shm = (char*)lds + RING_OFF; constexpr int NT8 = (NCMP + 31) / 32; const int nunits = 2 * B_ * 2 * NT8;
      for (int uid = (int)blockIdx.x; uid < nunits; uid += NG) { const int nt = uid % NT8, g = (uid / NT8) & 1, b = (uid / (2 * NT8)) % B_, which = uid / (2 * NT8 * B_);
          at::compress_unit(PROJB + (size_t)b * S_ * at::PITCH + (which ? 640 : 512) + g * 64, 32 * nt, NCMP, which ? pe_v : pe_k, which ? W1VT : W1KT, which ? W2VT : W2KT,
                            which ? (const float*)nullptr : ROPE + (size_t)b * S_ * 16, (which ? VCB : KCB) + (size_t)b * 256 * 128 + g * 64, shm); }
      PHASE_IDS(); const int gw = vcu * NWAVES + wave, NGW = NG * NWAVES; constexpr int PER = S_ / 64; constexpr int NCH = S_ / 64;
      for (int task = gw; task < B_ * 8; task += NGW) {
          if (task < B_ * 8) { const int bh = task, b = bh >> 3, h = bh & 7; const float* lf = LOGF + ((size_t)b * S_ + (size_t)PER * lane) * 8 + h;
              float vals[PER]; float s = 0.f;
#pragma unroll
              for (int j = 0; j < PER; ++j) { vals[j] = lf[j * 8]; s += vals[j]; }
              float incl = s;
#pragma unroll
              for (int o = 1; o < 64; o <<= 1) { const float v = __builtin_bit_cast(float, __builtin_amdgcn_ds_bpermute((lane - o) << 2, __builtin_bit_cast(int, incl))); if (lane >= o) incl += v; }
              float run = incl - s; float* cp = CUM2 + (size_t)bh * S_ + PER * lane;
#pragma unroll
              for (int j = 0; j < PER; ++j) { run += vals[j]; cp[j] = run * 1.4426950408889634f; }
          } } }
    }
    xcd_barrier(bar); if (PROBE_DUP == 60) xcd_barrier(bar);
    {   PHASE_PTRS();
    REP(4)
    { PHASE_IDS(); const int r32 = lane & 31, hi = lane >> 5;
      char* shm = (char*)lds + RING_OFF;
      const int nunits = B_ * 2 * NBLK;
      for (int it = 0;; ++it) {
          int bg, c;
          if (NG == 256 && S_ == 4096 && B_ == 8) { if (it >= 4) break; const int s = vcu & 15; bg = vcu >> 4; c = it == 0 ? s : it == 1 ? 31 - s : it == 2 ? 32 + s : 63 - s; }
          else { const int uid = it * NG + (int)blockIdx.x; if (uid >= nunits) break; bg = uid / NBLK; c = uid % NBLK; }
          const int b = bg >> 1, g = bg & 1, h = g * 4 + (wave >> 1), tq0 = c * 64 + 32 * (wave & 1);
          const size_t tokb = (size_t)b * S_ + tq0;
          at::UnitIO U; U.Qw = PROJB + tokb * at::PITCH + h * 64; U.t_hi = c; U.t_first = c; U.qpos = tq0 + r32;
          unsigned short* ob = OMIX + tokb * DM + h * 64; const float* gp = GATES + tokb * 24 + h * 3;
          at::f32x16 o[2], osum; float l; float rli[16];
          bool fast_sel, fast_win;
          { const float* hmt = (const float*)(ws + WS_NRM) + ((size_t)b * (S_ / 256) * 2 + (lane & 31)) * 28; float q2 = 0.f;
#pragma unroll
            for (int hh = 0; hh < 4; ++hh) q2 = fmaxf(q2, lx::max64(hmt[g * 4 + hh]));
            const float qmax = sqrtf(q2), ksm = sqrtf(lx::max64(hmt[8 + g])), kwm = sqrtf(lx::max64(hmt[10 + g]));
            fast_sel = __builtin_amdgcn_readfirstlane((int)(qmax * ksm <= 60.0f)) != 0; fast_win = __builtin_amdgcn_readfirstlane((int)(qmax * kwm <= 60.0f)) != 0; }
          for (int pr_ = 0; pr_ < (PROBE_DUP == 22 ? 2 : 1); ++pr_)
          at::cmp_stage(U.Qw, KCB + (size_t)b * 256 * 128 + g * 64, VCB + (size_t)b * 256 * 128 + g * 64, c, nv::NSEL, shm, o);
          float* accw = (float*)(shm + at::CMP_IMP) + wave * 2048; static_assert(at::CMP_SELM + 512 <= LDSCTL_OFF, "NSA LDS map"); at::fold_rows<true, false>(accw, o, nullptr, gp, 24);
          U.Kh = PROJB + (size_t)b * S_ * at::PITCH + 768 + g * 64; U.Vh = PROJB + (size_t)b * S_ * at::PITCH + 896 + g * 64; U.t_lo = 0; U.win = 0;
          U.selm = ((const unsigned long long*)(shm + at::CMP_SELM))[32 * (wave & 1) + r32];
          if (PROBE_DUP >= 41 && PROBE_DUP <= 43) { at::f32x16 o_[2], os_; float l_; at::attn_tiles<at::M_SEL, true, PROBE_DUP - 40>(U, shm, o_, l_, os_); asm volatile("" :: "v"(o_[0]), "v"(o_[1]), "v"(os_)); }
          for (int pr_ = 0; pr_ < (PROBE_DUP == 20 ? 2 : 1); ++pr_)
          if (fast_sel) { at::attn_tiles<at::M_SEL, true>(U, shm, o, l, osum);
#pragma unroll
              for (int r = 0; r < 16; ++r) rli[r] = 1.0f / osum[r]; }
          else { at::attn_tiles<at::M_SEL, false>(U, shm, o, l, osum); at::row_inv(l, shm, rli); }
          at::fold_rows<false, false>(accw, o, rli, gp + 1, 24);
          U.Kh = PROJB + (size_t)b * S_ * at::PITCH + 1024 + g * 64; U.Vh = PROJB + (size_t)b * S_ * at::PITCH + 1152 + g * 64; U.t_lo = c > (nv::WIN / 64) ? c - (nv::WIN / 64) : 0; U.win = nv::WIN; U.selm = 0ull;
          for (int pr_ = 0; pr_ < (PROBE_DUP == 21 ? 2 : 1); ++pr_)
          if (fast_win) { at::attn_tiles<at::M_WIN, true>(U, shm, o, l, osum);
#pragma unroll
              for (int r = 0; r < 16; ++r) rli[r] = 1.0f / osum[r]; }
          else { at::attn_tiles<at::M_WIN, false>(U, shm, o, l, osum); at::row_inv(l, shm, rli); }
          at::fold_rows<false, true>(accw, o, rli, gp + 2, 24);
          at::store_rows<false>(o, nullptr, ob, DM, nullptr, 0);
      } }
    REP(5)
    { PHASE_IDS(); const int r32 = lane & 31;
      char* shm = (char*)lds + RING_OFF; (void)r32;
      const int nunits = B_ * 8 * (S_ / 256); gu32* qctr = (gu32*)(ws + WS_CTL) + CW_FOXQ + 64 * rep_;
      for (;;) {
          if (tid == 0) MISC[4] = __hip_atomic_fetch_add(qctr, 1u, RLX_AGENT);
          __syncthreads();
          const int uid = __builtin_amdgcn_readfirstlane((int)MISC[4]);
          __syncthreads();
          if (uid >= nunits) break;
          const int qb = (S_ / 256 - 1) - uid / (B_ * 8), bh = uid % (B_ * 8);
          const int b = bh >> 3, h = bh & 7, q0 = qb * 256;
          int t_lo; float sbnd;
          bool fast;
          { const float* c2 = CUM2 + (size_t)bh * S_; const float* hmb = (const float*)(ws + WS_NRM) + (size_t)b * (S_ / 256) * 2 * 28;
            const float qn = sqrtf(fmaxf(hmb[(qb * 2) * 28 + 12 + h], hmb[(qb * 2 + 1) * 28 + 12 + h]));
            const float knu = sqrtf(fmaxf(hmb[(qb * 2) * 28 + 20 + h], hmb[(qb * 2 + 1) * 28 + 20 + h]));
            const float knt = sqrtf(hmb[(lane >> 1) * 28 + 20 + h]);
            const bool skip = (lane < 4 * qb) && (qn * (knt + knu) + (c2[q0] - c2[64 * lane + 63]) < -30.0f);
            const unsigned long long sk = __ballot(skip); t_lo = sk == ~0ull ? 64 : __builtin_ctzll(~sk); if (t_lo > 4 * qb) t_lo = 4 * qb; t_lo = __builtin_amdgcn_readfirstlane(t_lo);
            const float kmax = sqrtf(lx::max64(hmb[(lane & 31) * 28 + 20 + h]));
            fast = __builtin_amdgcn_readfirstlane((int)(qn * kmax <= 60.0f)) != 0; sbnd = qn * kmax; }
          { LAS float* ck = (LAS float*)(ldsp + RING_OFF + at::LDS_CK); const float* src = CUM2 + (size_t)bh * S_; const int nk = q0 + 256;
            for (int k = 64 * t_lo + tid; k < nk; k += NTHREADS) ck[k] = src[k]; }
          __syncthreads();
          at::UnitIO U; U.Qw = PROJB + ((size_t)b * S_ + q0 + 32 * wave) * at::PITCH + 1280 + h * 64; U.Kh = PROJB + (size_t)b * S_ * at::PITCH + 1792 + h * 64; U.Vh = PROJB + (size_t)b * S_ * at::PITCH + 2304 + h * 64;
          U.t_hi = 4 * qb + 3; U.t_lo = t_lo; U.t_first = 4 * qb + (wave >> 1); U.qpos = q0 + 32 * wave + r32; U.selm = 0ull; U.win = 0; U.cq = CUM2[(size_t)bh * S_ + U.qpos]; U.sbound = sbnd; U.c2q0 = CUM2[(size_t)bh * S_ + q0];
          at::f32x16 o[2], osum; float l; float rli[16];
          if (fast) { at::attn_tiles<at::M_FOX, true>(U, shm, o, l, osum);
#pragma unroll
              for (int r = 0; r < 16; ++r) rli[r] = 1.0f / osum[r]; }
          else { at::attn_tiles<at::M_FOX, false>(U, shm, o, l, osum); at::row_inv(l, shm, rli); }
          at::store_rows<false>(o, rli, OMIX + ((size_t)b * S_ + q0 + 32 * wave) * DM + 512 + h * 64, DM, nullptr, 0);
      } }
    }
    xcd_barrier(bar); if (PROBE_DUP == 60) xcd_barrier(bar);
    {   PHASE_PTRS();
    REP(6)
    { PHASE_IDS(); const int gw = vcu * NWAVES + wave, NGW = NG * NWAVES;
      for (int m = gw; m < T_; m += NGW) {
          typedef unsigned u32x2m __attribute__((ext_vector_type(2))); const GAS u32x2m* xr = (const GAS u32x2m*)(OMIX + (size_t)m * DM) + lane; f32x4 v[4]; float s0 = 0.f, s1 = 0.f;
#pragma unroll
          for (int j = 0; j < 4; ++j) { const u32x2m w = xr[64 * j]; v[j] = (f32x4){__builtin_bit_cast(float, w.x << 16), __builtin_bit_cast(float, w.x & 0xffff0000u), __builtin_bit_cast(float, w.y << 16), __builtin_bit_cast(float, w.y & 0xffff0000u)};
              const float q = (v[j].x * v[j].x + v[j].y * v[j].y) + (v[j].z * v[j].z + v[j].w * v[j].w); if (j < 2) s0 += q; else s1 += q; }
          const float r0 = 1.f / sqrtf(wave_sum(s0) * (1.f / 512.f) + 1e-6f), r1 = 1.f / sqrtf(wave_sum(s1) * (1.f / 512.f) + 1e-6f);
          GAS unsigned long long* o8 = (GAS unsigned long long*)(XN + (size_t)m * DM) + lane;
#pragma unroll
          for (int j = 0; j < 4; ++j) { const f32x4 g = j < 2 ? ((const GAS f32x4*)beta_nsa)[lane + 64 * j] : ((const GAS f32x4*)beta_fox)[lane + 64 * (j - 2)]; const float r = j < 2 ? r0 : r1;
              o8[64 * j] = (unsigned long long)pk2(v[j].x * r * g.x, v[j].y * r * g.y) | ((unsigned long long)pk2(v[j].z * r * g.z, v[j].w * r * g.w) << 32); }
      } }
    }
    xcd_barrier(bar); if (PROBE_DUP == 60) xcd_barrier(bar);
    {   PHASE_PTRS();
    REP(7)
    { pg8::Gemm g{XN, WOUT_T, T_, DM, DM, 0}; pg8::StaticOrder S; S.init(T_, DM, NG, (int)blockIdx.x);
      pg8::EpiResBf16 E{in_x, H1B, DM};
      pg8::gemm_phase<pg8::EpiResBf16, pg8::StaticOrder, true, true>(ldsp + RING_OFF, g, S, E); }
    }
    xcd_barrier(bar); if (PROBE_DUP == 60) xcd_barrier(bar);
    {   PHASE_PTRS();
    REP(8)
    { PHASE_IDS();
      LAS float* WR = (LAS float*)(ldsp + RING_OFF); LAS int* LCNT = (LAS int*)(ldsp + RING_OFF + 81920); LAS float* RS = (LAS float*)(ldsp + RING_OFF + 81920 + 64) + wave * (16 * 24);
#pragma unroll
      for (int kk = 0; kk < 1024 / NTHREADS; ++kk) { const int k = tid + kk * NTHREADS; const float gk = g_ffn[k];
          const f32x4 wg4 = *(const GAS f32x4*)(w_group + k * 4); const GAS f32x4* wr4 = (const GAS f32x4*)(w_router + k * 16); const f32x4 r0 = wr4[0], r1 = wr4[1], r2 = wr4[2], r3 = wr4[3];
          LAS f32x4* dst = (LAS f32x4*)(WR + ((((k >> 8) * 4 + (k & 3)) * 64) + ((k >> 2) & 63)) * 20);   dst[0] = wg4 * gk; dst[1] = r0 * gk; dst[2] = r1 * gk; dst[3] = r2 * gk; dst[4] = r3 * gk; }
      if (tid < 16) LCNT[tid] = 0;
      __syncthreads();
      for (int pa_ = 0; pa_ < (PROBE_DUP == 50 ? 2 : 1); ++pa_)
      {
      typedef unsigned u32x2r __attribute__((ext_vector_type(2)));
      u32x2r na[4], nb[4];
      { const int tA = tok0 + (wave < ntok ? wave : 0), tB = (wave + NWAVES < ntok) ? tA + NWAVES : tA;
        const GAS u32x2r* xa = (const GAS u32x2r*)(H1B + (size_t)tA * DM) + lane; const GAS u32x2r* xb = (const GAS u32x2r*)(H1B + (size_t)tB * DM) + lane;
#pragma unroll
        for (int j = 0; j < 4; ++j) { na[j] = xa[64 * j]; nb[j] = xb[64 * j]; } }
      for (int tt = wave; tt < ntok; tt += 2 * NWAVES) { const int tokA = tok0 + tt; const bool hasB = tt + NWAVES < ntok; const int tokB = hasB ? tokA + NWAVES : tokA;
          f32x4 ha[4], hb[4];
#pragma unroll
          for (int j = 0; j < 4; ++j) { ha[j] = (f32x4){__builtin_bit_cast(float, na[j].x << 16), __builtin_bit_cast(float, na[j].x & 0xffff0000u), __builtin_bit_cast(float, na[j].y << 16), __builtin_bit_cast(float, na[j].y & 0xffff0000u)};
              hb[j] = (f32x4){__builtin_bit_cast(float, nb[j].x << 16), __builtin_bit_cast(float, nb[j].x & 0xffff0000u), __builtin_bit_cast(float, nb[j].y << 16), __builtin_bit_cast(float, nb[j].y & 0xffff0000u)}; }
          if (tt + 2 * NWAVES < ntok) { const int tA = tokA + 2 * NWAVES, tB = (tt + 3 * NWAVES < ntok) ? tA + NWAVES : tA;
              const GAS u32x2r* xa = (const GAS u32x2r*)(H1B + (size_t)tA * DM) + lane; const GAS u32x2r* xb = (const GAS u32x2r*)(H1B + (size_t)tB * DM) + lane;
#pragma unroll
              for (int j = 0; j < 4; ++j) { na[j] = xa[64 * j]; nb[j] = xb[64 * j]; } }
          float va[32], vb[32];
#pragma unroll
          for (int c = 0; c < 32; ++c) { va[c] = 0.f; vb[c] = 0.f; }
#pragma unroll
          for (int m = 0; m < 16; ++m) { const float a_ = ha[m >> 2][m & 3], b_ = hb[m >> 2][m & 3]; va[20] += a_ * a_; vb[20] += b_ * b_; const LAS f32x4* wp = (const LAS f32x4*)(WR + (64 * m + lane) * 20);
#pragma unroll
              for (int q = 0; q < 5; ++q) { const f32x4 w = wp[q];
                  va[4 * q] += a_ * w[0]; va[4 * q + 1] += a_ * w[1]; va[4 * q + 2] += a_ * w[2]; va[4 * q + 3] += a_ * w[3];
                  vb[4 * q] += b_ * w[0]; vb[4 * q + 1] += b_ * w[1]; vb[4 * q + 2] += b_ * w[2]; vb[4 * q + 3] += b_ * w[3]; } }
#define RT_BFLY(v) do { \
          _Pragma("unroll") for (int c = 0; c < 16; ++c) { const bool hi = lane & 32; const float keep = hi ? v[c + 16] : v[c], send = hi ? v[c] : v[c + 16]; v[c] = keep + lx::x32f(send, hi); } \
          _Pragma("unroll") for (int c = 0; c < 8; ++c) { const bool hi = lane & 16; const float keep = hi ? v[c + 8] : v[c], send = hi ? v[c] : v[c + 8]; v[c] = keep + lx::xf<16>(send); } \
          _Pragma("unroll") for (int c = 0; c < 4; ++c) { const bool hi = lane & 8; const float keep = hi ? v[c + 4] : v[c], send = hi ? v[c] : v[c + 4]; v[c] = keep + lx::xf<8>(send); } \
          _Pragma("unroll") for (int c = 0; c < 2; ++c) { const bool hi = lane & 4; const float keep = hi ? v[c + 2] : v[c], send = hi ? v[c] : v[c + 2]; v[c] = keep + lx::xf<4>(send); } \
          { const bool hi = lane & 2; const float keep = hi ? v[1] : v[0], send = hi ? v[0] : v[1]; v[0] = keep + lx::xf<2>(send); } \
          v[0] += lx::xf<1>(v[0]); } while (0)
          RT_BFLY(va); RT_BFLY(vb);
#undef RT_BFLY
          if (!(lane & 1) && (lane >> 1) < 21) { RS[(tt >> 3) * 24 + (lane >> 1)] = va[0]; if (hasB) RS[((tt >> 3) + 1) * 24 + (lane >> 1)] = vb[0]; }
      }
      }
      asm volatile("s_waitcnt lgkmcnt(0)" ::: "memory");
      { const int tt = wave + NWAVES * lane; const bool have = lane < 16 && tt < ntok; const int tok = tok0 + (have ? tt : 0);
          float s[21];
#pragma unroll
          for (int c = 0; c < 21; ++c) s[c] = RS[(lane & 15) * 24 + c];
          const float rstd = 1.0f / sqrtf(s[20] * (1.f / 1024.f) + 1e-6f);
          float gl[4], el[16];
#pragma unroll
          for (int c = 0; c < 4; ++c) gl[c] = s[c] * rstd + b_group[c];
#pragma unroll
          for (int e = 0; e < 16; ++e) el[e] = s[4 + e] * rstd + b_router[e];
          int gs = 0; float gm = gl[0];
#pragma unroll
          for (int c = 1; c < 4; ++c) if (gl[c] > gm) { gm = gl[c]; gs = c; }
          float gsum = 0.f;
#pragma unroll
          for (int c = 0; c < 4; ++c) gsum += expf(gl[c] - gm);
          const float gprob = 1.0f / gsum;
          float il[4] = {0.f, 0.f, 0.f, 0.f};
#pragma unroll
          for (int c = 0; c < 4; ++c)
#pragma unroll
              for (int e = 0; e < 4; ++e) if (gs == c) il[e] = el[c * 4 + e];
          float im = fmaxf(fmaxf(il[0], il[1]), fmaxf(il[2], il[3])); float ipr[4], isum = 0.f;
#pragma unroll
          for (int e = 0; e < 4; ++e) { ipr[e] = expf(il[e] - im); isum += ipr[e]; }
#pragma unroll
          for (int e = 0; e < 4; ++e) ipr[e] /= isum;
          int i0 = 0; float v0 = ipr[0];
#pragma unroll
          for (int e = 1; e < 4; ++e) if (ipr[e] > v0) { v0 = ipr[e]; i0 = e; }
          int i1 = -1; float v1 = -1.f;
#pragma unroll
          for (int e = 0; e < 4; ++e) if (e != i0 && ipr[e] > v1) { v1 = ipr[e]; i1 = e; }
          const float den = v0 + v1;
          if (have) { const int e0 = gs * 4 + i0, e1 = gs * 4 + i1; EIDB[tok * 2] = e0; EIDB[tok * 2 + 1] = e1; CWB[tok * 2] = gprob * (v0 / den); CWB[tok * 2 + 1] = gprob * (v1 / den); RSTD2[tok] = rstd;
              atomicAdd((int*)&LCNT[e0], 1); atomicAdd((int*)&LCNT[e1], 1); }
      }
      __syncthreads();
      if (tid < 16) LC[(int)blockIdx.x * 16 + tid] = LCNT[tid];
    }
    }
    xcd_barrier(bar); if (PROBE_DUP == 60) xcd_barrier(bar);
    {   PHASE_PTRS();
    REP(9)
    { PHASE_IDS();
      LAS int* L = (LAS int*)(ldsp + RING_OFF); LAS int* TOT = L + 1024 * 16; LAS int* MINE = TOT + 16; LAS int* BASE = MINE + 16; LAS int* ME = BASE + 32; LAS int* MPOS = ME + 2 * 512;
      for (int i = tid; i < NG * 16; i += NTHREADS) L[i] = LC[i];
      for (int i = tid; i < 2 * ntok; i += NTHREADS) ME[i] = EIDB[tok0 * 2 + i];
      __syncthreads();
      for (int e = wave; e < 16; e += NWAVES) {
          int tot = 0, mine = 0; for (int w = lane; w < NG; w += 64) { const int c = L[w * 16 + e]; tot += c; if (w < (int)blockIdx.x) mine += c; }
          tot = (int)lx::sum64((float)tot); mine = (int)lx::sum64((float)mine);
          if (lane == 0) { TOT[e] = tot; MINE[e] = mine; } }
      __syncthreads();
      if (tid == 0) { int base = 0; for (int e = 0; e < 16; ++e) { BASE[e] = base; base += (TOT[e] + 255) / 256 * 256; } BASE[16] = base; }
      __syncthreads();
      if (blockIdx.x == 0) { const int nt = BASE[16] / 256; for (int pm = tid; pm < nt; pm += NTHREADS) { int e = 0; for (int q = 1; q < 16; ++q) if (BASE[q] <= pm * 256) e = q; TILE_E[pm] = e; } if (tid == 0) NTILES[0] = nt; }
      for (int e = wave; e < 16; e += NWAVES) { int pos = BASE[e] + MINE[e];
          for (int i0 = 0; i0 < 2 * ntok; i0 += 64) { const int i = i0 + lane; const bool mine_ = i < 2 * ntok && ME[i] == e; const unsigned long long bm = __ballot(mine_);
              if (mine_) MPOS[i] = pos + __builtin_popcountll(bm & ((1ull << lane) - 1ull)); pos += __builtin_popcountll(bm); } }
      __syncthreads();
      for (int i = tid; i < 2 * ntok; i += NTHREADS) { POS[tok0 * 2 + i] = MPOS[i]; ROWIDX[MPOS[i]] = tok0 + (i >> 1); RSS[MPOS[i]] = RSTD2[tok0 + (i >> 1)]; }
      if (blockIdx.x == 0) for (int e = wave; e < 16; e += NWAVES) for (int s = BASE[e] + TOT[e] + lane; s < BASE[e + 1]; s += 64) { ROWIDX[s] = 0; RSS[s] = 0.f; }
    }
    }
    xcd_barrier(bar); if (PROBE_DUP == 60) xcd_barrier(bar);
    {   PHASE_PTRS();
    REP(10)
    { const int NT = __builtin_amdgcn_readfirstlane(__hip_atomic_load(NTILES, __ATOMIC_RELAXED, __HIP_MEMORY_SCOPE_AGENT));
      pg8::Gemm g{H1B, WGU_T, NT * 256, DM, DM, (size_t)1024 * 1024 * 2, ROWIDX}; pg8::GroupOrder S; S.init(NT, 4, NG, (int)blockIdx.x, TILE_E);
      pg8::EpiSwiGlu E{HIDB, RSS};
      pg8::gemm_phase<pg8::EpiSwiGlu, pg8::GroupOrder, true, true, true>(ldsp + RING_OFF, g, S, E); }
    }
    xcd_barrier(bar); if (PROBE_DUP == 60) xcd_barrier(bar);
    {   PHASE_PTRS();
    REP(11)
    { const int NT = __builtin_amdgcn_readfirstlane(__hip_atomic_load(NTILES, __ATOMIC_RELAXED, __HIP_MEMORY_SCOPE_AGENT));
      pg8::Gemm g{HIDB, WD_T, NT * 256, DM, 512, (size_t)1024 * 512 * 2}; pg8::GroupOrder S; S.init(NT, 4, NG, (int)blockIdx.x, TILE_E);
      pg8::EpiBf16Plain E{YB, DM};
      pg8::gemm_phase<pg8::EpiBf16Plain, pg8::GroupOrder, true, true>(ldsp + RING_OFF, g, S, E); }
    REP(13)
    { pg8::Gemm g{PB, WPP_T, T_, DM, 256, 0}; pg8::StaticOrder S; S.init(T_, DM, NG, (int)blockIdx.x);
      pg8::EpiBf16Plain E{PPB, DM};
      pg8::gemm_phase<pg8::EpiBf16Plain, pg8::StaticOrder, true, true>(ldsp + RING_OFF, g, S, E); }
    }
    xcd_barrier(bar); if (PROBE_DUP == 60) xcd_barrier(bar);
    {   PHASE_PTRS();
    for (int rep_ = 0; rep_ < (PROBE_DUP == 12 ? 2 : 1); ++rep_)
    { PHASE_IDS(); const int gw = vcu * NWAVES + wave, NGW = NG * NWAVES; const float wsc = rep_ ? 0.f : 1.f;
      typedef unsigned u32x2v __attribute__((ext_vector_type(2))); typedef int i32x2v __attribute__((ext_vector_type(2))); typedef float f32x2v __attribute__((ext_vector_type(2)));
      i32x2v npA, npB; f32x2v nwA, nwB;
      { const int mA = gw < T_ ? gw : 0, mB = gw + NGW < T_ ? gw + NGW : mA; npA = ((const GAS i32x2v*)POS)[mA]; npB = ((const GAS i32x2v*)POS)[mB]; nwA = ((const GAS f32x2v*)CWB)[mA]; nwB = ((const GAS f32x2v*)CWB)[mB]; }
      for (int m = gw; m < T_; m += 2 * NGW) { const bool hasB = m + NGW < T_; const int mA = m, mB = hasB ? m + NGW : m;
          const i32x2v pA = npA, pB = npB; const f32x2v wA = nwA * wsc, wB = nwB * wsc;
          const GAS u32x2v* xa = (const GAS u32x2v*)(H1B + (size_t)mA * DM) + lane; const GAS u32x2v* xb = (const GAS u32x2v*)(H1B + (size_t)mB * DM) + lane;
          const GAS u32x2v* ya0 = (const GAS u32x2v*)(YB + (size_t)pA.x * DM) + lane; const GAS u32x2v* ya1 = (const GAS u32x2v*)(YB + (size_t)pA.y * DM) + lane;
          const GAS u32x2v* yb0 = (const GAS u32x2v*)(YB + (size_t)pB.x * DM) + lane; const GAS u32x2v* yb1 = (const GAS u32x2v*)(YB + (size_t)pB.y * DM) + lane;
          f32x4 va[4], vb[4]; u32x2v ha_[4], hb_[4], a0[4], a1[4], b0[4], b1[4];
#pragma unroll
          for (int j = 0; j < 4; ++j) { ha_[j] = xa[64 * j]; hb_[j] = xb[64 * j]; a0[j] = ya0[64 * j]; a1[j] = ya1[64 * j]; b0[j] = yb0[64 * j]; b1[j] = yb1[64 * j]; }
          if (m + 2 * NGW < T_) { const int nA = m + 2 * NGW, nB = m + 3 * NGW < T_ ? m + 3 * NGW : nA; npA = ((const GAS i32x2v*)POS)[nA]; npB = ((const GAS i32x2v*)POS)[nB]; nwA = ((const GAS f32x2v*)CWB)[nA]; nwB = ((const GAS f32x2v*)CWB)[nB]; }
          float sa = 0.f, sb = 0.f;
#define CB_ADD(V_, Y0_, Y1_, W_) do { V_[0] += W_[0] * __builtin_bit_cast(float, Y0_[0] << 16) + W_[1] * __builtin_bit_cast(float, Y1_[0] << 16); V_[1] += W_[0] * __builtin_bit_cast(float, Y0_[0] & 0xffff0000u) + W_[1] * __builtin_bit_cast(float, Y1_[0] & 0xffff0000u); \
              V_[2] += W_[0] * __builtin_bit_cast(float, Y0_[1] << 16) + W_[1] * __builtin_bit_cast(float, Y1_[1] << 16); V_[3] += W_[0] * __builtin_bit_cast(float, Y0_[1] & 0xffff0000u) + W_[1] * __builtin_bit_cast(float, Y1_[1] & 0xffff0000u); } while (0)
#pragma unroll
          for (int j = 0; j < 4; ++j) { va[j] = (f32x4){__builtin_bit_cast(float, ha_[j].x << 16), __builtin_bit_cast(float, ha_[j].x & 0xffff0000u), __builtin_bit_cast(float, ha_[j].y << 16), __builtin_bit_cast(float, ha_[j].y & 0xffff0000u)};
              vb[j] = (f32x4){__builtin_bit_cast(float, hb_[j].x << 16), __builtin_bit_cast(float, hb_[j].x & 0xffff0000u), __builtin_bit_cast(float, hb_[j].y << 16), __builtin_bit_cast(float, hb_[j].y & 0xffff0000u)};
              CB_ADD(va[j], a0[j], a1[j], wA); CB_ADD(vb[j], b0[j], b1[j], wB);
              sa += (va[j].x * va[j].x + va[j].y * va[j].y) + (va[j].z * va[j].z + va[j].w * va[j].w); sb += (vb[j].x * vb[j].x + vb[j].y * vb[j].y) + (vb[j].z * vb[j].z + vb[j].w * vb[j].w); }
#undef CB_ADD
          const float ra = 1.f / sqrtf(wave_sum(sa) * (1.f / 1024.f) + 1e-6f), rb = 1.f / sqrtf(wave_sum(sb) * (1.f / 1024.f) + 1e-6f);
          GAS unsigned long long* oa = (GAS unsigned long long*)(VPLE + (size_t)mA * DM) + lane; GAS unsigned long long* ob = (GAS unsigned long long*)(VPLE + (size_t)mB * DM) + lane;
#pragma unroll
          for (int j = 0; j < 4; ++j) {
              oa[64 * j] = (unsigned long long)pk2(va[j].x, va[j].y) | ((unsigned long long)pk2(va[j].z, va[j].w) << 32);
              if (hasB) ob[64 * j] = (unsigned long long)pk2(vb[j].x, vb[j].y) | ((unsigned long long)pk2(vb[j].z, vb[j].w) << 32); }
          if (lane == 0) { RA[mA] = ra; if (hasB) RA[mB] = rb; }
      } }
    }
    xcd_barrier(bar); if (PROBE_DUP == 60) xcd_barrier(bar);
    {   PHASE_PTRS();
    if (NG == 256 && T_ == 32768) {
      pg8::Gemm g{VPLE, WPG_T, T_, DM, DM, 0}; pg8::StaticOrder S; S.init(T_, DM, NG, (int)blockIdx.x);
      pg8::EpiPleGateNorm E{HB, VPLE, RA, PPB, b_ple, g_final, (float*)(ws + WS_XS), (unsigned*)(ws + WS_CTL) + CW_PANEL, ldsp + RING_BYTES, DM};
      pg8::gemm_phase<pg8::EpiPleGateNorm, pg8::StaticOrder, true, true>(ldsp + RING_OFF, g, S, E);
    } else {
    { pg8::Gemm g{VPLE, WPG_T, T_, DM, DM, 0}; pg8::StaticOrder S; S.init(T_, DM, NG, (int)blockIdx.x);
      pg8::EpiPleGate E{HB, VPLE, RA, PPB, b_ple, DM};
      pg8::gemm_phase<pg8::EpiPleGate, pg8::StaticOrder, true, true>(ldsp + RING_OFF, g, S, E); }
      xcd_barrier(bar);
    { PHASE_IDS(); const int gw = vcu * NWAVES + wave, NGW = NG * NWAVES;
      for (int m = gw; m < T_; m += NGW) {
          GAS f32x4* xr = (GAS f32x4*)(HB + (size_t)m * DM) + lane; f32x4 v[4]; float s = 0.f;
#pragma unroll
          for (int j = 0; j < 4; ++j) { v[j] = xr[64 * j]; s += (v[j].x * v[j].x + v[j].y * v[j].y) + (v[j].z * v[j].z + v[j].w * v[j].w); }
          const float r = 1.f / sqrtf(wave_sum(s) * (1.f / 1024.f) + 1e-6f);
#pragma unroll
          for (int j = 0; j < 4; ++j) { const f32x4 g = ((const GAS f32x4*)g_final)[lane + 64 * j]; xr[64 * j] = (f32x4){v[j].x * r * g.x, v[j].y * r * g.y, v[j].z * r * g.z, v[j].w * r * g.w}; }
      } }
    }
    }
}
}
extern "C" void kernel_launch(void* const* d_in, const int* in_sizes, int n_in, void* d_out, int out_size, void* d_ws, size_t ws_size, hipStream_t stream) {
    static int grid = 0;
    if (grid == 0) {
        int dev = 0, cus = 0;
        if (n_in != 29 || ws_size < ((size_t)512 << 20)) { fprintf(stderr, "kernel_launch: unexpected n_in %d or ws_size %zu\n", n_in, ws_size); grid = -1; return; }
        if (hipGetDevice(&dev) != hipSuccess || hipDeviceGetAttribute(&cus, hipDeviceAttributeMultiprocessorCount, dev) != hipSuccess) { grid = -1; return; }
        if (hipFuncSetAttribute((const void*)mk::mk_fwd, hipFuncAttributeMaxDynamicSharedMemorySize, mk::LDS_BYTES) != hipSuccess) { fprintf(stderr, "kernel_launch: hipFuncSetAttribute failed\n"); grid = -1; return; }
        int per_cu = 0;
        if (hipOccupancyMaxActiveBlocksPerMultiprocessor(&per_cu, (const void*)mk::mk_fwd, mk::NTHREADS, mk::LDS_BYTES) != hipSuccess || per_cu < 1) { fprintf(stderr, "kernel_launch: occupancy query says %d\n", per_cu); }
        (void)hipGetLastError();
        grid = cus;
    }
    if (grid < 0) return;
    (void)hipMemsetAsync((char*)d_ws + mk::WS_CTL, 0, mk::CTL_ZERO_BYTES, stream);
    mk::Args a{};
    for (int i = 0; i < 29; ++i) a.in[i] = d_in[i];
    a.out = d_out; a.ws = d_ws;
    hipLaunchKernelGGL(mk::mk_fwd, dim3(grid), dim3(mk::NTHREADS), mk::LDS_BYTES, stream, a);
}
```

```cpp
#define PROBE_DUP (-1)
#include <hip/hip_runtime.h>
#include <hip/hip_bf16.h>
#include <cstdio>
#include <cstdint>
#include <cmath>
namespace lx {
template <int M> __device__ __forceinline__ float xf(float v) { static_assert(M >= 1 && M < 32, "xf: within a 32-lane half"); return __builtin_bit_cast(float, __builtin_amdgcn_ds_swizzle(__builtin_bit_cast(int, v), (M << 10) | 0x1f)); }
template <int M> __device__ __forceinline__ int xi(int v) { static_assert(M >= 1 && M < 32, "xi: within a 32-lane half"); return __builtin_amdgcn_ds_swizzle(v, (M << 10) | 0x1f); }
__device__ __forceinline__ float x32f(float v, bool hi) { auto rr = __builtin_amdgcn_permlane32_swap(__float_as_uint(v), __float_as_uint(v), false, false); return __uint_as_float(hi ? rr[0] : rr[1]); }
__device__ __forceinline__ float sum64(float v) { v += xf<1>(v); v += xf<2>(v); v += xf<4>(v); v += xf<8>(v); v += xf<16>(v);
    auto rr = __builtin_amdgcn_permlane32_swap(__float_as_uint(v), __float_as_uint(v), false, false); return __uint_as_float(rr[0]) + __uint_as_float(rr[1]); }
__device__ __forceinline__ float max64(float v) { v = fmaxf(v, xf<1>(v)); v = fmaxf(v, xf<2>(v)); v = fmaxf(v, xf<4>(v)); v = fmaxf(v, xf<8>(v)); v = fmaxf(v, xf<16>(v));
    auto rr = __builtin_amdgcn_permlane32_swap(__float_as_uint(v), __float_as_uint(v), false, false); return fmaxf(__uint_as_float(rr[0]), __uint_as_float(rr[1])); }
}
#ifndef CFG_BATCH
#define CFG_BATCH 8
#endif
#ifndef CFG_SEQ
#define CFG_SEQ 4096
#endif
#ifndef CFG_NSEL
#define CFG_NSEL 16
#endif
#ifndef CFG_WINDOW
#define CFG_WINDOW 512
#endif
namespace nv {
constexpr int B_ = CFG_BATCH, S_ = CFG_SEQ, T_ = B_ * S_, DM = 1024, HD = 64;
constexpr int IN_COLS = 2848;
constexpr int OFF_QA = 0, OFF_KC = 512, OFF_VC = 640, OFF_KS = 768, OFF_VS = 896, OFF_KW = 1024, OFF_VW = 1152,
              OFF_GATE = 1280, OFF_QB = 1304, OFF_KB = 1816, OFF_VB = 2328, OFF_F = 2840;
constexpr int NCMP = (S_ - 32) / 16 + 1, NBLK = S_ / 64, NSEL = (CFG_NSEL < NBLK ? CFG_NSEL : NBLK), WIN = CFG_WINDOW;
constexpr float EPS = 1e-6f;
static_assert(NBLK <= 64, "selection mask is 64 bits");


__device__ __forceinline__ float nv_sigmoid(float x) { return 1.0f / (1.0f + expf(-x)); }
__device__ __forceinline__ float nv_silu(float x) { return x / (1.0f + expf(-x)); }
__device__ __forceinline__ float nv_logsigmoid(float x) { return fminf(x, 0.0f) - log1pf(expf(-fabsf(x))); }


constexpr float C2F = 0.125f * 1.4426950408889634f;
constexpr int PB_COLS = 2816;
struct ProjF32 { const float* p;
    __device__ __forceinline__ float operator()(long tok, int off, int i) const { return p[tok * IN_COLS + off + i]; } };
struct ProjB16 { const unsigned short* p; const float* gates; const float* logf;
    __device__ __forceinline__ float operator()(long tok, int off, int i) const {
        if (off == OFF_GATE) return gates[tok * 24 + i];
        if (off == OFF_F) return logf[tok * 8 + i];
        const int nb = off < OFF_GATE ? off : off - 24;
        const unsigned u = (unsigned)p[tok * PB_COLS + nb + i] << 16;
#ifdef CPU_EMU
        float v; memcpy(&v, &u, 4);
#else
        float v = __builtin_bit_cast(float, u);
#endif
        if (off == OFF_QA || off == OFF_QB) v *= (1.0f / C2F);
        return v; } };

__device__ __forceinline__ void d_rstd(long gid_, const float* __restrict__ x, float* __restrict__ rstd, int rows) {
    long r = gid_; if (r >= rows) return;
    const float* xr = x + r * DM; float s = 0.f;
    for (int k = 0; k < DM; ++k) s += xr[k] * xr[k];
    rstd[r] = 1.0f / sqrtf(s / DM + EPS);
}

__device__ __forceinline__ void d_gemm(long gid_, const float* __restrict__ A, int lda, const float* __restrict__ rs, const float* __restrict__ cs,
                       const float* __restrict__ Bm, int ldb, float* __restrict__ C, int ldc, int M, int N, int K,
                       const float* __restrict__ Res, int ldr) {
    long gid = gid_; const int tn = N / 4; long tiles = (long)(M / 4) * tn; if (gid >= tiles) return;
    const int m0 = (int)(gid / tn) * 4, n0 = (int)(gid % tn) * 4;
    float acc[4][4];
#pragma unroll
    for (int r = 0; r < 4; ++r)
#pragma unroll
        for (int c = 0; c < 4; ++c) acc[r][c] = 0.f;
    for (int k = 0; k < K; ++k) {
        const float sc = cs ? cs[k] : 1.0f;
        const float* bp = Bm + (long)k * ldb + n0;
        const float b0 = bp[0], b1 = bp[1], b2 = bp[2], b3 = bp[3];
#pragma unroll
        for (int r = 0; r < 4; ++r) {
            const float a = A[(long)(m0 + r) * lda + k] * sc;
            acc[r][0] += a * b0; acc[r][1] += a * b1; acc[r][2] += a * b2; acc[r][3] += a * b3;
        }
    }
#pragma unroll
    for (int r = 0; r < 4; ++r) {
        const float s = rs ? rs[m0 + r] : 1.0f;
#pragma unroll
        for (int c = 0; c < 4; ++c) {
            float v = acc[r][c] * s;
            if (Res) v += Res[(long)(m0 + r) * ldr + n0 + c];
            C[(long)(m0 + r) * ldc + n0 + c] = v;
        }
    }
}

__device__ __forceinline__ void d_postproj(long gid_, float* __restrict__ proj, const int* __restrict__ positions, const float* __restrict__ b_gate,
                           const float* __restrict__ b_forget) {
    long gid = gid_; if (gid >= (long)T_ * 14) return;
    const int tok = (int)(gid / 14), unit = (int)(gid % 14);
    float* row = proj + (long)tok * IN_COLS;
    if (unit < 12) {
        int off = unit < 8 ? OFF_QA + unit * 64 : (unit < 10 ? OFF_KS + (unit - 8) * 64 : OFF_KW + (unit - 10) * 64);
        const float pos = (float)positions[tok];
        for (int i = 0; i < 8; ++i) {
            const float inv = powf(500000.0f, -(float)i / 8.0f);
            const float ang = pos * inv, c = cosf(ang), s = sinf(ang);
            const float x1 = row[off + i], x2 = row[off + 8 + i];
            row[off + i] = x1 * c - x2 * s; row[off + 8 + i] = x2 * c + x1 * s;
        }
    } else if (unit == 12) {
        for (int i = 0; i < 24; ++i) row[OFF_GATE + i] = nv_sigmoid(row[OFF_GATE + i] + b_gate[i]);
    } else {
        for (int i = 0; i < 8; ++i) row[OFF_F + i] = nv_logsigmoid(row[OFF_F + i] + b_forget[i]);
    }
}

template <class PJ> __device__ __forceinline__ void d_cumsum(long gid_, const PJ proj, float* __restrict__ cum) {
    long gid = gid_; if (gid >= B_ * 8) return;
    const int b = (int)gid / 8, h = (int)gid % 8; double c = 0.0;
    for (int t = 0; t < S_; ++t) { c += (double)proj((long)b * S_ + t, OFF_F, h); cum[((long)b * 8 + h) * S_ + t] = (float)c; }
}

template <class PJ> __device__ __forceinline__ void d_cmp_hidden(long gid_, const PJ proj, int coloff, const float* __restrict__ pe, const float* __restrict__ w1,
                             float* __restrict__ hid) {
    long gid = gid_; if (gid >= (long)B_ * NCMP * 2 * 128) return;
    const int j = (int)(gid % 128); const int row = (int)(gid / 128); const int g = row % 2, n = (row / 2) % NCMP, b = row / (2 * NCMP);
    float acc = 0.f;
    for (int l = 0; l < 32; ++l) {
        const long tk = (long)b * S_ + 16 * n + l;
        for (int d = 0; d < 64; ++d) acc += (proj(tk, coloff, g * 64 + d) + pe[l * 64 + d]) * w1[(long)(l * 64 + d) * 128 + j];
    }
    hid[(long)row * 128 + j] = nv_silu(acc);
}
__device__ __forceinline__ void d_cmp_out(long gid_, const float* __restrict__ hid, const float* __restrict__ w2, float* __restrict__ out,
                          const int* __restrict__ positions, int dorope) {
    long gid = gid_; if (gid >= (long)B_ * NCMP * 2 * 56) return;
    const int u = (int)(gid % 56); const int row = (int)(gid / 56); const int n = (row / 2) % NCMP, b = row / (2 * NCMP);
    const float* hp = hid + (long)row * 128;
    if (u < 8) {
        float a1 = 0.f, a2 = 0.f;
        for (int j = 0; j < 128; ++j) { a1 += hp[j] * w2[j * 64 + u]; a2 += hp[j] * w2[j * 64 + u + 8]; }
        if (dorope) {
            const float pos = (float)positions[(long)b * S_ + 16 * n + 31];
            const float inv = powf(500000.0f, -(float)u / 8.0f); const float ang = pos * inv, c = cosf(ang), s = sinf(ang);
            const float x1 = a1, x2 = a2; a1 = x1 * c - x2 * s; a2 = x2 * c + x1 * s;
        }
        out[(long)row * 64 + u] = a1; out[(long)row * 64 + u + 8] = a2;
    } else {
        const int d = u + 8; float a = 0.f;
        for (int j = 0; j < 128; ++j) a += hp[j] * w2[j * 64 + d];
        out[(long)row * 64 + d] = a;
    }
}

template <class PJ> __device__ __forceinline__ void d_nsa_cmp(long gid_, const PJ proj, const float* __restrict__ kc, const float* __restrict__ vc,
                          float* __restrict__ imp, unsigned long long* __restrict__ selmask, float* __restrict__ omix) {
    long gid = gid_; if (gid >= (long)T_ * 2) return;
    const int g = (int)(gid % 2); const int tok = (int)(gid / 2); const int b = tok / S_, t = tok % S_;
    const int nvis = t >= 31 ? (t - 31) / 16 + 1 : 0;
    float* ip = imp + ((long)(b * 2 + g) * S_ + t) * 64;
    for (int j = 0; j < NBLK; ++j) ip[j] = 0.f;
#pragma unroll 1
    for (int hh = 0; hh < 4; ++hh) {
        const int h = g * 4 + hh;
        float m = -1e30f;
#pragma unroll 1
        for (int n = 0; n < nvis; ++n) {
            asm volatile("" ::: "memory");
            const float* kp = kc + ((long)(b * NCMP + n) * 2 + g) * 64; float l = 0.f;
#pragma unroll
            for (int d = 0; d < 64; ++d) l += proj(tok, OFF_QA, h * 64 + d) * kp[d];
            m = fmaxf(m, l * 0.125f);
        }
        float sum = 0.f;
#pragma unroll 1
        for (int n = 0; n < nvis; ++n) {
            asm volatile("" ::: "memory");
            const float* kp = kc + ((long)(b * NCMP + n) * 2 + g) * 64; float l = 0.f;
#pragma unroll
            for (int d = 0; d < 64; ++d) l += proj(tok, OFF_QA, h * 64 + d) * kp[d];
            sum += expf(l * 0.125f - m);
        }
        const float g0 = proj(tok, OFF_GATE, h * 3 + 0);
#pragma unroll 1
        for (int dh = 0; dh < 2; ++dh) {
            float o[32];
#pragma unroll
            for (int d = 0; d < 32; ++d) o[d] = 0.f;
#pragma unroll 1
            for (int n = 0; n < nvis; ++n) {
                asm volatile("" ::: "memory");
                const float* kp = kc + ((long)(b * NCMP + n) * 2 + g) * 64; float l = 0.f;
#pragma unroll
                for (int d = 0; d < 64; ++d) l += proj(tok, OFF_QA, h * 64 + d) * kp[d];
                const float p = expf(l * 0.125f - m) / sum;
                const float* vp = vc + ((long)(b * NCMP + n) * 2 + g) * 64 + dh * 32;
#pragma unroll
                for (int d = 0; d < 32; ++d) o[d] += p * vp[d];
                if (dh == 0) {
                    const int j0 = n >> 2;
                    if ((n & 3) < 3) ip[j0] += p; else { ip[j0] += 0.5f * p; if (j0 + 1 < NBLK) ip[j0 + 1] += 0.5f * p; }
                }
            }
#pragma unroll
            for (int d = 0; d < 32; ++d) omix[(long)tok * DM + h * 64 + dh * 32 + d] = g0 * o[d];
        }
    }
    const int cur = t / 64; unsigned long long mask = 0ull;
#pragma unroll 1
    for (int s = 0; s < NSEL; ++s) {
        float best = -3e38f; int bj = -1;
#pragma unroll 1
        for (int j = 0; j < NBLK; ++j) {
            if ((mask >> j) & 1ull) continue;
            const bool forced = (j == 0) || (j == cur) || (j == cur - 1);
            const float sc = (j * 64 > t) ? -1.0f : ip[j] + (forced ? 1e4f : 0.0f);
            if (sc > best) { best = sc; bj = j; }
        }
        mask |= 1ull << bj;
    }
    selmask[(long)(b * 2 + g) * S_ + t] = mask;
}

template <class PJ> __device__ __forceinline__ void d_nsa_selwin(long gid_, const PJ proj, const unsigned long long* __restrict__ selmask, float* __restrict__ omix) {
    long gid = gid_; if (gid >= (long)T_ * 8) return;
    const int h = (int)(gid % 8); const int tok = (int)(gid / 8); const int b = tok / S_, t = tok % S_, g = h >> 2;
    float q[64], o[64];
#pragma unroll
    for (int d = 0; d < 64; ++d) { q[d] = proj(tok, OFF_QA, h * 64 + d); o[d] = 0.f; }
    const unsigned long long mask = selmask[(long)(b * 2 + g) * S_ + t];
    float m = -1e30f, l = 0.f;
    for (int j = 0; j < NBLK; ++j) {
        if (!((mask >> j) & 1ull)) continue;
        for (int kk = 0; kk < 64; ++kk) {
            const int kp = j * 64 + kk; if (kp > t) break;
            const long kr = (long)b * S_ + kp; float s = 0.f;
#pragma unroll
            for (int d = 0; d < 64; ++d) s += q[d] * proj(kr, OFF_KS, g * 64 + d);
            s *= 0.125f;
            const float mn = fmaxf(m, s), al = expf(m - mn), p = expf(s - mn);
            l = l * al + p;
#pragma unroll
            for (int d = 0; d < 64; ++d) o[d] = o[d] * al + p * proj(kr, OFF_VS, g * 64 + d);
            m = mn;
        }
    }
    {
        const float g1 = proj(tok, OFF_GATE, h * 3 + 1) / l;
#pragma unroll
        for (int d = 0; d < 64; ++d) { omix[(long)tok * DM + h * 64 + d] += g1 * o[d]; o[d] = 0.f; }
    }
    m = -1e30f; l = 0.f;
    const int lo = t - WIN + 1 > 0 ? t - WIN + 1 : 0;
    for (int kp = lo; kp <= t; ++kp) {
        const long kr = (long)b * S_ + kp; float s = 0.f;
#pragma unroll
        for (int d = 0; d < 64; ++d) s += q[d] * proj(kr, OFF_KW, g * 64 + d);
        s *= 0.125f;
        const float mn = fmaxf(m, s), al = expf(m - mn), p = expf(s - mn);
        l = l * al + p;
#pragma unroll
        for (int d = 0; d < 64; ++d) o[d] = o[d] * al + p * proj(kr, OFF_VW, g * 64 + d);
        m = mn;
    }
    {
        const float g2 = proj(tok, OFF_GATE, h * 3 + 2) / l;
#pragma unroll
        for (int d = 0; d < 64; ++d) omix[(long)tok * DM + h * 64 + d] += g2 * o[d];
    }
}

template <class PJ> __device__ __forceinline__ void d_fox(long gid_, const PJ proj, const float* __restrict__ cum, float* __restrict__ omix) {
    long gid = gid_; if (gid >= (long)T_ * 8) return;
    const int t = (int)(gid % S_); const int bh = (int)(gid / S_); const int b = bh / 8, h = bh % 8;
    const long tok = (long)b * S_ + t;
    float q[64], o[64];
#pragma unroll
    for (int d = 0; d < 64; ++d) { q[d] = proj(tok, OFF_QB, h * 64 + d); o[d] = 0.f; }
    const float* cp = cum + ((long)b * 8 + h) * S_; const float cq = cp[t];
    float m = -1e30f, l = 0.f;
    for (int kp = 0; kp <= t; ++kp) {
        const long kr = (long)b * S_ + kp; float s = 0.f;
#pragma unroll
        for (int d = 0; d < 64; ++d) s += q[d] * proj(kr, OFF_KB, h * 64 + d);
        s = s * 0.125f + (cq - cp[kp]);
        const float mn = fmaxf(m, s), al = expf(m - mn), p = expf(s - mn);
        l = l * al + p;
#pragma unroll
        for (int d = 0; d < 64; ++d) o[d] = o[d] * al + p * proj(kr, OFF_VB, h * 64 + d);
        m = mn;
    }
    const float il = 1.0f / l;
#pragma unroll
    for (int d = 0; d < 64; ++d) omix[tok * DM + 512 + h * 64 + d] = o[d] * il;
}

__device__ __forceinline__ void d_mixnorm(long gid_, float* __restrict__ omix, const float* __restrict__ beta_nsa, const float* __restrict__ beta_fox) {
    long gid = gid_; if (gid >= (long)T_ * 2) return;
    const int half = (int)(gid % 2); float* v = omix + (gid / 2) * DM + half * 512; const float* be = half ? beta_fox : beta_nsa;
    float s = 0.f; for (int k = 0; k < 512; ++k) s += v[k] * v[k];
    const float r = 1.0f / sqrtf(s / 512 + EPS);
    for (int k = 0; k < 512; ++k) v[k] = v[k] * r * be[k];
}

__device__ __forceinline__ void d_router(long gid_, const float* __restrict__ H, const float* __restrict__ g_ffn, const float* __restrict__ w_group, const float* __restrict__ b_group,
                         const float* __restrict__ w_router, const float* __restrict__ b_router, float* __restrict__ U, int* __restrict__ eid, float* __restrict__ cw) {
    long tok = gid_; if (tok >= T_) return;
    const float* hr = H + tok * DM; float ss = 0.f;
    for (int k = 0; k < DM; ++k) ss += hr[k] * hr[k];
    const float rstd = 1.0f / sqrtf(ss / DM + EPS);
    float gl[4], el[16];
#pragma unroll
    for (int c = 0; c < 4; ++c) gl[c] = 0.f;
#pragma unroll
    for (int e = 0; e < 16; ++e) el[e] = 0.f;
    for (int k = 0; k < DM; ++k) {
        const float u = hr[k] * rstd * g_ffn[k]; U[tok * DM + k] = u;
#pragma unroll
        for (int c = 0; c < 4; ++c) gl[c] += u * w_group[k * 4 + c];
#pragma unroll
        for (int e = 0; e < 16; ++e) el[e] += u * w_router[k * 16 + e];
    }
#pragma unroll
    for (int c = 0; c < 4; ++c) gl[c] += b_group[c];
#pragma unroll
    for (int e = 0; e < 16; ++e) el[e] += b_router[e];
    int gs = 0; float gm = gl[0];
#pragma unroll
    for (int c = 1; c < 4; ++c) if (gl[c] > gm) { gm = gl[c]; gs = c; }
    float gsum = 0.f;
#pragma unroll
    for (int c = 0; c < 4; ++c) gsum += expf(gl[c] - gm);
    const float gprob = 1.0f / gsum;
    float il[4] = {0.f, 0.f, 0.f, 0.f};
#pragma unroll
    for (int c = 0; c < 4; ++c)
#pragma unroll
        for (int e = 0; e < 4; ++e) if (gs == c) il[e] = el[c * 4 + e];
    float im = il[0];
#pragma unroll
    for (int e = 1; e < 4; ++e) im = fmaxf(im, il[e]);
    float ipr[4], isum = 0.f;
#pragma unroll
    for (int e = 0; e < 4; ++e) { ipr[e] = expf(il[e] - im); isum += ipr[e]; }
#pragma unroll
    for (int e = 0; e < 4; ++e) ipr[e] /= isum;
    int i0 = 0; float v0 = ipr[0];
#pragma unroll
    for (int e = 1; e < 4; ++e) if (ipr[e] > v0) { v0 = ipr[e]; i0 = e; }
    int i1 = -1; float v1 = -1.f;
#pragma unroll
    for (int e = 0; e < 4; ++e) if (e != i0 && ipr[e] > v1) { v1 = ipr[e]; i1 = e; }
    const float den = v0 + v1;
    eid[tok * 2 + 0] = gs * 4 + i0; eid[tok * 2 + 1] = gs * 4 + i1;
    cw[tok * 2 + 0] = gprob * (v0 / den); cw[tok * 2 + 1] = gprob * (v1 / den);
}

__device__ __forceinline__ void d_expert_up(long gid_, const float* __restrict__ U, const int* __restrict__ eid, const float* __restrict__ wg, const float* __restrict__ wu, float* __restrict__ hid) {
    long gid = gid_; if (gid >= (long)T_ * 2 * 128) return;
    const int jg = (int)(gid % 128); const long tk = gid / 128; const long tok = tk / 2; const int e = eid[tk];
    const float* ur = U + tok * DM; const float* gp = wg + (long)e * DM * 512 + jg * 4; const float* up = wu + (long)e * DM * 512 + jg * 4;
    float ga[4] = {0.f, 0.f, 0.f, 0.f}, ua[4] = {0.f, 0.f, 0.f, 0.f};
    for (int i = 0; i < DM; ++i) {
        const float u = ur[i];
#pragma unroll
        for (int c = 0; c < 4; ++c) { ga[c] += u * gp[(long)i * 512 + c]; ua[c] += u * up[(long)i * 512 + c]; }
    }
#pragma unroll
    for (int c = 0; c < 4; ++c) hid[tk * 512 + jg * 4 + c] = nv_silu(ga[c]) * ua[c];
}
__device__ __forceinline__ void d_expert_down(long gid_, float* __restrict__ H, const int* __restrict__ eid, const float* __restrict__ cw, const float* __restrict__ wd, const float* __restrict__ hid) {
    long gid = gid_; if (gid >= (long)T_ * 256) return;
    const int cg = (int)(gid % 256); const long tok = gid / 256;
    float acc[4] = {0.f, 0.f, 0.f, 0.f};
    for (int k = 0; k < 2; ++k) {
        const int e = eid[tok * 2 + k]; const float w = cw[tok * 2 + k];
        const float* hp = hid + (tok * 2 + k) * 512; const float* dp = wd + (long)e * 512 * DM + cg * 4;
        float tmp[4] = {0.f, 0.f, 0.f, 0.f};
        for (int j = 0; j < 512; ++j) {
            const float hv = hp[j];
#pragma unroll
            for (int c = 0; c < 4; ++c) tmp[c] += hv * dp[(long)j * DM + c];
        }
#pragma unroll
        for (int c = 0; c < 4; ++c) acc[c] += w * tmp[c];
    }
#pragma unroll
    for (int c = 0; c < 4; ++c) H[tok * DM + cg * 4 + c] += acc[c];
}

__device__ __forceinline__ void d_final(long gid_, const float* __restrict__ H, float* __restrict__ G, const float* __restrict__ PP, const float* __restrict__ b_ple,
                        const float* __restrict__ g_final, float* __restrict__ out) {
    long tok = gid_; if (tok >= T_) return;
    float ss = 0.f;
    for (int c = 0; c < DM; ++c) {
        const float h3 = H[tok * DM + c] + nv_sigmoid(G[tok * DM + c] + b_ple[c]) * PP[tok * DM + c];
        G[tok * DM + c] = h3; ss += h3 * h3;
    }
    const float r = 1.0f / sqrtf(ss / DM + EPS);
    for (int c = 0; c < DM; ++c) out[tok * DM + c] = G[tok * DM + c] * r * g_final[c];
}

constexpr size_t MiB = 1u << 20;
constexpr size_t SZ_PROJ = (size_t)T_ * IN_COLS * 4, SZ_ACT = (size_t)T_ * DM * 4;
constexpr size_t A16(size_t x) { return (x + 255) / 256 * 256; }
constexpr size_t W_PROJ = 0;
constexpr size_t W_RSTD1 = A16(W_PROJ + SZ_PROJ);
constexpr size_t W_CUM = A16(W_RSTD1 + (size_t)T_ * 4);
constexpr size_t W_KC = A16(W_CUM + (size_t)T_ * 8 * 4);
constexpr size_t W_VC = A16(W_KC + (size_t)B_ * NCMP * 2 * 64 * 4);
constexpr size_t W_CMPH = A16(W_VC + (size_t)B_ * NCMP * 2 * 64 * 4);
constexpr size_t W_IMP = A16(W_CMPH + (size_t)B_ * NCMP * 2 * 128 * 4 * 2);
constexpr size_t W_SELM = A16(W_IMP + (size_t)B_ * 2 * S_ * 64 * 4);
constexpr size_t W_END1 = A16(W_SELM + (size_t)B_ * 2 * S_ * 8);
constexpr size_t W_H = 0, W_U = SZ_ACT, W_HID = 2 * SZ_ACT, W_EID = 3 * SZ_ACT, W_CW = A16(W_EID + (size_t)T_ * 8), W_RS3 = A16(W_CW + (size_t)T_ * 8),
                 W_END2 = A16(W_RS3 + (size_t)T_ * 4);
constexpr size_t W_PP = W_U, W_G = W_HID;
constexpr size_t W_TOTAL = W_END1 > W_END2 ? W_END1 : W_END2;


#ifndef NV_DBG
#define NV_DBG(name)
#endif
#ifndef CPU_EMU
template <auto F, class... A> __global__ void __launch_bounds__(256) k_wrap(long n, A... a) {
    const long gid = (long)blockIdx.x * (long)blockDim.x + (long)threadIdx.x; if (gid < n) F(gid, a...);
}
#endif
}
namespace pg8 {
#define PG8_LAS __attribute__((address_space(3)))
typedef unsigned short bf16_t;
typedef short bf16x8 __attribute__((ext_vector_type(8)));
typedef float f32x4 __attribute__((ext_vector_type(4)));
typedef unsigned u32x4 __attribute__((ext_vector_type(4)));
constexpr int BM = 256, BK = 64, HALF = 128, HTB = HALF * BK * 2  , STAGE_BYTES = 8 * HTB, NXCD = 8, WGM = 8;

__host__ __device__ __forceinline__ int lds_byte(int r, int c) { const int st = (r >> 4) * 2 + (c >> 5), rr = r & 15, cc = c & 31, ob = rr * 64 + cc * 2; return st * 1024 + (ob ^ (((ob >> 9) & 1) << 5)); }
__host__ __device__ __forceinline__ void stage_rc(int b, int& R, int& C) { const int st = b / 1024, sb = b % 1024, swz = sb ^ (((sb >> 9) & 1) << 5); R = (st >> 1) * 16 + swz / 64; C = (st & 1) * 32 + (swz % 64) / 2; }
__host__ __device__ __forceinline__ int perm32(int rho) { const int n = rho >> 4, i = rho & 15; return 8 * (i >> 2) + 4 * n + (i & 3); }

struct Unit { int pm, pn, be; };
struct Gemm { const bf16_t* A; const bf16_t* Bt; int M, N, K; size_t bstride; const int* rowidx; };

struct StaticOrder {
    int nM, nN, nwg, G, c;
    __host__ __device__ void init(int M, int N, int G_, int c_) { nM = M / BM; nN = N / BM; nwg = nM * nN; G = G_; c = c_; }
    __host__ __device__ bool next(int i, Unit& u) const {
        const long L = (long)i * G + c; if (L >= nwg) return false;
        int wgid = (int)L; { const int q = nwg / NXCD, r = nwg % NXCD, xcd = wgid % NXCD, off = wgid / NXCD; wgid = (xcd < r ? xcd * (q + 1) : r * (q + 1) + (xcd - r) * q) + off; }
        const int nig = WGM * nN, gid = wgid / nig, fm = gid * WGM, gsz = (nM - fm) < WGM ? (nM - fm) : WGM;
        u.pm = fm + ((wgid % nig) % gsz); u.pn = (wgid % nig) / gsz; u.be = 0; return true;
    }
    __device__ __forceinline__ void a_ready(const Unit&) const {}
    __device__ __forceinline__ void done(const Unit&) const {}
};

#define EPI_LANE_IDS() int t__ = threadIdx.x; asm volatile("" : "+v"(t__)); const int wid__ = __builtin_amdgcn_readfirstlane(t__ >> 6), lane__ = t__ & 63, wr = wid__ >> 2, wc = wid__ & 3, fr = lane__ & 15, fq = lane__ >> 4; (void)wr_; (void)wc_; (void)fr_; (void)fq_
__device__ __forceinline__ unsigned cvt_pk_bf16(float lo, float hi) { unsigned r; asm volatile("v_cvt_pk_bf16_f32 %0, %1, %2" : "=v"(r) : "v"(lo), "v"(hi)); return r; }
constexpr float C2 = 0.125f * 1.4426950408889634f;
constexpr int PB_COLS = 2816;
struct EpiInProj {
    static constexpr bool PERM = true, AFTER_DRAIN = false;
    bf16_t* O; const float* rope; const float* rsx; float* gates; float* logf; const float* b_gate; const float* b_forget; float* hm; int dbg;
    __device__ __forceinline__ void operator()(const f32x4 (&acc)[2][2][4][2], const Unit& u, int wr_, int wc_, int fr_, int fq_) const {
        EPI_LANE_IDS();
        const int pn = u.pn, row0 = u.pm * BM + wr * 64 + fr;
        if (pn == 11) {
            if (wc != 0) return;
#pragma unroll
            for (int ai = 0; ai < 2; ++ai)
#pragma unroll
                for (int m = 0; m < 4; ++m) { const size_t row = (size_t)(row0 + ai * HALF + m * 16); const float rs = rsx[row];
                    const f32x4 v0 = acc[ai][0][m][0] * rs, v1 = acc[ai][0][m][1] * rs;
                    float o[8] = {v0[0], v0[1], v0[2], v0[3], v1[0], v1[1], v1[2], v1[3]};
                    if (fq < 3) {
#pragma unroll
                        for (int i = 0; i < 8; ++i) { const float z = o[i] + b_gate[8 * fq + i]; o[i] = __builtin_amdgcn_rcpf(1.0f + __builtin_amdgcn_exp2f(-1.4426950408889634f * z)); }
                        *(f32x4*)(gates + row * 24 + 8 * fq) = (f32x4){o[0], o[1], o[2], o[3]}; *(f32x4*)(gates + row * 24 + 8 * fq + 4) = (f32x4){o[4], o[5], o[6], o[7]};
                    } else {
#pragma unroll
                        for (int i = 0; i < 8; ++i) { const float z = o[i] + b_forget[i]; o[i] = fminf(z, 0.f) - 0.6931471805599453f * __builtin_amdgcn_logf(1.0f + __builtin_amdgcn_exp2f(-1.4426950408889634f * fabsf(z))); }
                        *(f32x4*)(logf + row * 8) = (f32x4){o[0], o[1], o[2], o[3]}; *(f32x4*)(logf + row * 8 + 4) = (f32x4){o[4], o[5], o[6], o[7]};
                    } }
            return;
        }
        const int head = pn * 4 + wc;
        const bool roped = !(dbg & 2) && (head < 8 || head == 12 || head == 13 || head == 16 || head == 17);
        const int j = (dbg & 1) ? -1 : head < 8 ? head : head == 12 || head == 13 ? head - 4 : head == 16 || head == 17 ? head - 6 : head >= 20 && head < 36 ? head - 8 : -1;
        const float sc = (pn <= 1 || pn == 5 || pn == 6) ? C2 : 1.0f;
        const int col0 = head * 64 + 8 * fq; float nmax = 0.f;
#pragma unroll
        for (int ai = 0; ai < 2; ++ai) {
            f32x4 rc[4][4];
            float rsv[4];
#pragma unroll
            for (int m = 0; m < 4; ++m) rsv[m] = rsx[row0 + ai * HALF + m * 16] * sc;
            if (roped && fq < 2) {
#pragma unroll
                for (int m = 0; m < 4; ++m) { const f32x4* rp = (const f32x4*)(rope + (size_t)(row0 + ai * HALF + m * 16) * 16); rc[m][0] = rp[0]; rc[m][1] = rp[1]; rc[m][2] = rp[2]; rc[m][3] = rp[3]; } }
#pragma unroll
            for (int m = 0; m < 4; ++m) { const size_t row = (size_t)(row0 + ai * HALF + m * 16); bf16_t* rowp = O + row * PB_COLS + col0; float q = 0.f;
#pragma unroll
                for (int bj = 0; bj < 2; ++bj) { f32x4 v0 = acc[ai][bj][m][0], v1 = acc[ai][bj][m][1];
                    if (bj == 0 && roped) {
                        f32x4 p0, p1;
#pragma unroll
                        for (int i = 0; i < 4; ++i) { p0[i] = lx::xf<16>(v0[i]); p1[i] = lx::xf<16>(v1[i]); }
                        if (fq < 2) {
                            const f32x4 a = rc[m][0], b = rc[m][1], c = rc[m][2], d = rc[m][3]; const float sg = fq == 0 ? -1.0f : 1.0f;
                            v0[0] = v0[0] * a[0] + sg * p0[0] * a[1]; v0[1] = v0[1] * a[2] + sg * p0[1] * a[3];
                            v0[2] = v0[2] * b[0] + sg * p0[2] * b[1]; v0[3] = v0[3] * b[2] + sg * p0[3] * b[3];
                            v1[0] = v1[0] * c[0] + sg * p1[0] * c[1]; v1[1] = v1[1] * c[2] + sg * p1[1] * c[3];
                            v1[2] = v1[2] * d[0] + sg * p1[2] * d[1]; v1[3] = v1[3] * d[2] + sg * p1[3] * d[3];
                        }
                    }
                    v0 = v0 * rsv[m]; v1 = v1 * rsv[m]; u32x4 w; w.x = cvt_pk_bf16(v0[0], v0[1]); w.y = cvt_pk_bf16(v0[2], v0[3]); w.z = cvt_pk_bf16(v1[0], v1[1]); w.w = cvt_pk_bf16(v1[2], v1[3]);
                    *(u32x4*)(rowp + bj * 32) = w;
                    if (j >= 0) q += (v0[0] * v0[0] + v0[1] * v0[1]) + (v0[2] * v0[2] + v0[3] * v0[3]) + (v1[0] * v1[0] + v1[1] * v1[1]) + (v1[2] * v1[2] + v1[3] * v1[3]); }
                if (j >= 0) { q += lx::xf<16>(q); { auto rr = __builtin_amdgcn_permlane32_swap(__float_as_uint(q), __float_as_uint(q), false, false); q = __uint_as_float(rr[0]) + __uint_as_float(rr[1]); }
                    nmax = fmaxf(nmax, q); } } }
        if (j >= 0) { float q = nmax; q = fmaxf(q, lx::xf<1>(q)); q = fmaxf(q, lx::xf<2>(q)); q = fmaxf(q, lx::xf<4>(q)); q = fmaxf(q, lx::xf<8>(q));
            if (lane__ == 0) hm[((size_t)u.pm * 2 + wr) * 28 + j] = q * 1.02f; }
    }
};

struct EpiResF32 {
    static constexpr bool PERM = false, AFTER_DRAIN = false;
    const float* res; float* out; int ldc;
    __device__ __forceinline__ void operator()(const f32x4 (&acc)[2][2][4][2], const Unit& u, int wr_, int wc_, int fr_, int fq_) const {
        EPI_LANE_IDS();
        const int col0 = u.pn * BM + wc * 32 + 4 * fq;
#pragma unroll
        for (int ai = 0; ai < 2; ++ai) {
            f32x4 r[4][2][2];
#pragma unroll
            for (int m = 0; m < 4; ++m) { const size_t off = (size_t)(u.pm * BM + ai * HALF + wr * 64 + m * 16 + fr) * ldc + col0;
#pragma unroll
                for (int bj = 0; bj < 2; ++bj)
#pragma unroll
                    for (int n = 0; n < 2; ++n) r[m][bj][n] = *(const f32x4*)(res + off + bj * HALF + n * 16); }
#pragma unroll
            for (int m = 0; m < 4; ++m) { const size_t off = (size_t)(u.pm * BM + ai * HALF + wr * 64 + m * 16 + fr) * ldc + col0;
#pragma unroll
                for (int bj = 0; bj < 2; ++bj)
#pragma unroll
                    for (int n = 0; n < 2; ++n) *(f32x4*)(out + off + bj * HALF + n * 16) = acc[ai][bj][m][n] + r[m][bj][n]; } }
    }
};
struct EpiResBf16 {
    static constexpr bool PERM = true, AFTER_DRAIN = false;
    const bf16_t* res; bf16_t* O; int ldc;
    __device__ __forceinline__ void operator()(const f32x4 (&acc)[2][2][4][2], const Unit& u, int wr_, int wc_, int fr_, int fq_) const {
        EPI_LANE_IDS();
        const int row0 = u.pm * BM + wr * 64 + fr, col0 = u.pn * BM + wc * 32 + 8 * fq;
#pragma unroll
        for (int ai = 0; ai < 2; ++ai) {
            u32x4 r[4][2];
#pragma unroll
            for (int m = 0; m < 4; ++m)
#pragma unroll
                for (int bj = 0; bj < 2; ++bj) r[m][bj] = *(const u32x4*)(res + (size_t)(row0 + ai * HALF + m * 16) * ldc + col0 + bj * HALF);
#pragma unroll
            for (int m = 0; m < 4; ++m) { bf16_t* rowp = O + (size_t)(row0 + ai * HALF + m * 16) * ldc + col0;
#pragma unroll
                for (int bj = 0; bj < 2; ++bj) { const u32x4 q = r[m][bj];
                    const f32x4 v0 = acc[ai][bj][m][0] + (f32x4){__builtin_bit_cast(float, q.x << 16), __builtin_bit_cast(float, q.x & 0xffff0000u), __builtin_bit_cast(float, q.y << 16), __builtin_bit_cast(float, q.y & 0xffff0000u)};
                    const f32x4 v1 = acc[ai][bj][m][1] + (f32x4){__builtin_bit_cast(float, q.z << 16), __builtin_bit_cast(float, q.z & 0xffff0000u), __builtin_bit_cast(float, q.w << 16), __builtin_bit_cast(float, q.w & 0xffff0000u)};
                    u32x4 w; w.x = cvt_pk_bf16(v0[0], v0[1]); w.y = cvt_pk_bf16(v0[2], v0[3]); w.z = cvt_pk_bf16(v1[0], v1[1]); w.w = cvt_pk_bf16(v1[2], v1[3]);
                    *(u32x4*)(rowp + bj * HALF) = w; } } }
    }
};
struct EpiPleGate {
    static constexpr bool PERM = false, AFTER_DRAIN = false;
    float* io; const bf16_t* hb; const float* ra; const bf16_t* pp; const float* bias; int ldc;
    __device__ __forceinline__ void operator()(const f32x4 (&acc)[2][2][4][2], const Unit& u, int wr_, int wc_, int fr_, int fq_) const {
        EPI_LANE_IDS();
        typedef unsigned u32x2v __attribute__((ext_vector_type(2)));
        const int col0 = u.pn * BM + wc * 32 + 4 * fq;
#pragma unroll
        for (int ai = 0; ai < 2; ++ai)
#pragma unroll
            for (int m = 0; m < 4; ++m) { const int row = u.pm * BM + ai * HALF + wr * 64 + m * 16 + fr; const size_t off = (size_t)row * ldc + col0; const float rr_ = ra[row];
#pragma unroll
                for (int bj = 0; bj < 2; ++bj)
#pragma unroll
                    for (int n = 0; n < 2; ++n) { const size_t o = off + bj * HALF + n * 16; const u32x2v hw = *(const u32x2v*)(hb + o); const u32x2v pw = *(const u32x2v*)(pp + o);
                        const f32x4 h = {__builtin_bit_cast(float, hw.x << 16), __builtin_bit_cast(float, hw.x & 0xffff0000u), __builtin_bit_cast(float, hw.y << 16), __builtin_bit_cast(float, hw.y & 0xffff0000u)};
                        const f32x4 bv = *(const f32x4*)(bias + col0 + bj * HALF + n * 16); const f32x4 z = acc[ai][bj][m][n] * rr_ + bv; f32x4 r;
                        r[0] = h[0] + __builtin_bit_cast(float, pw.x << 16) * __builtin_amdgcn_rcpf(1.0f + __builtin_amdgcn_exp2f(-1.4426950408889634f * z[0])); r[1] = h[1] + __builtin_bit_cast(float, pw.x & 0xffff0000u) * __builtin_amdgcn_rcpf(1.0f + __builtin_amdgcn_exp2f(-1.4426950408889634f * z[1]));
                        r[2] = h[2] + __builtin_bit_cast(float, pw.y << 16) * __builtin_amdgcn_rcpf(1.0f + __builtin_amdgcn_exp2f(-1.4426950408889634f * z[2])); r[3] = h[3] + __builtin_bit_cast(float, pw.y & 0xffff0000u) * __builtin_amdgcn_rcpf(1.0f + __builtin_amdgcn_exp2f(-1.4426950408889634f * z[3]));
                        *(f32x4*)(io + o) = r; } }
    }
};

struct EpiBf16Plain {
    static constexpr bool PERM = true, AFTER_DRAIN = false;
    bf16_t* O; int ldc;
    __device__ __forceinline__ void operator()(const f32x4 (&acc)[2][2][4][2], const Unit& u, int wr_, int wc_, int fr_, int fq_) const {
        EPI_LANE_IDS();
        const int row0 = u.pm * BM + wr * 64 + fr, col0 = u.pn * BM + wc * 32 + 8 * fq;
#pragma unroll
        for (int ai = 0; ai < 2; ++ai)
#pragma unroll
            for (int m = 0; m < 4; ++m) { bf16_t* rowp = O + (size_t)(row0 + ai * HALF + m * 16) * ldc + col0;
#pragma unroll
                for (int bj = 0; bj < 2; ++bj) { const f32x4 v0 = acc[ai][bj][m][0], v1 = acc[ai][bj][m][1];
                    u32x4 w; w.x = cvt_pk_bf16(v0[0], v0[1]); w.y = cvt_pk_bf16(v0[2], v0[3]); w.z = cvt_pk_bf16(v1[0], v1[1]); w.w = cvt_pk_bf16(v1[2], v1[3]);
                    *(u32x4*)(rowp + bj * HALF) = w; } }
    }
};

struct EpiSwiGlu {
    static constexpr bool PERM = true, AFTER_DRAIN = false;
    bf16_t* O; const float* rss;
    __device__ __forceinline__ void operator()(const f32x4 (&acc)[2][2][4][2], const Unit& u, int wr_, int wc_, int fr_, int fq_) const {
        EPI_LANE_IDS();
        typedef unsigned u32x2v __attribute__((ext_vector_type(2)));
        const int row0 = u.pm * BM + wr * 64 + fr, col0 = u.pn * 128 + wc * 16 + 4 * fq;
#pragma unroll
        for (int ai = 0; ai < 2; ++ai)
#pragma unroll
            for (int m = 0; m < 4; ++m) { bf16_t* rowp = O + (size_t)(row0 + ai * HALF + m * 16) * 512 + col0; const float rs = rss[row0 + ai * HALF + m * 16];
#pragma unroll
                for (int bj = 0; bj < 2; ++bj) { const f32x4 g = acc[ai][bj][m][0] * rs, v = acc[ai][bj][m][1] * rs; float h[4];
#pragma unroll
                    for (int i = 0; i < 4; ++i) h[i] = g[i] * __builtin_amdgcn_rcpf(1.0f + __builtin_amdgcn_exp2f(-1.4426950408889634f * g[i])) * v[i];
                    u32x2v w; w.x = cvt_pk_bf16(h[0], h[1]); w.y = cvt_pk_bf16(h[2], h[3]); *(u32x2v*)(rowp + bj * 64) = w; } }
    }
};
struct GroupOrder {
    int nM, nN, nwg, G, c; const int* tile_e;
    __device__ void init(int nM_, int nN_, int G_, int c_, const int* te) { nM = nM_; nN = nN_; nwg = nM * nN; G = G_; c = c_; tile_e = te; }
    __device__ bool next(int i, Unit& u) const {
        const long L = (long)i * G + c; if (L >= nwg) return false;
        int wgid = (int)L; { const int q = nwg / NXCD, r = nwg % NXCD, xcd = wgid % NXCD, off = wgid / NXCD; wgid = (xcd < r ? xcd * (q + 1) : r * (q + 1) + (xcd - r) * q) + off; }
        const int nig = WGM * nN, gid = wgid / nig, fm = gid * WGM, gsz = (nM - fm) < WGM ? (nM - fm) : WGM;
        u.pm = fm + ((wgid % nig) % gsz); u.pn = (wgid % nig) / gsz; u.be = __builtin_amdgcn_readfirstlane(tile_e[u.pm]); return true;
    }
    __device__ __forceinline__ void a_ready(const Unit&) const {}
    __device__ __forceinline__ void done(const Unit&) const {}
};

struct EpiPleGateNorm {
    static constexpr bool PERM = false, AFTER_DRAIN = false;
    float* io; const bf16_t* hb; const float* ra; const bf16_t* pp; const float* bias; const float* gfin; float* xs; unsigned* cnt; PG8_LAS unsigned char* scr; int ldc;
    __device__ __forceinline__ void operator()(f32x4 (&acc)[2][2][4][2], const Unit& u, int wr_, int wc_, int fr_, int fq_) const {
        typedef unsigned u32x2v __attribute__((ext_vector_type(2)));
        int t__ = threadIdx.x; asm volatile("" : "+v"(t__)); const int tid = t__, wid = __builtin_amdgcn_readfirstlane(tid >> 6), lane = tid & 63, wr = wid >> 2, wc = wid & 3, fr = lane & 15, fq = lane >> 4; (void)wr_; (void)wc_; (void)fr_; (void)fq_;
        PG8_LAS float* P = (PG8_LAS float*)scr; PG8_LAS float* S = (PG8_LAS float*)(scr + 4096); PG8_LAS unsigned* flag = (PG8_LAS unsigned*)(scr + 5120);
        const int col0 = u.pn * BM + wc * 32 + 4 * fq;
#pragma unroll
        for (int ai = 0; ai < 2; ++ai)
#pragma unroll
            for (int m = 0; m < 4; ++m) { const int rl = ai * HALF + wr * 64 + m * 16 + fr; const size_t off = (size_t)(u.pm * BM + rl) * ldc + col0; float q = 0.f; const float rr_ = ra[u.pm * BM + rl];
#pragma unroll
                for (int bj = 0; bj < 2; ++bj)
#pragma unroll
                    for (int n = 0; n < 2; ++n) { const size_t o = off + bj * HALF + n * 16; const u32x2v hw = *(const u32x2v*)(hb + o); const u32x2v pw = *(const u32x2v*)(pp + o);
                        const f32x4 h = {__builtin_bit_cast(float, hw.x << 16), __builtin_bit_cast(float, hw.x & 0xffff0000u), __builtin_bit_cast(float, hw.y << 16), __builtin_bit_cast(float, hw.y & 0xffff0000u)};
                        const f32x4 bv = *(const f32x4*)(bias + col0 + bj * HALF + n * 16); const f32x4 z = acc[ai][bj][m][n] * rr_ + bv; f32x4 r;
                        r[0] = h[0] + __builtin_bit_cast(float, pw.x << 16) * __builtin_amdgcn_rcpf(1.0f + __builtin_amdgcn_exp2f(-1.4426950408889634f * z[0])); r[1] = h[1] + __builtin_bit_cast(float, pw.x & 0xffff0000u) * __builtin_amdgcn_rcpf(1.0f + __builtin_amdgcn_exp2f(-1.4426950408889634f * z[1]));
                        r[2] = h[2] + __builtin_bit_cast(float, pw.y << 16) * __builtin_amdgcn_rcpf(1.0f + __builtin_amdgcn_exp2f(-1.4426950408889634f * z[2])); r[3] = h[3] + __builtin_bit_cast(float, pw.y & 0xffff0000u) * __builtin_amdgcn_rcpf(1.0f + __builtin_amdgcn_exp2f(-1.4426950408889634f * z[3]));
                        acc[ai][bj][m][n] = r; q += (r[0] * r[0] + r[1] * r[1]) + (r[2] * r[2] + r[3] * r[3]); }
                q += lx::xf<16>(q); { auto rr = __builtin_amdgcn_permlane32_swap(__float_as_uint(q), __float_as_uint(q), false, false); q = __uint_as_float(rr[0]) + __uint_as_float(rr[1]); }
                if (fq == 0) P[rl * 4 + wc] = q; }
        asm volatile("s_waitcnt lgkmcnt(0)\n\ts_barrier" ::: "memory");
        unsigned* cw = cnt + 64 * u.pm;
        if (tid < 256) { const float tot = (P[tid * 4] + P[tid * 4 + 1]) + (P[tid * 4 + 2] + P[tid * 4 + 3]);
            __hip_atomic_store(xs + (size_t)(u.pm * BM + tid) * 4 + u.pn, tot, __ATOMIC_RELAXED, __HIP_MEMORY_SCOPE_AGENT);
            asm volatile("s_waitcnt vmcnt(0)" ::: "memory");
            if (lane == 0) __hip_atomic_fetch_add(cw, 1u, __ATOMIC_RELAXED, __HIP_MEMORY_SCOPE_AGENT); }
        if (wid == 0) { unsigned sp = 0;
            while ((unsigned)__builtin_amdgcn_readfirstlane(__hip_atomic_load(cw, __ATOMIC_RELAXED, __HIP_MEMORY_SCOPE_AGENT)) < 16u && ++sp < (1u << 24)) __builtin_amdgcn_s_sleep(2);
            __builtin_amdgcn_fence(__ATOMIC_ACQUIRE, "agent");
            if (lane == 0) flag[0] = sp; }
        asm volatile("s_waitcnt vmcnt(0) lgkmcnt(0)\n\ts_barrier" ::: "memory");
        if (tid < 256) { const float* sl = xs + (size_t)(u.pm * BM + tid) * 4; float s4[4];
#pragma unroll
            for (int t = 0; t < 4; ++t) s4[t] = __hip_atomic_load(sl + t, __ATOMIC_RELAXED, __HIP_MEMORY_SCOPE_AGENT);
            S[tid] = 1.0f / sqrtf(((s4[0] + s4[1]) + (s4[2] + s4[3])) * (1.0f / 1024.0f) + 1e-6f); }
        asm volatile("s_waitcnt lgkmcnt(0)\n\ts_barrier" ::: "memory");
#pragma unroll
        for (int ai = 0; ai < 2; ++ai)
#pragma unroll
            for (int m = 0; m < 4; ++m) { const int rl = ai * HALF + wr * 64 + m * 16 + fr; const size_t off = (size_t)(u.pm * BM + rl) * ldc + col0; const float rs = S[rl];
#pragma unroll
                for (int bj = 0; bj < 2; ++bj)
#pragma unroll
                    for (int n = 0; n < 2; ++n) { const f32x4 g = *(const f32x4*)(gfin + col0 + bj * HALF + n * 16); *(f32x4*)(io + off + bj * HALF + n * 16) = acc[ai][bj][m][n] * rs * g; } }
    }
};

struct EpiNull {
    static constexpr bool PERM = true, AFTER_DRAIN = false;
    __device__ __forceinline__ void operator()(const f32x4 (&acc)[2][2][4][2], const Unit&, int, int, int, int) const {
#pragma unroll
        for (int a = 0; a < 2; ++a)
#pragma unroll
            for (int b = 0; b < 2; ++b)
#pragma unroll
                for (int m = 0; m < 4; ++m) asm volatile("" :: "v"(acc[a][b][m][0]), "v"(acc[a][b][m][1]));
    }
};
template <class Epi, class Sched, bool ALIGN_EPI = false, bool SP2 = false, bool GATHER = false>
__device__ __forceinline__ void gemm_phase(PG8_LAS unsigned char* lds, const Gemm g, const Sched& S, const Epi& E) {
    int tid_ = threadIdx.x; asm volatile("" : "+v"(tid_));
    const int tid = tid_, wid = __builtin_amdgcn_readfirstlane(tid >> 6), lane = tid & 63, wr = wid >> 2, wc = wid & 3, fr = lane & 15, fq = lane >> 4;
    const int K = g.K, nt = K / BK;
    unsigned voffA[2], voffB[2];
#pragma unroll
    for (int i = 0; i < 2; ++i) { int R, C; stage_rc(tid * 16 + i * 8192, R, C); const int Rb = Epi::PERM ? ((R & ~31) + perm32(R & 31)) : R;
        voffA[i] = (unsigned)(R * K + C) * 2u; voffB[i] = (unsigned)(Rb * K + C) * 2u; }
    static_assert(!GATHER || SP2, "GATHER is wired into the two-super-phase loop only");
    unsigned gC[2][2] = {{0u, 0u}, {0u, 0u}}, gN[2][2] = {{0u, 0u}, {0u, 0u}};
#define PG8_GOFF(dst, u_) do { _Pragma("unroll") for (int h_ = 0; h_ < 2; ++h_) _Pragma("unroll") for (int i_ = 0; i_ < 2; ++i_) { int R_, C_; stage_rc(tid * 16 + i_ * 8192, R_, C_); \
        dst[h_][i_] = (unsigned)g.rowidx[(u_).pm * BM + h_ * HALF + R_] * (unsigned)(K * 2) + (unsigned)(C_ * 2); } } while (0)
    const size_t kstep = (size_t)(BK * 2);
    const size_t hstep = (size_t)HALF * K * 2;
    const size_t hstepA = GATHER ? 0 : hstep;
    const size_t tstep = 2 * hstep;
    const unsigned ldsw = (unsigned)wid * 1024u;
    const int aoff = lds_byte(wr * 64 + fr, fq * 8), boff = lds_byte(wc * 32 + fr, fq * 8);
#define PG8_SA(b, h) (((b) * 2 + (h)) * HTB)
#define PG8_SB(b, h) ((4 + (b) * 2 + (h)) * HTB)
#define PG8_STAGE(bufoff, gbase, voff) do { _Pragma("unroll") for (int _i = 0; _i < 2; ++_i) \
        __builtin_amdgcn_global_load_lds((const unsigned*)((const char*)(gbase) + (voff)[_i]), (PG8_LAS unsigned*)(lds + (bufoff) + ldsw + _i * 8192), 16, 0, 0); } while (0)
#define PG8_LDA(dst, b, h) do { _Pragma("unroll") for (int m = 0; m < 4; ++m) _Pragma("unroll") for (int k = 0; k < 2; ++k) dst[m][k] = *(const PG8_LAS bf16x8*)(lds + PG8_SA(b, h) + aoff + m * 2048 + k * 1024); } while (0)
#define PG8_LDB(dst, b, h) do { _Pragma("unroll") for (int n = 0; n < 2; ++n) _Pragma("unroll") for (int k = 0; k < 2; ++k) dst[n][k] = *(const PG8_LAS bf16x8*)(lds + PG8_SB(b, h) + boff + n * 2048 + k * 1024); } while (0)
#define PG8_MMA(ai, bj, At, Bt) do { __builtin_amdgcn_s_setprio(1); _Pragma("unroll") for (int m = 0; m < 4; ++m) _Pragma("unroll") for (int n = 0; n < 2; ++n) _Pragma("unroll") for (int k = 0; k < 2; ++k) \
        acc[ai][bj][m][n] = __builtin_amdgcn_mfma_f32_16x16x32_bf16(Bt[n][k], At[m][k], acc[ai][bj][m][n], 0, 0, 0); __builtin_amdgcn_s_setprio(0); } while (0)
#define PG8_WAIT_V(n) asm volatile("s_waitcnt vmcnt(" #n ")" ::: "memory")
#define PG8_WAIT_L(n) asm volatile("s_waitcnt lgkmcnt(" #n ")" ::: "memory")
#define PG8_BAR __builtin_amdgcn_s_barrier()
#define PG8_SCHED __builtin_amdgcn_sched_barrier(0)
    Unit cur, nxt; int ui = 0;
    if (!S.next(0, cur)) return;
    f32x4 acc[2][2][4][2];
#pragma unroll
    for (int a = 0; a < 2; ++a)
#pragma unroll
        for (int b = 0; b < 2; ++b)
#pragma unroll
            for (int m = 0; m < 4; ++m)
#pragma unroll
                for (int n = 0; n < 2; ++n) acc[a][b][m][n] = (f32x4){0.f, 0.f, 0.f, 0.f};
    bf16x8 At[4][2], B0[2][2], B1[2][2];
    const char* cA = (const char*)g.A + (GATHER ? (size_t)0 : (size_t)cur.pm * tstep); if (GATHER) PG8_GOFF(gC, cur);
    const char* cB = (const char*)g.Bt + (size_t)cur.pn * tstep + (size_t)cur.be * g.bstride;
    S.a_ready(cur);
    if constexpr (SP2) {
        PG8_STAGE(PG8_SB(0, 0), cB, voffB); PG8_STAGE(PG8_SB(0, 1), cB + hstep, voffB); PG8_STAGE(PG8_SA(0, 0), cA, (GATHER ? gC[0] : voffA)); PG8_STAGE(PG8_SA(0, 1), cA + hstepA, (GATHER ? gC[1] : voffA));
        if (wr == 1) PG8_BAR;
        PG8_WAIT_V(2); PG8_BAR;
        PG8_STAGE(PG8_SB(1, 0), cB + kstep, voffB); PG8_STAGE(PG8_SA(1, 0), cA + kstep, (GATHER ? gC[0] : voffA)); PG8_STAGE(PG8_SB(1, 1), cB + hstep + kstep, voffB);
        PG8_WAIT_V(6); PG8_BAR;
    } else {
        PG8_STAGE(PG8_SB(0, 0), cB, voffB); PG8_STAGE(PG8_SA(0, 0), cA, voffA); PG8_STAGE(PG8_SB(0, 1), cB + hstep, voffB); PG8_STAGE(PG8_SA(0, 1), cA + hstep, voffA);
        if (wr == 1) PG8_BAR;
        PG8_WAIT_V(4); PG8_BAR;
        PG8_STAGE(PG8_SB(1, 0), cB + kstep, voffB); PG8_STAGE(PG8_SA(1, 0), cA + kstep, voffA); PG8_STAGE(PG8_SB(1, 1), cB + hstep + kstep, voffB);
        PG8_WAIT_V(6); PG8_BAR;
    }
    for (;;) {
        const bool has_next = S.next(ui + 1, nxt);
        if (GATHER) { if (has_next) PG8_GOFF(gN, nxt); else { gN[0][0] = gC[0][0]; gN[0][1] = gC[0][1]; gN[1][0] = gC[1][0]; gN[1][1] = gC[1][1]; } }
        const char* nA = (has_next && !GATHER) ? (const char*)g.A + (size_t)nxt.pm * tstep : cA; const char* nB = has_next ? (const char*)g.Bt + (size_t)nxt.pn * tstep + (size_t)nxt.be * g.bstride : cB;
        for (int t = 0; t < nt; t += 2) {
            const bool last = (t == nt - 2);
            const char* a1 = cA + (size_t)(t + 1) * kstep;
            const char* a2 = last ? nA : cA + (size_t)(t + 2) * kstep; const char* b2 = last ? nB : cB + (size_t)(t + 2) * kstep;
            const char* a3 = a2 + kstep; const char* b3 = b2 + kstep;
            if (last && has_next) S.a_ready(nxt);
            if constexpr (SP2) {
            unsigned g2[2][2];
            if (GATHER) { g2[0][0] = last ? gN[0][0] : gC[0][0]; g2[0][1] = last ? gN[0][1] : gC[0][1]; g2[1][0] = last ? gN[1][0] : gC[1][0]; g2[1][1] = last ? gN[1][1] : gC[1][1]; }
            PG8_LDB(B0, 0, 0); PG8_LDB(B1, 0, 1); PG8_SCHED; PG8_LDA(At, 0, 0); PG8_STAGE(PG8_SA(1, 1), a1 + hstepA, (GATHER ? gC[1] : voffA));
            PG8_WAIT_V(8); PG8_WAIT_L(0); PG8_BAR; PG8_MMA(0, 0, At, B0); PG8_MMA(0, 1, At, B1); PG8_BAR; PG8_SCHED;
            PG8_LDA(At, 0, 1); PG8_STAGE(PG8_SB(0, 0), b2, voffB); PG8_STAGE(PG8_SB(0, 1), b2 + hstep, voffB); PG8_STAGE(PG8_SA(0, 0), a2, (GATHER ? g2[0] : voffA));
            PG8_WAIT_V(8); PG8_WAIT_L(0); PG8_BAR; PG8_MMA(1, 0, At, B0); PG8_MMA(1, 1, At, B1); PG8_BAR; PG8_SCHED;
            PG8_LDB(B0, 1, 0); PG8_LDB(B1, 1, 1); PG8_SCHED; PG8_LDA(At, 1, 0); PG8_STAGE(PG8_SA(0, 1), a2 + hstepA, (GATHER ? g2[1] : voffA));
            PG8_WAIT_V(8); PG8_WAIT_L(0); PG8_BAR; PG8_MMA(0, 0, At, B0); PG8_MMA(0, 1, At, B1); PG8_BAR; PG8_SCHED;
            PG8_LDA(At, 1, 1); PG8_STAGE(PG8_SB(1, 0), b3, voffB); PG8_STAGE(PG8_SB(1, 1), b3 + hstep, voffB); PG8_STAGE(PG8_SA(1, 0), a3, (GATHER ? g2[0] : voffA));
            PG8_WAIT_V(8); PG8_WAIT_L(0); PG8_BAR; PG8_MMA(1, 0, At, B0); PG8_MMA(1, 1, At, B1); PG8_BAR; PG8_SCHED;
            } else {
            PG8_LDB(B0, 0, 0); PG8_SCHED; PG8_LDA(At, 0, 0); PG8_STAGE(PG8_SA(1, 1), a1 + hstep, voffA);
            PG8_WAIT_L(8); PG8_BAR; PG8_WAIT_L(0); PG8_MMA(0, 0, At, B0); PG8_BAR; PG8_SCHED;
            PG8_LDB(B1, 0, 1); PG8_STAGE(PG8_SB(0, 0), b2, voffB);
            PG8_BAR; PG8_WAIT_L(0); PG8_MMA(0, 1, At, B1); PG8_BAR;
            PG8_LDA(At, 0, 1); PG8_STAGE(PG8_SA(0, 0), a2, voffA);
            PG8_BAR; PG8_WAIT_L(0); PG8_MMA(1, 0, At, B0); PG8_BAR; PG8_SCHED;
            PG8_STAGE(PG8_SB(0, 1), b2 + hstep, voffB);
            PG8_WAIT_V(6); PG8_BAR; PG8_MMA(1, 1, At, B1); PG8_BAR;
            PG8_LDB(B0, 1, 0); PG8_SCHED; PG8_LDA(At, 1, 0); PG8_STAGE(PG8_SA(0, 1), a2 + hstep, voffA);
            PG8_WAIT_L(8); PG8_BAR; PG8_WAIT_L(0); PG8_MMA(0, 0, At, B0); PG8_BAR; PG8_SCHED;
            PG8_LDB(B1, 1, 1); PG8_STAGE(PG8_SB(1, 0), b3, voffB);
            PG8_BAR; PG8_WAIT_L(0); PG8_MMA(0, 1, At, B1); PG8_BAR;
            PG8_LDA(At, 1, 1); PG8_STAGE(PG8_SA(1, 0), a3, voffA);
            PG8_BAR; PG8_WAIT_L(0); PG8_MMA(1, 0, At, B0); PG8_BAR; PG8_SCHED;
            PG8_STAGE(PG8_SB(1, 1), b3 + hstep, voffB);
            PG8_WAIT_V(6); PG8_BAR; PG8_MMA(1, 1, At, B1); PG8_BAR;
            }
        }
        if constexpr (ALIGN_EPI) { if (wr == 0) PG8_BAR; }
        if constexpr (!Epi::AFTER_DRAIN) { E(acc, cur, wr, wc, fr, fq); S.done(cur); }
        if (!has_next) break;
#pragma unroll
        for (int a = 0; a < 2; ++a)
#pragma unroll
            for (int b = 0; b < 2; ++b)
#pragma unroll
                for (int m = 0; m < 4; ++m)
#pragma unroll
                    for (int n = 0; n < 2; ++n) acc[a][b][m][n] = (f32x4){0.f, 0.f, 0.f, 0.f};
        cur = nxt; cA = nA; cB = nB; ++ui; if (GATHER) { gC[0][0] = gN[0][0]; gC[0][1] = gN[0][1]; gC[1][0] = gN[1][0]; gC[1][1] = gN[1][1]; }
        if constexpr (ALIGN_EPI) { if (wr == 1) PG8_BAR; }
    }
    PG8_WAIT_V(0);
    if constexpr (!ALIGN_EPI) { if (wr == 0) PG8_BAR; }
    PG8_BAR;
    if constexpr (Epi::AFTER_DRAIN) { E.fused(acc, cur, wr, wc, fr, fq, lds, wid, lane); S.done(cur); }
#undef PG8_GOFF
#undef PG8_SA
#undef PG8_SB
#undef PG8_STAGE
#undef PG8_LDA
#undef PG8_LDB
#undef PG8_MMA
#undef PG8_WAIT_V
#undef PG8_WAIT_L
#undef PG8_BAR
#undef PG8_SCHED
}
}
namespace at {
using bf16x8 = __attribute__((ext_vector_type(8))) short;
using s16x4 = __attribute__((ext_vector_type(4))) short;
using f32x16 = __attribute__((ext_vector_type(16))) float;
using f32x4 = __attribute__((ext_vector_type(4))) float;
using u32x4 = __attribute__((ext_vector_type(4))) unsigned;
typedef unsigned short bf16;
constexpr int PITCH = 2816;
constexpr int NSLOT = 4, SLOTB = 8192;
constexpr int NVSLOT = 5;
constexpr int LDS_K = 0, LDS_V = NSLOT * SLOTB, LDS_WS = LDS_V + NVSLOT * SLOTB, LDS_CK = LDS_WS + 8 * 256, LDS_END = LDS_CK + 16384;
constexpr float NEG = -1e30f;
constexpr float THR = 8.0f;
typedef __attribute__((address_space(3))) const char* lds_cptr;
typedef short v4i16_t __attribute__((ext_vector_type(4)));
__device__ __forceinline__ int crow(int r, int hi) { return (r & 3) + 8 * (r >> 2) + 4 * hi; }
__device__ __forceinline__ void glds16(const void* gsrc, unsigned lds_dst) { unsigned keep;
    asm volatile("s_mov_b32 %0, m0\n\ts_mov_b32 m0, %2\n\ts_nop 0\n\tglobal_load_lds_dwordx4 %1, off\n\ts_mov_b32 m0, %0" : "=&s"(keep) : "v"(gsrc), "s"(lds_dst) : "memory"); }
typedef float f32x2_t __attribute__((ext_vector_type(2))); typedef __bf16 bf16x2_t __attribute__((ext_vector_type(2)));
__device__ __forceinline__ unsigned cvtpk(float lo, float hi) { f32x2_t v = {lo, hi}; bf16x2_t b = __builtin_convertvector(v, bf16x2_t); return __builtin_bit_cast(unsigned, b); }
__device__ __forceinline__ s16x4 vtr(lds_cptr p) { return __builtin_bit_cast(s16x4, __builtin_amdgcn_ds_read_tr16_b64_v4i16((__attribute__((address_space(3))) v4i16_t*)p)); }
#define AT_WAIT_BAR(N) asm volatile("s_waitcnt vmcnt(" #N ") lgkmcnt(0)\n\ts_barrier" ::: "memory")

enum { M_FOX = 0, M_SEL = 1, M_WIN = 2 };
struct UnitIO {
    const bf16* Qw;
    const bf16* Kh;
    const bf16* Vh;
    int t_hi, t_lo;
    int t_first;
    int qpos;
    unsigned long long selm;
    int win;
    float sbound, c2q0;
    float cq;
};
template <int MODE, bool FAST, int ABL = 0>
__device__ __forceinline__ void attn_tiles(const UnitIO& U, char* shm, f32x16 (&o)[2], float& l_out, f32x16& osum) {
    int tid_ = threadIdx.x; asm volatile("" : "+v"(tid_));
    const int tid = tid_, lane = tid & 63, r32 = lane & 31, hi = lane >> 5; const int wid = __builtin_amdgcn_readfirstlane(tid >> 6);
    const unsigned lds0 = (unsigned)(uintptr_t)shm;
    float* wsf = (float*)(shm + LDS_WS) + wid * 64;
    const bf16* ksrc = U.Kh + (long)lane * PITCH + wid * 8;
    const bf16* vsrc = U.Vh + (long)(16 * (wid & 3) + (lane >> 2)) * PITCH + (wid >> 2) * 32 + (lane & 3) * 8;
    const unsigned kdst = lds0 + LDS_K + wid * 1024, vdst = lds0 + LDS_V + wid * 1024;
#define AT_DMA(t, kslot, vslot) do { glds16(ksrc + (long)(t) * 64 * PITCH, (unsigned)__builtin_amdgcn_readfirstlane(kdst + (kslot) * SLOTB)); \
                                     glds16(vsrc + (long)(t) * 64 * PITCH, (unsigned)__builtin_amdgcn_readfirstlane(vdst + (vslot) * SLOTB)); } while (0)
    const lds_cptr shm3 = (lds_cptr)shm;
    const lds_cptr kp0 = shm3 + LDS_K + hi * 1024 + r32 * 16;
    const lds_cptr vp0 = shm3 + LDS_V + ((lane >> 4) & 1) * 32 + (lane & 3) * 8 + (4 * hi + ((lane & 15) >> 2)) * 64;
    const int n = U.t_hi - U.t_lo + 1;
    AT_DMA(U.t_hi, 0, 0); if (n > 1) AT_DMA(U.t_hi - 1, 1, 1); if (n > 2) AT_DMA(U.t_hi - 2, 2, 2);
    bf16x8 qr[4];
#pragma unroll
    for (int d0 = 0; d0 < 4; ++d0) qr[d0] = *reinterpret_cast<const bf16x8*>(&U.Qw[(long)r32 * PITCH + d0 * 16 + hi * 8]);
    float mref = 0.f, l = 0.f; o[0] = f32x16{}; o[1] = f32x16{};
    f32x16 negm = f32x16{};
    if (FAST && MODE == M_FOX) {
#pragma unroll
        for (int r = 0; r < 16; ++r) negm[r] = U.cq; }
    osum = f32x16{};
    const bool lag = FAST && ABL == 0 && wid >= 4;
    u32x4 pw0, pw1, pw2, pw3; bool pend = false; int vslot_pend = 0;
#define AT_PV(vslot_) do { const lds_cptr vp = vp0 + (vslot_) * SLOTB; \
        _Pragma("unroll") for (int d0 = 0; d0 < 2; ++d0) { s16x4 lo[4], hh[4]; \
            _Pragma("unroll") for (int ks = 0; ks < 4; ++ks) { lo[ks] = vtr(vp + d0 * 4096 + ks * 1024); hh[ks] = vtr(vp + d0 * 4096 + ks * 1024 + 512); } \
            o[d0] = __builtin_amdgcn_mfma_f32_32x32x16_bf16(__builtin_bit_cast(bf16x8, pw0), AT_PK(0), o[d0], 0, 0, 0); \
            o[d0] = __builtin_amdgcn_mfma_f32_32x32x16_bf16(__builtin_bit_cast(bf16x8, pw1), AT_PK(1), o[d0], 0, 0, 0); \
            o[d0] = __builtin_amdgcn_mfma_f32_32x32x16_bf16(__builtin_bit_cast(bf16x8, pw2), AT_PK(2), o[d0], 0, 0, 0); \
            o[d0] = __builtin_amdgcn_mfma_f32_32x32x16_bf16(__builtin_bit_cast(bf16x8, pw3), AT_PK(3), o[d0], 0, 0, 0); } } while (0)
#define AT_PK(k) (bf16x8){lo[k][0], lo[k][1], lo[k][2], lo[k][3], hh[k][0], hh[k][1], hh[k][2], hh[k][3]}
#define AT_ONES() do { const bf16x8 ones_ = (bf16x8){0x3F80, 0x3F80, 0x3F80, 0x3F80, 0x3F80, 0x3F80, 0x3F80, 0x3F80}; \
        osum = __builtin_amdgcn_mfma_f32_32x32x16_bf16(__builtin_bit_cast(bf16x8, pw0), ones_, osum, 0, 0, 0); osum = __builtin_amdgcn_mfma_f32_32x32x16_bf16(__builtin_bit_cast(bf16x8, pw1), ones_, osum, 0, 0, 0); \
        osum = __builtin_amdgcn_mfma_f32_32x32x16_bf16(__builtin_bit_cast(bf16x8, pw2), ones_, osum, 0, 0, 0); osum = __builtin_amdgcn_mfma_f32_32x32x16_bf16(__builtin_bit_cast(bf16x8, pw3), ones_, osum, 0, 0, 0); } while (0)
    int kslot = 0, vslot = 0;
    for (int i = 0; i < n; ++i) {
        const int t = U.t_hi - i;
        if (i + 2 < n) AT_WAIT_BAR(4); else if (i + 1 < n) AT_WAIT_BAR(2); else AT_WAIT_BAR(0);
        if (i + 3 < n) { const int k3 = (kslot + 3) & 3, v3 = vslot >= 2 ? vslot - 2 : vslot + 3; AT_DMA(t - 3, k3, v3); }
        if (pend) { AT_PV(vslot_pend); if (FAST) AT_ONES(); pend = false; }
        if (FAST && ABL != 1 && t <= U.t_first) {
            const lds_cptr kp = kp0 + kslot * SLOTB;
            f32x16 p0, p1;
#pragma unroll
            for (int d0 = 0; d0 < 4; ++d0) {
                const bf16x8 b0 = *(const __attribute__((address_space(3))) bf16x8*)(kp + d0 * 2048);
                const bf16x8 b1 = *(const __attribute__((address_space(3))) bf16x8*)(kp + d0 * 2048 + 512);
                if (d0 == 0) { p0 = __builtin_amdgcn_mfma_f32_32x32x16_bf16(b0, qr[0], negm, 0, 0, 0); p1 = __builtin_amdgcn_mfma_f32_32x32x16_bf16(b1, qr[0], negm, 0, 0, 0); }
                else { p0 = __builtin_amdgcn_mfma_f32_32x32x16_bf16(b0, qr[d0], p0, 0, 0, 0); p1 = __builtin_amdgcn_mfma_f32_32x32x16_bf16(b1, qr[d0], p1, 0, 0, 0); }
            }
            if (ABL == 2) { asm volatile("" :: "v"(p0), "v"(p1)); } else {
            if (MODE == M_FOX) {
                const __attribute__((address_space(3))) f32x4* ck = (const __attribute__((address_space(3))) f32x4*)(shm3 + LDS_CK + (64 * t + 4 * hi) * 4);
#pragma unroll
                for (int a = 0; a < 4; ++a) { const f32x4 c0 = ck[2 * a], c1 = ck[2 * a + 8];
#pragma unroll
                    for (int j = 0; j < 4; ++j) { p0[4 * a + j] -= c0[j]; p1[4 * a + j] -= c1[j]; } }
            }
            if (t == U.t_first) {
                const int kb = 64 * t + 4 * hi;
#pragma unroll
                for (int r = 0; r < 16; ++r) { const int kv = kb + (r & 3) + 8 * (r >> 2); if (kv > U.qpos) p0[r] = NEG; if (kv + 32 > U.qpos) p1[r] = NEG; }
            }
            if (MODE == M_WIN && t == U.t_lo) {
                const int kb = 64 * t + 4 * hi, lim = U.qpos - U.win;
#pragma unroll
                for (int r = 0; r < 16; ++r) { const int kv = kb + (r & 3) + 8 * (r >> 2); if (kv <= lim) p0[r] = NEG; if (kv + 32 <= lim) p1[r] = NEG; }
            }
#pragma unroll
            for (int r = 0; r < 16; ++r) { p0[r] = __builtin_amdgcn_exp2f(p0[r]); p1[r] = __builtin_amdgcn_exp2f(p1[r]); }
            pw0 = (u32x4){cvtpk(p0[0], p0[1]), cvtpk(p0[2], p0[3]), cvtpk(p0[4], p0[5]), cvtpk(p0[6], p0[7])};
            pw1 = (u32x4){cvtpk(p0[8], p0[9]), cvtpk(p0[10], p0[11]), cvtpk(p0[12], p0[13]), cvtpk(p0[14], p0[15])};
            pw2 = (u32x4){cvtpk(p1[0], p1[1]), cvtpk(p1[2], p1[3]), cvtpk(p1[4], p1[5]), cvtpk(p1[6], p1[7])};
            pw3 = (u32x4){cvtpk(p1[8], p1[9]), cvtpk(p1[10], p1[11]), cvtpk(p1[12], p1[13]), cvtpk(p1[14], p1[15])};
            if (MODE == M_SEL) { const bool sel = (U.selm >> t) & 1ull;
#pragma unroll
                for (int j = 0; j < 4; ++j) { pw0[j] = sel ? pw0[j] : 0u; pw1[j] = sel ? pw1[j] : 0u; pw2[j] = sel ? pw2[j] : 0u; pw3[j] = sel ? pw3[j] : 0u; } }
            if (ABL == 3) { asm volatile("" :: "v"(pw0), "v"(pw1), "v"(pw2), "v"(pw3)); } else {
            if (lag) { pend = true; vslot_pend = vslot; } else { AT_PV(vslot); AT_ONES(); }
            } }
        }
        if (!FAST && t <= U.t_first) {
        const lds_cptr kp = kp0 + kslot * SLOTB;
        const f32x16& cinit = negm;
        f32x16 p0, p1;
#pragma unroll
        for (int d0 = 0; d0 < 4; ++d0) {
            const bf16x8 b0 = *(const __attribute__((address_space(3))) bf16x8*)(kp + d0 * 2048);
            const bf16x8 b1 = *(const __attribute__((address_space(3))) bf16x8*)(kp + d0 * 2048 + 512);
            if (d0 == 0) { p0 = __builtin_amdgcn_mfma_f32_32x32x16_bf16(b0, qr[0], cinit, 0, 0, 0); p1 = __builtin_amdgcn_mfma_f32_32x32x16_bf16(b1, qr[0], cinit, 0, 0, 0); }
            else { p0 = __builtin_amdgcn_mfma_f32_32x32x16_bf16(b0, qr[d0], p0, 0, 0, 0); p1 = __builtin_amdgcn_mfma_f32_32x32x16_bf16(b1, qr[d0], p1, 0, 0, 0); }
        }
        if (MODE == M_SEL) { const bool sel = (U.selm >> t) & 1ull;
#pragma unroll
            for (int r = 0; r < 16; ++r) { p0[r] = sel ? p0[r] : NEG; p1[r] = sel ? p1[r] : NEG; } }
        if (MODE == M_FOX) {
            const __attribute__((address_space(3))) f32x4* ck = (const __attribute__((address_space(3))) f32x4*)(shm3 + LDS_CK + (64 * t + 4 * hi) * 4);
#pragma unroll
            for (int a = 0; a < 4; ++a) { const f32x4 c0 = ck[2 * a], c1 = ck[2 * a + 8];
#pragma unroll
                for (int j = 0; j < 4; ++j) { p0[4 * a + j] -= c0[j]; p1[4 * a + j] -= c1[j]; } }
        }
        if (t == U.t_first) {
            const int kb = 64 * t + 4 * hi;
#pragma unroll
            for (int r = 0; r < 16; ++r) { const int kv = kb + (r & 3) + 8 * (r >> 2); if (kv > U.qpos) p0[r] = NEG; if (kv + 32 > U.qpos) p1[r] = NEG; }
        }
        if (MODE == M_WIN && t == U.t_lo) {
            const int kb = 64 * t + 4 * hi, lim = U.qpos - U.win;
#pragma unroll
            for (int r = 0; r < 16; ++r) { const int kv = kb + (r & 3) + 8 * (r >> 2); if (kv <= lim) p0[r] = NEG; if (kv + 32 <= lim) p1[r] = NEG; }
        }
        float rm = fmaxf(p0[0], p1[0]);
#pragma unroll
        for (int r = 1; r < 16; ++r) rm = fmaxf(rm, fmaxf(p0[r], p1[r]));
        { auto rr = __builtin_amdgcn_permlane32_swap(__float_as_uint(rm), __float_as_uint(rm), false, false); rm = fmaxf(__uint_as_float(rr[0]), __uint_as_float(rr[1])); }
        const bool first = (t == U.t_first);
        if (first || __any(rm > THR)) {
            const float dl = first ? rm : fmaxf(rm, 0.f); mref += dl;
#pragma unroll
            for (int r = 0; r < 16; ++r) { p0[r] -= dl; p1[r] -= dl; negm[r] = -mref; }
            if (!first) { const float f = __builtin_amdgcn_exp2f(-dl); l *= f; if (hi == 0) wsf[r32] = f;
                asm volatile("s_waitcnt lgkmcnt(0)" ::: "memory");
#pragma unroll
                for (int a = 0; a < 4; ++a) { const f32x4 fv = *(const f32x4*)(wsf + 8 * a + 4 * hi);
#pragma unroll
                    for (int j = 0; j < 4; ++j) { o[0][4 * a + j] *= fv[j]; o[1][4 * a + j] *= fv[j]; } }
            }
        }
        float sacc = 0.f;
#pragma unroll
        for (int r = 0; r < 16; ++r) { p0[r] = __builtin_amdgcn_exp2f(p0[r]); p1[r] = __builtin_amdgcn_exp2f(p1[r]); sacc += p0[r] + p1[r]; }
        l += sacc;
        pw0 = (u32x4){cvtpk(p0[0], p0[1]), cvtpk(p0[2], p0[3]), cvtpk(p0[4], p0[5]), cvtpk(p0[6], p0[7])};
        pw1 = (u32x4){cvtpk(p0[8], p0[9]), cvtpk(p0[10], p0[11]), cvtpk(p0[12], p0[13]), cvtpk(p0[14], p0[15])};
        pw2 = (u32x4){cvtpk(p1[0], p1[1]), cvtpk(p1[2], p1[3]), cvtpk(p1[4], p1[5]), cvtpk(p1[6], p1[7])};
        pw3 = (u32x4){cvtpk(p1[8], p1[9]), cvtpk(p1[10], p1[11]), cvtpk(p1[12], p1[13]), cvtpk(p1[14], p1[15])};
        if (lag) { pend = true; vslot_pend = vslot; } else { AT_PV(vslot); }
        }
        kslot = (kslot + 1) & 3; vslot = vslot == 4 ? 0 : vslot + 1;
    }
    if (pend) { AT_PV(vslot_pend); if (FAST) AT_ONES(); }
#undef AT_PV
#undef AT_ONES
#undef AT_PK
    asm volatile("s_waitcnt vmcnt(0) lgkmcnt(0)\n\ts_barrier" ::: "memory");
    l_out = l;
#undef AT_DMA
}
__device__ __forceinline__ void row_inv(float l, char* shm, float (&rli)[16]) {
    int tid_ = threadIdx.x; asm volatile("" : "+v"(tid_));
    const int lane = tid_ & 63, r32 = lane & 31, hi = lane >> 5; const int wid = __builtin_amdgcn_readfirstlane(tid_ >> 6);
    float* wsf = (float*)(shm + LDS_WS) + wid * 64;
    { auto rr = __builtin_amdgcn_permlane32_swap(__float_as_uint(l), __float_as_uint(l), false, false); l = __uint_as_float(rr[0]) + __uint_as_float(rr[1]); }
    if (hi == 0) wsf[32 + r32] = l;
    asm volatile("s_waitcnt lgkmcnt(0)" ::: "memory");
#pragma unroll
    for (int a = 0; a < 4; ++a) { const f32x4 lv = *(const f32x4*)(wsf + 32 + 8 * a + 4 * hi);
#pragma unroll
        for (int j = 0; j < 4; ++j) rli[4 * a + j] = lv[j] > 0.f ? 1.0f / lv[j] : 0.f; }
    asm volatile("s_waitcnt lgkmcnt(0)" ::: "memory");
}
}
namespace at {
constexpr int CMP_K = 0, CMP_V = 32768, CMP_IMP = LDS_CK, CMP_SELM = LDS_CK + 65536;
constexpr int KCP = 128;
__device__ __forceinline__ int imp_idx(int j, int q) { return j * 64 + (q ^ ((j >> 3) << 3)); }
__device__ __forceinline__ void cmp_scores(f32x16& p0, f32x16& p1, lds_cptr kp, const bf16x8 (&qr)[4], const f32x16& cinit, int tt, int hi, int nlim) {
#pragma unroll
    for (int d0 = 0; d0 < 4; ++d0) {
        const bf16x8 b0 = *(const __attribute__((address_space(3))) bf16x8*)(kp + d0 * 2048);
        const bf16x8 b1 = *(const __attribute__((address_space(3))) bf16x8*)(kp + d0 * 2048 + 512);
        if (d0 == 0) { p0 = __builtin_amdgcn_mfma_f32_32x32x16_bf16(b0, qr[0], cinit, 0, 0, 0); p1 = __builtin_amdgcn_mfma_f32_32x32x16_bf16(b1, qr[0], cinit, 0, 0, 0); }
        else { p0 = __builtin_amdgcn_mfma_f32_32x32x16_bf16(b0, qr[d0], p0, 0, 0, 0); p1 = __builtin_amdgcn_mfma_f32_32x32x16_bf16(b1, qr[d0], p1, 0, 0, 0); }
    }
    const int nb = 64 * tt + 4 * hi;
#pragma unroll
    for (int r = 0; r < 16; ++r) { const int n = nb + (r & 3) + 8 * (r >> 2); if (n > nlim) p0[r] = NEG; if (n + 32 > nlim) p1[r] = NEG; }
}
__device__ __forceinline__ void cmp_stage(const bf16* Qw, const bf16* Kc, const bf16* Vc, int c, int nsel, char* shm, f32x16 (&o)[2]) {
    int tid_ = threadIdx.x; asm volatile("" : "+v"(tid_));
    const int tid = tid_, lane = tid & 63, r32 = lane & 31, hi = lane >> 5; const int wid = __builtin_amdgcn_readfirstlane(tid >> 6);
    const unsigned lds0 = (unsigned)(uintptr_t)shm; const lds_cptr shm3 = (lds_cptr)shm;
    asm volatile("s_waitcnt lgkmcnt(0)\n\ts_barrier" ::: "memory");
    const int ntc = (4 * c + 2) / 64 + 1;
    const int tq = 64 * c + 32 * (wid & 1) + r32, nlim = tq >= 31 ? (tq - 31) >> 4 : -1;
    bf16x8 qr[4];
#pragma unroll
    for (int d0 = 0; d0 < 4; ++d0) qr[d0] = *reinterpret_cast<const bf16x8*>(&Qw[(long)r32 * PITCH + d0 * 16 + hi * 8]);
    float* slab = (float*)(shm + CMP_IMP) + (wid >> 1) * 4096; const int qloc = 32 * (wid & 1) + r32;
#ifdef PROBE_DUP
    for (int pr_ = 0; pr_ < (PROBE_DUP == 33 ? 2 : 1); ++pr_)
#endif
    {   if (PROBE_DUP == 33) asm volatile("s_waitcnt vmcnt(0) lgkmcnt(0)\n\ts_barrier" ::: "memory");
        const bf16* ksrc = Kc + (long)lane * KCP + wid * 8;
        const bf16* vsrc = Vc + (long)(16 * (wid & 3) + (lane >> 2)) * KCP + (wid >> 2) * 32 + (lane & 3) * 8;
        for (int tt = 0; tt < ntc; ++tt) { glds16(ksrc + (long)tt * 64 * KCP, (unsigned)__builtin_amdgcn_readfirstlane(lds0 + CMP_K + tt * SLOTB + wid * 1024));
                                           glds16(vsrc + (long)tt * 64 * KCP, (unsigned)__builtin_amdgcn_readfirstlane(lds0 + CMP_V + tt * SLOTB + wid * 1024)); }
        AT_WAIT_BAR(0);
    }
    const lds_cptr kp0 = shm3 + CMP_K + hi * 1024 + r32 * 16;
    const lds_cptr vp0 = shm3 + CMP_V + ((lane >> 4) & 1) * 32 + (lane & 3) * 8 + (4 * hi + ((lane & 15) >> 2)) * 64;
    float m = NEG, l = 0.f; const f32x16 zero = f32x16{};
#ifdef PROBE_DUP
    for (int pr_ = 0; pr_ < (PROBE_DUP == 30 ? 2 : 1); ++pr_)
#endif
    for (int tt = 0; tt < ntc; ++tt) {
        f32x16 p0, p1; cmp_scores(p0, p1, kp0 + tt * SLOTB, qr, zero, tt, hi, nlim);
        float rm = fmaxf(p0[0], p1[0]);
#pragma unroll
        for (int r = 1; r < 16; ++r) rm = fmaxf(rm, fmaxf(p0[r], p1[r]));
        { auto rr = __builtin_amdgcn_permlane32_swap(__float_as_uint(rm), __float_as_uint(rm), false, false); rm = fmaxf(__uint_as_float(rr[0]), __uint_as_float(rr[1])); }
        const float mn = fmaxf(m, rm); float s = 0.f;
#pragma unroll
        for (int r = 0; r < 16; ++r) s += __builtin_amdgcn_exp2f(p0[r] - mn) + __builtin_amdgcn_exp2f(p1[r] - mn);
        l = l * __builtin_amdgcn_exp2f(m - mn) + s; m = mn;
    }
    { auto rr = __builtin_amdgcn_permlane32_swap(__float_as_uint(l), __float_as_uint(l), false, false); l = __uint_as_float(rr[0]) + __uint_as_float(rr[1]); }
    const float rl = nlim >= 0 ? 1.0f / l : 0.f;
    f32x16 negm;
#pragma unroll
    for (int r = 0; r < 16; ++r) negm[r] = -m;
    o[0] = f32x16{}; o[1] = f32x16{}; float carry = 0.f;
    for (int tt = 0; tt < ntc; ++tt) {
        f32x16 p0, p1; cmp_scores(p0, p1, kp0 + tt * SLOTB, qr, negm, tt, hi, nlim);
#pragma unroll
        for (int r = 0; r < 16; ++r) { p0[r] = __builtin_amdgcn_exp2f(p0[r]) * rl; p1[r] = __builtin_amdgcn_exp2f(p1[r]) * rl; }
        {   float own[8], sp[8];
#pragma unroll
            for (int a = 0; a < 4; ++a) { sp[a] = 0.5f * p0[4 * a + 3]; sp[4 + a] = 0.5f * p1[4 * a + 3];
                own[a] = (p0[4 * a] + p0[4 * a + 1]) + (p0[4 * a + 2] + sp[a]); own[4 + a] = (p1[4 * a] + p1[4 * a + 1]) + (p1[4 * a + 2] + sp[4 + a]); }
            float rc[8];
#pragma unroll
            for (int k = 0; k < 8; ++k) rc[k] = lx::x32f(sp[k], hi != 0);
            if (hi) {
#pragma unroll
                for (int k = 0; k < 8; ++k) own[k] += rc[k];
            } else { own[0] += carry;
#pragma unroll
                for (int k = 0; k < 7; ++k) own[k + 1] += rc[k];
                carry = rc[7]; }
#pragma unroll
            for (int a = 0; a < 4; ++a) { slab[imp_idx(16 * tt + 2 * a + hi, qloc)] = own[a]; slab[imp_idx(16 * tt + 8 + 2 * a + hi, qloc)] = own[4 + a]; }
        }
        const lds_cptr vp = vp0 + tt * SLOTB;
        u32x4 pw0, pw1, pw2, pw3;
        pw0 = (u32x4){cvtpk(p0[0], p0[1]), cvtpk(p0[2], p0[3]), cvtpk(p0[4], p0[5]), cvtpk(p0[6], p0[7])};
        pw1 = (u32x4){cvtpk(p0[8], p0[9]), cvtpk(p0[10], p0[11]), cvtpk(p0[12], p0[13]), cvtpk(p0[14], p0[15])};
        pw2 = (u32x4){cvtpk(p1[0], p1[1]), cvtpk(p1[2], p1[3]), cvtpk(p1[4], p1[5]), cvtpk(p1[6], p1[7])};
        pw3 = (u32x4){cvtpk(p1[8], p1[9]), cvtpk(p1[10], p1[11]), cvtpk(p1[12], p1[13]), cvtpk(p1[14], p1[15])};
#pragma unroll
        for (int d0 = 0; d0 < 2; ++d0) {
            s16x4 lo[4], hh[4];
#pragma unroll
            for (int ks = 0; ks < 4; ++ks) { lo[ks] = vtr(vp + d0 * 4096 + ks * 1024); hh[ks] = vtr(vp + d0 * 4096 + ks * 1024 + 512); }
#define AT_PK(k) (bf16x8){lo[k][0], lo[k][1], lo[k][2], lo[k][3], hh[k][0], hh[k][1], hh[k][2], hh[k][3]}
            o[d0] = __builtin_amdgcn_mfma_f32_32x32x16_bf16(__builtin_bit_cast(bf16x8, pw0), AT_PK(0), o[d0], 0, 0, 0);
            o[d0] = __builtin_amdgcn_mfma_f32_32x32x16_bf16(__builtin_bit_cast(bf16x8, pw1), AT_PK(1), o[d0], 0, 0, 0);
            o[d0] = __builtin_amdgcn_mfma_f32_32x32x16_bf16(__builtin_bit_cast(bf16x8, pw2), AT_PK(2), o[d0], 0, 0, 0);
            o[d0] = __builtin_amdgcn_mfma_f32_32x32x16_bf16(__builtin_bit_cast(bf16x8, pw3), AT_PK(3), o[d0], 0, 0, 0);
#undef AT_PK
        }
    }
    asm volatile("s_waitcnt lgkmcnt(0)\n\ts_barrier" ::: "memory");
#ifdef PROBE_DUP
    for (int pr_ = 0; pr_ < (PROBE_DUP == 32 ? 2 : 1); ++pr_)
#endif
    {   const int q = tid >> 3, part = tid & 7; const float* s0 = (const float*)(shm + CMP_IMP);
        const int t = 64 * c + q, cur = c;
        unsigned key[8];
#pragma unroll
        for (int i = 0; i < 8; ++i) { const int j = part * 8 + i; const int ix = imp_idx(j, q); const float imp = ((s0[ix] + s0[4096 + ix]) + s0[8192 + ix]) + s0[12288 + ix];
            const bool forced = (j == 0) || (j == cur) || (j == cur - 1);
            const float sc = imp + (forced ? 1e4f : 0.0f);
            key[i] = (j * 64 > t) ? (unsigned)(63 - j) : ((__float_as_uint(sc) & ~63u) | (unsigned)(63 - j)) + 64u; }
        unsigned sel8 = 0u;
        for (int s = 0; s < nsel; ++s) {
            unsigned best = key[0];
#pragma unroll
            for (int i = 1; i < 8; ++i) best = best > key[i] ? best : key[i];
            { const unsigned o1 = (unsigned)__builtin_amdgcn_update_dpp(0, (int)best, 0xB1, 0xF, 0xF, false); best = best > o1 ? best : o1; }
            { const unsigned o2 = (unsigned)__builtin_amdgcn_update_dpp(0, (int)best, 0x4E, 0xF, 0xF, false); best = best > o2 ? best : o2; }
            { const unsigned o3 = (unsigned)__builtin_amdgcn_update_dpp(0, (int)best, 0x141, 0xF, 0xF, false); best = best > o3 ? best : o3; }
#pragma unroll
            for (int i = 0; i < 8; ++i) { const bool hit = key[i] == best; sel8 |= hit ? (1u << i) : 0u; key[i] = hit ? 0u : key[i]; }
        }
        unsigned mlo = part < 4 ? sel8 << (8 * part) : 0u, mhi = part >= 4 ? sel8 << (8 * (part - 4)) : 0u;
        mlo |= (unsigned)__builtin_amdgcn_update_dpp(0, (int)mlo, 0xB1, 0xF, 0xF, false); mhi |= (unsigned)__builtin_amdgcn_update_dpp(0, (int)mhi, 0xB1, 0xF, 0xF, false);
        mlo |= (unsigned)__builtin_amdgcn_update_dpp(0, (int)mlo, 0x4E, 0xF, 0xF, false); mhi |= (unsigned)__builtin_amdgcn_update_dpp(0, (int)mhi, 0x4E, 0xF, 0xF, false);
        mlo |= (unsigned)__builtin_amdgcn_update_dpp(0, (int)mlo, 0x141, 0xF, 0xF, false); mhi |= (unsigned)__builtin_amdgcn_update_dpp(0, (int)mhi, 0x141, 0xF, 0xF, false);
        const unsigned long long mk = ((unsigned long long)mhi << 32) | mlo;
        if (part == 0) ((unsigned long long*)(shm + CMP_SELM))[q] = mk;
    }
    asm volatile("s_waitcnt lgkmcnt(0)\n\ts_barrier" ::: "memory");
}
}

namespace at {
__device__ __forceinline__ void compress_unit(const bf16* tokb  , int n0, int ncmp, const float* pe, const bf16* W1T, const bf16* W2T,
                                              const float* ropeb  , bf16* outb  , char* shm) {
    int tid_ = threadIdx.x; asm volatile("" : "+v"(tid_));
    const int tid = tid_, lane = tid & 63, r32 = lane & 31, hi = lane >> 5; const int wid = __builtin_amdgcn_readfirstlane(tid >> 6);
    const int cb = wid & 3, kh = wid >> 2;
    const int n = n0 + r32, nc = n < ncmp ? n : ncmp - 1;
    f32x16 acc = f32x16{};
    const bf16* wrow = W1T + (long)(32 * cb + r32) * 2048 + 8 * hi;
#pragma unroll 16
    for (int s = 64 * kh; s < 64 * kh + 64; ++s) {
        const int l = s >> 2, d = 16 * (s & 3) + 8 * hi;
        const u32x4 tv = *(const u32x4*)(tokb + (long)(16 * nc + l) * PITCH + d);
        const f32x4 pa = *(const f32x4*)(pe + l * 64 + d), pb = *(const f32x4*)(pe + l * 64 + d + 4);
        u32x4 av;
        av.x = cvtpk(__builtin_bit_cast(float, tv.x << 16) + pa[0], __builtin_bit_cast(float, tv.x & 0xffff0000u) + pa[1]);
        av.y = cvtpk(__builtin_bit_cast(float, tv.y << 16) + pa[2], __builtin_bit_cast(float, tv.y & 0xffff0000u) + pa[3]);
        av.z = cvtpk(__builtin_bit_cast(float, tv.z << 16) + pb[0], __builtin_bit_cast(float, tv.z & 0xffff0000u) + pb[1]);
        av.w = cvtpk(__builtin_bit_cast(float, tv.w << 16) + pb[2], __builtin_bit_cast(float, tv.w & 0xffff0000u) + pb[3]);
        const bf16x8 bv = *(const bf16x8*)(wrow + 16 * s);
        acc = __builtin_amdgcn_mfma_f32_32x32x16_bf16(__builtin_bit_cast(bf16x8, av), bv, acc, 0, 0, 0);
    }
    float* red = (float*)shm;
    unsigned short* hb = (unsigned short*)(shm + 16384);
    asm volatile("s_waitcnt lgkmcnt(0)\n\ts_barrier" ::: "memory");
    if (kh == 1) {
#pragma unroll
        for (int r = 0; r < 16; ++r) red[(cb * 16 + r) * 64 + lane] = acc[r];
    }
    asm volatile("s_waitcnt lgkmcnt(0)\n\ts_barrier" ::: "memory");
    if (kh == 0) {
#pragma unroll
        for (int r = 0; r < 16; ++r) { const float v = acc[r] + red[(cb * 16 + r) * 64 + lane]; const float hsl = v / (1.0f + __expf(-v));
            hb[crow(r, hi) * 136 + 32 * cb + r32] = (unsigned short)(cvtpk(hsl, 0.f) & 0xffffu); }
    }
    asm volatile("s_waitcnt lgkmcnt(0)\n\ts_barrier" ::: "memory");
    if (wid < 2) {
        f32x16 o2 = f32x16{};
#pragma unroll
        for (int s = 0; s < 8; ++s) { const bf16x8 a = *(const bf16x8*)(hb + r32 * 136 + 16 * s + 8 * hi); const bf16x8 b = *(const bf16x8*)(W2T + (long)(32 * wid + r32) * 128 + 16 * s + 8 * hi);
            o2 = __builtin_amdgcn_mfma_f32_32x32x16_bf16(a, b, o2, 0, 0, 0); }
#pragma unroll
        for (int r = 0; r < 16; ++r) { const int nn = n0 + crow(r, hi); float v = o2[r];
            if (ropeb != nullptr && wid == 0) {
                const float pv = lx::xf<8>(v);
                if (r32 < 16 && nn < ncmp) { const float* cs = ropeb + ((long)(16 * nn + 31) * 8 + (r32 & 7)) * 2; const float cc = cs[0], sn = cs[1]; v = r32 < 8 ? v * cc - pv * sn : v * cc + pv * sn; }
            }
            if (nn < 256) outb[(long)nn * 128 + 32 * wid + r32] = nn < ncmp ? (unsigned short)(cvtpk(v, 0.f) & 0xffffu) : (unsigned short)0; }
    }
    asm volatile("s_waitcnt lgkmcnt(0)\n\ts_barrier" ::: "memory");
}
}

namespace at {
template <bool ACCUM>
__device__ __forceinline__ void store_rows(const f32x16 (&o)[2], const float* rli  , unsigned short* obase  , int ldo,
                                           const float* gbase  , int ldg) {
    static_assert(!ACCUM, "the mixer outputs are written once, as bf16");
    int t_ = threadIdx.x; asm volatile("" : "+v"(t_)); const int lane = t_ & 63, r32 = lane & 31, hi = lane >> 5;
    unsigned short* ob = obase + r32;
#pragma unroll
    for (int r = 0; r < 16; ++r) { const int row = crow(r, hi); float sc = rli ? rli[r] : 1.0f; if (gbase) sc *= gbase[(size_t)row * ldg];
        unsigned short* p = ob + (size_t)row * ldo; const unsigned w = cvtpk(o[0][r] * sc, o[1][r] * sc);
        p[0] = (unsigned short)(w & 0xffffu); p[32] = (unsigned short)(w >> 16); }
}
}

namespace at {
template <bool INIT, bool LAST>
__device__ __forceinline__ void fold_rows(float* accw  , f32x16 (&o)[2], const float* rli  , const float* gbase, int ldg) {
    int t_ = threadIdx.x; asm volatile("" : "+v"(t_)); const int lane = t_ & 63, hi = lane >> 5;
#pragma unroll
    for (int r = 0; r < 16; ++r) { float sc = gbase[(size_t)crow(r, hi) * ldg]; if (rli) sc *= rli[r];
        float v0 = o[0][r] * sc, v1 = o[1][r] * sc;
        if (!INIT) { v0 += accw[r * 64 + lane]; v1 += accw[(16 + r) * 64 + lane]; }
        if (LAST) { o[0][r] = v0; o[1][r] = v1; } else { accw[r * 64 + lane] = v0; accw[(16 + r) * 64 + lane] = v1; } }
    asm volatile("s_waitcnt lgkmcnt(0)" ::: "memory");
}
}
namespace at {
template <int MODE>
__device__ __forceinline__ void attn_tiles_pipe(const UnitIO& U, char* shm, f32x16 (&o)[2], f32x16& osum) {
    int tid_ = threadIdx.x; asm volatile("" : "+v"(tid_));
    const int tid = tid_, lane = tid & 63, r32 = lane & 31, hi = lane >> 5; const int wid = __builtin_amdgcn_readfirstlane(tid >> 6);
    const unsigned lds0 = (unsigned)(uintptr_t)shm;
    const bf16* ksrc = U.Kh + (long)lane * PITCH + wid * 8;
    const bf16* vsrc = U.Vh + (long)(16 * (wid & 3) + (lane >> 2)) * PITCH + (wid >> 2) * 32 + (lane & 3) * 8;
    const unsigned kdst = lds0 + LDS_K + wid * 1024, vdst = lds0 + LDS_V + wid * 1024;
#define PP_DMA_K(step, slot) glds16(ksrc + (long)(U.t_hi - (step)) * 64 * PITCH, (unsigned)__builtin_amdgcn_readfirstlane(kdst + (slot) * SLOTB))
#define PP_DMA_V(step, slot) glds16(vsrc + (long)(U.t_hi - (step)) * 64 * PITCH, (unsigned)__builtin_amdgcn_readfirstlane(vdst + (slot) * SLOTB))
    const lds_cptr shm3 = (lds_cptr)shm;
    const lds_cptr kp0 = shm3 + LDS_K + hi * 1024 + r32 * 16;
    const lds_cptr vp0 = shm3 + LDS_V + ((lane >> 4) & 1) * 32 + (lane & 3) * 8 + (4 * hi + ((lane & 15) >> 2)) * 64;
    const int n = U.t_hi - U.t_lo + 1, i0 = U.t_hi - U.t_first;
    bf16x8 qr[4];
#pragma unroll
    for (int d0 = 0; d0 < 4; ++d0) qr[d0] = *reinterpret_cast<const bf16x8*>(&U.Qw[(long)r32 * PITCH + d0 * 16 + hi * 8]);
    asm volatile("" ::: "memory");
    PP_DMA_K(0, 0); if (n > 1) PP_DMA_K(1, 1); PP_DMA_V(0, 0); if (n > 2) PP_DMA_K(2, 2); if (n > 1) PP_DMA_V(1, 1);
    f32x16 cini = f32x16{};
    if (MODE == M_FOX) {
#pragma unroll
        for (int r = 0; r < 16; ++r) cini[r] = U.cq; }
    o[0] = f32x16{}; o[1] = f32x16{}; osum = f32x16{};
    const bf16x8 ones = (bf16x8){0x3F80, 0x3F80, 0x3F80, 0x3F80, 0x3F80, 0x3F80, 0x3F80, 0x3F80};
    if (n > 2) asm volatile("s_waitcnt vmcnt(4) lgkmcnt(0)\n\ts_barrier" ::: "memory"); else if (n == 2) asm volatile("s_waitcnt vmcnt(3) lgkmcnt(0)\n\ts_barrier" ::: "memory");
    else asm volatile("s_waitcnt vmcnt(1) lgkmcnt(0)\n\ts_barrier" ::: "memory");
#define PP_QK(S0, S1, slot) do { const lds_cptr kp = kp0 + (slot) * SLOTB; \
        _Pragma("unroll") for (int d0 = 0; d0 < 4; ++d0) { \
            const bf16x8 b0 = *(const __attribute__((address_space(3))) bf16x8*)(kp + d0 * 2048); \
            const bf16x8 b1 = *(const __attribute__((address_space(3))) bf16x8*)(kp + d0 * 2048 + 512); \
            if (d0 == 0) { S0 = __builtin_amdgcn_mfma_f32_32x32x16_bf16(b0, qr[0], cini, 0, 0, 0); S1 = __builtin_amdgcn_mfma_f32_32x32x16_bf16(b1, qr[0], cini, 0, 0, 0); } \
            else { S0 = __builtin_amdgcn_mfma_f32_32x32x16_bf16(b0, qr[d0], S0, 0, 0, 0); S1 = __builtin_amdgcn_mfma_f32_32x32x16_bf16(b1, qr[d0], S1, 0, 0, 0); } } } while (0)
    f32x16 s0 = f32x16{}, s1 = f32x16{};
    if (i0 == 0) PP_QK(s0, s1, 0);
    int ks = 0;
    for (int i = 0; i < n; ++i) {
        const int t = U.t_hi - i;
        if (i + 2 < n) asm volatile("s_waitcnt vmcnt(2) lgkmcnt(0)\n\ts_barrier" ::: "memory");
        else if (i + 1 < n) asm volatile("s_waitcnt vmcnt(1) lgkmcnt(0)\n\ts_barrier" ::: "memory");
        else asm volatile("s_waitcnt vmcnt(0) lgkmcnt(0)\n\ts_barrier" ::: "memory");
        const int ks1 = ks == 2 ? 0 : ks + 1, ks2 = ks == 0 ? 2 : ks - 1;
        if (i + 3 < n) PP_DMA_K(i + 3, ks);
        if (i + 2 < n) PP_DMA_V(i + 2, ks2);
        const bool act = i >= i0, actn = (i + 1 >= i0) && (i + 1 < n);
        f32x16 n0 = f32x16{}, n1 = f32x16{};
        u32x4 pw0, pw1, pw2, pw3;
#define PP_SOFT(DIAG, WLO) do { \
            if (MODE == M_FOX) { const __attribute__((address_space(3))) f32x4* ck = (const __attribute__((address_space(3))) f32x4*)(shm3 + LDS_CK + (64 * t + 4 * hi) * 4); \
                _Pragma("unroll") for (int a = 0; a < 4; ++a) { const f32x4 c0 = ck[2 * a], c1 = ck[2 * a + 8]; \
                    _Pragma("unroll") for (int j = 0; j < 4; ++j) { s0[4 * a + j] -= c0[j]; s1[4 * a + j] -= c1[j]; } } } \
            if (DIAG) { const int kb = 64 * t + 4 * hi; \
                _Pragma("unroll") for (int r = 0; r < 16; ++r) { const int kv = kb + (r & 3) + 8 * (r >> 2); if (kv > U.qpos) s0[r] = NEG; if (kv + 32 > U.qpos) s1[r] = NEG; } } \
            if (WLO) { const int kb = 64 * t + 4 * hi, lim = U.qpos - U.win; \
                _Pragma("unroll") for (int r = 0; r < 16; ++r) { const int kv = kb + (r & 3) + 8 * (r >> 2); if (kv <= lim) s0[r] = NEG; if (kv + 32 <= lim) s1[r] = NEG; } } \
            _Pragma("unroll") for (int r = 0; r < 16; ++r) { s0[r] = __builtin_amdgcn_exp2f(s0[r]); s1[r] = __builtin_amdgcn_exp2f(s1[r]); } \
            pw0 = (u32x4){cvtpk(s0[0], s0[1]), cvtpk(s0[2], s0[3]), cvtpk(s0[4], s0[5]), cvtpk(s0[6], s0[7])}; \
            pw1 = (u32x4){cvtpk(s0[8], s0[9]), cvtpk(s0[10], s0[11]), cvtpk(s0[12], s0[13]), cvtpk(s0[14], s0[15])}; \
            pw2 = (u32x4){cvtpk(s1[0], s1[1]), cvtpk(s1[2], s1[3]), cvtpk(s1[4], s1[5]), cvtpk(s1[6], s1[7])}; \
            pw3 = (u32x4){cvtpk(s1[8], s1[9]), cvtpk(s1[10], s1[11]), cvtpk(s1[12], s1[13]), cvtpk(s1[14], s1[15])}; \
            if (MODE == M_SEL) { const bool sel = (U.selm >> t) & 1ull; \
                _Pragma("unroll") for (int j = 0; j < 4; ++j) { pw0[j] = sel ? pw0[j] : 0u; pw1[j] = sel ? pw1[j] : 0u; pw2[j] = sel ? pw2[j] : 0u; pw3[j] = sel ? pw3[j] : 0u; } } } while (0)
#define PP_HINT() do { _Pragma("unroll") for (int k_ = 0; k_ < 8; ++k_) { __builtin_amdgcn_sched_group_barrier(0x100, 1, 0); __builtin_amdgcn_sched_group_barrier(0x008, 1, 0); \
            __builtin_amdgcn_sched_group_barrier(0x400, 4, 0); __builtin_amdgcn_sched_group_barrier(0x002, 6, 0); } } while (0)
        if (act) {
            const bool diag = (i == i0), wlo = (MODE == M_WIN) && (i == n - 1);
            if (diag) { if (actn) { PP_QK(n0, n1, ks1); PP_SOFT(true, false); PP_HINT(); } else { PP_SOFT(true, (MODE == M_WIN) && wlo); } }
            else if (wlo) { PP_SOFT(false, true); }
            else if (actn) { PP_QK(n0, n1, ks1); PP_SOFT(false, false); PP_HINT(); }
            else { PP_SOFT(false, false); }
            const lds_cptr vp = vp0 + ks * SLOTB;
#pragma unroll
            for (int d0 = 0; d0 < 2; ++d0) { s16x4 lo[4], hh[4];
#pragma unroll
                for (int q4 = 0; q4 < 4; ++q4) { lo[q4] = vtr(vp + d0 * 4096 + q4 * 1024); hh[q4] = vtr(vp + d0 * 4096 + q4 * 1024 + 512); }
#define PP_PK(k) (bf16x8){lo[k][0], lo[k][1], lo[k][2], lo[k][3], hh[k][0], hh[k][1], hh[k][2], hh[k][3]}
                o[d0] = __builtin_amdgcn_mfma_f32_32x32x16_bf16(__builtin_bit_cast(bf16x8, pw0), PP_PK(0), o[d0], 0, 0, 0);
                o[d0] = __builtin_amdgcn_mfma_f32_32x32x16_bf16(__builtin_bit_cast(bf16x8, pw1), PP_PK(1), o[d0], 0, 0, 0);
                o[d0] = __builtin_amdgcn_mfma_f32_32x32x16_bf16(__builtin_bit_cast(bf16x8, pw2), PP_PK(2), o[d0], 0, 0, 0);
                o[d0] = __builtin_amdgcn_mfma_f32_32x32x16_bf16(__builtin_bit_cast(bf16x8, pw3), PP_PK(3), o[d0], 0, 0, 0);
#undef PP_PK
            }
            osum = __builtin_amdgcn_mfma_f32_32x32x16_bf16(__builtin_bit_cast(bf16x8, pw0), ones, osum, 0, 0, 0);
            osum = __builtin_amdgcn_mfma_f32_32x32x16_bf16(__builtin_bit_cast(bf16x8, pw1), ones, osum, 0, 0, 0);
            osum = __builtin_amdgcn_mfma_f32_32x32x16_bf16(__builtin_bit_cast(bf16x8, pw2), ones, osum, 0, 0, 0);
            osum = __builtin_amdgcn_mfma_f32_32x32x16_bf16(__builtin_bit_cast(bf16x8, pw3), ones, osum, 0, 0, 0);
        } else if (actn) { PP_QK(n0, n1, ks1); }
        s0 = n0; s1 = n1; ks = ks1;
    }
    asm volatile("s_waitcnt lgkmcnt(0)\n\ts_barrier" ::: "memory");
#undef PP_SOFT
#undef PP_HINT
#undef PP_QK
#undef PP_DMA_K
#undef PP_DMA_V
}
}
namespace mk {
#define GAS __attribute__((address_space(1)))
#define LAS __attribute__((address_space(3)))
typedef unsigned short bf16;
typedef unsigned v4u __attribute__((ext_vector_type(4)));
typedef float f32x4 __attribute__((ext_vector_type(4)));
typedef short bf16x8 __attribute__((ext_vector_type(8)));
typedef GAS unsigned gu32;
typedef GAS unsigned long long gu64;
#define RLX_AGENT __ATOMIC_RELAXED, __HIP_MEMORY_SCOPE_AGENT
#define LDS_WAIT() asm volatile("s_waitcnt lgkmcnt(0)" ::: "memory")
#define VM_WAIT() asm volatile("s_waitcnt vmcnt(0)" ::: "memory")
__device__ __forceinline__ unsigned long long rt() { return __builtin_amdgcn_s_memrealtime(); }
__device__ __forceinline__ unsigned f2bf(float f) { unsigned u = __builtin_bit_cast(unsigned, f); return (u + 0x7fffu + ((u >> 16) & 1u)) >> 16; }
__device__ __forceinline__ unsigned pk2(float lo, float hi) { return f2bf(lo) | (f2bf(hi) << 16); }

#define XB_TMO      128
#define XB_XCNT(j)  (256  + 64 * (j))
#define XB_XSUB(j)  (1280 + 64 * (j))
#define XB_XGEN(j)  (2304 + 64 * (j))
#define XB_TOP      3328
#define XB_TOPGEN   3392
#define XCD_BAR_WORDS 3456
#ifndef XB_SPIN_CAP
#define XB_SPIN_CAP (1u << 24)
#endif

__device__ __forceinline__ unsigned xb_ld(unsigned* p)              { return __hip_atomic_load(p, __ATOMIC_RELAXED, __HIP_MEMORY_SCOPE_AGENT); }
__device__ __forceinline__ unsigned xb_add(unsigned* p, unsigned v) { return __hip_atomic_fetch_add(p, v, __ATOMIC_RELAXED, __HIP_MEMORY_SCOPE_AGENT); }
__device__ __forceinline__ unsigned xb_xcc_id() { return (unsigned)__builtin_amdgcn_s_getreg((3 << 11) | 20) & 0xFu; }
#define XB_SPIN(cond, bar) do { unsigned _sp = 0; while (cond) { __builtin_amdgcn_s_sleep(1); \
    if ((++_sp & 255u) == 0u) { if (xb_ld(&(bar)[XB_TMO])) break; if (_sp > XB_SPIN_CAP) { atomicAdd(&(bar)[XB_TMO], 1u); break; } } } } while (0)

struct XcdBarrier {
    unsigned* bar; unsigned x;
    volatile LAS unsigned* st;
};

__device__ __forceinline__ XcdBarrier xcd_barrier_post(unsigned* bar, volatile LAS unsigned* st) {
    XcdBarrier b; b.bar = bar; b.x = xb_xcc_id(); b.st = st;
    if (threadIdx.x == 0) (void)xb_add(&bar[XB_XCNT(b.x)], 1u);
    return b;
}
__device__ __forceinline__ void xcd_barrier_complete(unsigned* bar, unsigned x, unsigned& nloc, unsigned& nx) {
    const unsigned G = gridDim.x * gridDim.y * gridDim.z;
    unsigned sum, cnt, mine, sp = 0u;
    for (;;) {
        sum = 0u; cnt = 0u; mine = 0u;
#pragma unroll
        for (unsigned j = 0; j < 16; ++j) { const unsigned c = xb_ld(&bar[XB_XCNT(j)]); sum += c; cnt += (c > 0u) ? 1u : 0u; mine = (j == x) ? c : mine; }
        if (sum == G) break;
        __builtin_amdgcn_s_sleep(1);
        if ((++sp & 255u) == 0u) { if (xb_ld(&bar[XB_TMO])) break; if (sp > XB_SPIN_CAP) { atomicAdd(&bar[XB_TMO], 1u); break; } }
    }
    nloc = mine > 0u ? mine : 1u; nx = cnt > 0u ? cnt : 1u;
}

__device__ __forceinline__ void xcd_barrier(const XcdBarrier& b) {
    asm volatile("s_waitcnt vmcnt(0)" ::: "memory");
    __syncthreads();
    if (threadIdx.x == 0) {
        unsigned* bar = b.bar;
        __builtin_amdgcn_s_waitcnt(0);
        unsigned nloc = b.st[0], nx = b.st[1];
        if (nloc == 0u) { xcd_barrier_complete(bar, b.x, nloc, nx); b.st[0] = nloc; b.st[1] = nx; }
        const unsigned old = xb_add(&bar[XB_XSUB(b.x)], 1u);
        const unsigned gen = old / nloc;
        if (old + 1u == (gen + 1u) * nloc) {
            __builtin_amdgcn_fence(__ATOMIC_RELEASE, "agent");
            asm volatile("s_waitcnt vmcnt(0)" ::: "memory");
            const unsigned og = xb_add(&bar[XB_TOP], 1u);
            const unsigned tg = og / nx;
            if (og + 1u == (tg + 1u) * nx) xb_add(&bar[XB_TOPGEN], 1u);
            else XB_SPIN(xb_ld(&bar[XB_TOPGEN]) == tg, bar);
            __builtin_amdgcn_fence(__ATOMIC_ACQUIRE, "agent");
            xb_add(&bar[XB_XGEN(b.x)], 1u);
            asm volatile("s_waitcnt vmcnt(0)" ::: "memory");
        } else {
            XB_SPIN(xb_ld(&bar[XB_XGEN(b.x)]) == gen, bar);
            __builtin_amdgcn_fence(__ATOMIC_ACQUIRE, "agent");
            asm volatile("s_waitcnt vmcnt(0)" ::: "memory");
        }
    }
    __syncthreads();
}
using nv::B_; using nv::S_; using nv::T_; using nv::DM; using nv::NCMP; using nv::NBLK;
constexpr int NWAVES = 8, NTHREADS = NWAVES * 64;
constexpr int RING_OFF = 0, RING_BYTES = 131072, LDS_BYTES = 147456, LDSCTL_OFF = LDS_BYTES - 1024, MISC_OFF = LDSCTL_OFF + 320;
constexpr int CW_BAR = 4096, CW_FOXQ = 8192, CW_PANEL = 16384, CW_HM = 24576;
constexpr int NIN = 3072;
constexpr size_t MiB = (size_t)1 << 20;
constexpr size_t WS_CTL = 0, CTL_ZERO_BYTES = 1 * MiB;
constexpr size_t WS_WIN = 2 * MiB;
constexpr size_t WS_WOUT = 8 * MiB, WS_WPG = 10 * MiB, WS_WPP = 12 * MiB, WS_CMPW = 13 * MiB;
constexpr size_t WS_ROPE = 15 * MiB;
constexpr size_t WS_GATES = 17 * MiB;
constexpr size_t WS_LOGF = 20 * MiB, WS_CUM = 21 * MiB;
constexpr size_t WS_KC = 22 * MiB, WS_VC = 23 * MiB, WS_SELM = 24 * MiB, WS_EID = 25 * MiB, WS_CW = 26 * MiB, WS_RS3 = 27 * MiB, WS_CMPH = 28 * MiB;
constexpr size_t WS_WGU = 40 * MiB, WS_WD = 72 * MiB;
constexpr size_t WS_RA = 39 * MiB;
constexpr size_t WS_XN = 88 * MiB;
constexpr size_t WS_PROJB = 152 * MiB;
constexpr size_t WS_TAB = 1 * MiB;
constexpr size_t WS_ROPEH = 38 * MiB;
constexpr size_t WS_ROWIDX = 37 * MiB;
constexpr size_t WS_XS = 36 * MiB;
constexpr size_t WS_POS = 34 * MiB, WS_NRM = 35 * MiB;
constexpr size_t WS_USORT = 152 * MiB, WS_HIDB = 288 * MiB, WS_YB = 356 * MiB;
constexpr size_t WS_PB = 496 * MiB;
constexpr size_t WS_IMP = 328 * MiB;
constexpr size_t WS_NH = 88 * MiB, WS_NU = 216 * MiB, WS_NHID = 344 * MiB;
static_assert(WS_NHID + (size_t)T_ * 1024 * 4 <= 512 * MiB && WS_PROJB + (size_t)T_ * 2816 * 2 <= WS_IMP, "d_ws map");

__device__ __forceinline__ float wave_sum(float v) { return lx::sum64(v); }
template <int MODE, bool SC = false>
__device__ __forceinline__ void p0_transpose_item(const float* W, int ldw, int col0, int K, int nblk, bf16* WT, int row_off, LAS float* scr, int item, int lane, const float* ksc = nullptr) {
    const int kb = item / nblk, nb = item % nblk, k0 = 64 * kb, n0 = 32 * nb;
#pragma unroll 8
    for (int i = 0; i < 32; ++i) { const int kk = 2 * i + (lane >> 5); const int cl = lane & 31; const int sc = (MODE == 2 && cl >= 24) ? col0 + 1536 + cl : col0 + n0 + cl; scr[kk * 33 + cl] = SC ? W[(size_t)(k0 + kk) * ldw + sc] * ksc[k0 + kk] : W[(size_t)(k0 + kk) * ldw + sc]; }
    LDS_WAIT(); asm volatile("" ::: "memory");
    const int c = lane & 7;
#pragma unroll
    for (int j = 0; j < 4; ++j) { const int n = (lane >> 3) + 8 * j; const LAS float* s = scr + (8 * c) * 33 + n;
        v4u o; o.x = pk2(s[0 * 33], s[1 * 33]); o.y = pk2(s[2 * 33], s[3 * 33]); o.z = pk2(s[4 * 33], s[5 * 33]); o.w = pk2(s[6 * 33], s[7 * 33]);
        const int nn = n0 + n; const int ln = row_off + nn;
        const int drow = MODE == 3 ? (ln & ~255) + 128 * ((ln >> 5) & 1) + 32 * ((ln >> 6) & 3) + (ln & 31) : MODE != 1 ? row_off + nn : (nn >> 2) * 8 + (nn & 3) + row_off;
        *(GAS v4u*)(WT + (size_t)drow * K + k0 + 8 * c) = o; }
    LDS_WAIT(); asm volatile("" ::: "memory");
}
__device__ __forceinline__ void rms_row_to_bf16(const float* xrow, const float* gain, bf16* orow, int lane) {
    const GAS f32x4* xr = (const GAS f32x4*)xrow + lane; const GAS f32x4* gr = (const GAS f32x4*)gain + lane;
    f32x4 v[4]; float s = 0.f;
#pragma unroll
    for (int j = 0; j < 4; ++j) { v[j] = xr[64 * j]; s += (v[j].x * v[j].x + v[j].y * v[j].y) + (v[j].z * v[j].z + v[j].w * v[j].w); }
    const float rstd = 1.f / sqrtf(wave_sum(s) * (1.f / 1024.f) + 1e-6f);
    GAS unsigned long long* o8 = (GAS unsigned long long*)orow + lane;
#pragma unroll
    for (int j = 0; j < 4; ++j) { const f32x4 g = gr[64 * j];
        o8[64 * j] = (unsigned long long)pk2(v[j].x * rstd * g.x, v[j].y * rstd * g.y) | ((unsigned long long)pk2(v[j].z * rstd * g.z, v[j].w * rstd * g.w) << 32); }
}

#ifndef PROBE_DUP
#define PROBE_DUP (-1)
#endif
#define REP(k) for (int rep_ = 0; rep_ < ((PROBE_DUP == (k)) ? 2 : 1); ++rep_)
struct Args { const void* in[29]; void* out; void* ws; };
#define LDP_(k) ((uintptr_t)args.in[k])
#define PHASE_PTRS() size_t zo_ = 0; asm volatile("" : "+s"(zo_)); char* ws = ws0_ + zo_; float* out = out0_ + zo_;     volatile LAS unsigned* LPV_ = (volatile LAS unsigned*)(ldsp + LDSCTL_OFF + 512); (void)LPV_; \
    const float* in_x = (const float*)LDP_(0); const float* in_p = (const float*)LDP_(1); const int* positions = (const int*)LDP_(2); const float* g_mix = (const float*)LDP_(3); const float* w_in = (const float*)LDP_(4); const float* b_gate = (const float*)LDP_(5); const float* b_forget = (const float*)LDP_(6); const float* pe_k = (const float*)LDP_(7); const float* w_k1 = (const float*)LDP_(8); const float* w_k2 = (const float*)LDP_(9); const float* pe_v = (const float*)LDP_(10); const float* w_v1 = (const float*)LDP_(11); const float* w_v2 = (const float*)LDP_(12); const float* beta_nsa = (const float*)LDP_(13); const float* beta_fox = (const float*)LDP_(14); const float* w_out = (const float*)LDP_(15); const float* g_ffn = (const float*)LDP_(16); const float* w_group = (const float*)LDP_(17); const float* b_group = (const float*)LDP_(18); const float* w_router = (const float*)LDP_(19); const float* b_router = (const float*)LDP_(20); const float* w_gate_e = (const float*)LDP_(21); const float* w_up_e = (const float*)LDP_(22); const float* w_down_e = (const float*)LDP_(23); const float* g_ple = (const float*)LDP_(24); const float* w_ple_gate = (const float*)LDP_(25); const float* b_ple = (const float*)LDP_(26); const float* w_ple_proj = (const float*)LDP_(27); const float* g_final = (const float*)LDP_(28); \
    bf16* WIN_T = (bf16*)(ws + WS_WIN); bf16* WOUT_T = (bf16*)(ws + WS_WOUT); bf16* WPG_T = (bf16*)(ws + WS_WPG); bf16* WPP_T = (bf16*)(ws + WS_WPP); bf16* WGU_T = (bf16*)(ws + WS_WGU); bf16* WD_T = (bf16*)(ws + WS_WD); bf16* XN = (bf16*)(ws + WS_XN); bf16* PROJB = (bf16*)(ws + WS_PROJB); bf16* W1KT = (bf16*)(ws + WS_CMPW); bf16* W1VT = W1KT + 128 * 2048; bf16* W2KT = W1VT + 128 * 2048; bf16* W2VT = W2KT + 64 * 128; bf16* KCB = (bf16*)(ws + WS_KC); bf16* VCB = (bf16*)(ws + WS_VC); bf16* PB = (bf16*)(ws + WS_PB); bf16* PPB = XN; bf16* VPLE = (bf16*)(ws + WS_USORT); float* ROPE = (float*)(ws + WS_ROPE); float* GATES = (float*)(ws + WS_GATES); float* LOGF = (float*)(ws + WS_LOGF); unsigned short* OMIX = (unsigned short*)out; float* HB = out;   float* CUM2 = (float*)(ws + WS_CUM); float* RA = (float*)(ws + WS_RA); float* RSX = (float*)(ws + WS_RA + 128 * 1024); bf16* MIXB = (bf16*)(ws + WS_PROJB);   float* RSS = (float*)(ws + WS_RA + 512 * 1024); bf16* H1B = (bf16*)out;   int* EIDB = (int*)(ws + WS_EID); float* CWB = (float*)(ws + WS_CW); float* RSTD2 = (float*)(ws + WS_RS3); int* LC = (int*)(ws + WS_TAB); int* TILE_E = LC + 1024 * 16; int* NTILES = TILE_E + 1024; int* POS = (int*)(ws + WS_POS); int* ROWIDX = (int*)(ws + WS_ROWIDX); bf16* USORT = (bf16*)(ws + WS_USORT); bf16* HIDB = (bf16*)(ws + WS_HIDB); bf16* YB = (bf16*)(ws + WS_YB); \
    const int chunk = (T_ + NG - 1) / NG, tok0 = (int)blockIdx.x * chunk, ntok = (tok0 + chunk <= T_) ? chunk : (T_ > tok0 ? T_ - tok0 : 0); (void)chunk; (void)tok0; (void)ntok;
__global__ void __launch_bounds__(NTHREADS, 2) mk_fwd(Args args) {
    using namespace nv;
    extern __shared__ __attribute__((aligned(16))) unsigned char lds[];
    LAS unsigned char* ldsp = (LAS unsigned char*)lds;
    volatile LAS unsigned* MISC = (volatile LAS unsigned*)(ldsp + MISC_OFF);
    for (int u = threadIdx.x; u < (LDS_BYTES - LDSCTL_OFF) / 4; u += NTHREADS) ((LAS unsigned*)(ldsp + LDSCTL_OFF))[u] = 0u;
    __syncthreads();
    char* const ws0_ = (char*)args.ws; float* const out0_ = (float*)args.out;
    { LAS unsigned long long* LP_ = (LAS unsigned long long*)(ldsp + LDSCTL_OFF + 512); if (threadIdx.x < 29) LP_[threadIdx.x] = (unsigned long long)(uintptr_t)args.in[threadIdx.x]; }
    __syncthreads();
    XcdBarrier bar = xcd_barrier_post((unsigned*)(ws0_ + WS_CTL) + CW_BAR, MISC + 8);
    const int wave = __builtin_amdgcn_readfirstlane((int)threadIdx.x >> 6);
#define PHASE_IDS() int tid = threadIdx.x; asm volatile("" : "+v"(tid)); const int lane = tid & 63; (void)lane
    const int NG = gridDim.x; const int vcu = (NG % 8 == 0) ? ((int)blockIdx.x % 8) * (NG / 8) + (int)blockIdx.x / 8 : (int)blockIdx.x;
    {   PHASE_PTRS();
    REP(0)
    {
        PHASE_IDS();
        LAS float* scr = (LAS float*)(ldsp + RING_OFF + wave * 16384);
        const int gw = vcu * NWAVES + wave, NGW = NG * NWAVES;
        constexpr int I_IN_A = 16 * 40, I_IN_B = 16 * 48, I_IN_C = 16 * 1, I_SQ = 16 * 32, I_PP = 4 * 32, I_EG = 16 * 16, I_ED = 8 * 32;
        constexpr int I_C1 = 32 * 4, I_C2 = 2 * 2;
        constexpr int NITEMS = I_IN_A + I_IN_B + I_IN_C + 2 * I_SQ + I_PP + 2 * (I_C1 + I_C2) + 16 * (2 * I_EG + I_ED);
        for (int it = gw; it < NITEMS; it += NGW) {
            int r = it;
            if (r < I_IN_A) { p0_transpose_item<3, true>(w_in, IN_COLS, 0, 1024, 40, WIN_T, 0, scr, r, lane, g_mix); continue; } r -= I_IN_A;
            if (r < I_IN_B) { p0_transpose_item<3, true>(w_in, IN_COLS, OFF_QB, 1024, 48, WIN_T, 1280, scr, r, lane, g_mix); continue; } r -= I_IN_B;
            if (r < I_IN_C) { p0_transpose_item<2, true>(w_in, IN_COLS, OFF_GATE, 1024, 1, WIN_T, 2816, scr, r, lane, g_mix); continue; } r -= I_IN_C;
            if (r < I_SQ) { p0_transpose_item<0>(w_out, 1024, 0, 1024, 32, WOUT_T, 0, scr, r, lane); continue; } r -= I_SQ;
            if (r < I_SQ) { p0_transpose_item<0, true>(w_ple_gate, 1024, 0, 1024, 32, WPG_T, 0, scr, r, lane, g_ple); continue; }     r -= I_SQ;
            if (r < I_PP) { p0_transpose_item<0>(w_ple_proj, 1024, 0, 256, 32, WPP_T, 0, scr, r, lane); continue; } r -= I_PP;
            if (r < I_C1) { p0_transpose_item<0>(w_k1, 128, 0, 2048, 4, W1KT, 0, scr, r, lane); continue; } r -= I_C1;
            if (r < I_C1) { p0_transpose_item<0>(w_v1, 128, 0, 2048, 4, W1VT, 0, scr, r, lane); continue; } r -= I_C1;
            if (r < I_C2) { p0_transpose_item<0>(w_k2, 64, 0, 128, 2, W2KT, 0, scr, r, lane); continue; } r -= I_C2;
            if (r < I_C2) { p0_transpose_item<0>(w_v2, 64, 0, 128, 2, W2VT, 0, scr, r, lane); continue; } r -= I_C2;
            const int e = r / (2 * I_EG + I_ED); r -= e * (2 * I_EG + I_ED);
            if (r < I_EG) { p0_transpose_item<1, true>(w_gate_e + (size_t)e * 1024 * 512, 512, 0, 1024, 16, WGU_T + (size_t)e * 1024 * 1024, 0, scr, r, lane, g_ffn); continue; } r -= I_EG;
            if (r < I_EG) { p0_transpose_item<1, true>(w_up_e + (size_t)e * 1024 * 512, 512, 0, 1024, 16, WGU_T + (size_t)e * 1024 * 1024, 4, scr, r, lane, g_ffn);     continue; } r -= I_EG;
            p0_transpose_item<0>(w_down_e + (size_t)e * 512 * 1024, 1024, 0, 512, 32, WD_T + (size_t)e * 1024 * 512, 0, scr, r, lane);
        }
        for (int i = (int)blockIdx.x * NTHREADS + tid; i < T_ * 8; i += NG * NTHREADS) { const int tok = i >> 3, j = i & 7;
            const float inv = powf(500000.0f, -(float)j / 8.0f); const float ang = (float)positions[tok] * inv; const float cv = cosf(ang), sv = sinf(ang); ROPE[(size_t)i * 2] = cv; ROPE[(size_t)i * 2 + 1] = sv;
            typedef _Float16 h2_t __attribute__((ext_vector_type(2))); const h2_t hv = {(_Float16)cv, (_Float16)sv}; ((unsigned*)(ws + WS_ROPEH))[i] = __builtin_bit_cast(unsigned, hv); }
        for (int m = gw; m < T_; m += 2 * NGW) {
            const bool hasB = m + NGW < T_; const int mB = hasB ? m + NGW : m;
            const GAS f32x4* xa = (const GAS f32x4*)(in_x + (size_t)m * DM) + lane; const GAS f32x4* xb = (const GAS f32x4*)(in_x + (size_t)mB * DM) + lane;
            f32x4 va[4], vb[4]; float sa = 0.f, sb = 0.f;
#pragma unroll
            for (int j = 0; j < 4; ++j) { va[j] = xa[64 * j]; vb[j] = xb[64 * j]; }
            const f32x4 pa = ((const GAS f32x4*)(in_p + (size_t)m * 256))[lane], pb = ((const GAS f32x4*)(in_p + (size_t)mB * 256))[lane];
#pragma unroll
            for (int j = 0; j < 4; ++j) { sa += (va[j].x * va[j].x + va[j].y * va[j].y) + (va[j].z * va[j].z + va[j].w * va[j].w); sb += (vb[j].x * vb[j].x + vb[j].y * vb[j].y) + (vb[j].z * vb[j].z + vb[j].w * vb[j].w); }
            const float ra = 1.f / sqrtf(wave_sum(sa) * (1.f / 1024.f) + 1e-6f), rb = 1.f / sqrtf(wave_sum(sb) * (1.f / 1024.f) + 1e-6f);
            GAS unsigned long long* oa = (GAS unsigned long long*)(XN + (size_t)m * DM) + lane; GAS unsigned long long* ob = (GAS unsigned long long*)(XN + (size_t)mB * DM) + lane;
#pragma unroll
            for (int j = 0; j < 4; ++j) {
                oa[64 * j] = (unsigned long long)pk2(va[j].x, va[j].y) | ((unsigned long long)pk2(va[j].z, va[j].w) << 32);
                if (hasB) ob[64 * j] = (unsigned long long)pk2(vb[j].x, vb[j].y) | ((unsigned long long)pk2(vb[j].z, vb[j].w) << 32); }
            if (lane == 0) { RSX[m] = ra; if (hasB) RSX[mB] = rb; }
            ((GAS unsigned long long*)(PB + (size_t)m * 256))[lane] = (unsigned long long)pk2(pa.x, pa.y) | ((unsigned long long)pk2(pa.z, pa.w) << 32);
            if (hasB) ((GAS unsigned long long*)(PB + (size_t)mB * 256))[lane] = (unsigned long long)pk2(pb.x, pb.y) | ((unsigned long long)pk2(pb.z, pb.w) << 32); }
    }
    }
    xcd_barrier(bar); if (PROBE_DUP == 60) xcd_barrier(bar);
    {   PHASE_PTRS();

    REP(1)
    {
        pg8::Gemm g{XN, WIN_T, T_, NIN, DM, 0}; pg8::StaticOrder S; S.init(T_, NIN, NG, (int)blockIdx.x);
        pg8::EpiInProj E{PROJB, ROPE, RSX, GATES, LOGF, b_gate, b_forget, (float*)(ws + WS_NRM), 0};
        if (PROBE_DUP >= 64 && PROBE_DUP <= 66) { pg8::EpiInProj E2 = E; E2.dbg = PROBE_DUP - 63; pg8::gemm_phase<pg8::EpiInProj, pg8::StaticOrder, false, true>(ldsp + RING_OFF, g, S, E2); }
        if (PROBE_DUP == 63) { pg8::EpiBf16Plain EP{PROJB, at::PITCH}; pg8::Gemm g2{XN, WIN_T, T_, 2816, DM, 0}; pg8::StaticOrder S2; S2.init(T_, 2816, NG, (int)blockIdx.x); pg8::gemm_phase<pg8::EpiBf16Plain, pg8::StaticOrder, false, true>(ldsp + RING_OFF, g2, S2, EP); }
        pg8::gemm_phase<pg8::EpiInProj, pg8::StaticOrder, false, true>(ldsp + RING_OFF, g, S, E);
        if (PROBE_DUP == 61) { pg8::EpiNull EN; pg8::gemm_phase<pg8::EpiNull, pg8::StaticOrder, true, true>(ldsp + RING_OFF, g, S, EN); }
    }
    }
    xcd_barrier(bar); if (PROBE_DUP == 60) xcd_barrier(bar);
    {   PHASE_PTRS();

    REP(3)
    { char* shm = (char*)lds + RING_OFF; constexpr int NT8 = (NCMP + 31) / 32; const int nunits = 2 * B_ * 2 * NT8;
      for (int uid = (int)blockIdx.x; uid < nunits; uid += NG) { const int nt = uid % NT8, g = (uid / NT8) & 1, b = (uid / (2 * NT8)) % B_, which = uid / (2 * NT8 * B_);
          at::compress_unit(PROJB + (size_t)b * S_ * at::PITCH + (which ? 640 : 512) + g * 64, 32 * nt, NCMP, which ? pe_v : pe_k, which ? W1VT : W1KT, which ? W2VT : W2KT,
                            which ? (const float*)nullptr : ROPE + (size_t)b * S_ * 16, (which ? VCB : KCB) + (size_t)b * 256 * 128 + g * 64, shm); }
      PHASE_IDS(); const int gw = vcu * NWAVES + wave, NGW = NG * NWAVES; constexpr int PER = S_ / 64; constexpr int NCH = S_ / 64;
      for (int task = gw; task < B_ * 8; task += NGW) {
          if (task < B_ * 8) { const int bh = task, b = bh >> 3, h = bh & 7; const float* lf = LOGF + ((size_t)b * S_ + (size_t)PER * lane) * 8 + h;
              float vals[PER]; float s = 0.f;
#pragma unroll
              for (int j = 0; j < PER; ++j) { vals[j] = lf[j * 8]; s += vals[j]; }
              float incl = s;
#pragma unroll
              for (int o = 1; o < 64; o <<= 1) { const float v = __builtin_bit_cast(float, __builtin_amdgcn_ds_bpermute((lane - o) << 2, __builtin_bit_cast(int, incl))); if (lane >= o) incl += v; }
              float run = incl - s; float* cp = CUM2 + (size_t)bh * S_ + PER * lane;
#pragma unroll
              for (int j = 0; j < PER; ++j) { run += vals[j]; cp[j] = run * 1.4426950408889634f; }
          } } }
    }
    xcd_barrier(bar); if (PROBE_DUP == 60) xcd_barrier(bar);
    {   PHASE_PTRS();
    REP(4)
    { PHASE_IDS(); const int r32 = lane & 31, hi = lane >> 5;
      char* shm = (char*)lds + RING_OFF;
      const int nunits = B_ * 2 * NBLK;
      for (int it = 0;; ++it) {
          int bg, c;
          if (NG == 256 && S_ == 4096 && B_ == 8) { if (it >= 4) break; const int s = vcu & 15; bg = vcu >> 4; c = it == 0 ? s : it == 1 ? 31 - s : it == 2 ? 32 + s : 63 - s; }
          else { const int uid = it * NG + (int)blockIdx.x; if (uid >= nunits) break; bg = uid / NBLK; c = uid % NBLK; }
          const int b = bg >> 1, g = bg & 1, h = g * 4 + (wave >> 1), tq0 = c * 64 + 32 * (wave & 1);
          const size_t tokb = (size_t)b * S_ + tq0;
          at::UnitIO U; U.Qw = PROJB + tokb * at::PITCH + h * 64; U.t_hi = c; U.t_first = c; U.qpos = tq0 + r32;
          unsigned short* ob = OMIX + tokb * DM + h * 64; const float* gp = GATES + tokb * 24 + h * 3;
          at::f32x16 o[2], osum; float l; float rli[16];
          bool fast_sel, fast_win;
          { const float* hmt = (const float*)(ws + WS_NRM) + ((size_t)b * (S_ / 256) * 2 + (lane & 31)) * 28; float q2 = 0.f;
#pragma unroll
            for (int hh = 0; hh < 4; ++hh) q2 = fmaxf(q2, lx::max64(hmt[g * 4 + hh]));
            const float qmax = sqrtf(q2), ksm = sqrtf(lx::max64(hmt[8 + g])), kwm = sqrtf(lx::max64(hmt[10 + g]));
            fast_sel = __builtin_amdgcn_readfirstlane((int)(qmax * ksm <= 60.0f)) != 0; fast_win = __builtin_amdgcn_readfirstlane((int)(qmax * kwm <= 60.0f)) != 0; }
          for (int pr_ = 0; pr_ < (PROBE_DUP == 22 ? 2 : 1); ++pr_)
          at::cmp_stage(U.Qw, KCB + (size_t)b * 256 * 128 + g * 64, VCB + (size_t)b * 256 * 128 + g * 64, c, nv::NSEL, shm, o);
          float* accw = (float*)(shm + at::CMP_IMP) + wave * 2048; static_assert(at::CMP_SELM + 512 <= LDSCTL_OFF, "NSA LDS map"); at::fold_rows<true, false>(accw, o, nullptr, gp, 24);
          U.Kh = PROJB + (size_t)b * S_ * at::PITCH + 768 + g * 64; U.Vh = PROJB + (size_t)b * S_ * at::PITCH + 896 + g * 64; U.t_lo = 0; U.win = 0;
          U.selm = ((const unsigned long long*)(shm + at::CMP_SELM))[32 * (wave & 1) + r32];
          if (PROBE_DUP >= 41 && PROBE_DUP <= 43) { at::f32x16 o_[2], os_; float l_; at::attn_tiles<at::M_SEL, true, PROBE_DUP - 40>(U, shm, o_, l_, os_); asm volatile("" :: "v"(o_[0]), "v"(o_[1]), "v"(os_)); }
          for (int pr_ = 0; pr_ < (PROBE_DUP == 20 ? 2 : 1); ++pr_)
          if (fast_sel) { at::attn_tiles<at::M_SEL, true>(U, shm, o, l, osum);
#pragma unroll
              for (int r = 0; r < 16; ++r) rli[r] = 1.0f / osum[r]; }
          else { at::attn_tiles<at::M_SEL, false>(U, shm, o, l, osum); at::row_inv(l, shm, rli); }
          at::fold_rows<false, false>(accw, o, rli, gp + 1, 24);
          U.Kh = PROJB + (size_t)b * S_ * at::PITCH + 1024 + g * 64; U.Vh = PROJB + (size_t)b * S_ * at::PITCH + 1152 + g * 64; U.t_lo = c > (nv::WIN / 64) ? c - (nv::WIN / 64) : 0; U.win = nv::WIN; U.selm = 0ull;
          for (int pr_ = 0; pr_ < (PROBE_DUP == 21 ? 2 : 1); ++pr_)
          if (fast_win) { at::attn_tiles<at::M_WIN, true>(U, shm, o, l, osum);
#pragma unroll
              for (int r = 0; r < 16; ++r) rli[r] = 1.0f / osum[r]; }
          else { at::attn_tiles<at::M_WIN, false>(U, shm, o, l, osum); at::row_inv(l, shm, rli); }
          at::fold_rows<false, true>(accw, o, rli, gp + 2, 24);
          at::store_rows<false>(o, nullptr, ob, DM, nullptr, 0);
      } }
    REP(5)
    { PHASE_IDS(); const int r32 = lane & 31;
      char* shm = (char*)lds + RING_OFF; (void)r32;
      const int nunits = B_ * 8 * (S_ / 256); gu32* qctr = (gu32*)(ws + WS_CTL) + CW_FOXQ + 64 * rep_;
      for (;;) {
          if (tid == 0) MISC[4] = __hip_atomic_fetch_add(qctr, 1u, RLX_AGENT);
          __syncthreads();
          const int uid = __builtin_amdgcn_readfirstlane((int)MISC[4]);
          __syncthreads();
          if (uid >= nunits) break;
          const int qb = (S_ / 256 - 1) - uid / (B_ * 8), bh = uid % (B_ * 8);
          const int b = bh >> 3, h = bh & 7, q0 = qb * 256;
          int t_lo; float sbnd;
          bool fast;
          { const float* c2 = CUM2 + (size_t)bh * S_; const float* hmb = (const float*)(ws + WS_NRM) + (size_t)b * (S_ / 256) * 2 * 28;
            const float qn = sqrtf(fmaxf(hmb[(qb * 2) * 28 + 12 + h], hmb[(qb * 2 + 1) * 28 + 12 + h]));
            const float knu = sqrtf(fmaxf(hmb[(qb * 2) * 28 + 20 + h], hmb[(qb * 2 + 1) * 28 + 20 + h]));
            const float knt = sqrtf(hmb[(lane >> 1) * 28 + 20 + h]);
            const bool skip = (lane < 4 * qb) && (qn * (knt + knu) + (c2[q0] - c2[64 * lane + 63]) < -30.0f);
            const unsigned long long sk = __ballot(skip); t_lo = sk == ~0ull ? 64 : __builtin_ctzll(~sk); if (t_lo > 4 * qb) t_lo = 4 * qb; t_lo = __builtin_amdgcn_readfirstlane(t_lo);
            const float kmax = sqrtf(lx::max64(hmb[(lane & 31) * 28 + 20 + h]));
            fast = __builtin_amdgcn_readfirstlane((int)(qn * kmax <= 60.0f)) != 0; sbnd = qn * kmax; }
          { LAS float* ck = (LAS float*)(ldsp + RING_OFF + at::LDS_CK); const float* src = CUM2 + (size_t)bh * S_; const int nk = q0 + 256;
            for (int k = 64 * t_lo + tid; k < nk; k += NTHREADS) ck[k] = src[k]; }
          __syncthreads();
          at::UnitIO U; U.Qw = PROJB + ((size_t)b * S_ + q0 + 32 * wave) * at::PITCH + 1280 + h * 64; U.Kh = PROJB + (size_t)b * S_ * at::PITCH + 1792 + h * 64; U.Vh = PROJB + (size_t)b * S_ * at::PITCH + 2304 + h * 64;
          U.t_hi = 4 * qb + 3; U.t_lo = t_lo; U.t_first = 4 * qb + (wave >> 1); U.qpos = q0 + 32 * wave + r32; U.selm = 0ull; U.win = 0; U.cq = CUM2[(size_t)bh * S_ + U.qpos]; U.sbound = sbnd; U.c2q0 = CUM2[(size_t)bh * S_ + q0];
          at::f32x16 o[2], osum; float l; float rli[16];
          if (fast) { at::attn_tiles<at::M_FOX, true>(U, shm, o, l, osum);
#pragma unroll
              for (int r = 0; r < 16; ++r) rli[r] = 1.0f / osum[r]; }
          else { at::attn_tiles<at::M_FOX, false>(U, shm, o, l, osum); at::row_inv(l, shm, rli); }
          at::store_rows<false>(o, rli, OMIX + ((size_t)b * S_ + q0 + 32 * wave) * DM + 512 + h * 64, DM, nullptr, 0);
      } }
    }
    xcd_barrier(bar); if (PROBE_DUP == 60) xcd_barrier(bar);
    {   PHASE_PTRS();
    REP(6)
    { PHASE_IDS(); const int gw = vcu * NWAVES + wave, NGW = NG * NWAVES;
      for (int m = gw; m < T_; m += NGW) {
          typedef unsigned u32x2m __attribute__((ext_vector_type(2))); const GAS u32x2m* xr = (const GAS u32x2m*)(OMIX + (size_t)m * DM) + lane; f32x4 v[4]; float s0 = 0.f, s1 = 0.f;
#pragma unroll
          for (int j = 0; j < 4; ++j) { const u32x2m w = xr[64 * j]; v[j] = (f32x4){__builtin_bit_cast(float, w.x << 16), __builtin_bit_cast(float, w.x & 0xffff0000u), __builtin_bit_cast(float, w.y << 16), __builtin_bit_cast(float, w.y & 0xffff0000u)};
              const float q = (v[j].x * v[j].x + v[j].y * v[j].y) + (v[j].z * v[j].z + v[j].w * v[j].w); if (j < 2) s0 += q; else s1 += q; }
          const float r0 = 1.f / sqrtf(wave_sum(s0) * (1.f / 512.f) + 1e-6f), r1 = 1.f / sqrtf(wave_sum(s1) * (1.f / 512.f) + 1e-6f);
          GAS unsigned long long* o8 = (GAS unsigned long long*)(MIXB + (size_t)m * DM) + lane;
#pragma unroll
          for (int j = 0; j < 4; ++j) { const f32x4 g = j < 2 ? ((const GAS f32x4*)beta_nsa)[lane + 64 * j] : ((const GAS f32x4*)beta_fox)[lane + 64 * (j - 2)]; const float r = j < 2 ? r0 : r1;
              o8[64 * j] = (unsigned long long)pk2(v[j].x * r * g.x, v[j].y * r * g.y) | ((unsigned long long)pk2(v[j].z * r * g.z, v[j].w * r * g.w) << 32); }
      } }
    }
    xcd_barrier(bar); if (PROBE_DUP == 60) xcd_barrier(bar);
    {   PHASE_PTRS();
    REP(7)
    { pg8::Gemm g{MIXB, WOUT_T, T_, DM, DM, 0}; pg8::StaticOrder S; S.init(T_, DM, NG, (int)blockIdx.x);
      pg8::EpiResBf16 E{XN, H1B, DM};
      pg8::gemm_phase<pg8::EpiResBf16, pg8::StaticOrder, true, true>(ldsp + RING_OFF, g, S, E); }
    }
    xcd_barrier(bar); if (PROBE_DUP == 60) xcd_barrier(bar);
    {   PHASE_PTRS();
    REP(8)
    { PHASE_IDS();
      LAS float* WR = (LAS float*)(ldsp + RING_OFF); LAS int* LCNT = (LAS int*)(ldsp + RING_OFF + 81920); LAS float* RS = (LAS float*)(ldsp + RING_OFF + 81920 + 64) + wave * (16 * 24);
#pragma unroll
      for (int kk = 0; kk < 1024 / NTHREADS; ++kk) { const int k = tid + kk * NTHREADS; const float gk = g_ffn[k];
          const f32x4 wg4 = *(const GAS f32x4*)(w_group + k * 4); const GAS f32x4* wr4 = (const GAS f32x4*)(w_router + k * 16); const f32x4 r0 = wr4[0], r1 = wr4[1], r2 = wr4[2], r3 = wr4[3];
          LAS f32x4* dst = (LAS f32x4*)(WR + ((((k >> 8) * 4 + (k & 3)) * 64) + ((k >> 2) & 63)) * 20);   dst[0] = wg4 * gk; dst[1] = r0 * gk; dst[2] = r1 * gk; dst[3] = r2 * gk; dst[4] = r3 * gk; }
      if (tid < 16) LCNT[tid] = 0;
      __syncthreads();
      for (int pa_ = 0; pa_ < (PROBE_DUP == 50 ? 2 : 1); ++pa_)
      {
      typedef unsigned u32x2r __attribute__((ext_vector_type(2)));
      u32x2r na[4], nb[4];
      { const int tA = tok0 + (wave < ntok ? wave : 0), tB = (wave + NWAVES < ntok) ? tA + NWAVES : tA;
        const GAS u32x2r* xa = (const GAS u32x2r*)(H1B + (size_t)tA * DM) + lane; const GAS u32x2r* xb = (const GAS u32x2r*)(H1B + (size_t)tB * DM) + lane;
#pragma unroll
        for (int j = 0; j < 4; ++j) { na[j] = xa[64 * j]; nb[j] = xb[64 * j]; } }
      for (int tt = wave; tt < ntok; tt += 2 * NWAVES) { const int tokA = tok0 + tt; const bool hasB = tt + NWAVES < ntok; const int tokB = hasB ? tokA + NWAVES : tokA;
          f32x4 ha[4], hb[4];
#pragma unroll
          for (int j = 0; j < 4; ++j) { ha[j] = (f32x4){__builtin_bit_cast(float, na[j].x << 16), __builtin_bit_cast(float, na[j].x & 0xffff0000u), __builtin_bit_cast(float, na[j].y << 16), __builtin_bit_cast(float, na[j].y & 0xffff0000u)};
              hb[j] = (f32x4){__builtin_bit_cast(float, nb[j].x << 16), __builtin_bit_cast(float, nb[j].x & 0xffff0000u), __builtin_bit_cast(float, nb[j].y << 16), __builtin_bit_cast(float, nb[j].y & 0xffff0000u)}; }
          if (tt + 2 * NWAVES < ntok) { const int tA = tokA + 2 * NWAVES, tB = (tt + 3 * NWAVES < ntok) ? tA + NWAVES : tA;
              const GAS u32x2r* xa = (const GAS u32x2r*)(H1B + (size_t)tA * DM) + lane; const GAS u32x2r* xb = (const GAS u32x2r*)(H1B + (size_t)tB * DM) + lane;
#pragma unroll
              for (int j = 0; j < 4; ++j) { na[j] = xa[64 * j]; nb[j] = xb[64 * j]; } }
          float va[32], vb[32];
#pragma unroll
          for (int c = 0; c < 32; ++c) { va[c] = 0.f; vb[c] = 0.f; }
#pragma unroll
          for (int m = 0; m < 16; ++m) { const float a_ = ha[m >> 2][m & 3], b_ = hb[m >> 2][m & 3]; va[20] += a_ * a_; vb[20] += b_ * b_; const LAS f32x4* wp = (const LAS f32x4*)(WR + (64 * m + lane) * 20);
#pragma unroll
              for (int q = 0; q < 5; ++q) { const f32x4 w = wp[q];
                  va[4 * q] += a_ * w[0]; va[4 * q + 1] += a_ * w[1]; va[4 * q + 2] += a_ * w[2]; va[4 * q + 3] += a_ * w[3];
                  vb[4 * q] += b_ * w[0]; vb[4 * q + 1] += b_ * w[1]; vb[4 * q + 2] += b_ * w[2]; vb[4 * q + 3] += b_ * w[3]; } }
#define RT_BFLY(v) do { \
          _Pragma("unroll") for (int c = 0; c < 16; ++c) { const bool hi = lane & 32; const float keep = hi ? v[c + 16] : v[c], send = hi ? v[c] : v[c + 16]; v[c] = keep + lx::x32f(send, hi); } \
          _Pragma("unroll") for (int c = 0; c < 8; ++c) { const bool hi = lane & 16; const float keep = hi ? v[c + 8] : v[c], send = hi ? v[c] : v[c + 8]; v[c] = keep + lx::xf<16>(send); } \
          _Pragma("unroll") for (int c = 0; c < 4; ++c) { const bool hi = lane & 8; const float keep = hi ? v[c + 4] : v[c], send = hi ? v[c] : v[c + 4]; v[c] = keep + lx::xf<8>(send); } \
          _Pragma("unroll") for (int c = 0; c < 2; ++c) { const bool hi = lane & 4; const float keep = hi ? v[c + 2] : v[c], send = hi ? v[c] : v[c + 2]; v[c] = keep + lx::xf<4>(send); } \
          { const bool hi = lane & 2; const float keep = hi ? v[1] : v[0], send = hi ? v[0] : v[1]; v[0] = keep + lx::xf<2>(send); } \
          v[0] += lx::xf<1>(v[0]); } while (0)
          RT_BFLY(va); RT_BFLY(vb);
#undef RT_BFLY
          if (!(lane & 1) && (lane >> 1) < 21) { RS[(tt >> 3) * 24 + (lane >> 1)] = va[0]; if (hasB) RS[((tt >> 3) + 1) * 24 + (lane >> 1)] = vb[0]; }
      }
      }
      asm volatile("s_waitcnt lgkmcnt(0)" ::: "memory");
      { const int tt = wave + NWAVES * lane; const bool have = lane < 16 && tt < ntok; const int tok = tok0 + (have ? tt : 0);
          float s[21];
#pragma unroll
          for (int c = 0; c < 21; ++c) s[c] = RS[(lane & 15) * 24 + c];
          const float rstd = 1.0f / sqrtf(s[20] * (1.f / 1024.f) + 1e-6f);
          float gl[4], el[16];
#pragma unroll
          for (int c = 0; c < 4; ++c) gl[c] = s[c] * rstd + b_group[c];
#pragma unroll
          for (int e = 0; e < 16; ++e) el[e] = s[4 + e] * rstd + b_router[e];
          int gs = 0; float gm = gl[0];
#pragma unroll
          for (int c = 1; c < 4; ++c) if (gl[c] > gm) { gm = gl[c]; gs = c; }
          float gsum = 0.f;
#pragma unroll
          for (int c = 0; c < 4; ++c) gsum += expf(gl[c] - gm);
          const float gprob = 1.0f / gsum;
          float il[4] = {0.f, 0.f, 0.f, 0.f};
#pragma unroll
          for (int c = 0; c < 4; ++c)
#pragma unroll
              for (int e = 0; e < 4; ++e) if (gs == c) il[e] = el[c * 4 + e];
          float im = fmaxf(fmaxf(il[0], il[1]), fmaxf(il[2], il[3])); float ipr[4], isum = 0.f;
#pragma unroll
          for (int e = 0; e < 4; ++e) { ipr[e] = expf(il[e] - im); isum += ipr[e]; }
#pragma unroll
          for (int e = 0; e < 4; ++e) ipr[e] /= isum;
          int i0 = 0; float v0 = ipr[0];
#pragma unroll
          for (int e = 1; e < 4; ++e) if (ipr[e] > v0) { v0 = ipr[e]; i0 = e; }
          int i1 = -1; float v1 = -1.f;
#pragma unroll
          for (int e = 0; e < 4; ++e) if (e != i0 && ipr[e] > v1) { v1 = ipr[e]; i1 = e; }
          const float den = v0 + v1;
          if (have) { const int e0 = gs * 4 + i0, e1 = gs * 4 + i1; EIDB[tok * 2] = e0; EIDB[tok * 2 + 1] = e1; CWB[tok * 2] = gprob * (v0 / den); CWB[tok * 2 + 1] = gprob * (v1 / den); RSTD2[tok] = rstd;
              atomicAdd((int*)&LCNT[e0], 1); atomicAdd((int*)&LCNT[e1], 1); }
      }
      __syncthreads();
      if (tid < 16) LC[(int)blockIdx.x * 16 + tid] = LCNT[tid];
    }
    }
    xcd_barrier(bar); if (PROBE_DUP == 60) xcd_barrier(bar);
    {   PHASE_PTRS();
    REP(9)
    { PHASE_IDS();
      LAS int* L = (LAS int*)(ldsp + RING_OFF); LAS int* TOT = L + 1024 * 16; LAS int* MINE = TOT + 16; LAS int* BASE = MINE + 16; LAS int* ME = BASE + 32; LAS int* MPOS = ME + 2 * 512;
      for (int i = tid; i < NG * 16; i += NTHREADS) L[i] = LC[i];
      for (int i = tid; i < 2 * ntok; i += NTHREADS) ME[i] = EIDB[tok0 * 2 + i];
      __syncthreads();
      for (int e = wave; e < 16; e += NWAVES) {
          int tot = 0, mine = 0; for (int w = lane; w < NG; w += 64) { const int c = L[w * 16 + e]; tot += c; if (w < (int)blockIdx.x) mine += c; }
          tot = (int)lx::sum64((float)tot); mine = (int)lx::sum64((float)mine);
          if (lane == 0) { TOT[e] = tot; MINE[e] = mine; } }
      __syncthreads();
      if (tid == 0) { int base = 0; for (int e = 0; e < 16; ++e) { BASE[e] = base; base += (TOT[e] + 255) / 256 * 256; } BASE[16] = base; }
      __syncthreads();
      if (blockIdx.x == 0) { const int nt = BASE[16] / 256; for (int pm = tid; pm < nt; pm += NTHREADS) { int e = 0; for (int q = 1; q < 16; ++q) if (BASE[q] <= pm * 256) e = q; TILE_E[pm] = e; } if (tid == 0) NTILES[0] = nt; }
      for (int e = wave; e < 16; e += NWAVES) { int pos = BASE[e] + MINE[e];
          for (int i0 = 0; i0 < 2 * ntok; i0 += 64) { const int i = i0 + lane; const bool mine_ = i < 2 * ntok && ME[i] == e; const unsigned long long bm = __ballot(mine_);
              if (mine_) MPOS[i] = pos + __builtin_popcountll(bm & ((1ull << lane) - 1ull)); pos += __builtin_popcountll(bm); } }
      __syncthreads();
      for (int i = tid; i < 2 * ntok; i += NTHREADS) { POS[tok0 * 2 + i] = MPOS[i]; ROWIDX[MPOS[i]] = tok0 + (i >> 1); RSS[MPOS[i]] = RSTD2[tok0 + (i >> 1)]; }
      if (blockIdx.x == 0) for (int e = wave; e < 16; e += NWAVES) for (int s = BASE[e] + TOT[e] + lane; s < BASE[e + 1]; s += 64) { ROWIDX[s] = 0; RSS[s] = 0.f; }
    }
    }
    xcd_barrier(bar); if (PROBE_DUP == 60) xcd_barrier(bar);
    {   PHASE_PTRS();
    REP(10)
    { const int NT = __builtin_amdgcn_readfirstlane(__hip_atomic_load(NTILES, __ATOMIC_RELAXED, __HIP_MEMORY_SCOPE_AGENT));
      pg8::Gemm g{H1B, WGU_T, NT * 256, DM, DM, (size_t)1024 * 1024 * 2, ROWIDX}; pg8::GroupOrder S; S.init(NT, 4, NG, (int)blockIdx.x, TILE_E);
      pg8::EpiSwiGlu E{HIDB, RSS};
      pg8::gemm_phase<pg8::EpiSwiGlu, pg8::GroupOrder, true, true, true>(ldsp + RING_OFF, g, S, E); }
    }
    xcd_barrier(bar); if (PROBE_DUP == 60) xcd_barrier(bar);
    {   PHASE_PTRS();
    REP(11)
    { const int NT = __builtin_amdgcn_readfirstlane(__hip_atomic_load(NTILES, __ATOMIC_RELAXED, __HIP_MEMORY_SCOPE_AGENT));
      pg8::Gemm g{HIDB, WD_T, NT * 256, DM, 512, (size_t)1024 * 512 * 2}; pg8::GroupOrder S; S.init(NT, 4, NG, (int)blockIdx.x, TILE_E);
      pg8::EpiBf16Plain E{YB, DM};
      pg8::gemm_phase<pg8::EpiBf16Plain, pg8::GroupOrder, true, true>(ldsp + RING_OFF, g, S, E); }
    REP(13)
    { pg8::Gemm g{PB, WPP_T, T_, DM, 256, 0}; pg8::StaticOrder S; S.init(T_, DM, NG, (int)blockIdx.x);
      pg8::EpiBf16Plain E{PPB, DM};
      pg8::gemm_phase<pg8::EpiBf16Plain, pg8::StaticOrder, true, true>(ldsp + RING_OFF, g, S, E); }
    }
    xcd_barrier(bar); if (PROBE_DUP == 60) xcd_barrier(bar);
    {   PHASE_PTRS();
    for (int rep_ = 0; rep_ < (PROBE_DUP == 12 ? 2 : 1); ++rep_)
    { PHASE_IDS(); const int gw = vcu * NWAVES + wave, NGW = NG * NWAVES; const float wsc = rep_ ? 0.f : 1.f;
      typedef unsigned u32x2v __attribute__((ext_vector_type(2))); typedef int i32x2v __attribute__((ext_vector_type(2))); typedef float f32x2v __attribute__((ext_vector_type(2)));
      i32x2v npA, npB; f32x2v nwA, nwB;
      { const int mA = gw < T_ ? gw : 0, mB = gw + NGW < T_ ? gw + NGW : mA; npA = ((const GAS i32x2v*)POS)[mA]; npB = ((const GAS i32x2v*)POS)[mB]; nwA = ((const GAS f32x2v*)CWB)[mA]; nwB = ((const GAS f32x2v*)CWB)[mB]; }
      for (int m = gw; m < T_; m += 2 * NGW) { const bool hasB = m + NGW < T_; const int mA = m, mB = hasB ? m + NGW : m;
          const i32x2v pA = npA, pB = npB; const f32x2v wA = nwA * wsc, wB = nwB * wsc;
          const GAS u32x2v* xa = (const GAS u32x2v*)(H1B + (size_t)mA * DM) + lane; const GAS u32x2v* xb = (const GAS u32x2v*)(H1B + (size_t)mB * DM) + lane;
          const GAS u32x2v* ya0 = (const GAS u32x2v*)(YB + (size_t)pA.x * DM) + lane; const GAS u32x2v* ya1 = (const GAS u32x2v*)(YB + (size_t)pA.y * DM) + lane;
          const GAS u32x2v* yb0 = (const GAS u32x2v*)(YB + (size_t)pB.x * DM) + lane; const GAS u32x2v* yb1 = (const GAS u32x2v*)(YB + (size_t)pB.y * DM) + lane;
          f32x4 va[4], vb[4]; u32x2v ha_[4], hb_[4], a0[4], a1[4], b0[4], b1[4];
#pragma unroll
          for (int j = 0; j < 4; ++j) { ha_[j] = xa[64 * j]; hb_[j] = xb[64 * j]; a0[j] = ya0[64 * j]; a1[j] = ya1[64 * j]; b0[j] = yb0[64 * j]; b1[j] = yb1[64 * j]; }
          if (m + 2 * NGW < T_) { const int nA = m + 2 * NGW, nB = m + 3 * NGW < T_ ? m + 3 * NGW : nA; npA = ((const GAS i32x2v*)POS)[nA]; npB = ((const GAS i32x2v*)POS)[nB]; nwA = ((const GAS f32x2v*)CWB)[nA]; nwB = ((const GAS f32x2v*)CWB)[nB]; }
          float sa = 0.f, sb = 0.f;
#define CB_ADD(V_, Y0_, Y1_, W_) do { V_[0] += W_[0] * __builtin_bit_cast(float, Y0_[0] << 16) + W_[1] * __builtin_bit_cast(float, Y1_[0] << 16); V_[1] += W_[0] * __builtin_bit_cast(float, Y0_[0] & 0xffff0000u) + W_[1] * __builtin_bit_cast(float, Y1_[0] & 0xffff0000u); \
              V_[2] += W_[0] * __builtin_bit_cast(float, Y0_[1] << 16) + W_[1] * __builtin_bit_cast(float, Y1_[1] << 16); V_[3] += W_[0] * __builtin_bit_cast(float, Y0_[1] & 0xffff0000u) + W_[1] * __builtin_bit_cast(float, Y1_[1] & 0xffff0000u); } while (0)
#pragma unroll
          for (int j = 0; j < 4; ++j) { va[j] = (f32x4){__builtin_bit_cast(float, ha_[j].x << 16), __builtin_bit_cast(float, ha_[j].x & 0xffff0000u), __builtin_bit_cast(float, ha_[j].y << 16), __builtin_bit_cast(float, ha_[j].y & 0xffff0000u)};
              vb[j] = (f32x4){__builtin_bit_cast(float, hb_[j].x << 16), __builtin_bit_cast(float, hb_[j].x & 0xffff0000u), __builtin_bit_cast(float, hb_[j].y << 16), __builtin_bit_cast(float, hb_[j].y & 0xffff0000u)};
              CB_ADD(va[j], a0[j], a1[j], wA); CB_ADD(vb[j], b0[j], b1[j], wB);
              sa += (va[j].x * va[j].x + va[j].y * va[j].y) + (va[j].z * va[j].z + va[j].w * va[j].w); sb += (vb[j].x * vb[j].x + vb[j].y * vb[j].y) + (vb[j].z * vb[j].z + vb[j].w * vb[j].w); }
#undef CB_ADD
          const float ra = 1.f / sqrtf(wave_sum(sa) * (1.f / 1024.f) + 1e-6f), rb = 1.f / sqrtf(wave_sum(sb) * (1.f / 1024.f) + 1e-6f);
          GAS unsigned long long* oa = (GAS unsigned long long*)(VPLE + (size_t)mA * DM) + lane; GAS unsigned long long* ob = (GAS unsigned long long*)(VPLE + (size_t)mB * DM) + lane;
#pragma unroll
          for (int j = 0; j < 4; ++j) {
              oa[64 * j] = (unsigned long long)pk2(va[j].x, va[j].y) | ((unsigned long long)pk2(va[j].z, va[j].w) << 32);
              if (hasB) ob[64 * j] = (unsigned long long)pk2(vb[j].x, vb[j].y) | ((unsigned long long)pk2(vb[j].z, vb[j].w) << 32); }
          if (lane == 0) { RA[mA] = ra; if (hasB) RA[mB] = rb; }
      } }
    }
    xcd_barrier(bar); if (PROBE_DUP == 60) xcd_barrier(bar);
    {   PHASE_PTRS();
    if (NG == 256 && T_ == 32768) {
      pg8::Gemm g{VPLE, WPG_T, T_, DM, DM, 0}; pg8::StaticOrder S; S.init(T_, DM, NG, (int)blockIdx.x);
      pg8::EpiPleGateNorm E{HB, VPLE, RA, PPB, b_ple, g_final, (float*)(ws + WS_XS), (unsigned*)(ws + WS_CTL) + CW_PANEL, ldsp + RING_BYTES, DM};
      pg8::gemm_phase<pg8::EpiPleGateNorm, pg8::StaticOrder, true, true>(ldsp + RING_OFF, g, S, E);
    } else {
    { pg8::Gemm g{VPLE, WPG_T, T_, DM, DM, 0}; pg8::StaticOrder S; S.init(T_, DM, NG, (int)blockIdx.x);
      pg8::EpiPleGate E{HB, VPLE, RA, PPB, b_ple, DM};
      pg8::gemm_phase<pg8::EpiPleGate, pg8::StaticOrder, true, true>(ldsp + RING_OFF, g, S, E); }
      xcd_barrier(bar);
    { PHASE_IDS(); const int gw = vcu * NWAVES + wave, NGW = NG * NWAVES;
      for (int m = gw; m < T_; m += NGW) {
          GAS f32x4* xr = (GAS f32x4*)(HB + (size_t)m * DM) + lane; f32x4 v[4]; float s = 0.f;
#pragma unroll
          for (int j = 0; j < 4; ++j) { v[j] = xr[64 * j]; s += (v[j].x * v[j].x + v[j].y * v[j].y) + (v[j].z * v[j].z + v[j].w * v[j].w); }
          const float r = 1.f / sqrtf(wave_sum(s) * (1.f / 1024.f) + 1e-6f);
#pragma unroll
          for (int j = 0; j < 4; ++j) { const f32x4 g = ((const GAS f32x4*)g_final)[lane + 64 * j]; xr[64 * j] = (f32x4){v[j].x * r * g.x, v[j].y * r * g.y, v[j].z * r * g.z, v[j].w * r * g.w}; }
      } }
    }
    }
}
}
extern "C" void kernel_launch(void* const* d_in, const int* in_sizes, int n_in, void* d_out, int out_size, void* d_ws, size_t ws_size, hipStream_t stream) {
    static int grid = 0;
    if (grid == 0) {
        int dev = 0, cus = 0;
        if (n_in != 29 || ws_size < ((size_t)512 << 20)) { fprintf(stderr, "kernel_launch: unexpected n_in %d or ws_size %zu\n", n_in, ws_size); grid = -1; return; }
        if (hipGetDevice(&dev) != hipSuccess || hipDeviceGetAttribute(&cus, hipDeviceAttributeMultiprocessorCount, dev) != hipSuccess) { grid = -1; return; }
        if (hipFuncSetAttribute((const void*)mk::mk_fwd, hipFuncAttributeMaxDynamicSharedMemorySize, mk::LDS_BYTES) != hipSuccess) { fprintf(stderr, "kernel_launch: hipFuncSetAttribute failed\n"); grid = -1; return; }
        int per_cu = 0;
        if (hipOccupancyMaxActiveBlocksPerMultiprocessor(&per_cu, (const void*)mk::mk_fwd, mk::NTHREADS, mk::LDS_BYTES) != hipSuccess || per_cu < 1) { fprintf(stderr, "kernel_launch: occupancy query says %d\n", per_cu); }
        (void)hipGetLastError();
        grid = cus;
    }
    if (grid < 0) return;
    (void)hipMemsetAsync((char*)d_ws + mk::WS_CTL, 0, mk::CTL_ZERO_BYTES, stream);
    mk::Args a{};
    for (int i = 0; i < 29; ++i) a.in[i] = d_in[i];
    a.out = d_out; a.ws = d_ws;
    hipLaunchKernelGGL(mk::mk_fwd, dim3(grid), dim3(mk::NTHREADS), mk::LDS_BYTES, stream, a);
}
```

```cpp
#define PROBE_DUP (-1)
#include <hip/hip_runtime.h>
#include <hip/hip_bf16.h>
#include <cstdio>
#include <cstdint>
#include <cmath>
namespace lx {
template <int M> __device__ __forceinline__ float xf(float v) { static_assert(M >= 1 && M < 32, "xf: within a 32-lane half"); return __builtin_bit_cast(float, __builtin_amdgcn_ds_swizzle(__builtin_bit_cast(int, v), (M << 10) | 0x1f)); }
template <int M> __device__ __forceinline__ int xi(int v) { static_assert(M >= 1 && M < 32, "xi: within a 32-lane half"); return __builtin_amdgcn_ds_swizzle(v, (M << 10) | 0x1f); }
__device__ __forceinline__ float x32f(float v, bool hi) { auto rr = __builtin_amdgcn_permlane32_swap(__float_as_uint(v), __float_as_uint(v), false, false); return __uint_as_float(hi ? rr[0] : rr[1]); }
__device__ __forceinline__ float sum64(float v) { v += xf<1>(v); v += xf<2>(v); v += xf<4>(v); v += xf<8>(v); v += xf<16>(v);
    auto rr = __builtin_amdgcn_permlane32_swap(__float_as_uint(v), __float_as_uint(v), false, false); return __uint_as_float(rr[0]) + __uint_as_float(rr[1]); }
__device__ __forceinline__ float max64(float v) { v = fmaxf(v, xf<1>(v)); v = fmaxf(v, xf<2>(v)); v = fmaxf(v, xf<4>(v)); v = fmaxf(v, xf<8>(v)); v = fmaxf(v, xf<16>(v));
    auto rr = __builtin_amdgcn_permlane32_swap(__float_as_uint(v), __float_as_uint(v), false, false); return fmaxf(__uint_as_float(rr[0]), __uint_as_float(rr[1])); }
}
#ifndef CFG_BATCH
#define CFG_BATCH 8
#endif
#ifndef CFG_SEQ
#define CFG_SEQ 4096
#endif
#ifndef CFG_NSEL
#define CFG_NSEL 16
#endif
#ifndef CFG_WINDOW
#define CFG_WINDOW 512
#endif
namespace nv {
constexpr int B_ = CFG_BATCH, S_ = CFG_SEQ, T_ = B_ * S_, DM = 1024, HD = 64;
constexpr int IN_COLS = 2848;
constexpr int OFF_QA = 0, OFF_KC = 512, OFF_VC = 640, OFF_KS = 768, OFF_VS = 896, OFF_KW = 1024, OFF_VW = 1152,
              OFF_GATE = 1280, OFF_QB = 1304, OFF_KB = 1816, OFF_VB = 2328, OFF_F = 2840;
constexpr int NCMP = (S_ - 32) / 16 + 1, NBLK = S_ / 64, NSEL = (CFG_NSEL < NBLK ? CFG_NSEL : NBLK), WIN = CFG_WINDOW;
constexpr float EPS = 1e-6f;
static_assert(NBLK <= 64, "selection mask is 64 bits");


__device__ __forceinline__ float nv_sigmoid(float x) { return 1.0f / (1.0f + expf(-x)); }
__device__ __forceinline__ float nv_silu(float x) { return x / (1.0f + expf(-x)); }
__device__ __forceinline__ float nv_logsigmoid(float x) { return fminf(x, 0.0f) - log1pf(expf(-fabsf(x))); }


constexpr float C2F = 0.125f * 1.4426950408889634f;
constexpr int PB_COLS = 2816;
struct ProjF32 { const float* p;
    __device__ __forceinline__ float operator()(long tok, int off, int i) const { return p[tok * IN_COLS + off + i]; } };
struct ProjB16 { const unsigned short* p; const float* gates; const float* logf;
    __device__ __forceinline__ float operator()(long tok, int off, int i) const {
        if (off == OFF_GATE) return gates[tok * 24 + i];
        if (off == OFF_F) return logf[tok * 8 + i];
        const int nb = off < OFF_GATE ? off : off - 24;
        const unsigned u = (unsigned)p[tok * PB_COLS + nb + i] << 16;
#ifdef CPU_EMU
        float v; memcpy(&v, &u, 4);
#else
        float v = __builtin_bit_cast(float, u);
#endif
        if (off == OFF_QA || off == OFF_QB) v *= (1.0f / C2F);
        return v; } };

__device__ __forceinline__ void d_rstd(long gid_, const float* __restrict__ x, float* __restrict__ rstd, int rows) {
    long r = gid_; if (r >= rows) return;
    const float* xr = x + r * DM; float s = 0.f;
    for (int k = 0; k < DM; ++k) s += xr[k] * xr[k];
    rstd[r] = 1.0f / sqrtf(s / DM + EPS);
}

__device__ __forceinline__ void d_gemm(long gid_, const float* __restrict__ A, int lda, const float* __restrict__ rs, const float* __restrict__ cs,
                       const float* __restrict__ Bm, int ldb, float* __restrict__ C, int ldc, int M, int N, int K,
                       const float* __restrict__ Res, int ldr) {
    long gid = gid_; const int tn = N / 4; long tiles = (long)(M / 4) * tn; if (gid >= tiles) return;
    const int m0 = (int)(gid / tn) * 4, n0 = (int)(gid % tn) * 4;
    float acc[4][4];
#pragma unroll
    for (int r = 0; r < 4; ++r)
#pragma unroll
        for (int c = 0; c < 4; ++c) acc[r][c] = 0.f;
    for (int k = 0; k < K; ++k) {
        const float sc = cs ? cs[k] : 1.0f;
        const float* bp = Bm + (long)k * ldb + n0;
        const float b0 = bp[0], b1 = bp[1], b2 = bp[2], b3 = bp[3];
#pragma unroll
        for (int r = 0; r < 4; ++r) {
            const float a = A[(long)(m0 + r) * lda + k] * sc;
            acc[r][0] += a * b0; acc[r][1] += a * b1; acc[r][2] += a * b2; acc[r][3] += a * b3;
        }
    }
#pragma unroll
    for (int r = 0; r < 4; ++r) {
        const float s = rs ? rs[m0 + r] : 1.0f;
#pragma unroll
        for (int c = 0; c < 4; ++c) {
            float v = acc[r][c] * s;
            if (Res) v += Res[(long)(m0 + r) * ldr + n0 + c];
            C[(long)(m0 + r) * ldc + n0 + c] = v;
        }
    }
}

__device__ __forceinline__ void d_postproj(long gid_, float* __restrict__ proj, const int* __restrict__ positions, const float* __restrict__ b_gate,
                           const float* __restrict__ b_forget) {
    long gid = gid_; if (gid >= (long)T_ * 14) return;
    const int tok = (int)(gid / 14), unit = (int)(gid % 14);
    float* row = proj + (long)tok * IN_COLS;
    if (unit < 12) {
        int off = unit < 8 ? OFF_QA + unit * 64 : (unit < 10 ? OFF_KS + (unit - 8) * 64 : OFF_KW + (unit - 10) * 64);
        const float pos = (float)positions[tok];
        for (int i = 0; i < 8; ++i) {
            const float inv = powf(500000.0f, -(float)i / 8.0f);
            const float ang = pos * inv, c = cosf(ang), s = sinf(ang);
            const float x1 = row[off + i], x2 = row[off + 8 + i];
            row[off + i] = x1 * c - x2 * s; row[off + 8 + i] = x2 * c + x1 * s;
        }
    } else if (unit == 12) {
        for (int i = 0; i < 24; ++i) row[OFF_GATE + i] = nv_sigmoid(row[OFF_GATE + i] + b_gate[i]);
    } else {
        for (int i = 0; i < 8; ++i) row[OFF_F + i] = nv_logsigmoid(row[OFF_F + i] + b_forget[i]);
    }
}

template <class PJ> __device__ __forceinline__ void d_cumsum(long gid_, const PJ proj, float* __restrict__ cum) {
    long gid = gid_; if (gid >= B_ * 8) return;
    const int b = (int)gid / 8, h = (int)gid % 8; double c = 0.0;
    for (int t = 0; t < S_; ++t) { c += (double)proj((long)b * S_ + t, OFF_F, h); cum[((long)b * 8 + h) * S_ + t] = (float)c; }
}

template <class PJ> __device__ __forceinline__ void d_cmp_hidden(long gid_, const PJ proj, int coloff, const float* __restrict__ pe, const float* __restrict__ w1,
                             float* __restrict__ hid) {
    long gid = gid_; if (gid >= (long)B_ * NCMP * 2 * 128) return;
    const int j = (int)(gid % 128); const int row = (int)(gid / 128); const int g = row % 2, n = (row / 2) % NCMP, b = row / (2 * NCMP);
    float acc = 0.f;
    for (int l = 0; l < 32; ++l) {
        const long tk = (long)b * S_ + 16 * n + l;
        for (int d = 0; d < 64; ++d) acc += (proj(tk, coloff, g * 64 + d) + pe[l * 64 + d]) * w1[(long)(l * 64 + d) * 128 + j];
    }
    hid[(long)row * 128 + j] = nv_silu(acc);
}
__device__ __forceinline__ void d_cmp_out(long gid_, const float* __restrict__ hid, const float* __restrict__ w2, float* __restrict__ out,
                          const int* __restrict__ positions, int dorope) {
    long gid = gid_; if (gid >= (long)B_ * NCMP * 2 * 56) return;
    const int u = (int)(gid % 56); const int row = (int)(gid / 56); const int n = (row / 2) % NCMP, b = row / (2 * NCMP);
    const float* hp = hid + (long)row * 128;
    if (u < 8) {
        float a1 = 0.f, a2 = 0.f;
        for (int j = 0; j < 128; ++j) { a1 += hp[j] * w2[j * 64 + u]; a2 += hp[j] * w2[j * 64 + u + 8]; }
        if (dorope) {
            const float pos = (float)positions[(long)b * S_ + 16 * n + 31];
            const float inv = powf(500000.0f, -(float)u / 8.0f); const float ang = pos * inv, c = cosf(ang), s = sinf(ang);
            const float x1 = a1, x2 = a2; a1 = x1 * c - x2 * s; a2 = x2 * c + x1 * s;
        }
        out[(long)row * 64 + u] = a1; out[(long)row * 64 + u + 8] = a2;
    } else {
        const int d = u + 8; float a = 0.f;
        for (int j = 0; j < 128; ++j) a += hp[j] * w2[j * 64 + d];
        out[(long)row * 64 + d] = a;
    }
}

template <class PJ> __device__ __forceinline__ void d_nsa_cmp(long gid_, const PJ proj, const float* __restrict__ kc, const float* __restrict__ vc,
                          float* __restrict__ imp, unsigned long long* __restrict__ selmask, float* __restrict__ omix) {
    long gid = gid_; if (gid >= (long)T_ * 2) return;
    const int g = (int)(gid % 2); const int tok = (int)(gid / 2); const int b = tok / S_, t = tok % S_;
    const int nvis = t >= 31 ? (t - 31) / 16 + 1 : 0;
    float* ip = imp + ((long)(b * 2 + g) * S_ + t) * 64;
    for (int j = 0; j < NBLK; ++j) ip[j] = 0.f;
#pragma unroll 1
    for (int hh = 0; hh < 4; ++hh) {
        const int h = g * 4 + hh;
        float m = -1e30f;
#pragma unroll 1
        for (int n = 0; n < nvis; ++n) {
            asm volatile("" ::: "memory");
            const float* kp = kc + ((long)(b * NCMP + n) * 2 + g) * 64; float l = 0.f;
#pragma unroll
            for (int d = 0; d < 64; ++d) l += proj(tok, OFF_QA, h * 64 + d) * kp[d];
            m = fmaxf(m, l * 0.125f);
        }
        float sum = 0.f;
#pragma unroll 1
        for (int n = 0; n < nvis; ++n) {
            asm volatile("" ::: "memory");
            const float* kp = kc + ((long)(b * NCMP + n) * 2 + g) * 64; float l = 0.f;
#pragma unroll
            for (int d = 0; d < 64; ++d) l += proj(tok, OFF_QA, h * 64 + d) * kp[d];
            sum += expf(l * 0.125f - m);
        }
        const float g0 = proj(tok, OFF_GATE, h * 3 + 0);
#pragma unroll 1
        for (int dh = 0; dh < 2; ++dh) {
            float o[32];
#pragma unroll
            for (int d = 0; d < 32; ++d) o[d] = 0.f;
#pragma unroll 1
            for (int n = 0; n < nvis; ++n) {
                asm volatile("" ::: "memory");
                const float* kp = kc + ((long)(b * NCMP + n) * 2 + g) * 64; float l = 0.f;
#pragma unroll
                for (int d = 0; d < 64; ++d) l += proj(tok, OFF_QA, h * 64 + d) * kp[d];
                const float p = expf(l * 0.125f - m) / sum;
                const float* vp = vc + ((long)(b * NCMP + n) * 2 + g) * 64 + dh * 32;
#pragma unroll
                for (int d = 0; d < 32; ++d) o[d] += p * vp[d];
                if (dh == 0) {
                    const int j0 = n >> 2;
                    if ((n & 3) < 3) ip[j0] += p; else { ip[j0] += 0.5f * p; if (j0 + 1 < NBLK) ip[j0 + 1] += 0.5f * p; }
                }
            }
#pragma unroll
            for (int d = 0; d < 32; ++d) omix[(long)tok * DM + h * 64 + dh * 32 + d] = g0 * o[d];
        }
    }
    const int cur = t / 64; unsigned long long mask = 0ull;
#pragma unroll 1
    for (int s = 0; s < NSEL; ++s) {
        float best = -3e38f; int bj = -1;
#pragma unroll 1
        for (int j = 0; j < NBLK; ++j) {
            if ((mask >> j) & 1ull) continue;
            const bool forced = (j == 0) || (j == cur) || (j == cur - 1);
            const float sc = (j * 64 > t) ? -1.0f : ip[j] + (forced ? 1e4f : 0.0f);
            if (sc > best) { best = sc; bj = j; }
        }
        mask |= 1ull << bj;
    }
    selmask[(long)(b * 2 + g) * S_ + t] = mask;
}

template <class PJ> __device__ __forceinline__ void d_nsa_selwin(long gid_, const PJ proj, const unsigned long long* __restrict__ selmask, float* __restrict__ omix) {
    long gid = gid_; if (gid >= (long)T_ * 8) return;
    const int h = (int)(gid % 8); const int tok = (int)(gid / 8); const int b = tok / S_, t = tok % S_, g = h >> 2;
    float q[64], o[64];
#pragma unroll
    for (int d = 0; d < 64; ++d) { q[d] = proj(tok, OFF_QA, h * 64 + d); o[d] = 0.f; }
    const unsigned long long mask = selmask[(long)(b * 2 + g) * S_ + t];
    float m = -1e30f, l = 0.f;
    for (int j = 0; j < NBLK; ++j) {
        if (!((mask >> j) & 1ull)) continue;
        for (int kk = 0; kk < 64; ++kk) {
            const int kp = j * 64 + kk; if (kp > t) break;
            const long kr = (long)b * S_ + kp; float s = 0.f;
#pragma unroll
            for (int d = 0; d < 64; ++d) s += q[d] * proj(kr, OFF_KS, g * 64 + d);
            s *= 0.125f;
            const float mn = fmaxf(m, s), al = expf(m - mn), p = expf(s - mn);
            l = l * al + p;
#pragma unroll
            for (int d = 0; d < 64; ++d) o[d] = o[d] * al + p * proj(kr, OFF_VS, g * 64 + d);
            m = mn;
        }
    }
    {
        const float g1 = proj(tok, OFF_GATE, h * 3 + 1) / l;
#pragma unroll
        for (int d = 0; d < 64; ++d) { omix[(long)tok * DM + h * 64 + d] += g1 * o[d]; o[d] = 0.f; }
    }
    m = -1e30f; l = 0.f;
    const int lo = t - WIN + 1 > 0 ? t - WIN + 1 : 0;
    for (int kp = lo; kp <= t; ++kp) {
        const long kr = (long)b * S_ + kp; float s = 0.f;
#pragma unroll
        for (int d = 0; d < 64; ++d) s += q[d] * proj(kr, OFF_KW, g * 64 + d);
        s *= 0.125f;
        const float mn = fmaxf(m, s), al = expf(m - mn), p = expf(s - mn);
        l = l * al + p;
#pragma unroll
        for (int d = 0; d < 64; ++d) o[d] = o[d] * al + p * proj(kr, OFF_VW, g * 64 + d);
        m = mn;
    }
    {
        const float g2 = proj(tok, OFF_GATE, h * 3 + 2) / l;
#pragma unroll
        for (int d = 0; d < 64; ++d) omix[(long)tok * DM + h * 64 + d] += g2 * o[d];
    }
}

template <class PJ> __device__ __forceinline__ void d_fox(long gid_, const PJ proj, const float* __restrict__ cum, float* __restrict__ omix) {
    long gid = gid_; if (gid >= (long)T_ * 8) return;
    const int t = (int)(gid % S_); const int bh = (int)(gid / S_); const int b = bh / 8, h = bh % 8;
    const long tok = (long)b * S_ + t;
    float q[64], o[64];
#pragma unroll
    for (int d = 0; d < 64; ++d) { q[d] = proj(tok, OFF_QB, h * 64 + d); o[d] = 0.f; }
    const float* cp = cum + ((long)b * 8 + h) * S_; const float cq = cp[t];
    float m = -1e30f, l = 0.f;
    for (int kp = 0; kp <= t; ++kp) {
        const long kr = (long)b * S_ + kp; float s = 0.f;
#pragma unroll
        for (int d = 0; d < 64; ++d) s += q[d] * proj(kr, OFF_KB, h * 64 + d);
        s = s * 0.125f + (cq - cp[kp]);
        const float mn = fmaxf(m, s), al = expf(m - mn), p = expf(s - mn);
        l = l * al + p;
#pragma unroll
        for (int d = 0; d < 64; ++d) o[d] = o[d] * al + p * proj(kr, OFF_VB, h * 64 + d);
        m = mn;
    }
    const float il = 1.0f / l;
#pragma unroll
    for (int d = 0; d < 64; ++d) omix[tok * DM + 512 + h * 64 + d] = o[d] * il;
}

__device__ __forceinline__ void d_mixnorm(long gid_, float* __restrict__ omix, const float* __restrict__ beta_nsa, const float* __restrict__ beta_fox) {
    long gid = gid_; if (gid >= (long)T_ * 2) return;
    const int half = (int)(gid % 2); float* v = omix + (gid / 2) * DM + half * 512; const float* be = half ? beta_fox : beta_nsa;
    float s = 0.f; for (int k = 0; k < 512; ++k) s += v[k] * v[k];
    const float r = 1.0f / sqrtf(s / 512 + EPS);
    for (int k = 0; k < 512; ++k) v[k] = v[k] * r * be[k];
}

__device__ __forceinline__ void d_router(long gid_, const float* __restrict__ H, const float* __restrict__ g_ffn, const float* __restrict__ w_group, const float* __restrict__ b_group,
                         const float* __restrict__ w_router, const float* __restrict__ b_router, float* __restrict__ U, int* __restrict__ eid, float* __restrict__ cw) {
    long tok = gid_; if (tok >= T_) return;
    const float* hr = H + tok * DM; float ss = 0.f;
    for (int k = 0; k < DM; ++k) ss += hr[k] * hr[k];
    const float rstd = 1.0f / sqrtf(ss / DM + EPS);
    float gl[4], el[16];
#pragma unroll
    for (int c = 0; c < 4; ++c) gl[c] = 0.f;
#pragma unroll
    for (int e = 0; e < 16; ++e) el[e] = 0.f;
    for (int k = 0; k < DM; ++k) {
        const float u = hr[k] * rstd * g_ffn[k]; U[tok * DM + k] = u;
#pragma unroll
        for (int c = 0; c < 4; ++c) gl[c] += u * w_group[k * 4 + c];
#pragma unroll
        for (int e = 0; e < 16; ++e) el[e] += u * w_router[k * 16 + e];
    }
#pragma unroll
    for (int c = 0; c < 4; ++c) gl[c] += b_group[c];
#pragma unroll
    for (int e = 0; e < 16; ++e) el[e] += b_router[e];
    int gs = 0; float gm = gl[0];
#pragma unroll
    for (int c = 1; c < 4; ++c) if (gl[c] > gm) { gm = gl[c]; gs = c; }
    float gsum = 0.f;
#pragma unroll
    for (int c = 0; c < 4; ++c) gsum += expf(gl[c] - gm);
    const float gprob = 1.0f / gsum;
    float il[4] = {0.f, 0.f, 0.f, 0.f};
#pragma unroll
    for (int c = 0; c < 4; ++c)
#pragma unroll
        for (int e = 0; e < 4; ++e) if (gs == c) il[e] = el[c * 4 + e];
    float im = il[0];
#pragma unroll
    for (int e = 1; e < 4; ++e) im = fmaxf(im, il[e]);
    float ipr[4], isum = 0.f;
#pragma unroll
    for (int e = 0; e < 4; ++e) { ipr[e] = expf(il[e] - im); isum += ipr[e]; }
#pragma unroll
    for (int e = 0; e < 4; ++e) ipr[e] /= isum;
    int i0 = 0; float v0 = ipr[0];
#pragma unroll
    for (int e = 1; e < 4; ++e) if (ipr[e] > v0) { v0 = ipr[e]; i0 = e; }
    int i1 = -1; float v1 = -1.f;
#pragma unroll
    for (int e = 0; e < 4; ++e) if (e != i0 && ipr[e] > v1) { v1 = ipr[e]; i1 = e; }
    const float den = v0 + v1;
    eid[tok * 2 + 0] = gs * 4 + i0; eid[tok * 2 + 1] = gs * 4 + i1;
    cw[tok * 2 + 0] = gprob * (v0 / den); cw[tok * 2 + 1] = gprob * (v1 / den);
}

__device__ __forceinline__ void d_expert_up(long gid_, const float* __restrict__ U, const int* __restrict__ eid, const float* __restrict__ wg, const float* __restrict__ wu, float* __restrict__ hid) {
    long gid = gid_; if (gid >= (long)T_ * 2 * 128) return;
    const int jg = (int)(gid % 128); const long tk = gid / 128; const long tok = tk / 2; const int e = eid[tk];
    const float* ur = U + tok * DM; const float* gp = wg + (long)e * DM * 512 + jg * 4; const float* up = wu + (long)e * DM * 512 + jg * 4;
    float ga[4] = {0.f, 0.f, 0.f, 0.f}, ua[4] = {0.f, 0.f, 0.f, 0.f};
    for (int i = 0; i < DM; ++i) {
        const float u = ur[i];
#pragma unroll
        for (int c = 0; c < 4; ++c) { ga[c] += u * gp[(long)i * 512 + c]; ua[c] += u * up[(long)i * 512 + c]; }
    }
#pragma unroll
    for (int c = 0; c < 4; ++c) hid[tk * 512 + jg * 4 + c] = nv_silu(ga[c]) * ua[c];
}
__device__ __forceinline__ void d_expert_down(long gid_, float* __restrict__ H, const int* __restrict__ eid, const float* __restrict__ cw, const float* __restrict__ wd, const float* __restrict__ hid) {
    long gid = gid_; if (gid >= (long)T_ * 256) return;
    const int cg = (int)(gid % 256); const long tok = gid / 256;
    float acc[4] = {0.f, 0.f, 0.f, 0.f};
    for (int k = 0; k < 2; ++k) {
        const int e = eid[tok * 2 + k]; const float w = cw[tok * 2 + k];
        const float* hp = hid + (tok * 2 + k) * 512; const float* dp = wd + (long)e * 512 * DM + cg * 4;
        float tmp[4] = {0.f, 0.f, 0.f, 0.f};
        for (int j = 0; j < 512; ++j) {
            const float hv = hp[j];
#pragma unroll
            for (int c = 0; c < 4; ++c) tmp[c] += hv * dp[(long)j * DM + c];
        }
#pragma unroll
        for (int c = 0; c < 4; ++c) acc[c] += w * tmp[c];
    }
#pragma unroll
    for (int c = 0; c < 4; ++c) H[tok * DM + cg * 4 + c] += acc[c];
}

__device__ __forceinline__ void d_final(long gid_, const float* __restrict__ H, float* __restrict__ G, const float* __restrict__ PP, const float* __restrict__ b_ple,
                        const float* __restrict__ g_final, float* __restrict__ out) {
    long tok = gid_; if (tok >= T_) return;
    float ss = 0.f;
    for (int c = 0; c < DM; ++c) {
        const float h3 = H[tok * DM + c] + nv_sigmoid(G[tok * DM + c] + b_ple[c]) * PP[tok * DM + c];
        G[tok * DM + c] = h3; ss += h3 * h3;
    }
    const float r = 1.0f / sqrtf(ss / DM + EPS);
    for (int c = 0; c < DM; ++c) out[tok * DM + c] = G[tok * DM + c] * r * g_final[c];
}

constexpr size_t MiB = 1u << 20;
constexpr size_t SZ_PROJ = (size_t)T_ * IN_COLS * 4, SZ_ACT = (size_t)T_ * DM * 4;
constexpr size_t A16(size_t x) { return (x + 255) / 256 * 256; }
constexpr size_t W_PROJ = 0;
constexpr size_t W_RSTD1 = A16(W_PROJ + SZ_PROJ);
constexpr size_t W_CUM = A16(W_RSTD1 + (size_t)T_ * 4);
constexpr size_t W_KC = A16(W_CUM + (size_t)T_ * 8 * 4);
constexpr size_t W_VC = A16(W_KC + (size_t)B_ * NCMP * 2 * 64 * 4);
constexpr size_t W_CMPH = A16(W_VC + (size_t)B_ * NCMP * 2 * 64 * 4);
constexpr size_t W_IMP = A16(W_CMPH + (size_t)B_ * NCMP * 2 * 128 * 4 * 2);
constexpr size_t W_SELM = A16(W_IMP + (size_t)B_ * 2 * S_ * 64 * 4);
constexpr size_t W_END1 = A16(W_SELM + (size_t)B_ * 2 * S_ * 8);
constexpr size_t W_H = 0, W_U = SZ_ACT, W_HID = 2 * SZ_ACT, W_EID = 3 * SZ_ACT, W_CW = A16(W_EID + (size_t)T_ * 8), W_RS3 = A16(W_CW + (size_t)T_ * 8),
                 W_END2 = A16(W_RS3 + (size_t)T_ * 4);
constexpr size_t W_PP = W_U, W_G = W_HID;
constexpr size_t W_TOTAL = W_END1 > W_END2 ? W_END1 : W_END2;


#ifndef NV_DBG
#define NV_DBG(name)
#endif
#ifndef CPU_EMU
template <auto F, class... A> __global__ void __launch_bounds__(256) k_wrap(long n, A... a) {
    const long gid = (long)blockIdx.x * (long)blockDim.x + (long)threadIdx.x; if (gid < n) F(gid, a...);
}
#endif
}
namespace pg8 {
#define PG8_LAS __attribute__((address_space(3)))
typedef unsigned short bf16_t;
typedef short bf16x8 __attribute__((ext_vector_type(8)));
typedef float f32x4 __attribute__((ext_vector_type(4)));
typedef unsigned u32x4 __attribute__((ext_vector_type(4)));
constexpr int BM = 256, BK = 64, HALF = 128, HTB = HALF * BK * 2  , STAGE_BYTES = 8 * HTB, NXCD = 8, WGM = 8;

__host__ __device__ __forceinline__ int lds_byte(int r, int c) { const int st = (r >> 4) * 2 + (c >> 5), rr = r & 15, cc = c & 31, ob = rr * 64 + cc * 2; return st * 1024 + (ob ^ (((ob >> 9) & 1) << 5)); }
__host__ __device__ __forceinline__ void stage_rc(int b, int& R, int& C) { const int st = b / 1024, sb = b % 1024, swz = sb ^ (((sb >> 9) & 1) << 5); R = (st >> 1) * 16 + swz / 64; C = (st & 1) * 32 + (swz % 64) / 2; }
__host__ __device__ __forceinline__ int perm32(int rho) { const int n = rho >> 4, i = rho & 15; return 8 * (i >> 2) + 4 * n + (i & 3); }

struct Unit { int pm, pn, be; };
struct Gemm { const bf16_t* A; const bf16_t* Bt; int M, N, K; size_t bstride; const int* rowidx; };

struct StaticOrder {
    int nM, nN, nwg, G, c;
    __host__ __device__ void init(int M, int N, int G_, int c_) { nM = M / BM; nN = N / BM; nwg = nM * nN; G = G_; c = c_; }
    __host__ __device__ bool next(int i, Unit& u) const {
        const long L = (long)i * G + c; if (L >= nwg) return false;
        int wgid = (int)L; { const int q = nwg / NXCD, r = nwg % NXCD, xcd = wgid % NXCD, off = wgid / NXCD; wgid = (xcd < r ? xcd * (q + 1) : r * (q + 1) + (xcd - r) * q) + off; }
        const int nig = WGM * nN, gid = wgid / nig, fm = gid * WGM, gsz = (nM - fm) < WGM ? (nM - fm) : WGM;
        u.pm = fm + ((wgid % nig) % gsz); u.pn = (wgid % nig) / gsz; u.be = 0; return true;
    }
    __device__ __forceinline__ void a_ready(const Unit&) const {}
    __device__ __forceinline__ void done(const Unit&) const {}
};

#define EPI_LANE_IDS() int t__ = threadIdx.x; asm volatile("" : "+v"(t__)); const int wid__ = __builtin_amdgcn_readfirstlane(t__ >> 6), lane__ = t__ & 63, wr = wid__ >> 2, wc = wid__ & 3, fr = lane__ & 15, fq = lane__ >> 4; (void)wr_; (void)wc_; (void)fr_; (void)fq_
#define EPI_LANE_IDS_NOARG() int t__ = threadIdx.x; asm volatile("" : "+v"(t__)); const int wid__ = __builtin_amdgcn_readfirstlane(t__ >> 6), lane__ = t__ & 63, wr = wid__ >> 2, wc = wid__ & 3, fr = lane__ & 15, fq = lane__ >> 4; (void)wc; (void)fq; (void)lane__
__device__ __forceinline__ unsigned cvt_pk_bf16(float lo, float hi) { unsigned r; asm volatile("v_cvt_pk_bf16_f32 %0, %1, %2" : "=v"(r) : "v"(lo), "v"(hi)); return r; }
constexpr float C2 = 0.125f * 1.4426950408889634f;
constexpr int PB_COLS = 2816;
struct EpiInProj {
    static constexpr bool PERM = true, AFTER_DRAIN = false;
    bf16_t* O; const float* rope; const float* rsx; float* gates; float* logf; const float* b_gate; const float* b_forget; float* hm; int dbg;
    __device__ __forceinline__ void operator()(const f32x4 (&acc)[2][2][4][2], const Unit& u, int wr_, int wc_, int fr_, int fq_) const {
        EPI_LANE_IDS();
        const int pn = u.pn, row0 = u.pm * BM + wr * 64 + fr;
        if (pn == 11) {
            if (wc != 0) return;
#pragma unroll
            for (int ai = 0; ai < 2; ++ai)
#pragma unroll
                for (int m = 0; m < 4; ++m) { const size_t row = (size_t)(row0 + ai * HALF + m * 16); const float rs = rsx[row];
                    const f32x4 v0 = acc[ai][0][m][0] * rs, v1 = acc[ai][0][m][1] * rs;
                    float o[8] = {v0[0], v0[1], v0[2], v0[3], v1[0], v1[1], v1[2], v1[3]};
                    if (fq < 3) {
#pragma unroll
                        for (int i = 0; i < 8; ++i) { const float z = o[i] + b_gate[8 * fq + i]; o[i] = __builtin_amdgcn_rcpf(1.0f + __builtin_amdgcn_exp2f(-1.4426950408889634f * z)); }
                        *(f32x4*)(gates + row * 24 + 8 * fq) = (f32x4){o[0], o[1], o[2], o[3]}; *(f32x4*)(gates + row * 24 + 8 * fq + 4) = (f32x4){o[4], o[5], o[6], o[7]};
                    } else {
#pragma unroll
                        for (int i = 0; i < 8; ++i) { const float z = o[i] + b_forget[i]; o[i] = fminf(z, 0.f) - 0.6931471805599453f * __builtin_amdgcn_logf(1.0f + __builtin_amdgcn_exp2f(-1.4426950408889634f * fabsf(z))); }
                        *(f32x4*)(logf + row * 8) = (f32x4){o[0], o[1], o[2], o[3]}; *(f32x4*)(logf + row * 8 + 4) = (f32x4){o[4], o[5], o[6], o[7]};
                    } }
            return;
        }
        const int head = pn * 4 + wc;
        const bool roped = !(dbg & 2) && (head < 8 || head == 12 || head == 13 || head == 16 || head == 17);
        const int j = (dbg & 1) ? -1 : head < 8 ? head : head == 12 || head == 13 ? head - 4 : head == 16 || head == 17 ? head - 6 : head >= 20 && head < 36 ? head - 8 : -1;
        const float sc = (pn <= 1 || pn == 5 || pn == 6) ? C2 : 1.0f;
        const int col0 = head * 64 + 8 * fq; float nmax = 0.f;
#pragma unroll
        for (int ai = 0; ai < 2; ++ai) {
            f32x4 rc[4][4];
            float rsv[4];
#pragma unroll
            for (int m = 0; m < 4; ++m) rsv[m] = rsx[row0 + ai * HALF + m * 16] * sc;
            if (roped && fq < 2) {
#pragma unroll
                for (int m = 0; m < 4; ++m) { const f32x4* rp = (const f32x4*)(rope + (size_t)(row0 + ai * HALF + m * 16) * 16); rc[m][0] = rp[0]; rc[m][1] = rp[1]; rc[m][2] = rp[2]; rc[m][3] = rp[3]; } }
#pragma unroll
            for (int m = 0; m < 4; ++m) { const size_t row = (size_t)(row0 + ai * HALF + m * 16); bf16_t* rowp = O + row * PB_COLS + col0; float q = 0.f;
#pragma unroll
                for (int bj = 0; bj < 2; ++bj) { f32x4 v0 = acc[ai][bj][m][0], v1 = acc[ai][bj][m][1];
                    if (bj == 0 && roped) {
                        f32x4 p0, p1;
#pragma unroll
                        for (int i = 0; i < 4; ++i) { p0[i] = lx::xf<16>(v0[i]); p1[i] = lx::xf<16>(v1[i]); }
                        if (fq < 2) {
                            const f32x4 a = rc[m][0], b = rc[m][1], c = rc[m][2], d = rc[m][3]; const float sg = fq == 0 ? -1.0f : 1.0f;
                            v0[0] = v0[0] * a[0] + sg * p0[0] * a[1]; v0[1] = v0[1] * a[2] + sg * p0[1] * a[3];
                            v0[2] = v0[2] * b[0] + sg * p0[2] * b[1]; v0[3] = v0[3] * b[2] + sg * p0[3] * b[3];
                            v1[0] = v1[0] * c[0] + sg * p1[0] * c[1]; v1[1] = v1[1] * c[2] + sg * p1[1] * c[3];
                            v1[2] = v1[2] * d[0] + sg * p1[2] * d[1]; v1[3] = v1[3] * d[2] + sg * p1[3] * d[3];
                        }
                    }
                    v0 = v0 * rsv[m]; v1 = v1 * rsv[m]; u32x4 w; w.x = cvt_pk_bf16(v0[0], v0[1]); w.y = cvt_pk_bf16(v0[2], v0[3]); w.z = cvt_pk_bf16(v1[0], v1[1]); w.w = cvt_pk_bf16(v1[2], v1[3]);
                    *(u32x4*)(rowp + bj * 32) = w;
                    if (j >= 0) q += (v0[0] * v0[0] + v0[1] * v0[1]) + (v0[2] * v0[2] + v0[3] * v0[3]) + (v1[0] * v1[0] + v1[1] * v1[1]) + (v1[2] * v1[2] + v1[3] * v1[3]); }
                if (j >= 0) { q += lx::xf<16>(q); { auto rr = __builtin_amdgcn_permlane32_swap(__float_as_uint(q), __float_as_uint(q), false, false); q = __uint_as_float(rr[0]) + __uint_as_float(rr[1]); }
                    nmax = fmaxf(nmax, q); } } }
        if (j >= 0) { float q = nmax; q = fmaxf(q, lx::xf<1>(q)); q = fmaxf(q, lx::xf<2>(q)); q = fmaxf(q, lx::xf<4>(q)); q = fmaxf(q, lx::xf<8>(q));
            if (lane__ == 0) hm[((size_t)u.pm * 2 + wr) * 28 + j] = q * 1.02f; }
    }
};

struct EpiResF32 {
    static constexpr bool PERM = false, AFTER_DRAIN = false;
    const float* res; float* out; int ldc;
    __device__ __forceinline__ void operator()(const f32x4 (&acc)[2][2][4][2], const Unit& u, int wr_, int wc_, int fr_, int fq_) const {
        EPI_LANE_IDS();
        const int col0 = u.pn * BM + wc * 32 + 4 * fq;
#pragma unroll
        for (int ai = 0; ai < 2; ++ai) {
            f32x4 r[4][2][2];
#pragma unroll
            for (int m = 0; m < 4; ++m) { const size_t off = (size_t)(u.pm * BM + ai * HALF + wr * 64 + m * 16 + fr) * ldc + col0;
#pragma unroll
                for (int bj = 0; bj < 2; ++bj)
#pragma unroll
                    for (int n = 0; n < 2; ++n) r[m][bj][n] = *(const f32x4*)(res + off + bj * HALF + n * 16); }
#pragma unroll
            for (int m = 0; m < 4; ++m) { const size_t off = (size_t)(u.pm * BM + ai * HALF + wr * 64 + m * 16 + fr) * ldc + col0;
#pragma unroll
                for (int bj = 0; bj < 2; ++bj)
#pragma unroll
                    for (int n = 0; n < 2; ++n) *(f32x4*)(out + off + bj * HALF + n * 16) = acc[ai][bj][m][n] + r[m][bj][n]; } }
    }
};
struct EpiResBf16 {
    static constexpr bool PERM = true, AFTER_DRAIN = false;
    const bf16_t* res; bf16_t* O; int ldc;
    __device__ __forceinline__ void operator()(const f32x4 (&acc)[2][2][4][2], const Unit& u, int wr_, int wc_, int fr_, int fq_) const {
        EPI_LANE_IDS();
        const int row0 = u.pm * BM + wr * 64 + fr, col0 = u.pn * BM + wc * 32 + 8 * fq;
#pragma unroll
        for (int ai = 0; ai < 2; ++ai) {
            u32x4 r[4][2];
#pragma unroll
            for (int m = 0; m < 4; ++m)
#pragma unroll
                for (int bj = 0; bj < 2; ++bj) r[m][bj] = *(const u32x4*)(res + (size_t)(row0 + ai * HALF + m * 16) * ldc + col0 + bj * HALF);
#pragma unroll
            for (int m = 0; m < 4; ++m) { bf16_t* rowp = O + (size_t)(row0 + ai * HALF + m * 16) * ldc + col0;
#pragma unroll
                for (int bj = 0; bj < 2; ++bj) { const u32x4 q = r[m][bj];
                    const f32x4 v0 = acc[ai][bj][m][0] + (f32x4){__builtin_bit_cast(float, q.x << 16), __builtin_bit_cast(float, q.x & 0xffff0000u), __builtin_bit_cast(float, q.y << 16), __builtin_bit_cast(float, q.y & 0xffff0000u)};
                    const f32x4 v1 = acc[ai][bj][m][1] + (f32x4){__builtin_bit_cast(float, q.z << 16), __builtin_bit_cast(float, q.z & 0xffff0000u), __builtin_bit_cast(float, q.w << 16), __builtin_bit_cast(float, q.w & 0xffff0000u)};
                    u32x4 w; w.x = cvt_pk_bf16(v0[0], v0[1]); w.y = cvt_pk_bf16(v0[2], v0[3]); w.z = cvt_pk_bf16(v1[0], v1[1]); w.w = cvt_pk_bf16(v1[2], v1[3]);
                    *(u32x4*)(rowp + bj * HALF) = w; } } }
    }
};
struct EpiOutProj {
    static constexpr bool PERM = true, AFTER_DRAIN = false;
    const float* ssq; bf16_t* io; int ldc;
    __device__ __forceinline__ void begin(const Unit& u, int ui, PG8_LAS unsigned char* scr) const {
        int t__ = threadIdx.x; asm volatile("" : "+v"(t__));
        if (t__ < BM) { const f32x4* p = (const f32x4*)(ssq + (size_t)(u.pm * BM + t__) * 16); const f32x4 a = p[0], b = p[1], c = p[2], d = p[3];
            const float s0 = ((a[0] + a[1]) + (a[2] + a[3])) + ((b[0] + b[1]) + (b[2] + b[3])), s1 = ((c[0] + c[1]) + (c[2] + c[3])) + ((d[0] + d[1]) + (d[2] + d[3]));
            const float r0 = 1.0f / sqrtf(s0 * (1.0f / 512.0f) + 1e-6f), r1 = 1.0f / sqrtf(s1 * (1.0f / 512.0f) + 1e-6f);
            PG8_LAS float* S = (PG8_LAS float*)(scr + (ui & 1) * 2048); S[t__ * 2] = r0 / r1; S[t__ * 2 + 1] = r1; }
    }
    __device__ __forceinline__ void mid(f32x4 (&acc)[2][2][4][2], const Unit& u, int ui, PG8_LAS unsigned char* scr) const {
        EPI_LANE_IDS_NOARG(); const PG8_LAS float* S = (const PG8_LAS float*)(scr + (ui & 1) * 2048);
#pragma unroll
        for (int ai = 0; ai < 2; ++ai)
#pragma unroll
            for (int m = 0; m < 4; ++m) { const float s = S[(ai * HALF + wr * 64 + m * 16 + fr) * 2];
#pragma unroll
                for (int bj = 0; bj < 2; ++bj)
#pragma unroll
                    for (int n = 0; n < 2; ++n) acc[ai][bj][m][n] = acc[ai][bj][m][n] * s; }
    }
    __device__ __forceinline__ void fin(const f32x4 (&acc)[2][2][4][2], const Unit& u, int ui, PG8_LAS unsigned char* scr) const {
        EPI_LANE_IDS_NOARG(); const PG8_LAS float* S = (const PG8_LAS float*)(scr + (ui & 1) * 2048);
        const int row0 = u.pm * BM + wr * 64 + fr, col0 = u.pn * BM + wc * 32 + 8 * fq;
#pragma unroll
        for (int ai = 0; ai < 2; ++ai) {
            u32x4 r[4][2];
#pragma unroll
            for (int m = 0; m < 4; ++m)
#pragma unroll
                for (int bj = 0; bj < 2; ++bj) r[m][bj] = *(const u32x4*)(io + (size_t)(row0 + ai * HALF + m * 16) * ldc + col0 + bj * HALF);
#pragma unroll
            for (int m = 0; m < 4; ++m) { bf16_t* rowp = io + (size_t)(row0 + ai * HALF + m * 16) * ldc + col0; const float s = S[(ai * HALF + wr * 64 + m * 16 + fr) * 2 + 1];
#pragma unroll
                for (int bj = 0; bj < 2; ++bj) { const u32x4 q = r[m][bj];
                    const f32x4 v0 = acc[ai][bj][m][0] * s + (f32x4){__builtin_bit_cast(float, q.x << 16), __builtin_bit_cast(float, q.x & 0xffff0000u), __builtin_bit_cast(float, q.y << 16), __builtin_bit_cast(float, q.y & 0xffff0000u)};
                    const f32x4 v1 = acc[ai][bj][m][1] * s + (f32x4){__builtin_bit_cast(float, q.z << 16), __builtin_bit_cast(float, q.z & 0xffff0000u), __builtin_bit_cast(float, q.w << 16), __builtin_bit_cast(float, q.w & 0xffff0000u)};
                    u32x4 w; w.x = cvt_pk_bf16(v0[0], v0[1]); w.y = cvt_pk_bf16(v0[2], v0[3]); w.z = cvt_pk_bf16(v1[0], v1[1]); w.w = cvt_pk_bf16(v1[2], v1[3]);
                    *(u32x4*)(rowp + bj * HALF) = w; } } }
    }
    __device__ __forceinline__ void operator()(const f32x4 (&)[2][2][4][2], const Unit&, int, int, int, int) const {}
};
struct EpiPleGate {
    static constexpr bool PERM = false, AFTER_DRAIN = false;
    float* io; const bf16_t* hb; const float* ra; const bf16_t* pp; const float* bias; int ldc;
    __device__ __forceinline__ void operator()(const f32x4 (&acc)[2][2][4][2], const Unit& u, int wr_, int wc_, int fr_, int fq_) const {
        EPI_LANE_IDS();
        typedef unsigned u32x2v __attribute__((ext_vector_type(2)));
        const int col0 = u.pn * BM + wc * 32 + 4 * fq;
#pragma unroll
        for (int ai = 0; ai < 2; ++ai)
#pragma unroll
            for (int m = 0; m < 4; ++m) { const int row = u.pm * BM + ai * HALF + wr * 64 + m * 16 + fr; const size_t off = (size_t)row * ldc + col0; const float rr_ = ra[row];
#pragma unroll
                for (int bj = 0; bj < 2; ++bj)
#pragma unroll
                    for (int n = 0; n < 2; ++n) { const size_t o = off + bj * HALF + n * 16; const u32x2v hw = *(const u32x2v*)(hb + o); const u32x2v pw = *(const u32x2v*)(pp + o);
                        const f32x4 h = {__builtin_bit_cast(float, hw.x << 16), __builtin_bit_cast(float, hw.x & 0xffff0000u), __builtin_bit_cast(float, hw.y << 16), __builtin_bit_cast(float, hw.y & 0xffff0000u)};
                        const f32x4 bv = *(const f32x4*)(bias + col0 + bj * HALF + n * 16); const f32x4 z = acc[ai][bj][m][n] * rr_ + bv; f32x4 r;
                        r[0] = h[0] + __builtin_bit_cast(float, pw.x << 16) * __builtin_amdgcn_rcpf(1.0f + __builtin_amdgcn_exp2f(-1.4426950408889634f * z[0])); r[1] = h[1] + __builtin_bit_cast(float, pw.x & 0xffff0000u) * __builtin_amdgcn_rcpf(1.0f + __builtin_amdgcn_exp2f(-1.4426950408889634f * z[1]));
                        r[2] = h[2] + __builtin_bit_cast(float, pw.y << 16) * __builtin_amdgcn_rcpf(1.0f + __builtin_amdgcn_exp2f(-1.4426950408889634f * z[2])); r[3] = h[3] + __builtin_bit_cast(float, pw.y & 0xffff0000u) * __builtin_amdgcn_rcpf(1.0f + __builtin_amdgcn_exp2f(-1.4426950408889634f * z[3]));
                        *(f32x4*)(io + o) = r; } }
    }
};

struct EpiBf16Plain {
    static constexpr bool PERM = true, AFTER_DRAIN = false;
    bf16_t* O; int ldc;
    __device__ __forceinline__ void operator()(const f32x4 (&acc)[2][2][4][2], const Unit& u, int wr_, int wc_, int fr_, int fq_) const {
        EPI_LANE_IDS();
        const int row0 = u.pm * BM + wr * 64 + fr, col0 = u.pn * BM + wc * 32 + 8 * fq;
#pragma unroll
        for (int ai = 0; ai < 2; ++ai)
#pragma unroll
            for (int m = 0; m < 4; ++m) { bf16_t* rowp = O + (size_t)(row0 + ai * HALF + m * 16) * ldc + col0;
#pragma unroll
                for (int bj = 0; bj < 2; ++bj) { const f32x4 v0 = acc[ai][bj][m][0], v1 = acc[ai][bj][m][1];
                    u32x4 w; w.x = cvt_pk_bf16(v0[0], v0[1]); w.y = cvt_pk_bf16(v0[2], v0[3]); w.z = cvt_pk_bf16(v1[0], v1[1]); w.w = cvt_pk_bf16(v1[2], v1[3]);
                    *(u32x4*)(rowp + bj * HALF) = w; } }
    }
};

struct EpiSwiGlu {
    static constexpr bool PERM = true, AFTER_DRAIN = false;
    bf16_t* O; const float* rss;
    __device__ __forceinline__ void operator()(const f32x4 (&acc)[2][2][4][2], const Unit& u, int wr_, int wc_, int fr_, int fq_) const {
        EPI_LANE_IDS();
        typedef unsigned u32x2v __attribute__((ext_vector_type(2)));
        const int row0 = u.pm * BM + wr * 64 + fr, col0 = u.pn * 128 + wc * 16 + 4 * fq;
#pragma unroll
        for (int ai = 0; ai < 2; ++ai)
#pragma unroll
            for (int m = 0; m < 4; ++m) { bf16_t* rowp = O + (size_t)(row0 + ai * HALF + m * 16) * 512 + col0; const float rs = rss[row0 + ai * HALF + m * 16];
#pragma unroll
                for (int bj = 0; bj < 2; ++bj) { const f32x4 g = acc[ai][bj][m][0] * rs, v = acc[ai][bj][m][1] * rs; float h[4];
#pragma unroll
                    for (int i = 0; i < 4; ++i) h[i] = g[i] * __builtin_amdgcn_rcpf(1.0f + __builtin_amdgcn_exp2f(-1.4426950408889634f * g[i])) * v[i];
                    u32x2v w; w.x = cvt_pk_bf16(h[0], h[1]); w.y = cvt_pk_bf16(h[2], h[3]); *(u32x2v*)(rowp + bj * 64) = w; } }
    }
};
struct GroupOrder {
    int nM, nN, nwg, G, c; const int* tile_e;
    __device__ void init(int nM_, int nN_, int G_, int c_, const int* te) { nM = nM_; nN = nN_; nwg = nM * nN; G = G_; c = c_; tile_e = te; }
    __device__ bool next(int i, Unit& u) const {
        const long L = (long)i * G + c; if (L >= nwg) return false;
        int wgid = (int)L; { const int q = nwg / NXCD, r = nwg % NXCD, xcd = wgid % NXCD, off = wgid / NXCD; wgid = (xcd < r ? xcd * (q + 1) : r * (q + 1) + (xcd - r) * q) + off; }
        const int nig = WGM * nN, gid = wgid / nig, fm = gid * WGM, gsz = (nM - fm) < WGM ? (nM - fm) : WGM;
        u.pm = fm + ((wgid % nig) % gsz); u.pn = (wgid % nig) / gsz; u.be = __builtin_amdgcn_readfirstlane(tile_e[u.pm]); return true;
    }
    __device__ __forceinline__ void a_ready(const Unit&) const {}
    __device__ __forceinline__ void done(const Unit&) const {}
};

struct EpiPleGateNorm {
    static constexpr bool PERM = false, AFTER_DRAIN = false;
    float* io; const bf16_t* hb; const float* ra; const bf16_t* pp; const float* bias; const float* gfin; float* xs; unsigned* cnt; PG8_LAS unsigned char* scr; int ldc;
    __device__ __forceinline__ void operator()(f32x4 (&acc)[2][2][4][2], const Unit& u, int wr_, int wc_, int fr_, int fq_) const {
        typedef unsigned u32x2v __attribute__((ext_vector_type(2)));
        int t__ = threadIdx.x; asm volatile("" : "+v"(t__)); const int tid = t__, wid = __builtin_amdgcn_readfirstlane(tid >> 6), lane = tid & 63, wr = wid >> 2, wc = wid & 3, fr = lane & 15, fq = lane >> 4; (void)wr_; (void)wc_; (void)fr_; (void)fq_;
        PG8_LAS float* P = (PG8_LAS float*)scr; PG8_LAS float* S = (PG8_LAS float*)(scr + 4096); PG8_LAS unsigned* flag = (PG8_LAS unsigned*)(scr + 5120);
        const int col0 = u.pn * BM + wc * 32 + 4 * fq;
#pragma unroll
        for (int ai = 0; ai < 2; ++ai)
#pragma unroll
            for (int m = 0; m < 4; ++m) { const int rl = ai * HALF + wr * 64 + m * 16 + fr; const size_t off = (size_t)(u.pm * BM + rl) * ldc + col0; float q = 0.f; const float rr_ = ra[u.pm * BM + rl];
#pragma unroll
                for (int bj = 0; bj < 2; ++bj)
#pragma unroll
                    for (int n = 0; n < 2; ++n) { const size_t o = off + bj * HALF + n * 16; const u32x2v hw = *(const u32x2v*)(hb + o); const u32x2v pw = *(const u32x2v*)(pp + o);
                        const f32x4 h = {__builtin_bit_cast(float, hw.x << 16), __builtin_bit_cast(float, hw.x & 0xffff0000u), __builtin_bit_cast(float, hw.y << 16), __builtin_bit_cast(float, hw.y & 0xffff0000u)};
                        const f32x4 bv = *(const f32x4*)(bias + col0 + bj * HALF + n * 16); const f32x4 z = acc[ai][bj][m][n] * rr_ + bv; f32x4 r;
                        r[0] = h[0] + __builtin_bit_cast(float, pw.x << 16) * __builtin_amdgcn_rcpf(1.0f + __builtin_amdgcn_exp2f(-1.4426950408889634f * z[0])); r[1] = h[1] + __builtin_bit_cast(float, pw.x & 0xffff0000u) * __builtin_amdgcn_rcpf(1.0f + __builtin_amdgcn_exp2f(-1.4426950408889634f * z[1]));
                        r[2] = h[2] + __builtin_bit_cast(float, pw.y << 16) * __builtin_amdgcn_rcpf(1.0f + __builtin_amdgcn_exp2f(-1.4426950408889634f * z[2])); r[3] = h[3] + __builtin_bit_cast(float, pw.y & 0xffff0000u) * __builtin_amdgcn_rcpf(1.0f + __builtin_amdgcn_exp2f(-1.4426950408889634f * z[3]));
                        acc[ai][bj][m][n] = r; q += (r[0] * r[0] + r[1] * r[1]) + (r[2] * r[2] + r[3] * r[3]); }
                q += lx::xf<16>(q); { auto rr = __builtin_amdgcn_permlane32_swap(__float_as_uint(q), __float_as_uint(q), false, false); q = __uint_as_float(rr[0]) + __uint_as_float(rr[1]); }
                if (fq == 0) P[rl * 4 + wc] = q; }
        asm volatile("s_waitcnt lgkmcnt(0)\n\ts_barrier" ::: "memory");
        unsigned* cw = cnt + 64 * u.pm;
        if (tid < 256) { const float tot = (P[tid * 4] + P[tid * 4 + 1]) + (P[tid * 4 + 2] + P[tid * 4 + 3]);
            __hip_atomic_store(xs + (size_t)(u.pm * BM + tid) * 4 + u.pn, tot, __ATOMIC_RELAXED, __HIP_MEMORY_SCOPE_AGENT);
            asm volatile("s_waitcnt vmcnt(0)" ::: "memory");
            if (lane == 0) __hip_atomic_fetch_add(cw, 1u, __ATOMIC_RELAXED, __HIP_MEMORY_SCOPE_AGENT); }
        if (wid == 0) { unsigned sp = 0;
            while ((unsigned)__builtin_amdgcn_readfirstlane(__hip_atomic_load(cw, __ATOMIC_RELAXED, __HIP_MEMORY_SCOPE_AGENT)) < 16u && ++sp < (1u << 24)) __builtin_amdgcn_s_sleep(2);
            __builtin_amdgcn_fence(__ATOMIC_ACQUIRE, "agent");
            if (lane == 0) flag[0] = sp; }
        asm volatile("s_waitcnt vmcnt(0) lgkmcnt(0)\n\ts_barrier" ::: "memory");
        if (tid < 256) { const float* sl = xs + (size_t)(u.pm * BM + tid) * 4; float s4[4];
#pragma unroll
            for (int t = 0; t < 4; ++t) s4[t] = __hip_atomic_load(sl + t, __ATOMIC_RELAXED, __HIP_MEMORY_SCOPE_AGENT);
            S[tid] = 1.0f / sqrtf(((s4[0] + s4[1]) + (s4[2] + s4[3])) * (1.0f / 1024.0f) + 1e-6f); }
        asm volatile("s_waitcnt lgkmcnt(0)\n\ts_barrier" ::: "memory");
#pragma unroll
        for (int ai = 0; ai < 2; ++ai)
#pragma unroll
            for (int m = 0; m < 4; ++m) { const int rl = ai * HALF + wr * 64 + m * 16 + fr; const size_t off = (size_t)(u.pm * BM + rl) * ldc + col0; const float rs = S[rl];
#pragma unroll
                for (int bj = 0; bj < 2; ++bj)
#pragma unroll
                    for (int n = 0; n < 2; ++n) { const f32x4 g = *(const f32x4*)(gfin + col0 + bj * HALF + n * 16); *(f32x4*)(io + off + bj * HALF + n * 16) = acc[ai][bj][m][n] * rs * g; } }
    }
};

struct EpiNull {
    static constexpr bool PERM = true, AFTER_DRAIN = false;
    __device__ __forceinline__ void operator()(const f32x4 (&acc)[2][2][4][2], const Unit&, int, int, int, int) const {
#pragma unroll
        for (int a = 0; a < 2; ++a)
#pragma unroll
            for (int b = 0; b < 2; ++b)
#pragma unroll
                for (int m = 0; m < 4; ++m) asm volatile("" :: "v"(acc[a][b][m][0]), "v"(acc[a][b][m][1]));
    }
};
template <class T, class = void> struct epi_has_mid { static constexpr bool value = false; };
template <class T> struct epi_has_mid<T, decltype((void)&T::mid)> { static constexpr bool value = true; };
template <class Epi, class Sched, bool ALIGN_EPI = false, bool SP2 = false, bool GATHER = false>
__device__ __forceinline__ void gemm_phase(PG8_LAS unsigned char* lds, const Gemm g, const Sched& S, const Epi& E) {
    int tid_ = threadIdx.x; asm volatile("" : "+v"(tid_));
    const int tid = tid_, wid = __builtin_amdgcn_readfirstlane(tid >> 6), lane = tid & 63, wr = wid >> 2, wc = wid & 3, fr = lane & 15, fq = lane >> 4;
    const int K = g.K, nt = K / BK;
    unsigned voffA[2], voffB[2];
#pragma unroll
    for (int i = 0; i < 2; ++i) { int R, C; stage_rc(tid * 16 + i * 8192, R, C); const int Rb = Epi::PERM ? ((R & ~31) + perm32(R & 31)) : R;
        voffA[i] = (unsigned)(R * K + C) * 2u; voffB[i] = (unsigned)(Rb * K + C) * 2u; }
    static_assert(!GATHER || SP2, "GATHER is wired into the two-super-phase loop only");
    unsigned gC[2][2] = {{0u, 0u}, {0u, 0u}}, gN[2][2] = {{0u, 0u}, {0u, 0u}};
#define PG8_GOFF(dst, u_) do { _Pragma("unroll") for (int h_ = 0; h_ < 2; ++h_) _Pragma("unroll") for (int i_ = 0; i_ < 2; ++i_) { int R_, C_; stage_rc(tid * 16 + i_ * 8192, R_, C_); \
        dst[h_][i_] = (unsigned)g.rowidx[(u_).pm * BM + h_ * HALF + R_] * (unsigned)(K * 2) + (unsigned)(C_ * 2); } } while (0)
    const size_t kstep = (size_t)(BK * 2);
    const size_t hstep = (size_t)HALF * K * 2;
    const size_t hstepA = GATHER ? 0 : hstep;
    const size_t tstep = 2 * hstep;
    const unsigned ldsw = (unsigned)wid * 1024u;
    const int aoff = lds_byte(wr * 64 + fr, fq * 8), boff = lds_byte(wc * 32 + fr, fq * 8);
#define PG8_SA(b, h) (((b) * 2 + (h)) * HTB)
#define PG8_SB(b, h) ((4 + (b) * 2 + (h)) * HTB)
#define PG8_STAGE(bufoff, gbase, voff) do { _Pragma("unroll") for (int _i = 0; _i < 2; ++_i) \
        __builtin_amdgcn_global_load_lds((const unsigned*)((const char*)(gbase) + (voff)[_i]), (PG8_LAS unsigned*)(lds + (bufoff) + ldsw + _i * 8192), 16, 0, 0); } while (0)
#define PG8_LDA(dst, b, h) do { _Pragma("unroll") for (int m = 0; m < 4; ++m) _Pragma("unroll") for (int k = 0; k < 2; ++k) dst[m][k] = *(const PG8_LAS bf16x8*)(lds + PG8_SA(b, h) + aoff + m * 2048 + k * 1024); } while (0)
#define PG8_LDB(dst, b, h) do { _Pragma("unroll") for (int n = 0; n < 2; ++n) _Pragma("unroll") for (int k = 0; k < 2; ++k) dst[n][k] = *(const PG8_LAS bf16x8*)(lds + PG8_SB(b, h) + boff + n * 2048 + k * 1024); } while (0)
#define PG8_MMA(ai, bj, At, Bt) do { __builtin_amdgcn_s_setprio(1); _Pragma("unroll") for (int m = 0; m < 4; ++m) _Pragma("unroll") for (int n = 0; n < 2; ++n) _Pragma("unroll") for (int k = 0; k < 2; ++k) \
        acc[ai][bj][m][n] = __builtin_amdgcn_mfma_f32_16x16x32_bf16(Bt[n][k], At[m][k], acc[ai][bj][m][n], 0, 0, 0); __builtin_amdgcn_s_setprio(0); } while (0)
#define PG8_WAIT_V(n) asm volatile("s_waitcnt vmcnt(" #n ")" ::: "memory")
#define PG8_WAIT_L(n) asm volatile("s_waitcnt lgkmcnt(" #n ")" ::: "memory")
#define PG8_BAR __builtin_amdgcn_s_barrier()
#define PG8_SCHED __builtin_amdgcn_sched_barrier(0)
    Unit cur, nxt; int ui = 0;
    if (!S.next(0, cur)) return;
    f32x4 acc[2][2][4][2];
#pragma unroll
    for (int a = 0; a < 2; ++a)
#pragma unroll
        for (int b = 0; b < 2; ++b)
#pragma unroll
            for (int m = 0; m < 4; ++m)
#pragma unroll
                for (int n = 0; n < 2; ++n) acc[a][b][m][n] = (f32x4){0.f, 0.f, 0.f, 0.f};
    bf16x8 At[4][2], B0[2][2], B1[2][2];
    const char* cA = (const char*)g.A + (GATHER ? (size_t)0 : (size_t)cur.pm * tstep); if (GATHER) PG8_GOFF(gC, cur);
    const char* cB = (const char*)g.Bt + (size_t)cur.pn * tstep + (size_t)cur.be * g.bstride;
    S.a_ready(cur);
    if constexpr (epi_has_mid<Epi>::value) E.begin(cur, 0, lds + STAGE_BYTES);
    if constexpr (SP2) {
        PG8_STAGE(PG8_SB(0, 0), cB, voffB); PG8_STAGE(PG8_SB(0, 1), cB + hstep, voffB); PG8_STAGE(PG8_SA(0, 0), cA, (GATHER ? gC[0] : voffA)); PG8_STAGE(PG8_SA(0, 1), cA + hstepA, (GATHER ? gC[1] : voffA));
        if (wr == 1) PG8_BAR;
        PG8_WAIT_V(2); PG8_BAR;
        PG8_STAGE(PG8_SB(1, 0), cB + kstep, voffB); PG8_STAGE(PG8_SA(1, 0), cA + kstep, (GATHER ? gC[0] : voffA)); PG8_STAGE(PG8_SB(1, 1), cB + hstep + kstep, voffB);
        PG8_WAIT_V(6); PG8_BAR;
    } else {
        PG8_STAGE(PG8_SB(0, 0), cB, voffB); PG8_STAGE(PG8_SA(0, 0), cA, voffA); PG8_STAGE(PG8_SB(0, 1), cB + hstep, voffB); PG8_STAGE(PG8_SA(0, 1), cA + hstep, voffA);
        if (wr == 1) PG8_BAR;
        PG8_WAIT_V(4); PG8_BAR;
        PG8_STAGE(PG8_SB(1, 0), cB + kstep, voffB); PG8_STAGE(PG8_SA(1, 0), cA + kstep, voffA); PG8_STAGE(PG8_SB(1, 1), cB + hstep + kstep, voffB);
        PG8_WAIT_V(6); PG8_BAR;
    }
    for (;;) {
        const bool has_next = S.next(ui + 1, nxt);
        if (GATHER) { if (has_next) PG8_GOFF(gN, nxt); else { gN[0][0] = gC[0][0]; gN[0][1] = gC[0][1]; gN[1][0] = gC[1][0]; gN[1][1] = gC[1][1]; } }
        const char* nA = (has_next && !GATHER) ? (const char*)g.A + (size_t)nxt.pm * tstep : cA; const char* nB = has_next ? (const char*)g.Bt + (size_t)nxt.pn * tstep + (size_t)nxt.be * g.bstride : cB;
        for (int t = 0; t < nt; t += 2) {
            const bool last = (t == nt - 2);
            const char* a1 = cA + (size_t)(t + 1) * kstep;
            const char* a2 = last ? nA : cA + (size_t)(t + 2) * kstep; const char* b2 = last ? nB : cB + (size_t)(t + 2) * kstep;
            const char* a3 = a2 + kstep; const char* b3 = b2 + kstep;
            if (last && has_next) S.a_ready(nxt);
            if constexpr (epi_has_mid<Epi>::value) { if (t == nt / 2) E.mid(acc, cur, ui, lds + STAGE_BYTES); }
            if constexpr (SP2) {
            unsigned g2[2][2];
            if (GATHER) { g2[0][0] = last ? gN[0][0] : gC[0][0]; g2[0][1] = last ? gN[0][1] : gC[0][1]; g2[1][0] = last ? gN[1][0] : gC[1][0]; g2[1][1] = last ? gN[1][1] : gC[1][1]; }
            PG8_LDB(B0, 0, 0); PG8_LDB(B1, 0, 1); PG8_SCHED; PG8_LDA(At, 0, 0); PG8_STAGE(PG8_SA(1, 1), a1 + hstepA, (GATHER ? gC[1] : voffA));
            PG8_WAIT_V(8); PG8_WAIT_L(0); PG8_BAR; PG8_MMA(0, 0, At, B0); PG8_MMA(0, 1, At, B1); PG8_BAR; PG8_SCHED;
            PG8_LDA(At, 0, 1); PG8_STAGE(PG8_SB(0, 0), b2, voffB); PG8_STAGE(PG8_SB(0, 1), b2 + hstep, voffB); PG8_STAGE(PG8_SA(0, 0), a2, (GATHER ? g2[0] : voffA));
            PG8_WAIT_V(8); PG8_WAIT_L(0); PG8_BAR; PG8_MMA(1, 0, At, B0); PG8_MMA(1, 1, At, B1); PG8_BAR; PG8_SCHED;
            PG8_LDB(B0, 1, 0); PG8_LDB(B1, 1, 1); PG8_SCHED; PG8_LDA(At, 1, 0); PG8_STAGE(PG8_SA(0, 1), a2 + hstepA, (GATHER ? g2[1] : voffA));
            PG8_WAIT_V(8); PG8_WAIT_L(0); PG8_BAR; PG8_MMA(0, 0, At, B0); PG8_MMA(0, 1, At, B1); PG8_BAR; PG8_SCHED;
            PG8_LDA(At, 1, 1); PG8_STAGE(PG8_SB(1, 0), b3, voffB); PG8_STAGE(PG8_SB(1, 1), b3 + hstep, voffB); PG8_STAGE(PG8_SA(1, 0), a3, (GATHER ? g2[0] : voffA));
            PG8_WAIT_V(8); PG8_WAIT_L(0); PG8_BAR; PG8_MMA(1, 0, At, B0); PG8_MMA(1, 1, At, B1); PG8_BAR; PG8_SCHED;
            } else {
            PG8_LDB(B0, 0, 0); PG8_SCHED; PG8_LDA(At, 0, 0); PG8_STAGE(PG8_SA(1, 1), a1 + hstep, voffA);
            PG8_WAIT_L(8); PG8_BAR; PG8_WAIT_L(0); PG8_MMA(0, 0, At, B0); PG8_BAR; PG8_SCHED;
            PG8_LDB(B1, 0, 1); PG8_STAGE(PG8_SB(0, 0), b2, voffB);
            PG8_BAR; PG8_WAIT_L(0); PG8_MMA(0, 1, At, B1); PG8_BAR;
            PG8_LDA(At, 0, 1); PG8_STAGE(PG8_SA(0, 0), a2, voffA);
            PG8_BAR; PG8_WAIT_L(0); PG8_MMA(1, 0, At, B0); PG8_BAR; PG8_SCHED;
            PG8_STAGE(PG8_SB(0, 1), b2 + hstep, voffB);
            PG8_WAIT_V(6); PG8_BAR; PG8_MMA(1, 1, At, B1); PG8_BAR;
            PG8_LDB(B0, 1, 0); PG8_SCHED; PG8_LDA(At, 1, 0); PG8_STAGE(PG8_SA(0, 1), a2 + hstep, voffA);
            PG8_WAIT_L(8); PG8_BAR; PG8_WAIT_L(0); PG8_MMA(0, 0, At, B0); PG8_BAR; PG8_SCHED;
            PG8_LDB(B1, 1, 1); PG8_STAGE(PG8_SB(1, 0), b3, voffB);
            PG8_BAR; PG8_WAIT_L(0); PG8_MMA(0, 1, At, B1); PG8_BAR;
            PG8_LDA(At, 1, 1); PG8_STAGE(PG8_SA(1, 0), a3, voffA);
            PG8_BAR; PG8_WAIT_L(0); PG8_MMA(1, 0, At, B0); PG8_BAR; PG8_SCHED;
            PG8_STAGE(PG8_SB(1, 1), b3 + hstep, voffB);
            PG8_WAIT_V(6); PG8_BAR; PG8_MMA(1, 1, At, B1); PG8_BAR;
            }
        }
        if constexpr (ALIGN_EPI) { if (wr == 0) PG8_BAR; }
        if constexpr (epi_has_mid<Epi>::value) { E.fin(acc, cur, ui, lds + STAGE_BYTES); S.done(cur); }
        else if constexpr (!Epi::AFTER_DRAIN) { E(acc, cur, wr, wc, fr, fq); S.done(cur); }
        if (!has_next) break;
#pragma unroll
        for (int a = 0; a < 2; ++a)
#pragma unroll
            for (int b = 0; b < 2; ++b)
#pragma unroll
                for (int m = 0; m < 4; ++m)
#pragma unroll
                    for (int n = 0; n < 2; ++n) acc[a][b][m][n] = (f32x4){0.f, 0.f, 0.f, 0.f};
        cur = nxt; cA = nA; cB = nB; ++ui; if constexpr (epi_has_mid<Epi>::value) E.begin(cur, ui, lds + STAGE_BYTES);
        if (GATHER) { gC[0][0] = gN[0][0]; gC[0][1] = gN[0][1]; gC[1][0] = gN[1][0]; gC[1][1] = gN[1][1]; }
        if constexpr (ALIGN_EPI) { if (wr == 1) PG8_BAR; }
    }
    PG8_WAIT_V(0);
    if constexpr (!ALIGN_EPI) { if (wr == 0) PG8_BAR; }
    PG8_BAR;
    if constexpr (Epi::AFTER_DRAIN) { E.fused(acc, cur, wr, wc, fr, fq, lds, wid, lane); S.done(cur); }
#undef PG8_GOFF
#undef PG8_SA
#undef PG8_SB
#undef PG8_STAGE
#undef PG8_LDA
#undef PG8_LDB
#undef PG8_MMA
#undef PG8_WAIT_V
#undef PG8_WAIT_L
#undef PG8_BAR
#undef PG8_SCHED
}
}
namespace at {
using bf16x8 = __attribute__((ext_vector_type(8))) short;
using s16x4 = __attribute__((ext_vector_type(4))) short;
using f32x16 = __attribute__((ext_vector_type(16))) float;
using f32x4 = __attribute__((ext_vector_type(4))) float;
using u32x4 = __attribute__((ext_vector_type(4))) unsigned;
typedef unsigned short bf16;
constexpr int PITCH = 2816;
constexpr int NSLOT = 4, SLOTB = 8192;
constexpr int NVSLOT = 5;
constexpr int LDS_K = 0, LDS_V = NSLOT * SLOTB, LDS_WS = LDS_V + NVSLOT * SLOTB, LDS_CK = LDS_WS + 8 * 256, LDS_END = LDS_CK + 16384;
constexpr float NEG = -1e30f;
constexpr float THR = 8.0f;
typedef __attribute__((address_space(3))) const char* lds_cptr;
typedef short v4i16_t __attribute__((ext_vector_type(4)));
__device__ __forceinline__ int crow(int r, int hi) { return (r & 3) + 8 * (r >> 2) + 4 * hi; }
__device__ __forceinline__ void glds16(const void* gsrc, unsigned lds_dst) { unsigned keep;
    asm volatile("s_mov_b32 %0, m0\n\ts_mov_b32 m0, %2\n\ts_nop 0\n\tglobal_load_lds_dwordx4 %1, off\n\ts_mov_b32 m0, %0" : "=&s"(keep) : "v"(gsrc), "s"(lds_dst) : "memory"); }
typedef float f32x2_t __attribute__((ext_vector_type(2))); typedef __bf16 bf16x2_t __attribute__((ext_vector_type(2)));
__device__ __forceinline__ unsigned cvtpk(float lo, float hi) { f32x2_t v = {lo, hi}; bf16x2_t b = __builtin_convertvector(v, bf16x2_t); return __builtin_bit_cast(unsigned, b); }
__device__ __forceinline__ s16x4 vtr(lds_cptr p) { return __builtin_bit_cast(s16x4, __builtin_amdgcn_ds_read_tr16_b64_v4i16((__attribute__((address_space(3))) v4i16_t*)p)); }
#define AT_WAIT_BAR(N) asm volatile("s_waitcnt vmcnt(" #N ") lgkmcnt(0)\n\ts_barrier" ::: "memory")

enum { M_FOX = 0, M_SEL = 1, M_WIN = 2 };
struct UnitIO {
    const bf16* Qw;
    const bf16* Kh;
    const bf16* Vh;
    int t_hi, t_lo;
    int t_first;
    int qpos;
    unsigned long long selm;
    int win;
    float sbound, c2q0;
    float cq;
};
template <int MODE, bool FAST, int ABL = 0>
__device__ __forceinline__ void attn_tiles(const UnitIO& U, char* shm, f32x16 (&o)[2], float& l_out, f32x16& osum) {
    int tid_ = threadIdx.x; asm volatile("" : "+v"(tid_));
    const int tid = tid_, lane = tid & 63, r32 = lane & 31, hi = lane >> 5; const int wid = __builtin_amdgcn_readfirstlane(tid >> 6);
    const unsigned lds0 = (unsigned)(uintptr_t)shm;
    float* wsf = (float*)(shm + LDS_WS) + wid * 64;
    const bf16* ksrc = U.Kh + (long)lane * PITCH + wid * 8;
    const bf16* vsrc = U.Vh + (long)(16 * (wid & 3) + (lane >> 2)) * PITCH + (wid >> 2) * 32 + (lane & 3) * 8;
    const unsigned kdst = lds0 + LDS_K + wid * 1024, vdst = lds0 + LDS_V + wid * 1024;
#define AT_DMA(t, kslot, vslot) do { glds16(ksrc + (long)(t) * 64 * PITCH, (unsigned)__builtin_amdgcn_readfirstlane(kdst + (kslot) * SLOTB)); \
                                     glds16(vsrc + (long)(t) * 64 * PITCH, (unsigned)__builtin_amdgcn_readfirstlane(vdst + (vslot) * SLOTB)); } while (0)
    const lds_cptr shm3 = (lds_cptr)shm;
    const lds_cptr kp0 = shm3 + LDS_K + hi * 1024 + r32 * 16;
    const lds_cptr vp0 = shm3 + LDS_V + ((lane >> 4) & 1) * 32 + (lane & 3) * 8 + (4 * hi + ((lane & 15) >> 2)) * 64;
    const int n = U.t_hi - U.t_lo + 1;
    AT_DMA(U.t_hi, 0, 0); if (n > 1) AT_DMA(U.t_hi - 1, 1, 1); if (n > 2) AT_DMA(U.t_hi - 2, 2, 2);
    bf16x8 qr[4];
#pragma unroll
    for (int d0 = 0; d0 < 4; ++d0) qr[d0] = *reinterpret_cast<const bf16x8*>(&U.Qw[(long)r32 * PITCH + d0 * 16 + hi * 8]);
    float mref = 0.f, l = 0.f; o[0] = f32x16{}; o[1] = f32x16{};
    f32x16 negm = f32x16{};
    if (FAST && MODE == M_FOX) {
#pragma unroll
        for (int r = 0; r < 16; ++r) negm[r] = U.cq; }
    osum = f32x16{};
    const bool lag = FAST && ABL == 0 && wid >= 4;
    u32x4 pw0, pw1, pw2, pw3; bool pend = false; int vslot_pend = 0;
#define AT_PV(vslot_) do { const lds_cptr vp = vp0 + (vslot_) * SLOTB; \
        _Pragma("unroll") for (int d0 = 0; d0 < 2; ++d0) { s16x4 lo[4], hh[4]; \
            _Pragma("unroll") for (int ks = 0; ks < 4; ++ks) { lo[ks] = vtr(vp + d0 * 4096 + ks * 1024); hh[ks] = vtr(vp + d0 * 4096 + ks * 1024 + 512); } \
            o[d0] = __builtin_amdgcn_mfma_f32_32x32x16_bf16(__builtin_bit_cast(bf16x8, pw0), AT_PK(0), o[d0], 0, 0, 0); \
            o[d0] = __builtin_amdgcn_mfma_f32_32x32x16_bf16(__builtin_bit_cast(bf16x8, pw1), AT_PK(1), o[d0], 0, 0, 0); \
            o[d0] = __builtin_amdgcn_mfma_f32_32x32x16_bf16(__builtin_bit_cast(bf16x8, pw2), AT_PK(2), o[d0], 0, 0, 0); \
            o[d0] = __builtin_amdgcn_mfma_f32_32x32x16_bf16(__builtin_bit_cast(bf16x8, pw3), AT_PK(3), o[d0], 0, 0, 0); } } while (0)
#define AT_PK(k) (bf16x8){lo[k][0], lo[k][1], lo[k][2], lo[k][3], hh[k][0], hh[k][1], hh[k][2], hh[k][3]}
#define AT_ONES() do { const bf16x8 ones_ = (bf16x8){0x3F80, 0x3F80, 0x3F80, 0x3F80, 0x3F80, 0x3F80, 0x3F80, 0x3F80}; \
        osum = __builtin_amdgcn_mfma_f32_32x32x16_bf16(__builtin_bit_cast(bf16x8, pw0), ones_, osum, 0, 0, 0); osum = __builtin_amdgcn_mfma_f32_32x32x16_bf16(__builtin_bit_cast(bf16x8, pw1), ones_, osum, 0, 0, 0); \
        osum = __builtin_amdgcn_mfma_f32_32x32x16_bf16(__builtin_bit_cast(bf16x8, pw2), ones_, osum, 0, 0, 0); osum = __builtin_amdgcn_mfma_f32_32x32x16_bf16(__builtin_bit_cast(bf16x8, pw3), ones_, osum, 0, 0, 0); } while (0)
    int kslot = 0, vslot = 0;
    for (int i = 0; i < n; ++i) {
        const int t = U.t_hi - i;
        if (i + 2 < n) AT_WAIT_BAR(4); else if (i + 1 < n) AT_WAIT_BAR(2); else AT_WAIT_BAR(0);
        if (i + 3 < n) { const int k3 = (kslot + 3) & 3, v3 = vslot >= 2 ? vslot - 2 : vslot + 3; AT_DMA(t - 3, k3, v3); }
        if (pend) { AT_PV(vslot_pend); if (FAST) AT_ONES(); pend = false; }
        if (FAST && ABL != 1 && t <= U.t_first) {
            const lds_cptr kp = kp0 + kslot * SLOTB;
            f32x16 p0, p1;
#pragma unroll
            for (int d0 = 0; d0 < 4; ++d0) {
                const bf16x8 b0 = *(const __attribute__((address_space(3))) bf16x8*)(kp + d0 * 2048);
                const bf16x8 b1 = *(const __attribute__((address_space(3))) bf16x8*)(kp + d0 * 2048 + 512);
                if (d0 == 0) { p0 = __builtin_amdgcn_mfma_f32_32x32x16_bf16(b0, qr[0], negm, 0, 0, 0); p1 = __builtin_amdgcn_mfma_f32_32x32x16_bf16(b1, qr[0], negm, 0, 0, 0); }
                else { p0 = __builtin_amdgcn_mfma_f32_32x32x16_bf16(b0, qr[d0], p0, 0, 0, 0); p1 = __builtin_amdgcn_mfma_f32_32x32x16_bf16(b1, qr[d0], p1, 0, 0, 0); }
            }
            if (ABL == 2) { asm volatile("" :: "v"(p0), "v"(p1)); } else {
            if (MODE == M_FOX) {
                const __attribute__((address_space(3))) f32x4* ck = (const __attribute__((address_space(3))) f32x4*)(shm3 + LDS_CK + (64 * t + 4 * hi) * 4);
#pragma unroll
                for (int a = 0; a < 4; ++a) { const f32x4 c0 = ck[2 * a], c1 = ck[2 * a + 8];
#pragma unroll
                    for (int j = 0; j < 4; ++j) { p0[4 * a + j] -= c0[j]; p1[4 * a + j] -= c1[j]; } }
            }
            if (t == U.t_first) {
                const int kb = 64 * t + 4 * hi;
#pragma unroll
                for (int r = 0; r < 16; ++r) { const int kv = kb + (r & 3) + 8 * (r >> 2); if (kv > U.qpos) p0[r] = NEG; if (kv + 32 > U.qpos) p1[r] = NEG; }
            }
            if (MODE == M_WIN && t == U.t_lo) {
                const int kb = 64 * t + 4 * hi, lim = U.qpos - U.win;
#pragma unroll
                for (int r = 0; r < 16; ++r) { const int kv = kb + (r & 3) + 8 * (r >> 2); if (kv <= lim) p0[r] = NEG; if (kv + 32 <= lim) p1[r] = NEG; }
            }
#pragma unroll
            for (int r = 0; r < 16; ++r) { p0[r] = __builtin_amdgcn_exp2f(p0[r]); p1[r] = __builtin_amdgcn_exp2f(p1[r]); }
            pw0 = (u32x4){cvtpk(p0[0], p0[1]), cvtpk(p0[2], p0[3]), cvtpk(p0[4], p0[5]), cvtpk(p0[6], p0[7])};
            pw1 = (u32x4){cvtpk(p0[8], p0[9]), cvtpk(p0[10], p0[11]), cvtpk(p0[12], p0[13]), cvtpk(p0[14], p0[15])};
            pw2 = (u32x4){cvtpk(p1[0], p1[1]), cvtpk(p1[2], p1[3]), cvtpk(p1[4], p1[5]), cvtpk(p1[6], p1[7])};
            pw3 = (u32x4){cvtpk(p1[8], p1[9]), cvtpk(p1[10], p1[11]), cvtpk(p1[12], p1[13]), cvtpk(p1[14], p1[15])};
            if (MODE == M_SEL) { const bool sel = (U.selm >> t) & 1ull;
#pragma unroll
                for (int j = 0; j < 4; ++j) { pw0[j] = sel ? pw0[j] : 0u; pw1[j] = sel ? pw1[j] : 0u; pw2[j] = sel ? pw2[j] : 0u; pw3[j] = sel ? pw3[j] : 0u; } }
            if (ABL == 3) { asm volatile("" :: "v"(pw0), "v"(pw1), "v"(pw2), "v"(pw3)); } else {
            if (lag) { pend = true; vslot_pend = vslot; } else { AT_PV(vslot); AT_ONES(); }
            } }
        }
        if (!FAST && t <= U.t_first) {
        const lds_cptr kp = kp0 + kslot * SLOTB;
        const f32x16& cinit = negm;
        f32x16 p0, p1;
#pragma unroll
        for (int d0 = 0; d0 < 4; ++d0) {
            const bf16x8 b0 = *(const __attribute__((address_space(3))) bf16x8*)(kp + d0 * 2048);
            const bf16x8 b1 = *(const __attribute__((address_space(3))) bf16x8*)(kp + d0 * 2048 + 512);
            if (d0 == 0) { p0 = __builtin_amdgcn_mfma_f32_32x32x16_bf16(b0, qr[0], cinit, 0, 0, 0); p1 = __builtin_amdgcn_mfma_f32_32x32x16_bf16(b1, qr[0], cinit, 0, 0, 0); }
            else { p0 = __builtin_amdgcn_mfma_f32_32x32x16_bf16(b0, qr[d0], p0, 0, 0, 0); p1 = __builtin_amdgcn_mfma_f32_32x32x16_bf16(b1, qr[d0], p1, 0, 0, 0); }
        }
        if (MODE == M_SEL) { const bool sel = (U.selm >> t) & 1ull;
#pragma unroll
            for (int r = 0; r < 16; ++r) { p0[r] = sel ? p0[r] : NEG; p1[r] = sel ? p1[r] : NEG; } }
        if (MODE == M_FOX) {
            const __attribute__((address_space(3))) f32x4* ck = (const __attribute__((address_space(3))) f32x4*)(shm3 + LDS_CK + (64 * t + 4 * hi) * 4);
#pragma unroll
            for (int a = 0; a < 4; ++a) { const f32x4 c0 = ck[2 * a], c1 = ck[2 * a + 8];
#pragma unroll
                for (int j = 0; j < 4; ++j) { p0[4 * a + j] -= c0[j]; p1[4 * a + j] -= c1[j]; } }
        }
        if (t == U.t_first) {
            const int kb = 64 * t + 4 * hi;
#pragma unroll
            for (int r = 0; r < 16; ++r) { const int kv = kb + (r & 3) + 8 * (r >> 2); if (kv > U.qpos) p0[r] = NEG; if (kv + 32 > U.qpos) p1[r] = NEG; }
        }
        if (MODE == M_WIN && t == U.t_lo) {
            const int kb = 64 * t + 4 * hi, lim = U.qpos - U.win;
#pragma unroll
            for (int r = 0; r < 16; ++r) { const int kv = kb + (r & 3) + 8 * (r >> 2); if (kv <= lim) p0[r] = NEG; if (kv + 32 <= lim) p1[r] = NEG; }
        }
        float rm = fmaxf(p0[0], p1[0]);
#pragma unroll
        for (int r = 1; r < 16; ++r) rm = fmaxf(rm, fmaxf(p0[r], p1[r]));
        { auto rr = __builtin_amdgcn_permlane32_swap(__float_as_uint(rm), __float_as_uint(rm), false, false); rm = fmaxf(__uint_as_float(rr[0]), __uint_as_float(rr[1])); }
        const bool first = (t == U.t_first);
        if (first || __any(rm > THR)) {
            const float dl = first ? rm : fmaxf(rm, 0.f); mref += dl;
#pragma unroll
            for (int r = 0; r < 16; ++r) { p0[r] -= dl; p1[r] -= dl; negm[r] = -mref; }
            if (!first) { const float f = __builtin_amdgcn_exp2f(-dl); l *= f; if (hi == 0) wsf[r32] = f;
                asm volatile("s_waitcnt lgkmcnt(0)" ::: "memory");
#pragma unroll
                for (int a = 0; a < 4; ++a) { const f32x4 fv = *(const f32x4*)(wsf + 8 * a + 4 * hi);
#pragma unroll
                    for (int j = 0; j < 4; ++j) { o[0][4 * a + j] *= fv[j]; o[1][4 * a + j] *= fv[j]; } }
            }
        }
        float sacc = 0.f;
#pragma unroll
        for (int r = 0; r < 16; ++r) { p0[r] = __builtin_amdgcn_exp2f(p0[r]); p1[r] = __builtin_amdgcn_exp2f(p1[r]); sacc += p0[r] + p1[r]; }
        l += sacc;
        pw0 = (u32x4){cvtpk(p0[0], p0[1]), cvtpk(p0[2], p0[3]), cvtpk(p0[4], p0[5]), cvtpk(p0[6], p0[7])};
        pw1 = (u32x4){cvtpk(p0[8], p0[9]), cvtpk(p0[10], p0[11]), cvtpk(p0[12], p0[13]), cvtpk(p0[14], p0[15])};
        pw2 = (u32x4){cvtpk(p1[0], p1[1]), cvtpk(p1[2], p1[3]), cvtpk(p1[4], p1[5]), cvtpk(p1[6], p1[7])};
        pw3 = (u32x4){cvtpk(p1[8], p1[9]), cvtpk(p1[10], p1[11]), cvtpk(p1[12], p1[13]), cvtpk(p1[14], p1[15])};
        if (lag) { pend = true; vslot_pend = vslot; } else { AT_PV(vslot); }
        }
        kslot = (kslot + 1) & 3; vslot = vslot == 4 ? 0 : vslot + 1;
    }
    if (pend) { AT_PV(vslot_pend); if (FAST) AT_ONES(); }
#undef AT_PV
#undef AT_ONES
#undef AT_PK
    asm volatile("s_waitcnt vmcnt(0) lgkmcnt(0)\n\ts_barrier" ::: "memory");
    l_out = l;
#undef AT_DMA
}
__device__ __forceinline__ void row_inv(float l, char* shm, float (&rli)[16]) {
    int tid_ = threadIdx.x; asm volatile("" : "+v"(tid_));
    const int lane = tid_ & 63, r32 = lane & 31, hi = lane >> 5; const int wid = __builtin_amdgcn_readfirstlane(tid_ >> 6);
    float* wsf = (float*)(shm + LDS_WS) + wid * 64;
    { auto rr = __builtin_amdgcn_permlane32_swap(__float_as_uint(l), __float_as_uint(l), false, false); l = __uint_as_float(rr[0]) + __uint_as_float(rr[1]); }
    if (hi == 0) wsf[32 + r32] = l;
    asm volatile("s_waitcnt lgkmcnt(0)" ::: "memory");
#pragma unroll
    for (int a = 0; a < 4; ++a) { const f32x4 lv = *(const f32x4*)(wsf + 32 + 8 * a + 4 * hi);
#pragma unroll
        for (int j = 0; j < 4; ++j) rli[4 * a + j] = lv[j] > 0.f ? 1.0f / lv[j] : 0.f; }
    asm volatile("s_waitcnt lgkmcnt(0)" ::: "memory");
}
}
namespace at {
constexpr int CMP_K = 0, CMP_V = 32768, CMP_IMP = LDS_CK, CMP_SELM = LDS_CK + 65536;
constexpr int KCP = 128;
__device__ __forceinline__ int imp_idx(int j, int q) { return j * 64 + (q ^ ((j >> 3) << 3)); }
__device__ __forceinline__ void cmp_scores(f32x16& p0, f32x16& p1, lds_cptr kp, const bf16x8 (&qr)[4], const f32x16& cinit, int tt, int hi, int nlim) {
#pragma unroll
    for (int d0 = 0; d0 < 4; ++d0) {
        const bf16x8 b0 = *(const __attribute__((address_space(3))) bf16x8*)(kp + d0 * 2048);
        const bf16x8 b1 = *(const __attribute__((address_space(3))) bf16x8*)(kp + d0 * 2048 + 512);
        if (d0 == 0) { p0 = __builtin_amdgcn_mfma_f32_32x32x16_bf16(b0, qr[0], cinit, 0, 0, 0); p1 = __builtin_amdgcn_mfma_f32_32x32x16_bf16(b1, qr[0], cinit, 0, 0, 0); }
        else { p0 = __builtin_amdgcn_mfma_f32_32x32x16_bf16(b0, qr[d0], p0, 0, 0, 0); p1 = __builtin_amdgcn_mfma_f32_32x32x16_bf16(b1, qr[d0], p1, 0, 0, 0); }
    }
    const int nb = 64 * tt + 4 * hi;
#pragma unroll
    for (int r = 0; r < 16; ++r) { const int n = nb + (r & 3) + 8 * (r >> 2); if (n > nlim) p0[r] = NEG; if (n + 32 > nlim) p1[r] = NEG; }
}
__device__ __forceinline__ void cmp_stage(const bf16* Qw, const bf16* Kc, const bf16* Vc, int c, int nsel, char* shm, f32x16 (&o)[2]) {
    int tid_ = threadIdx.x; asm volatile("" : "+v"(tid_));
    const int tid = tid_, lane = tid & 63, r32 = lane & 31, hi = lane >> 5; const int wid = __builtin_amdgcn_readfirstlane(tid >> 6);
    const unsigned lds0 = (unsigned)(uintptr_t)shm; const lds_cptr shm3 = (lds_cptr)shm;
    asm volatile("s_waitcnt lgkmcnt(0)\n\ts_barrier" ::: "memory");
    const int ntc = (4 * c + 2) / 64 + 1;
    const int tq = 64 * c + 32 * (wid & 1) + r32, nlim = tq >= 31 ? (tq - 31) >> 4 : -1;
    bf16x8 qr[4];
#pragma unroll
    for (int d0 = 0; d0 < 4; ++d0) qr[d0] = *reinterpret_cast<const bf16x8*>(&Qw[(long)r32 * PITCH + d0 * 16 + hi * 8]);
    float* slab = (float*)(shm + CMP_IMP) + (wid >> 1) * 4096; const int qloc = 32 * (wid & 1) + r32;
#ifdef PROBE_DUP
    for (int pr_ = 0; pr_ < (PROBE_DUP == 33 ? 2 : 1); ++pr_)
#endif
    {   if (PROBE_DUP == 33) asm volatile("s_waitcnt vmcnt(0) lgkmcnt(0)\n\ts_barrier" ::: "memory");
        const bf16* ksrc = Kc + (long)lane * KCP + wid * 8;
        const bf16* vsrc = Vc + (long)(16 * (wid & 3) + (lane >> 2)) * KCP + (wid >> 2) * 32 + (lane & 3) * 8;
        for (int tt = 0; tt < ntc; ++tt) { glds16(ksrc + (long)tt * 64 * KCP, (unsigned)__builtin_amdgcn_readfirstlane(lds0 + CMP_K + tt * SLOTB + wid * 1024));
                                           glds16(vsrc + (long)tt * 64 * KCP, (unsigned)__builtin_amdgcn_readfirstlane(lds0 + CMP_V + tt * SLOTB + wid * 1024)); }
        AT_WAIT_BAR(0);
    }
    const lds_cptr kp0 = shm3 + CMP_K + hi * 1024 + r32 * 16;
    const lds_cptr vp0 = shm3 + CMP_V + ((lane >> 4) & 1) * 32 + (lane & 3) * 8 + (4 * hi + ((lane & 15) >> 2)) * 64;
    float m = NEG, l = 0.f; const f32x16 zero = f32x16{};
#ifdef PROBE_DUP
    for (int pr_ = 0; pr_ < (PROBE_DUP == 30 ? 2 : 1); ++pr_)
#endif
    for (int tt = 0; tt < ntc; ++tt) {
        f32x16 p0, p1; cmp_scores(p0, p1, kp0 + tt * SLOTB, qr, zero, tt, hi, nlim);
        float rm = fmaxf(p0[0], p1[0]);
#pragma unroll
        for (int r = 1; r < 16; ++r) rm = fmaxf(rm, fmaxf(p0[r], p1[r]));
        { auto rr = __builtin_amdgcn_permlane32_swap(__float_as_uint(rm), __float_as_uint(rm), false, false); rm = fmaxf(__uint_as_float(rr[0]), __uint_as_float(rr[1])); }
        const float mn = fmaxf(m, rm); float s = 0.f;
#pragma unroll
        for (int r = 0; r < 16; ++r) s += __builtin_amdgcn_exp2f(p0[r] - mn) + __builtin_amdgcn_exp2f(p1[r] - mn);
        l = l * __builtin_amdgcn_exp2f(m - mn) + s; m = mn;
    }
    { auto rr = __builtin_amdgcn_permlane32_swap(__float_as_uint(l), __float_as_uint(l), false, false); l = __uint_as_float(rr[0]) + __uint_as_float(rr[1]); }
    const float rl = nlim >= 0 ? 1.0f / l : 0.f;
    f32x16 negm;
#pragma unroll
    for (int r = 0; r < 16; ++r) negm[r] = -m;
    o[0] = f32x16{}; o[1] = f32x16{}; float carry = 0.f;
    for (int tt = 0; tt < ntc; ++tt) {
        f32x16 p0, p1; cmp_scores(p0, p1, kp0 + tt * SLOTB, qr, negm, tt, hi, nlim);
#pragma unroll
        for (int r = 0; r < 16; ++r) { p0[r] = __builtin_amdgcn_exp2f(p0[r]) * rl; p1[r] = __builtin_amdgcn_exp2f(p1[r]) * rl; }
        {   float own[8], sp[8];
#pragma unroll
            for (int a = 0; a < 4; ++a) { sp[a] = 0.5f * p0[4 * a + 3]; sp[4 + a] = 0.5f * p1[4 * a + 3];
                own[a] = (p0[4 * a] + p0[4 * a + 1]) + (p0[4 * a + 2] + sp[a]); own[4 + a] = (p1[4 * a] + p1[4 * a + 1]) + (p1[4 * a + 2] + sp[4 + a]); }
            float rc[8];
#pragma unroll
            for (int k = 0; k < 8; ++k) rc[k] = lx::x32f(sp[k], hi != 0);
            if (hi) {
#pragma unroll
                for (int k = 0; k < 8; ++k) own[k] += rc[k];
            } else { own[0] += carry;
#pragma unroll
                for (int k = 0; k < 7; ++k) own[k + 1] += rc[k];
                carry = rc[7]; }
#pragma unroll
            for (int a = 0; a < 4; ++a) { slab[imp_idx(16 * tt + 2 * a + hi, qloc)] = own[a]; slab[imp_idx(16 * tt + 8 + 2 * a + hi, qloc)] = own[4 + a]; }
        }
        const lds_cptr vp = vp0 + tt * SLOTB;
        u32x4 pw0, pw1, pw2, pw3;
        pw0 = (u32x4){cvtpk(p0[0], p0[1]), cvtpk(p0[2], p0[3]), cvtpk(p0[4], p0[5]), cvtpk(p0[6], p0[7])};
        pw1 = (u32x4){cvtpk(p0[8], p0[9]), cvtpk(p0[10], p0[11]), cvtpk(p0[12], p0[13]), cvtpk(p0[14], p0[15])};
        pw2 = (u32x4){cvtpk(p1[0], p1[1]), cvtpk(p1[2], p1[3]), cvtpk(p1[4], p1[5]), cvtpk(p1[6], p1[7])};
        pw3 = (u32x4){cvtpk(p1[8], p1[9]), cvtpk(p1[10], p1[11]), cvtpk(p1[12], p1[13]), cvtpk(p1[14], p1[15])};
#pragma unroll
        for (int d0 = 0; d0 < 2; ++d0) {
            s16x4 lo[4], hh[4];
#pragma unroll
            for (int ks = 0; ks < 4; ++ks) { lo[ks] = vtr(vp + d0 * 4096 + ks * 1024); hh[ks] = vtr(vp + d0 * 4096 + ks * 1024 + 512); }
#define AT_PK(k) (bf16x8){lo[k][0], lo[k][1], lo[k][2], lo[k][3], hh[k][0], hh[k][1], hh[k][2], hh[k][3]}
            o[d0] = __builtin_amdgcn_mfma_f32_32x32x16_bf16(__builtin_bit_cast(bf16x8, pw0), AT_PK(0), o[d0], 0, 0, 0);
            o[d0] = __builtin_amdgcn_mfma_f32_32x32x16_bf16(__builtin_bit_cast(bf16x8, pw1), AT_PK(1), o[d0], 0, 0, 0);
            o[d0] = __builtin_amdgcn_mfma_f32_32x32x16_bf16(__builtin_bit_cast(bf16x8, pw2), AT_PK(2), o[d0], 0, 0, 0);
            o[d0] = __builtin_amdgcn_mfma_f32_32x32x16_bf16(__builtin_bit_cast(bf16x8, pw3), AT_PK(3), o[d0], 0, 0, 0);
#undef AT_PK
        }
    }
    asm volatile("s_waitcnt lgkmcnt(0)\n\ts_barrier" ::: "memory");
#ifdef PROBE_DUP
    for (int pr_ = 0; pr_ < (PROBE_DUP == 32 ? 2 : 1); ++pr_)
#endif
    {   const int q = tid >> 3, part = tid & 7; const float* s0 = (const float*)(shm + CMP_IMP);
        const int t = 64 * c + q, cur = c;
        unsigned key[8];
#pragma unroll
        for (int i = 0; i < 8; ++i) { const int j = part * 8 + i; const int ix = imp_idx(j, q); const float imp = ((s0[ix] + s0[4096 + ix]) + s0[8192 + ix]) + s0[12288 + ix];
            const bool forced = (j == 0) || (j == cur) || (j == cur - 1);
            const float sc = imp + (forced ? 1e4f : 0.0f);
            key[i] = (j * 64 > t) ? (unsigned)(63 - j) : ((__float_as_uint(sc) & ~63u) | (unsigned)(63 - j)) + 64u; }
        unsigned sel8 = 0u;
        for (int s = 0; s < nsel; ++s) {
            unsigned best = key[0];
#pragma unroll
            for (int i = 1; i < 8; ++i) best = best > key[i] ? best : key[i];
            { const unsigned o1 = (unsigned)__builtin_amdgcn_update_dpp(0, (int)best, 0xB1, 0xF, 0xF, false); best = best > o1 ? best : o1; }
            { const unsigned o2 = (unsigned)__builtin_amdgcn_update_dpp(0, (int)best, 0x4E, 0xF, 0xF, false); best = best > o2 ? best : o2; }
            { const unsigned o3 = (unsigned)__builtin_amdgcn_update_dpp(0, (int)best, 0x141, 0xF, 0xF, false); best = best > o3 ? best : o3; }
#pragma unroll
            for (int i = 0; i < 8; ++i) { const bool hit = key[i] == best; sel8 |= hit ? (1u << i) : 0u; key[i] = hit ? 0u : key[i]; }
        }
        unsigned mlo = part < 4 ? sel8 << (8 * part) : 0u, mhi = part >= 4 ? sel8 << (8 * (part - 4)) : 0u;
        mlo |= (unsigned)__builtin_amdgcn_update_dpp(0, (int)mlo, 0xB1, 0xF, 0xF, false); mhi |= (unsigned)__builtin_amdgcn_update_dpp(0, (int)mhi, 0xB1, 0xF, 0xF, false);
        mlo |= (unsigned)__builtin_amdgcn_update_dpp(0, (int)mlo, 0x4E, 0xF, 0xF, false); mhi |= (unsigned)__builtin_amdgcn_update_dpp(0, (int)mhi, 0x4E, 0xF, 0xF, false);
        mlo |= (unsigned)__builtin_amdgcn_update_dpp(0, (int)mlo, 0x141, 0xF, 0xF, false); mhi |= (unsigned)__builtin_amdgcn_update_dpp(0, (int)mhi, 0x141, 0xF, 0xF, false);
        const unsigned long long mk = ((unsigned long long)mhi << 32) | mlo;
        if (part == 0) ((unsigned long long*)(shm + CMP_SELM))[q] = mk;
    }
    asm volatile("s_waitcnt lgkmcnt(0)\n\ts_barrier" ::: "memory");
}
}

namespace at {
__device__ __forceinline__ void compress_unit(const bf16* tokb  , int n0, int ncmp, const float* pe, const bf16* W1T, const bf16* W2T,
                                              const float* ropeb  , bf16* outb  , char* shm) {
    int tid_ = threadIdx.x; asm volatile("" : "+v"(tid_));
    const int tid = tid_, lane = tid & 63, r32 = lane & 31, hi = lane >> 5; const int wid = __builtin_amdgcn_readfirstlane(tid >> 6);
    const int cb = wid & 3, kh = wid >> 2;
    const int n = n0 + r32, nc = n < ncmp ? n : ncmp - 1;
    f32x16 acc = f32x16{};
    const bf16* wrow = W1T + (long)(32 * cb + r32) * 2048 + 8 * hi;
#pragma unroll 16
    for (int s = 64 * kh; s < 64 * kh + 64; ++s) {
        const int l = s >> 2, d = 16 * (s & 3) + 8 * hi;
        const u32x4 tv = *(const u32x4*)(tokb + (long)(16 * nc + l) * PITCH + d);
        const f32x4 pa = *(const f32x4*)(pe + l * 64 + d), pb = *(const f32x4*)(pe + l * 64 + d + 4);
        u32x4 av;
        av.x = cvtpk(__builtin_bit_cast(float, tv.x << 16) + pa[0], __builtin_bit_cast(float, tv.x & 0xffff0000u) + pa[1]);
        av.y = cvtpk(__builtin_bit_cast(float, tv.y << 16) + pa[2], __builtin_bit_cast(float, tv.y & 0xffff0000u) + pa[3]);
        av.z = cvtpk(__builtin_bit_cast(float, tv.z << 16) + pb[0], __builtin_bit_cast(float, tv.z & 0xffff0000u) + pb[1]);
        av.w = cvtpk(__builtin_bit_cast(float, tv.w << 16) + pb[2], __builtin_bit_cast(float, tv.w & 0xffff0000u) + pb[3]);
        const bf16x8 bv = *(const bf16x8*)(wrow + 16 * s);
        acc = __builtin_amdgcn_mfma_f32_32x32x16_bf16(__builtin_bit_cast(bf16x8, av), bv, acc, 0, 0, 0);
    }
    float* red = (float*)shm;
    unsigned short* hb = (unsigned short*)(shm + 16384);
    asm volatile("s_waitcnt lgkmcnt(0)\n\ts_barrier" ::: "memory");
    if (kh == 1) {
#pragma unroll
        for (int r = 0; r < 16; ++r) red[(cb * 16 + r) * 64 + lane] = acc[r];
    }
    asm volatile("s_waitcnt lgkmcnt(0)\n\ts_barrier" ::: "memory");
    if (kh == 0) {
#pragma unroll
        for (int r = 0; r < 16; ++r) { const float v = acc[r] + red[(cb * 16 + r) * 64 + lane]; const float hsl = v / (1.0f + __expf(-v));
            hb[crow(r, hi) * 136 + 32 * cb + r32] = (unsigned short)(cvtpk(hsl, 0.f) & 0xffffu); }
    }
    asm volatile("s_waitcnt lgkmcnt(0)\n\ts_barrier" ::: "memory");
    if (wid < 2) {
        f32x16 o2 = f32x16{};
#pragma unroll
        for (int s = 0; s < 8; ++s) { const bf16x8 a = *(const bf16x8*)(hb + r32 * 136 + 16 * s + 8 * hi); const bf16x8 b = *(const bf16x8*)(W2T + (long)(32 * wid + r32) * 128 + 16 * s + 8 * hi);
            o2 = __builtin_amdgcn_mfma_f32_32x32x16_bf16(a, b, o2, 0, 0, 0); }
#pragma unroll
        for (int r = 0; r < 16; ++r) { const int nn = n0 + crow(r, hi); float v = o2[r];
            if (ropeb != nullptr && wid == 0) {
                const float pv = lx::xf<8>(v);
                if (r32 < 16 && nn < ncmp) { const float* cs = ropeb + ((long)(16 * nn + 31) * 8 + (r32 & 7)) * 2; const float cc = cs[0], sn = cs[1]; v = r32 < 8 ? v * cc - pv * sn : v * cc + pv * sn; }
            }
            if (nn < 256) outb[(long)nn * 128 + 32 * wid + r32] = nn < ncmp ? (unsigned short)(cvtpk(v, 0.f) & 0xffffu) : (unsigned short)0; }
    }
    asm volatile("s_waitcnt lgkmcnt(0)\n\ts_barrier" ::: "memory");
}
}

namespace at {
template <bool ACCUM>
__device__ __forceinline__ void store_rows(const f32x16 (&o)[2], const float* rli  , unsigned short* obase  , int ldo,
                                           const float* gbase  , int ldg, float* ssq = nullptr  ) {
    static_assert(!ACCUM, "the mixer outputs are written once, as bf16");
    int t_ = threadIdx.x; asm volatile("" : "+v"(t_)); const int lane = t_ & 63, r32 = lane & 31, hi = lane >> 5;
    unsigned short* ob = obase + r32; float q[16];
#pragma unroll
    for (int r = 0; r < 16; ++r) { const int row = crow(r, hi); float sc = rli ? rli[r] : 1.0f; if (gbase) sc *= gbase[(size_t)row * ldg];
        const float v0 = o[0][r] * sc, v1 = o[1][r] * sc; q[r] = v0 * v0 + v1 * v1;
        unsigned short* p = ob + (size_t)row * ldo; const unsigned w = cvtpk(v0, v1);
        p[0] = (unsigned short)(w & 0xffffu); p[32] = (unsigned short)(w >> 16); }
    if (ssq) {
#pragma unroll
        for (int r = 0; r < 16; ++r) q[r] += lx::xf<16>(q[r]);
#pragma unroll
        for (int c = 0; c < 8; ++c) { const bool h_ = lane & 8; const float keep = h_ ? q[c + 8] : q[c], send = h_ ? q[c] : q[c + 8]; q[c] = keep + lx::xf<8>(send); }
#pragma unroll
        for (int c = 0; c < 4; ++c) { const bool h_ = lane & 4; const float keep = h_ ? q[c + 4] : q[c], send = h_ ? q[c] : q[c + 4]; q[c] = keep + lx::xf<4>(send); }
#pragma unroll
        for (int c = 0; c < 2; ++c) { const bool h_ = lane & 2; const float keep = h_ ? q[c + 2] : q[c], send = h_ ? q[c] : q[c + 2]; q[c] = keep + lx::xf<2>(send); }
        { const bool h_ = lane & 1; const float keep = h_ ? q[1] : q[0], send = h_ ? q[0] : q[1]; q[0] = keep + lx::xf<1>(send); }
        if (!(lane & 16)) ssq[(size_t)crow(lane & 15, hi) * 16] = q[0];
    }
}
}

namespace at {
template <bool INIT, bool LAST>
__device__ __forceinline__ void fold_rows(float* accw  , f32x16 (&o)[2], const float* rli  , const float* gbase, int ldg) {
    int t_ = threadIdx.x; asm volatile("" : "+v"(t_)); const int lane = t_ & 63, hi = lane >> 5;
#pragma unroll
    for (int r = 0; r < 16; ++r) { float sc = gbase[(size_t)crow(r, hi) * ldg]; if (rli) sc *= rli[r];
        float v0 = o[0][r] * sc, v1 = o[1][r] * sc;
        if (!INIT) { v0 += accw[r * 64 + lane]; v1 += accw[(16 + r) * 64 + lane]; }
        if (LAST) { o[0][r] = v0; o[1][r] = v1; } else { accw[r * 64 + lane] = v0; accw[(16 + r) * 64 + lane] = v1; } }
    asm volatile("s_waitcnt lgkmcnt(0)" ::: "memory");
}
}
namespace at {
template <int MODE>
__device__ __forceinline__ void attn_tiles_pipe(const UnitIO& U, char* shm, f32x16 (&o)[2], f32x16& osum) {
    int tid_ = threadIdx.x; asm volatile("" : "+v"(tid_));
    const int tid = tid_, lane = tid & 63, r32 = lane & 31, hi = lane >> 5; const int wid = __builtin_amdgcn_readfirstlane(tid >> 6);
    const unsigned lds0 = (unsigned)(uintptr_t)shm;
    const bf16* ksrc = U.Kh + (long)lane * PITCH + wid * 8;
    const bf16* vsrc = U.Vh + (long)(16 * (wid & 3) + (lane >> 2)) * PITCH + (wid >> 2) * 32 + (lane & 3) * 8;
    const unsigned kdst = lds0 + LDS_K + wid * 1024, vdst = lds0 + LDS_V + wid * 1024;
#define PP_DMA_K(step, slot) glds16(ksrc + (long)(U.t_hi - (step)) * 64 * PITCH, (unsigned)__builtin_amdgcn_readfirstlane(kdst + (slot) * SLOTB))
#define PP_DMA_V(step, slot) glds16(vsrc + (long)(U.t_hi - (step)) * 64 * PITCH, (unsigned)__builtin_amdgcn_readfirstlane(vdst + (slot) * SLOTB))
    const lds_cptr shm3 = (lds_cptr)shm;
    const lds_cptr kp0 = shm3 + LDS_K + hi * 1024 + r32 * 16;
    const lds_cptr vp0 = shm3 + LDS_V + ((lane >> 4) & 1) * 32 + (lane & 3) * 8 + (4 * hi + ((lane & 15) >> 2)) * 64;
    const int n = U.t_hi - U.t_lo + 1, i0 = U.t_hi - U.t_first;
    bf16x8 qr[4];
#pragma unroll
    for (int d0 = 0; d0 < 4; ++d0) qr[d0] = *reinterpret_cast<const bf16x8*>(&U.Qw[(long)r32 * PITCH + d0 * 16 + hi * 8]);
    asm volatile("" ::: "memory");
    PP_DMA_K(0, 0); if (n > 1) PP_DMA_K(1, 1); PP_DMA_V(0, 0); if (n > 2) PP_DMA_K(2, 2); if (n > 1) PP_DMA_V(1, 1);
    f32x16 cini = f32x16{};
    if (MODE == M_FOX) {
#pragma unroll
        for (int r = 0; r < 16; ++r) cini[r] = U.cq; }
    o[0] = f32x16{}; o[1] = f32x16{}; osum = f32x16{};
    const bf16x8 ones = (bf16x8){0x3F80, 0x3F80, 0x3F80, 0x3F80, 0x3F80, 0x3F80, 0x3F80, 0x3F80};
    if (n > 2) asm volatile("s_waitcnt vmcnt(4) lgkmcnt(0)\n\ts_barrier" ::: "memory"); else if (n == 2) asm volatile("s_waitcnt vmcnt(3) lgkmcnt(0)\n\ts_barrier" ::: "memory");
    else asm volatile("s_waitcnt vmcnt(1) lgkmcnt(0)\n\ts_barrier" ::: "memory");
#define PP_QK(S0, S1, slot) do { const lds_cptr kp = kp0 + (slot) * SLOTB; \
        _Pragma("unroll") for (int d0 = 0; d0 < 4; ++d0) { \
            const bf16x8 b0 = *(const __attribute__((address_space(3))) bf16x8*)(kp + d0 * 2048); \
            const bf16x8 b1 = *(const __attribute__((address_space(3))) bf16x8*)(kp + d0 * 2048 + 512); \
            if (d0 == 0) { S0 = __builtin_amdgcn_mfma_f32_32x32x16_bf16(b0, qr[0], cini, 0, 0, 0); S1 = __builtin_amdgcn_mfma_f32_32x32x16_bf16(b1, qr[0], cini, 0, 0, 0); } \
            else { S0 = __builtin_amdgcn_mfma_f32_32x32x16_bf16(b0, qr[d0], S0, 0, 0, 0); S1 = __builtin_amdgcn_mfma_f32_32x32x16_bf16(b1, qr[d0], S1, 0, 0, 0); } } } while (0)
    f32x16 s0 = f32x16{}, s1 = f32x16{};
    if (i0 == 0) PP_QK(s0, s1, 0);
    int ks = 0;
    for (int i = 0; i < n; ++i) {
        const int t = U.t_hi - i;
        if (i + 2 < n) asm volatile("s_waitcnt vmcnt(2) lgkmcnt(0)\n\ts_barrier" ::: "memory");
        else if (i + 1 < n) asm volatile("s_waitcnt vmcnt(1) lgkmcnt(0)\n\ts_barrier" ::: "memory");
        else asm volatile("s_waitcnt vmcnt(0) lgkmcnt(0)\n\ts_barrier" ::: "memory");
        const int ks1 = ks == 2 ? 0 : ks + 1, ks2 = ks == 0 ? 2 : ks - 1;
        if (i + 3 < n) PP_DMA_K(i + 3, ks);
        if (i + 2 < n) PP_DMA_V(i + 2, ks2);
        const bool act = i >= i0, actn = (i + 1 >= i0) && (i + 1 < n);
        f32x16 n0 = f32x16{}, n1 = f32x16{};
        u32x4 pw0, pw1, pw2, pw3;
#define PP_SOFT(DIAG, WLO) do { \
            if (MODE == M_FOX) { const __attribute__((address_space(3))) f32x4* ck = (const __attribute__((address_space(3))) f32x4*)(shm3 + LDS_CK + (64 * t + 4 * hi) * 4); \
                _Pragma("unroll") for (int a = 0; a < 4; ++a) { const f32x4 c0 = ck[2 * a], c1 = ck[2 * a + 8]; \
                    _Pragma("unroll") for (int j = 0; j < 4; ++j) { s0[4 * a + j] -= c0[j]; s1[4 * a + j] -= c1[j]; } } } \
            if (DIAG) { const int kb = 64 * t + 4 * hi; \
                _Pragma("unroll") for (int r = 0; r < 16; ++r) { const int kv = kb + (r & 3) + 8 * (r >> 2); if (kv > U.qpos) s0[r] = NEG; if (kv + 32 > U.qpos) s1[r] = NEG; } } \
            if (WLO) { const int kb = 64 * t + 4 * hi, lim = U.qpos - U.win; \
                _Pragma("unroll") for (int r = 0; r < 16; ++r) { const int kv = kb + (r & 3) + 8 * (r >> 2); if (kv <= lim) s0[r] = NEG; if (kv + 32 <= lim) s1[r] = NEG; } } \
            _Pragma("unroll") for (int r = 0; r < 16; ++r) { s0[r] = __builtin_amdgcn_exp2f(s0[r]); s1[r] = __builtin_amdgcn_exp2f(s1[r]); } \
            pw0 = (u32x4){cvtpk(s0[0], s0[1]), cvtpk(s0[2], s0[3]), cvtpk(s0[4], s0[5]), cvtpk(s0[6], s0[7])}; \
            pw1 = (u32x4){cvtpk(s0[8], s0[9]), cvtpk(s0[10], s0[11]), cvtpk(s0[12], s0[13]), cvtpk(s0[14], s0[15])}; \
            pw2 = (u32x4){cvtpk(s1[0], s1[1]), cvtpk(s1[2], s1[3]), cvtpk(s1[4], s1[5]), cvtpk(s1[6], s1[7])}; \
            pw3 = (u32x4){cvtpk(s1[8], s1[9]), cvtpk(s1[10], s1[11]), cvtpk(s1[12], s1[13]), cvtpk(s1[14], s1[15])}; \
            if (MODE == M_SEL) { const bool sel = (U.selm >> t) & 1ull; \
                _Pragma("unroll") for (int j = 0; j < 4; ++j) { pw0[j] = sel ? pw0[j] : 0u; pw1[j] = sel ? pw1[j] : 0u; pw2[j] = sel ? pw2[j] : 0u; pw3[j] = sel ? pw3[j] : 0u; } } } while (0)
#define PP_HINT() do { _Pragma("unroll") for (int k_ = 0; k_ < 8; ++k_) { __builtin_amdgcn_sched_group_barrier(0x100, 1, 0); __builtin_amdgcn_sched_group_barrier(0x008, 1, 0); \
            __builtin_amdgcn_sched_group_barrier(0x400, 4, 0); __builtin_amdgcn_sched_group_barrier(0x002, 6, 0); } } while (0)
        if (act) {
            const bool diag = (i == i0), wlo = (MODE == M_WIN) && (i == n - 1);
            if (diag) { if (actn) { PP_QK(n0, n1, ks1); PP_SOFT(true, false); PP_HINT(); } else { PP_SOFT(true, (MODE == M_WIN) && wlo); } }
            else if (wlo) { PP_SOFT(false, true); }
            else if (actn) { PP_QK(n0, n1, ks1); PP_SOFT(false, false); PP_HINT(); }
            else { PP_SOFT(false, false); }
            const lds_cptr vp = vp0 + ks * SLOTB;
#pragma unroll
            for (int d0 = 0; d0 < 2; ++d0) { s16x4 lo[4], hh[4];
#pragma unroll
                for (int q4 = 0; q4 < 4; ++q4) { lo[q4] = vtr(vp + d0 * 4096 + q4 * 1024); hh[q4] = vtr(vp + d0 * 4096 + q4 * 1024 + 512); }
#define PP_PK(k) (bf16x8){lo[k][0], lo[k][1], lo[k][2], lo[k][3], hh[k][0], hh[k][1], hh[k][2], hh[k][3]}
                o[d0] = __builtin_amdgcn_mfma_f32_32x32x16_bf16(__builtin_bit_cast(bf16x8, pw0), PP_PK(0), o[d0], 0, 0, 0);
                o[d0] = __builtin_amdgcn_mfma_f32_32x32x16_bf16(__builtin_bit_cast(bf16x8, pw1), PP_PK(1), o[d0], 0, 0, 0);
                o[d0] = __builtin_amdgcn_mfma_f32_32x32x16_bf16(__builtin_bit_cast(bf16x8, pw2), PP_PK(2), o[d0], 0, 0, 0);
                o[d0] = __builtin_amdgcn_mfma_f32_32x32x16_bf16(__builtin_bit_cast(bf16x8, pw3), PP_PK(3), o[d0], 0, 0, 0);
#undef PP_PK
            }
            osum = __builtin_amdgcn_mfma_f32_32x32x16_bf16(__builtin_bit_cast(bf16x8, pw0), ones, osum, 0, 0, 0);
            osum = __builtin_amdgcn_mfma_f32_32x32x16_bf16(__builtin_bit_cast(bf16x8, pw1), ones, osum, 0, 0, 0);
            osum = __builtin_amdgcn_mfma_f32_32x32x16_bf16(__builtin_bit_cast(bf16x8, pw2), ones, osum, 0, 0, 0);
            osum = __builtin_amdgcn_mfma_f32_32x32x16_bf16(__builtin_bit_cast(bf16x8, pw3), ones, osum, 0, 0, 0);
        } else if (actn) { PP_QK(n0, n1, ks1); }
        s0 = n0; s1 = n1; ks = ks1;
    }
    asm volatile("s_waitcnt lgkmcnt(0)\n\ts_barrier" ::: "memory");
#undef PP_SOFT
#undef PP_HINT
#undef PP_QK
#undef PP_DMA_K
#undef PP_DMA_V
}
}
namespace mk {
#define GAS __attribute__((address_space(1)))
#define LAS __attribute__((address_space(3)))
typedef unsigned short bf16;
typedef unsigned v4u __attribute__((ext_vector_type(4)));
typedef float f32x4 __attribute__((ext_vector_type(4)));
typedef short bf16x8 __attribute__((ext_vector_type(8)));
typedef GAS unsigned gu32;
typedef GAS unsigned long long gu64;
#define RLX_AGENT __ATOMIC_RELAXED, __HIP_MEMORY_SCOPE_AGENT
#define LDS_WAIT() asm volatile("s_waitcnt lgkmcnt(0)" ::: "memory")
#define VM_WAIT() asm volatile("s_waitcnt vmcnt(0)" ::: "memory")
__device__ __forceinline__ unsigned long long rt() { return __builtin_amdgcn_s_memrealtime(); }
__device__ __forceinline__ unsigned f2bf(float f) { unsigned u = __builtin_bit_cast(unsigned, f); return (u + 0x7fffu + ((u >> 16) & 1u)) >> 16; }
__device__ __forceinline__ unsigned pk2(float lo, float hi) { return f2bf(lo) | (f2bf(hi) << 16); }

#define XB_TMO      128
#define XB_XCNT(j)  (256  + 64 * (j))
#define XB_XSUB(j)  (1280 + 64 * (j))
#define XB_XGEN(j)  (2304 + 64 * (j))
#define XB_TOP      3328
#define XB_TOPGEN   3392
#define XCD_BAR_WORDS 3456
#ifndef XB_SPIN_CAP
#define XB_SPIN_CAP (1u << 24)
#endif

__device__ __forceinline__ unsigned xb_ld(unsigned* p)              { return __hip_atomic_load(p, __ATOMIC_RELAXED, __HIP_MEMORY_SCOPE_AGENT); }
__device__ __forceinline__ unsigned xb_add(unsigned* p, unsigned v) { return __hip_atomic_fetch_add(p, v, __ATOMIC_RELAXED, __HIP_MEMORY_SCOPE_AGENT); }
__device__ __forceinline__ unsigned xb_xcc_id() { return (unsigned)__builtin_amdgcn_s_getreg((3 << 11) | 20) & 0xFu; }
#define XB_SPIN(cond, bar) do { unsigned _sp = 0; while (cond) { __builtin_amdgcn_s_sleep(1); \
    if ((++_sp & 255u) == 0u) { if (xb_ld(&(bar)[XB_TMO])) break; if (_sp > XB_SPIN_CAP) { atomicAdd(&(bar)[XB_TMO], 1u); break; } } } } while (0)

struct XcdBarrier {
    unsigned* bar; unsigned x;
    volatile LAS unsigned* st;
};

__device__ __forceinline__ XcdBarrier xcd_barrier_post(unsigned* bar, volatile LAS unsigned* st) {
    XcdBarrier b; b.bar = bar; b.x = xb_xcc_id(); b.st = st;
    if (threadIdx.x == 0) (void)xb_add(&bar[XB_XCNT(b.x)], 1u);
    return b;
}
__device__ __forceinline__ void xcd_barrier_complete(unsigned* bar, unsigned x, unsigned& nloc, unsigned& nx) {
    const unsigned G = gridDim.x * gridDim.y * gridDim.z;
    unsigned sum, cnt, mine, sp = 0u;
    for (;;) {
        sum = 0u; cnt = 0u; mine = 0u;
#pragma unroll
        for (unsigned j = 0; j < 16; ++j) { const unsigned c = xb_ld(&bar[XB_XCNT(j)]); sum += c; cnt += (c > 0u) ? 1u : 0u; mine = (j == x) ? c : mine; }
        if (sum == G) break;
        __builtin_amdgcn_s_sleep(1);
        if ((++sp & 255u) == 0u) { if (xb_ld(&bar[XB_TMO])) break; if (sp > XB_SPIN_CAP) { atomicAdd(&bar[XB_TMO], 1u); break; } }
    }
    nloc = mine > 0u ? mine : 1u; nx = cnt > 0u ? cnt : 1u;
}

__device__ __forceinline__ void xcd_barrier(const XcdBarrier& b) {
    asm volatile("s_waitcnt vmcnt(0)" ::: "memory");
    __syncthreads();
    if (threadIdx.x == 0) {
        unsigned* bar = b.bar;
        __builtin_amdgcn_s_waitcnt(0);
        unsigned nloc = b.st[0], nx = b.st[1];
        if (nloc == 0u) { xcd_barrier_complete(bar, b.x, nloc, nx); b.st[0] = nloc; b.st[1] = nx; }
        const unsigned old = xb_add(&bar[XB_XSUB(b.x)], 1u);
        const unsigned gen = old / nloc;
        if (old + 1u == (gen + 1u) * nloc) {
            __builtin_amdgcn_fence(__ATOMIC_RELEASE, "agent");
            asm volatile("s_waitcnt vmcnt(0)" ::: "memory");
            const unsigned og = xb_add(&bar[XB_TOP], 1u);
            const unsigned tg = og / nx;
            if (og + 1u == (tg + 1u) * nx) xb_add(&bar[XB_TOPGEN], 1u);
            else XB_SPIN(xb_ld(&bar[XB_TOPGEN]) == tg, bar);
            __builtin_amdgcn_fence(__ATOMIC_ACQUIRE, "agent");
            xb_add(&bar[XB_XGEN(b.x)], 1u);
            asm volatile("s_waitcnt vmcnt(0)" ::: "memory");
        } else {
            XB_SPIN(xb_ld(&bar[XB_XGEN(b.x)]) == gen, bar);
            __builtin_amdgcn_fence(__ATOMIC_ACQUIRE, "agent");
            asm volatile("s_waitcnt vmcnt(0)" ::: "memory");
        }
    }
    __syncthreads();
}
using nv::B_; using nv::S_; using nv::T_; using nv::DM; using nv::NCMP; using nv::NBLK;
constexpr int NWAVES = 8, NTHREADS = NWAVES * 64;
constexpr int RING_OFF = 0, RING_BYTES = 131072, LDS_BYTES = 147456, LDSCTL_OFF = LDS_BYTES - 1024, MISC_OFF = LDSCTL_OFF + 320;
constexpr int CW_BAR = 4096, CW_FOXQ = 8192, CW_PANEL = 16384, CW_HM = 24576;
constexpr int NIN = 3072;
constexpr size_t MiB = (size_t)1 << 20;
constexpr size_t WS_CTL = 0, CTL_ZERO_BYTES = 1 * MiB;
constexpr size_t WS_WIN = 2 * MiB;
constexpr size_t WS_WOUT = 8 * MiB, WS_WPG = 10 * MiB, WS_WPP = 12 * MiB, WS_CMPW = 13 * MiB;
constexpr size_t WS_ROPE = 15 * MiB;
constexpr size_t WS_GATES = 17 * MiB;
constexpr size_t WS_LOGF = 20 * MiB, WS_CUM = 21 * MiB;
constexpr size_t WS_KC = 22 * MiB, WS_VC = 23 * MiB, WS_SELM = 24 * MiB, WS_EID = 25 * MiB, WS_CW = 26 * MiB, WS_RS3 = 27 * MiB, WS_CMPH = 28 * MiB;
constexpr size_t WS_WGU = 40 * MiB, WS_WD = 72 * MiB;
constexpr size_t WS_RA = 39 * MiB;
constexpr size_t WS_XN = 88 * MiB;
constexpr size_t WS_PROJB = 152 * MiB;
constexpr size_t WS_TAB = 1 * MiB;
constexpr size_t WS_ROPEH = 38 * MiB;
constexpr size_t WS_ROWIDX = 37 * MiB;
constexpr size_t WS_XS = 36 * MiB;
constexpr size_t WS_POS = 34 * MiB, WS_NRM = 35 * MiB;
constexpr size_t WS_USORT = 152 * MiB, WS_HIDB = 288 * MiB, WS_YB = 356 * MiB;
constexpr size_t WS_PB = 496 * MiB;
constexpr size_t WS_IMP = 328 * MiB;
constexpr size_t WS_NH = 88 * MiB, WS_NU = 216 * MiB, WS_NHID = 344 * MiB;
static_assert(WS_NHID + (size_t)T_ * 1024 * 4 <= 512 * MiB && WS_PROJB + (size_t)T_ * 2816 * 2 <= WS_IMP, "d_ws map");

__device__ __forceinline__ float wave_sum(float v) { return lx::sum64(v); }
template <int MODE, bool SC = false>
__device__ __forceinline__ void p0_transpose_item(const float* W, int ldw, int col0, int K, int nblk, bf16* WT, int row_off, LAS float* scr, int item, int lane, const float* ksc = nullptr) {
    const int kb = item / nblk, nb = item % nblk, k0 = 64 * kb, n0 = 32 * nb;
#pragma unroll 8
    for (int i = 0; i < 32; ++i) { const int kk = 2 * i + (lane >> 5); const int cl = lane & 31; const int sc = (MODE == 2 && cl >= 24) ? col0 + 1536 + cl : col0 + n0 + cl; scr[kk * 33 + cl] = SC ? W[(size_t)(k0 + kk) * ldw + sc] * ksc[k0 + kk] : W[(size_t)(k0 + kk) * ldw + sc]; }
    LDS_WAIT(); asm volatile("" ::: "memory");
    const int c = lane & 7;
#pragma unroll
    for (int j = 0; j < 4; ++j) { const int n = (lane >> 3) + 8 * j; const LAS float* s = scr + (8 * c) * 33 + n;
        v4u o; o.x = pk2(s[0 * 33], s[1 * 33]); o.y = pk2(s[2 * 33], s[3 * 33]); o.z = pk2(s[4 * 33], s[5 * 33]); o.w = pk2(s[6 * 33], s[7 * 33]);
        const int nn = n0 + n; const int ln = row_off + nn;
        const int drow = MODE == 3 ? (ln & ~255) + 128 * ((ln >> 5) & 1) + 32 * ((ln >> 6) & 3) + (ln & 31) : MODE != 1 ? row_off + nn : (nn >> 2) * 8 + (nn & 3) + row_off;
        *(GAS v4u*)(WT + (size_t)drow * K + k0 + 8 * c) = o; }
    LDS_WAIT(); asm volatile("" ::: "memory");
}
__device__ __forceinline__ void rms_row_to_bf16(const float* xrow, const float* gain, bf16* orow, int lane) {
    const GAS f32x4* xr = (const GAS f32x4*)xrow + lane; const GAS f32x4* gr = (const GAS f32x4*)gain + lane;
    f32x4 v[4]; float s = 0.f;
#pragma unroll
    for (int j = 0; j < 4; ++j) { v[j] = xr[64 * j]; s += (v[j].x * v[j].x + v[j].y * v[j].y) + (v[j].z * v[j].z + v[j].w * v[j].w); }
    const float rstd = 1.f / sqrtf(wave_sum(s) * (1.f / 1024.f) + 1e-6f);
    GAS unsigned long long* o8 = (GAS unsigned long long*)orow + lane;
#pragma unroll
    for (int j = 0; j < 4; ++j) { const f32x4 g = gr[64 * j];
        o8[64 * j] = (unsigned long long)pk2(v[j].x * rstd * g.x, v[j].y * rstd * g.y) | ((unsigned long long)pk2(v[j].z * rstd * g.z, v[j].w * rstd * g.w) << 32); }
}

#ifndef PROBE_DUP
#define PROBE_DUP (-1)
#endif
#define REP(k) for (int rep_ = 0; rep_ < ((PROBE_DUP == (k)) ? 2 : 1); ++rep_)
struct Args { const void* in[29]; void* out; void* ws; };
#define LDP_(k) ((uintptr_t)args.in[k])
#define PHASE_PTRS() size_t zo_ = 0; asm volatile("" : "+s"(zo_)); char* ws = ws0_ + zo_; float* out = out0_ + zo_;     volatile LAS unsigned* LPV_ = (volatile LAS unsigned*)(ldsp + LDSCTL_OFF + 512); (void)LPV_; \
    const float* in_x = (const float*)LDP_(0); const float* in_p = (const float*)LDP_(1); const int* positions = (const int*)LDP_(2); const float* g_mix = (const float*)LDP_(3); const float* w_in = (const float*)LDP_(4); const float* b_gate = (const float*)LDP_(5); const float* b_forget = (const float*)LDP_(6); const float* pe_k = (const float*)LDP_(7); const float* w_k1 = (const float*)LDP_(8); const float* w_k2 = (const float*)LDP_(9); const float* pe_v = (const float*)LDP_(10); const float* w_v1 = (const float*)LDP_(11); const float* w_v2 = (const float*)LDP_(12); const float* beta_nsa = (const float*)LDP_(13); const float* beta_fox = (const float*)LDP_(14); const float* w_out = (const float*)LDP_(15); const float* g_ffn = (const float*)LDP_(16); const float* w_group = (const float*)LDP_(17); const float* b_group = (const float*)LDP_(18); const float* w_router = (const float*)LDP_(19); const float* b_router = (const float*)LDP_(20); const float* w_gate_e = (const float*)LDP_(21); const float* w_up_e = (const float*)LDP_(22); const float* w_down_e = (const float*)LDP_(23); const float* g_ple = (const float*)LDP_(24); const float* w_ple_gate = (const float*)LDP_(25); const float* b_ple = (const float*)LDP_(26); const float* w_ple_proj = (const float*)LDP_(27); const float* g_final = (const float*)LDP_(28); \
    bf16* WIN_T = (bf16*)(ws + WS_WIN); bf16* WOUT_T = (bf16*)(ws + WS_WOUT); bf16* WPG_T = (bf16*)(ws + WS_WPG); bf16* WPP_T = (bf16*)(ws + WS_WPP); bf16* WGU_T = (bf16*)(ws + WS_WGU); bf16* WD_T = (bf16*)(ws + WS_WD); bf16* XN = (bf16*)(ws + WS_XN); bf16* PROJB = (bf16*)(ws + WS_PROJB); bf16* W1KT = (bf16*)(ws + WS_CMPW); bf16* W1VT = W1KT + 128 * 2048; bf16* W2KT = W1VT + 128 * 2048; bf16* W2VT = W2KT + 64 * 128; bf16* KCB = (bf16*)(ws + WS_KC); bf16* VCB = (bf16*)(ws + WS_VC); bf16* PB = (bf16*)(ws + WS_PB); bf16* PPB = (bf16*)(ws + 216 * MiB);   bf16* VPLE = (bf16*)(ws + WS_USORT); float* ROPE = (float*)(ws + WS_ROPE); float* GATES = (float*)(ws + WS_GATES); float* LOGF = (float*)(ws + WS_LOGF); unsigned short* OMIX = (unsigned short*)out; float* HB = out;   float* CUM2 = (float*)(ws + WS_CUM); float* RA = (float*)(ws + WS_RA); float* RSX = (float*)(ws + WS_RA + 128 * 1024); bf16* MIXB = (bf16*)(ws + WS_PROJB);   float* RSS = (float*)(ws + WS_RA + 512 * 1024); bf16* H1B = XN; float* SSQ = (float*)(ws + 28 * MiB);   int* EIDB = (int*)(ws + WS_EID); float* CWB = (float*)(ws + WS_CW); float* RSTD2 = (float*)(ws + WS_RS3); int* LC = (int*)(ws + WS_TAB); int* TILE_E = LC + 1024 * 16; int* NTILES = TILE_E + 1024; int* POS = (int*)(ws + WS_POS); int* ROWIDX = (int*)(ws + WS_ROWIDX); bf16* USORT = (bf16*)(ws + WS_USORT); bf16* HIDB = (bf16*)(ws + WS_HIDB); bf16* YB = (bf16*)(ws + WS_YB); \
    const int chunk = (T_ + NG - 1) / NG, tok0 = (int)blockIdx.x * chunk, ntok = (tok0 + chunk <= T_) ? chunk : (T_ > tok0 ? T_ - tok0 : 0); (void)chunk; (void)tok0; (void)ntok;
__global__ void __launch_bounds__(NTHREADS, 2) mk_fwd(Args args) {
    using namespace nv;
    extern __shared__ __attribute__((aligned(16))) unsigned char lds[];
    LAS unsigned char* ldsp = (LAS unsigned char*)lds;
    volatile LAS unsigned* MISC = (volatile LAS unsigned*)(ldsp + MISC_OFF);
    for (int u = threadIdx.x; u < (LDS_BYTES - LDSCTL_OFF) / 4; u += NTHREADS) ((LAS unsigned*)(ldsp + LDSCTL_OFF))[u] = 0u;
    __syncthreads();
    char* const ws0_ = (char*)args.ws; float* const out0_ = (float*)args.out;
    { LAS unsigned long long* LP_ = (LAS unsigned long long*)(ldsp + LDSCTL_OFF + 512); if (threadIdx.x < 29) LP_[threadIdx.x] = (unsigned long long)(uintptr_t)args.in[threadIdx.x]; }
    __syncthreads();
    XcdBarrier bar = xcd_barrier_post((unsigned*)(ws0_ + WS_CTL) + CW_BAR, MISC + 8);
    const int wave = __builtin_amdgcn_readfirstlane((int)threadIdx.x >> 6);
#define PHASE_IDS() int tid = threadIdx.x; asm volatile("" : "+v"(tid)); const int lane = tid & 63; (void)lane
    const int NG = gridDim.x; const int vcu = (NG % 8 == 0) ? ((int)blockIdx.x % 8) * (NG / 8) + (int)blockIdx.x / 8 : (int)blockIdx.x;
    {   PHASE_PTRS();
    REP(0)
    {
        PHASE_IDS();
        LAS float* scr = (LAS float*)(ldsp + RING_OFF + wave * 16384);
        const int gw = vcu * NWAVES + wave, NGW = NG * NWAVES;
        constexpr int I_IN_A = 16 * 40, I_IN_B = 16 * 48, I_IN_C = 16 * 1, I_SQ = 16 * 32, I_PP = 4 * 32, I_EG = 16 * 16, I_ED = 8 * 32;
        constexpr int I_C1 = 32 * 4, I_C2 = 2 * 2;
        constexpr int NITEMS = I_IN_A + I_IN_B + I_IN_C + 2 * I_SQ + I_PP + 2 * (I_C1 + I_C2) + 16 * (2 * I_EG + I_ED);
        for (int it = gw; it < NITEMS; it += NGW) {
            int r = it;
            if (r < I_IN_A) { p0_transpose_item<3, true>(w_in, IN_COLS, 0, 1024, 40, WIN_T, 0, scr, r, lane, g_mix); continue; } r -= I_IN_A;
            if (r < I_IN_B) { p0_transpose_item<3, true>(w_in, IN_COLS, OFF_QB, 1024, 48, WIN_T, 1280, scr, r, lane, g_mix); continue; } r -= I_IN_B;
            if (r < I_IN_C) { p0_transpose_item<2, true>(w_in, IN_COLS, OFF_GATE, 1024, 1, WIN_T, 2816, scr, r, lane, g_mix); continue; } r -= I_IN_C;
            if (r < I_SQ) { p0_transpose_item<0, true>(w_out, 1024, 0, 1024, 32, WOUT_T, 0, scr, r, lane, (r >> 5) < 8 ? beta_nsa : beta_fox - 512); continue; }     r -= I_SQ;
            if (r < I_SQ) { p0_transpose_item<0, true>(w_ple_gate, 1024, 0, 1024, 32, WPG_T, 0, scr, r, lane, g_ple); continue; }     r -= I_SQ;
            if (r < I_PP) { p0_transpose_item<0>(w_ple_proj, 1024, 0, 256, 32, WPP_T, 0, scr, r, lane); continue; } r -= I_PP;
            if (r < I_C1) { p0_transpose_item<0>(w_k1, 128, 0, 2048, 4, W1KT, 0, scr, r, lane); continue; } r -= I_C1;
            if (r < I_C1) { p0_transpose_item<0>(w_v1, 128, 0, 2048, 4, W1VT, 0, scr, r, lane); continue; } r -= I_C1;
            if (r < I_C2) { p0_transpose_item<0>(w_k2, 64, 0, 128, 2, W2KT, 0, scr, r, lane); continue; } r -= I_C2;
            if (r < I_C2) { p0_transpose_item<0>(w_v2, 64, 0, 128, 2, W2VT, 0, scr, r, lane); continue; } r -= I_C2;
            const int e = r / (2 * I_EG + I_ED); r -= e * (2 * I_EG + I_ED);
            if (r < I_EG) { p0_transpose_item<1, true>(w_gate_e + (size_t)e * 1024 * 512, 512, 0, 1024, 16, WGU_T + (size_t)e * 1024 * 1024, 0, scr, r, lane, g_ffn); continue; } r -= I_EG;
            if (r < I_EG) { p0_transpose_item<1, true>(w_up_e + (size_t)e * 1024 * 512, 512, 0, 1024, 16, WGU_T + (size_t)e * 1024 * 1024, 4, scr, r, lane, g_ffn);     continue; } r -= I_EG;
            p0_transpose_item<0>(w_down_e + (size_t)e * 512 * 1024, 1024, 0, 512, 32, WD_T + (size_t)e * 1024 * 512, 0, scr, r, lane);
        }
        for (int i = (int)blockIdx.x * NTHREADS + tid; i < T_ * 8; i += NG * NTHREADS) { const int tok = i >> 3, j = i & 7;
            const float inv = powf(500000.0f, -(float)j / 8.0f); const float ang = (float)positions[tok] * inv; const float cv = cosf(ang), sv = sinf(ang); ROPE[(size_t)i * 2] = cv; ROPE[(size_t)i * 2 + 1] = sv;
            typedef _Float16 h2_t __attribute__((ext_vector_type(2))); const h2_t hv = {(_Float16)cv, (_Float16)sv}; ((unsigned*)(ws + WS_ROPEH))[i] = __builtin_bit_cast(unsigned, hv); }
        for (int m = gw; m < T_; m += 2 * NGW) {
            const bool hasB = m + NGW < T_; const int mB = hasB ? m + NGW : m;
            const GAS f32x4* xa = (const GAS f32x4*)(in_x + (size_t)m * DM) + lane; const GAS f32x4* xb = (const GAS f32x4*)(in_x + (size_t)mB * DM) + lane;
            f32x4 va[4], vb[4]; float sa = 0.f, sb = 0.f;
#pragma unroll
            for (int j = 0; j < 4; ++j) { va[j] = xa[64 * j]; vb[j] = xb[64 * j]; }
            const f32x4 pa = ((const GAS f32x4*)(in_p + (size_t)m * 256))[lane], pb = ((const GAS f32x4*)(in_p + (size_t)mB * 256))[lane];
#pragma unroll
            for (int j = 0; j < 4; ++j) { sa += (va[j].x * va[j].x + va[j].y * va[j].y) + (va[j].z * va[j].z + va[j].w * va[j].w); sb += (vb[j].x * vb[j].x + vb[j].y * vb[j].y) + (vb[j].z * vb[j].z + vb[j].w * vb[j].w); }
            const float ra = 1.f / sqrtf(wave_sum(sa) * (1.f / 1024.f) + 1e-6f), rb = 1.f / sqrtf(wave_sum(sb) * (1.f / 1024.f) + 1e-6f);
            GAS unsigned long long* oa = (GAS unsigned long long*)(XN + (size_t)m * DM) + lane; GAS unsigned long long* ob = (GAS unsigned long long*)(XN + (size_t)mB * DM) + lane;
#pragma unroll
            for (int j = 0; j < 4; ++j) {
                oa[64 * j] = (unsigned long long)pk2(va[j].x, va[j].y) | ((unsigned long long)pk2(va[j].z, va[j].w) << 32);
                if (hasB) ob[64 * j] = (unsigned long long)pk2(vb[j].x, vb[j].y) | ((unsigned long long)pk2(vb[j].z, vb[j].w) << 32); }
            if (lane == 0) { RSX[m] = ra; if (hasB) RSX[mB] = rb; }
            ((GAS unsigned long long*)(PB + (size_t)m * 256))[lane] = (unsigned long long)pk2(pa.x, pa.y) | ((unsigned long long)pk2(pa.z, pa.w) << 32);
            if (hasB) ((GAS unsigned long long*)(PB + (size_t)mB * 256))[lane] = (unsigned long long)pk2(pb.x, pb.y) | ((unsigned long long)pk2(pb.z, pb.w) << 32); }
    }
    }
    xcd_barrier(bar); if (PROBE_DUP == 60) xcd_barrier(bar);
    {   PHASE_PTRS();

    REP(1)
    {
        pg8::Gemm g{XN, WIN_T, T_, NIN, DM, 0}; pg8::StaticOrder S; S.init(T_, NIN, NG, (int)blockIdx.x);
        pg8::EpiInProj E{PROJB, ROPE, RSX, GATES, LOGF, b_gate, b_forget, (float*)(ws + WS_NRM), 0};
        if (PROBE_DUP >= 64 && PROBE_DUP <= 66) { pg8::EpiInProj E2 = E; E2.dbg = PROBE_DUP - 63; pg8::gemm_phase<pg8::EpiInProj, pg8::StaticOrder, false, true>(ldsp + RING_OFF, g, S, E2); }
        if (PROBE_DUP == 63) { pg8::EpiBf16Plain EP{PROJB, at::PITCH}; pg8::Gemm g2{XN, WIN_T, T_, 2816, DM, 0}; pg8::StaticOrder S2; S2.init(T_, 2816, NG, (int)blockIdx.x); pg8::gemm_phase<pg8::EpiBf16Plain, pg8::StaticOrder, false, true>(ldsp + RING_OFF, g2, S2, EP); }
        pg8::gemm_phase<pg8::EpiInProj, pg8::StaticOrder, false, true>(ldsp + RING_OFF, g, S, E);
        if (PROBE_DUP == 61) { pg8::EpiNull EN; pg8::gemm_phase<pg8::EpiNull, pg8::StaticOrder, true, true>(ldsp + RING_OFF, g, S, EN); }
    }
    }
    xcd_barrier(bar); if (PROBE_DUP == 60) xcd_barrier(bar);
    {   PHASE_PTRS();

    REP(3)
    { char* shm = (char*)lds + RING_OFF; constexpr int NT8 = (NCMP + 31) / 32; const int nunits = 2 * B_ * 2 * NT8;
      for (int uid = (int)blockIdx.x; uid < nunits; uid += NG) { const int nt = uid % NT8, g = (uid / NT8) & 1, b = (uid / (2 * NT8)) % B_, which = uid / (2 * NT8 * B_);
          at::compress_unit(PROJB + (size_t)b * S_ * at::PITCH + (which ? 640 : 512) + g * 64, 32 * nt, NCMP, which ? pe_v : pe_k, which ? W1VT : W1KT, which ? W2VT : W2KT,
                            which ? (const float*)nullptr : ROPE + (size_t)b * S_ * 16, (which ? VCB : KCB) + (size_t)b * 256 * 128 + g * 64, shm); }
      PHASE_IDS(); const int gw = vcu * NWAVES + wave, NGW = NG * NWAVES; constexpr int PER = S_ / 64; constexpr int NCH = S_ / 64;
      for (int task = gw; task < B_ * 8; task += NGW) {
          if (task < B_ * 8) { const int bh = task, b = bh >> 3, h = bh & 7; const float* lf = LOGF + ((size_t)b * S_ + (size_t)PER * lane) * 8 + h;
              float vals[PER]; float s = 0.f;
#pragma unroll
              for (int j = 0; j < PER; ++j) { vals[j] = lf[j * 8]; s += vals[j]; }
              float incl = s;
#pragma unroll
              for (int o = 1; o < 64; o <<= 1) { const float v = __builtin_bit_cast(float, __builtin_amdgcn_ds_bpermute((lane - o) << 2, __builtin_bit_cast(int, incl))); if (lane >= o) incl += v; }
              float run = incl - s; float* cp = CUM2 + (size_t)bh * S_ + PER * lane;
#pragma unroll
              for (int j = 0; j < PER; ++j) { run += vals[j]; cp[j] = run * 1.4426950408889634f; }
          } } }
    }
    xcd_barrier(bar); if (PROBE_DUP == 60) xcd_barrier(bar);
    {   PHASE_PTRS();
    REP(4)
    { PHASE_IDS(); const int r32 = lane & 31, hi = lane >> 5;
      char* shm = (char*)lds + RING_OFF;
      const int nunits = B_ * 2 * NBLK;
      for (int it = 0;; ++it) {
          int bg, c;
          if (NG == 256 && S_ == 4096 && B_ == 8) { if (it >= 4) break; const int s = vcu & 15; bg = vcu >> 4; c = it == 0 ? s : it == 1 ? 31 - s : it == 2 ? 32 + s : 63 - s; }
          else { const int uid = it * NG + (int)blockIdx.x; if (uid >= nunits) break; bg = uid / NBLK; c = uid % NBLK; }
          const int b = bg >> 1, g = bg & 1, h = g * 4 + (wave >> 1), tq0 = c * 64 + 32 * (wave & 1);
          const size_t tokb = (size_t)b * S_ + tq0;
          at::UnitIO U; U.Qw = PROJB + tokb * at::PITCH + h * 64; U.t_hi = c; U.t_first = c; U.qpos = tq0 + r32;
          unsigned short* ob = OMIX + tokb * DM + h * 64; const float* gp = GATES + tokb * 24 + h * 3;
          at::f32x16 o[2], osum; float l; float rli[16];
          bool fast_sel, fast_win;
          { const float* hmt = (const float*)(ws + WS_NRM) + ((size_t)b * (S_ / 256) * 2 + (lane & 31)) * 28; float q2 = 0.f;
#pragma unroll
            for (int hh = 0; hh < 4; ++hh) q2 = fmaxf(q2, lx::max64(hmt[g * 4 + hh]));
            const float qmax = sqrtf(q2), ksm = sqrtf(lx::max64(hmt[8 + g])), kwm = sqrtf(lx::max64(hmt[10 + g]));
            fast_sel = __builtin_amdgcn_readfirstlane((int)(qmax * ksm <= 60.0f)) != 0; fast_win = __builtin_amdgcn_readfirstlane((int)(qmax * kwm <= 60.0f)) != 0; }
          for (int pr_ = 0; pr_ < (PROBE_DUP == 22 ? 2 : 1); ++pr_)
          at::cmp_stage(U.Qw, KCB + (size_t)b * 256 * 128 + g * 64, VCB + (size_t)b * 256 * 128 + g * 64, c, nv::NSEL, shm, o);
          float* accw = (float*)(shm + at::CMP_IMP) + wave * 2048; static_assert(at::CMP_SELM + 512 <= LDSCTL_OFF, "NSA LDS map"); at::fold_rows<true, false>(accw, o, nullptr, gp, 24);
          U.Kh = PROJB + (size_t)b * S_ * at::PITCH + 768 + g * 64; U.Vh = PROJB + (size_t)b * S_ * at::PITCH + 896 + g * 64; U.t_lo = 0; U.win = 0;
          U.selm = ((const unsigned long long*)(shm + at::CMP_SELM))[32 * (wave & 1) + r32];
          if (PROBE_DUP >= 41 && PROBE_DUP <= 43) { at::f32x16 o_[2], os_; float l_; at::attn_tiles<at::M_SEL, true, PROBE_DUP - 40>(U, shm, o_, l_, os_); asm volatile("" :: "v"(o_[0]), "v"(o_[1]), "v"(os_)); }
          for (int pr_ = 0; pr_ < (PROBE_DUP == 20 ? 2 : 1); ++pr_)
          if (fast_sel) { at::attn_tiles<at::M_SEL, true>(U, shm, o, l, osum);
#pragma unroll
              for (int r = 0; r < 16; ++r) rli[r] = 1.0f / osum[r]; }
          else { at::attn_tiles<at::M_SEL, false>(U, shm, o, l, osum); at::row_inv(l, shm, rli); }
          at::fold_rows<false, false>(accw, o, rli, gp + 1, 24);
          U.Kh = PROJB + (size_t)b * S_ * at::PITCH + 1024 + g * 64; U.Vh = PROJB + (size_t)b * S_ * at::PITCH + 1152 + g * 64; U.t_lo = c > (nv::WIN / 64) ? c - (nv::WIN / 64) : 0; U.win = nv::WIN; U.selm = 0ull;
          for (int pr_ = 0; pr_ < (PROBE_DUP == 21 ? 2 : 1); ++pr_)
          if (fast_win) { at::attn_tiles<at::M_WIN, true>(U, shm, o, l, osum);
#pragma unroll
              for (int r = 0; r < 16; ++r) rli[r] = 1.0f / osum[r]; }
          else { at::attn_tiles<at::M_WIN, false>(U, shm, o, l, osum); at::row_inv(l, shm, rli); }
          at::fold_rows<false, true>(accw, o, rli, gp + 2, 24);
          at::store_rows<false>(o, nullptr, ob, DM, nullptr, 0, SSQ + tokb * 16 + h);
      } }
    REP(5)
    { PHASE_IDS(); const int r32 = lane & 31;
      char* shm = (char*)lds + RING_OFF; (void)r32;
      const int nunits = B_ * 8 * (S_ / 256); gu32* qctr = (gu32*)(ws + WS_CTL) + CW_FOXQ + 64 * rep_;
      for (;;) {
          if (tid == 0) MISC[4] = __hip_atomic_fetch_add(qctr, 1u, RLX_AGENT);
          __syncthreads();
          const int uid = __builtin_amdgcn_readfirstlane((int)MISC[4]);
          __syncthreads();
          if (uid >= nunits) break;
          const int qb = (S_ / 256 - 1) - uid / (B_ * 8), bh = uid % (B_ * 8);
          const int b = bh >> 3, h = bh & 7, q0 = qb * 256;
          int t_lo; float sbnd;
          bool fast;
          { const float* c2 = CUM2 + (size_t)bh * S_; const float* hmb = (const float*)(ws + WS_NRM) + (size_t)b * (S_ / 256) * 2 * 28;
            const float qn = sqrtf(fmaxf(hmb[(qb * 2) * 28 + 12 + h], hmb[(qb * 2 + 1) * 28 + 12 + h]));
            const float knu = sqrtf(fmaxf(hmb[(qb * 2) * 28 + 20 + h], hmb[(qb * 2 + 1) * 28 + 20 + h]));
            const float knt = sqrtf(hmb[(lane >> 1) * 28 + 20 + h]);
            const bool skip = (lane < 4 * qb) && (qn * (knt + knu) + (c2[q0] - c2[64 * lane + 63]) < -30.0f);
            const unsigned long long sk = __ballot(skip); t_lo = sk == ~0ull ? 64 : __builtin_ctzll(~sk); if (t_lo > 4 * qb) t_lo = 4 * qb; t_lo = __builtin_amdgcn_readfirstlane(t_lo);
            const float kmax = sqrtf(lx::max64(hmb[(lane & 31) * 28 + 20 + h]));
            fast = __builtin_amdgcn_readfirstlane((int)(qn * kmax <= 60.0f)) != 0; sbnd = qn * kmax; }
          { LAS float* ck = (LAS float*)(ldsp + RING_OFF + at::LDS_CK); const float* src = CUM2 + (size_t)bh * S_; const int nk = q0 + 256;
            for (int k = 64 * t_lo + tid; k < nk; k += NTHREADS) ck[k] = src[k]; }
          __syncthreads();
          at::UnitIO U; U.Qw = PROJB + ((size_t)b * S_ + q0 + 32 * wave) * at::PITCH + 1280 + h * 64; U.Kh = PROJB + (size_t)b * S_ * at::PITCH + 1792 + h * 64; U.Vh = PROJB + (size_t)b * S_ * at::PITCH + 2304 + h * 64;
          U.t_hi = 4 * qb + 3; U.t_lo = t_lo; U.t_first = 4 * qb + (wave >> 1); U.qpos = q0 + 32 * wave + r32; U.selm = 0ull; U.win = 0; U.cq = CUM2[(size_t)bh * S_ + U.qpos]; U.sbound = sbnd; U.c2q0 = CUM2[(size_t)bh * S_ + q0];
          at::f32x16 o[2], osum; float l; float rli[16];
          if (fast) { at::attn_tiles<at::M_FOX, true>(U, shm, o, l, osum);
#pragma unroll
              for (int r = 0; r < 16; ++r) rli[r] = 1.0f / osum[r]; }
          else { at::attn_tiles<at::M_FOX, false>(U, shm, o, l, osum); at::row_inv(l, shm, rli); }
          at::store_rows<false>(o, rli, OMIX + ((size_t)b * S_ + q0 + 32 * wave) * DM + 512 + h * 64, DM, nullptr, 0, SSQ + ((size_t)b * S_ + q0 + 32 * wave) * 16 + 8 + h);
      } }
    }
    xcd_barrier(bar); if (PROBE_DUP == 60) xcd_barrier(bar);
    {   PHASE_PTRS();
    REP(7)
    { pg8::Gemm g{(const bf16*)OMIX, WOUT_T, T_, DM, DM, 0}; pg8::StaticOrder S; S.init(T_, DM, NG, (int)blockIdx.x);
      pg8::EpiOutProj E{SSQ, XN, DM};
      pg8::gemm_phase<pg8::EpiOutProj, pg8::StaticOrder, true, true>(ldsp + RING_OFF, g, S, E); }
    }
    xcd_barrier(bar); if (PROBE_DUP == 60) xcd_barrier(bar);
    {   PHASE_PTRS();
    REP(8)
    { PHASE_IDS();
      LAS float* WR = (LAS float*)(ldsp + RING_OFF); LAS int* LCNT = (LAS int*)(ldsp + RING_OFF + 81920); LAS float* RS = (LAS float*)(ldsp + RING_OFF + 81920 + 64) + wave * (16 * 24);
#pragma unroll
      for (int kk = 0; kk < 1024 / NTHREADS; ++kk) { const int k = tid + kk * NTHREADS; const float gk = g_ffn[k];
          const f32x4 wg4 = *(const GAS f32x4*)(w_group + k * 4); const GAS f32x4* wr4 = (const GAS f32x4*)(w_router + k * 16); const f32x4 r0 = wr4[0], r1 = wr4[1], r2 = wr4[2], r3 = wr4[3];
          LAS f32x4* dst = (LAS f32x4*)(WR + ((((k >> 8) * 4 + (k & 3)) * 64) + ((k >> 2) & 63)) * 20);   dst[0] = wg4 * gk; dst[1] = r0 * gk; dst[2] = r1 * gk; dst[3] = r2 * gk; dst[4] = r3 * gk; }
      if (tid < 16) LCNT[tid] = 0;
      __syncthreads();
      for (int pa_ = 0; pa_ < (PROBE_DUP == 50 ? 2 : 1); ++pa_)
      {
      typedef unsigned u32x2r __attribute__((ext_vector_type(2)));
      u32x2r na[4], nb[4];
      { const int tA = tok0 + (wave < ntok ? wave : 0), tB = (wave + NWAVES < ntok) ? tA + NWAVES : tA;
        const GAS u32x2r* xa = (const GAS u32x2r*)(H1B + (size_t)tA * DM) + lane; const GAS u32x2r* xb = (const GAS u32x2r*)(H1B + (size_t)tB * DM) + lane;
#pragma unroll
        for (int j = 0; j < 4; ++j) { na[j] = xa[64 * j]; nb[j] = xb[64 * j]; } }
      for (int tt = wave; tt < ntok; tt += 2 * NWAVES) { const int tokA = tok0 + tt; const bool hasB = tt + NWAVES < ntok; const int tokB = hasB ? tokA + NWAVES : tokA;
          f32x4 ha[4], hb[4];
#pragma unroll
          for (int j = 0; j < 4; ++j) { ha[j] = (f32x4){__builtin_bit_cast(float, na[j].x << 16), __builtin_bit_cast(float, na[j].x & 0xffff0000u), __builtin_bit_cast(float, na[j].y << 16), __builtin_bit_cast(float, na[j].y & 0xffff0000u)};
              hb[j] = (f32x4){__builtin_bit_cast(float, nb[j].x << 16), __builtin_bit_cast(float, nb[j].x & 0xffff0000u), __builtin_bit_cast(float, nb[j].y << 16), __builtin_bit_cast(float, nb[j].y & 0xffff0000u)}; }
          if (tt + 2 * NWAVES < ntok) { const int tA = tokA + 2 * NWAVES, tB = (tt + 3 * NWAVES < ntok) ? tA + NWAVES : tA;
              const GAS u32x2r* xa = (const GAS u32x2r*)(H1B + (size_t)tA * DM) + lane; const GAS u32x2r* xb = (const GAS u32x2r*)(H1B + (size_t)tB * DM) + lane;
#pragma unroll
              for (int j = 0; j < 4; ++j) { na[j] = xa[64 * j]; nb[j] = xb[64 * j]; } }
          float va[32], vb[32];
#pragma unroll
          for (int c = 0; c < 32; ++c) { va[c] = 0.f; vb[c] = 0.f; }
#pragma unroll
          for (int m = 0; m < 16; ++m) { const float a_ = ha[m >> 2][m & 3], b_ = hb[m >> 2][m & 3]; va[20] += a_ * a_; vb[20] += b_ * b_; const LAS f32x4* wp = (const LAS f32x4*)(WR + (64 * m + lane) * 20);
#pragma unroll
              for (int q = 0; q < 5; ++q) { const f32x4 w = wp[q];
                  va[4 * q] += a_ * w[0]; va[4 * q + 1] += a_ * w[1]; va[4 * q + 2] += a_ * w[2]; va[4 * q + 3] += a_ * w[3];
                  vb[4 * q] += b_ * w[0]; vb[4 * q + 1] += b_ * w[1]; vb[4 * q + 2] += b_ * w[2]; vb[4 * q + 3] += b_ * w[3]; } }
#define RT_BFLY(v) do { \
          _Pragma("unroll") for (int c = 0; c < 16; ++c) { const bool hi = lane & 32; const float keep = hi ? v[c + 16] : v[c], send = hi ? v[c] : v[c + 16]; v[c] = keep + lx::x32f(send, hi); } \
          _Pragma("unroll") for (int c = 0; c < 8; ++c) { const bool hi = lane & 16; const float keep = hi ? v[c + 8] : v[c], send = hi ? v[c] : v[c + 8]; v[c] = keep + lx::xf<16>(send); } \
          _Pragma("unroll") for (int c = 0; c < 4; ++c) { const bool hi = lane & 8; const float keep = hi ? v[c + 4] : v[c], send = hi ? v[c] : v[c + 4]; v[c] = keep + lx::xf<8>(send); } \
          _Pragma("unroll") for (int c = 0; c < 2; ++c) { const bool hi = lane & 4; const float keep = hi ? v[c + 2] : v[c], send = hi ? v[c] : v[c + 2]; v[c] = keep + lx::xf<4>(send); } \
          { const bool hi = lane & 2; const float keep = hi ? v[1] : v[0], send = hi ? v[0] : v[1]; v[0] = keep + lx::xf<2>(send); } \
          v[0] += lx::xf<1>(v[0]); } while (0)
          RT_BFLY(va); RT_BFLY(vb);
#undef RT_BFLY
          if (!(lane & 1) && (lane >> 1) < 21) { RS[(tt >> 3) * 24 + (lane >> 1)] = va[0]; if (hasB) RS[((tt >> 3) + 1) * 24 + (lane >> 1)] = vb[0]; }
      }
      }
      asm volatile("s_waitcnt lgkmcnt(0)" ::: "memory");
      { const int tt = wave + NWAVES * lane; const bool have = lane < 16 && tt < ntok; const int tok = tok0 + (have ? tt : 0);
          float s[21];
#pragma unroll
          for (int c = 0; c < 21; ++c) s[c] = RS[(lane & 15) * 24 + c];
          const float rstd = 1.0f / sqrtf(s[20] * (1.f / 1024.f) + 1e-6f);
          float gl[4], el[16];
#pragma unroll
          for (int c = 0; c < 4; ++c) gl[c] = s[c] * rstd + b_group[c];
#pragma unroll
          for (int e = 0; e < 16; ++e) el[e] = s[4 + e] * rstd + b_router[e];
          int gs = 0; float gm = gl[0];
#pragma unroll
          for (int c = 1; c < 4; ++c) if (gl[c] > gm) { gm = gl[c]; gs = c; }
          float gsum = 0.f;
#pragma unroll
          for (int c = 0; c < 4; ++c) gsum += expf(gl[c] - gm);
          const float gprob = 1.0f / gsum;
          float il[4] = {0.f, 0.f, 0.f, 0.f};
#pragma unroll
          for (int c = 0; c < 4; ++c)
#pragma unroll
              for (int e = 0; e < 4; ++e) if (gs == c) il[e] = el[c * 4 + e];
          float im = fmaxf(fmaxf(il[0], il[1]), fmaxf(il[2], il[3])); float ipr[4], isum = 0.f;
#pragma unroll
          for (int e = 0; e < 4; ++e) { ipr[e] = expf(il[e] - im); isum += ipr[e]; }
#pragma unroll
          for (int e = 0; e < 4; ++e) ipr[e] /= isum;
          int i0 = 0; float v0 = ipr[0];
#pragma unroll
          for (int e = 1; e < 4; ++e) if (ipr[e] > v0) { v0 = ipr[e]; i0 = e; }
          int i1 = -1; float v1 = -1.f;
#pragma unroll
          for (int e = 0; e < 4; ++e) if (e != i0 && ipr[e] > v1) { v1 = ipr[e]; i1 = e; }
          const float den = v0 + v1;
          if (have) { const int e0 = gs * 4 + i0, e1 = gs * 4 + i1; EIDB[tok * 2] = e0; EIDB[tok * 2 + 1] = e1; CWB[tok * 2] = gprob * (v0 / den); CWB[tok * 2 + 1] = gprob * (v1 / den); RSTD2[tok] = rstd;
              atomicAdd((int*)&LCNT[e0], 1); atomicAdd((int*)&LCNT[e1], 1); }
      }
      __syncthreads();
      if (tid < 16) LC[(int)blockIdx.x * 16 + tid] = LCNT[tid];
    }
    }
    xcd_barrier(bar); if (PROBE_DUP == 60) xcd_barrier(bar);
    {   PHASE_PTRS();
    REP(9)
    { PHASE_IDS();
      LAS int* L = (LAS int*)(ldsp + RING_OFF); LAS int* TOT = L + 1024 * 16; LAS int* MINE = TOT + 16; LAS int* BASE = MINE + 16; LAS int* ME = BASE + 32; LAS int* MPOS = ME + 2 * 512;
      for (int i = tid; i < NG * 16; i += NTHREADS) L[i] = LC[i];
      for (int i = tid; i < 2 * ntok; i += NTHREADS) ME[i] = EIDB[tok0 * 2 + i];
      __syncthreads();
      for (int e = wave; e < 16; e += NWAVES) {
          int tot = 0, mine = 0; for (int w = lane; w < NG; w += 64) { const int c = L[w * 16 + e]; tot += c; if (w < (int)blockIdx.x) mine += c; }
          tot = (int)lx::sum64((float)tot); mine = (int)lx::sum64((float)mine);
          if (lane == 0) { TOT[e] = tot; MINE[e] = mine; } }
      __syncthreads();
      if (tid == 0) { int base = 0; for (int e = 0; e < 16; ++e) { BASE[e] = base; base += (TOT[e] + 255) / 256 * 256; } BASE[16] = base; }
      __syncthreads();
      if (blockIdx.x == 0) { const int nt = BASE[16] / 256; for (int pm = tid; pm < nt; pm += NTHREADS) { int e = 0; for (int q = 1; q < 16; ++q) if (BASE[q] <= pm * 256) e = q; TILE_E[pm] = e; } if (tid == 0) NTILES[0] = nt; }
      for (int e = wave; e < 16; e += NWAVES) { int pos = BASE[e] + MINE[e];
          for (int i0 = 0; i0 < 2 * ntok; i0 += 64) { const int i = i0 + lane; const bool mine_ = i < 2 * ntok && ME[i] == e; const unsigned long long bm = __ballot(mine_);
              if (mine_) MPOS[i] = pos + __builtin_popcountll(bm & ((1ull << lane) - 1ull)); pos += __builtin_popcountll(bm); } }
      __syncthreads();
      for (int i = tid; i < 2 * ntok; i += NTHREADS) { POS[tok0 * 2 + i] = MPOS[i]; ROWIDX[MPOS[i]] = tok0 + (i >> 1); RSS[MPOS[i]] = RSTD2[tok0 + (i >> 1)]; }
      if (blockIdx.x == 0) for (int e = wave; e < 16; e += NWAVES) for (int s = BASE[e] + TOT[e] + lane; s < BASE[e + 1]; s += 64) { ROWIDX[s] = 0; RSS[s] = 0.f; }
    }
    }
    xcd_barrier(bar); if (PROBE_DUP == 60) xcd_barrier(bar);
    {   PHASE_PTRS();
    REP(10)
    { const int NT = __builtin_amdgcn_readfirstlane(__hip_atomic_load(NTILES, __ATOMIC_RELAXED, __HIP_MEMORY_SCOPE_AGENT));
      pg8::Gemm g{H1B, WGU_T, NT * 256, DM, DM, (size_t)1024 * 1024 * 2, ROWIDX}; pg8::GroupOrder S; S.init(NT, 4, NG, (int)blockIdx.x, TILE_E);
      pg8::EpiSwiGlu E{HIDB, RSS};
      pg8::gemm_phase<pg8::EpiSwiGlu, pg8::GroupOrder, true, true, true>(ldsp + RING_OFF, g, S, E); }
    }
    xcd_barrier(bar); if (PROBE_DUP == 60) xcd_barrier(bar);
    {   PHASE_PTRS();
    REP(11)
    { const int NT = __builtin_amdgcn_readfirstlane(__hip_atomic_load(NTILES, __ATOMIC_RELAXED, __HIP_MEMORY_SCOPE_AGENT));
      pg8::Gemm g{HIDB, WD_T, NT * 256, DM, 512, (size_t)1024 * 512 * 2}; pg8::GroupOrder S; S.init(NT, 4, NG, (int)blockIdx.x, TILE_E);
      pg8::EpiBf16Plain E{YB, DM};
      pg8::gemm_phase<pg8::EpiBf16Plain, pg8::GroupOrder, true, true>(ldsp + RING_OFF, g, S, E); }
    REP(13)
    { pg8::Gemm g{PB, WPP_T, T_, DM, 256, 0}; pg8::StaticOrder S; S.init(T_, DM, NG, (int)blockIdx.x);
      pg8::EpiBf16Plain E{PPB, DM};
      pg8::gemm_phase<pg8::EpiBf16Plain, pg8::StaticOrder, true, true>(ldsp + RING_OFF, g, S, E); }
    }
    xcd_barrier(bar); if (PROBE_DUP == 60) xcd_barrier(bar);
    {   PHASE_PTRS();
    for (int rep_ = 0; rep_ < (PROBE_DUP == 12 ? 2 : 1); ++rep_)
    { PHASE_IDS(); const int gw = vcu * NWAVES + wave, NGW = NG * NWAVES; const float wsc = rep_ ? 0.f : 1.f;
      typedef unsigned u32x2v __attribute__((ext_vector_type(2))); typedef int i32x2v __attribute__((ext_vector_type(2))); typedef float f32x2v __attribute__((ext_vector_type(2)));
      i32x2v npA, npB; f32x2v nwA, nwB;
      { const int mA = gw < T_ ? gw : 0, mB = gw + NGW < T_ ? gw + NGW : mA; npA = ((const GAS i32x2v*)POS)[mA]; npB = ((const GAS i32x2v*)POS)[mB]; nwA = ((const GAS f32x2v*)CWB)[mA]; nwB = ((const GAS f32x2v*)CWB)[mB]; }
      for (int m = gw; m < T_; m += 2 * NGW) { const bool hasB = m + NGW < T_; const int mA = m, mB = hasB ? m + NGW : m;
          const i32x2v pA = npA, pB = npB; const f32x2v wA = nwA * wsc, wB = nwB * wsc;
          const GAS u32x2v* xa = (const GAS u32x2v*)(H1B + (size_t)mA * DM) + lane; const GAS u32x2v* xb = (const GAS u32x2v*)(H1B + (size_t)mB * DM) + lane;
          const GAS u32x2v* ya0 = (const GAS u32x2v*)(YB + (size_t)pA.x * DM) + lane; const GAS u32x2v* ya1 = (const GAS u32x2v*)(YB + (size_t)pA.y * DM) + lane;
          const GAS u32x2v* yb0 = (const GAS u32x2v*)(YB + (size_t)pB.x * DM) + lane; const GAS u32x2v* yb1 = (const GAS u32x2v*)(YB + (size_t)pB.y * DM) + lane;
          f32x4 va[4], vb[4]; u32x2v ha_[4], hb_[4], a0[4], a1[4], b0[4], b1[4];
#pragma unroll
          for (int j = 0; j < 4; ++j) { ha_[j] = xa[64 * j]; hb_[j] = xb[64 * j]; a0[j] = ya0[64 * j]; a1[j] = ya1[64 * j]; b0[j] = yb0[64 * j]; b1[j] = yb1[64 * j]; }
          if (m + 2 * NGW < T_) { const int nA = m + 2 * NGW, nB = m + 3 * NGW < T_ ? m + 3 * NGW : nA; npA = ((const GAS i32x2v*)POS)[nA]; npB = ((const GAS i32x2v*)POS)[nB]; nwA = ((const GAS f32x2v*)CWB)[nA]; nwB = ((const GAS f32x2v*)CWB)[nB]; }
          float sa = 0.f, sb = 0.f;
#define CB_ADD(V_, Y0_, Y1_, W_) do { V_[0] += W_[0] * __builtin_bit_cast(float, Y0_[0] << 16) + W_[1] * __builtin_bit_cast(float, Y1_[0] << 16); V_[1] += W_[0] * __builtin_bit_cast(float, Y0_[0] & 0xffff0000u) + W_[1] * __builtin_bit_cast(float, Y1_[0] & 0xffff0000u); \
              V_[2] += W_[0] * __builtin_bit_cast(float, Y0_[1] << 16) + W_[1] * __builtin_bit_cast(float, Y1_[1] << 16); V_[3] += W_[0] * __builtin_bit_cast(float, Y0_[1] & 0xffff0000u) + W_[1] * __builtin_bit_cast(float, Y1_[1] & 0xffff0000u); } while (0)
#pragma unroll
          for (int j = 0; j < 4; ++j) { va[j] = (f32x4){__builtin_bit_cast(float, ha_[j].x << 16), __builtin_bit_cast(float, ha_[j].x & 0xffff0000u), __builtin_bit_cast(float, ha_[j].y << 16), __builtin_bit_cast(float, ha_[j].y & 0xffff0000u)};
              vb[j] = (f32x4){__builtin_bit_cast(float, hb_[j].x << 16), __builtin_bit_cast(float, hb_[j].x & 0xffff0000u), __builtin_bit_cast(float, hb_[j].y << 16), __builtin_bit_cast(float, hb_[j].y & 0xffff0000u)};
              CB_ADD(va[j], a0[j], a1[j], wA); CB_ADD(vb[j], b0[j], b1[j], wB);
              sa += (va[j].x * va[j].x + va[j].y * va[j].y) + (va[j].z * va[j].z + va[j].w * va[j].w); sb += (vb[j].x * vb[j].x + vb[j].y * vb[j].y) + (vb[j].z * vb[j].z + vb[j].w * vb[j].w); }
#undef CB_ADD
          const float ra = 1.f / sqrtf(wave_sum(sa) * (1.f / 1024.f) + 1e-6f), rb = 1.f / sqrtf(wave_sum(sb) * (1.f / 1024.f) + 1e-6f);
          GAS unsigned long long* oa = (GAS unsigned long long*)(VPLE + (size_t)mA * DM) + lane; GAS unsigned long long* ob = (GAS unsigned long long*)(VPLE + (size_t)mB * DM) + lane;
#pragma unroll
          for (int j = 0; j < 4; ++j) {
              oa[64 * j] = (unsigned long long)pk2(va[j].x, va[j].y) | ((unsigned long long)pk2(va[j].z, va[j].w) << 32);
              if (hasB) ob[64 * j] = (unsigned long long)pk2(vb[j].x, vb[j].y) | ((unsigned long long)pk2(vb[j].z, vb[j].w) << 32); }
          if (lane == 0) { RA[mA] = ra; if (hasB) RA[mB] = rb; }
      } }
    }
    xcd_barrier(bar); if (PROBE_DUP == 60) xcd_barrier(bar);
    {   PHASE_PTRS();
    if (NG == 256 && T_ == 32768) {
      pg8::Gemm g{VPLE, WPG_T, T_, DM, DM, 0}; pg8::StaticOrder S; S.init(T_, DM, NG, (int)blockIdx.x);
      pg8::EpiPleGateNorm E{HB, VPLE, RA, PPB, b_ple, g_final, (float*)(ws + WS_XS), (unsigned*)(ws + WS_CTL) + CW_PANEL, ldsp + RING_BYTES, DM};
      pg8::gemm_phase<pg8::EpiPleGateNorm, pg8::StaticOrder, true, true>(ldsp + RING_OFF, g, S, E);
    } else {
    { pg8::Gemm g{VPLE, WPG_T, T_, DM, DM, 0}; pg8::StaticOrder S; S.init(T_, DM, NG, (int)blockIdx.x);
      pg8::EpiPleGate E{HB, VPLE, RA, PPB, b_ple, DM};
      pg8::gemm_phase<pg8::EpiPleGate, pg8::StaticOrder, true, true>(ldsp + RING_OFF, g, S, E); }
      xcd_barrier(bar);
    { PHASE_IDS(); const int gw = vcu * NWAVES + wave, NGW = NG * NWAVES;
      for (int m = gw; m < T_; m += NGW) {
          GAS f32x4* xr = (GAS f32x4*)(HB + (size_t)m * DM) + lane; f32x4 v[4]; float s = 0.f;
#pragma unroll
          for (int j = 0; j < 4; ++j) { v[j] = xr[64 * j]; s += (v[j].x * v[j].x + v[j].y * v[j].y) + (v[j].z * v[j].z + v[j].w * v[j].w); }
          const float r = 1.f / sqrtf(wave_sum(s) * (1.f / 1024.f) + 1e-6f);
#pragma unroll
          for (int j = 0; j < 4; ++j) { const f32x4 g = ((const GAS f32x4*)g_final)[lane + 64 * j]; xr[64 * j] = (f32x4){v[j].x * r * g.x, v[j].y * r * g.y, v[j].z * r * g.z, v[j].w * r * g.w}; }
      } }
    }
    }
}
}
extern "C" void kernel_launch(void* const* d_in, const int* in_sizes, int n_in, void* d_out, int out_size, void* d_ws, size_t ws_size, hipStream_t stream) {
    static int grid = 0;
    if (grid == 0) {
        int dev = 0, cus = 0;
        if (n_in != 29 || ws_size < ((size_t)512 << 20)) { fprintf(stderr, "kernel_launch: unexpected n_in %d or ws_size %zu\n", n_in, ws_size); grid = -1; return; }
        if (hipGetDevice(&dev) != hipSuccess || hipDeviceGetAttribute(&cus, hipDeviceAttributeMultiprocessorCount, dev) != hipSuccess) { grid = -1; return; }
        if (hipFuncSetAttribute((const void*)mk::mk_fwd, hipFuncAttributeMaxDynamicSharedMemorySize, mk::LDS_BYTES) != hipSuccess) { fprintf(stderr, "kernel_launch: hipFuncSetAttribute failed\n"); grid = -1; return; }
        int per_cu = 0;
        if (hipOccupancyMaxActiveBlocksPerMultiprocessor(&per_cu, (const void*)mk::mk_fwd, mk::NTHREADS, mk::LDS_BYTES) != hipSuccess || per_cu < 1) { fprintf(stderr, "kernel_launch: occupancy query says %d\n", per_cu); }
        (void)hipGetLastError();
        grid = cus;
    }
    if (grid < 0) return;
    (void)hipMemsetAsync((char*)d_ws + mk::WS_CTL, 0, mk::CTL_ZERO_BYTES, stream);
    mk::Args a{};
    for (int i = 0; i < 29; ++i) a.in[i] = d_in[i];
    a.out = d_out; a.ws = d_ws;
    hipLaunchKernelGGL(mk::mk_fwd, dim3(grid), dim3(mk::NTHREADS), mk::LDS_BYTES, stream, a);
}
```
